# Optimizing an MI355X kernel written in HIP

```python
import jax, jax.numpy as jnp
from jax import lax
import numpy as np

D_MODEL = 2048
BATCH = 4
SEQ = 4096
DEPTH = 1

CHUNK = 64
LRU_WIDTH = 1024
LRU_BLOCKS = 16
LRU_BLOCK_W = LRU_WIDTH // LRU_BLOCKS
CONV_WIDTH = 4
RG_C = 8.0
RWKV_WIDTH = D_MODEL - LRU_WIDTH
HEAD_SIZE = 64
RWKV_HEADS = RWKV_WIDTH // HEAD_SIZE
DECAY_LORA = 96
AAA_LORA = 96
GATE_LORA = 256
RWKV_SHIFT_W = 3 * RWKV_WIDTH + DECAY_LORA + AAA_LORA + GATE_LORA
IN_PROJ_W = 2 * LRU_WIDTH + RWKV_SHIFT_W
N_EXPERTS = 32
TOP_K = 4
D_EXPERT = D_MODEL
SWIGLU_LIMIT = 7.0
SWIGLU_ALPHA = 1.702
MOE_BLOCK = 128
LN_EPS = 1e-5
GN_EPS = HEAD_SIZE * 1e-5
DEEPNORM_ALPHA = (2.0 * DEPTH) ** 0.25
DEEPNORM_BETA = (8.0 * DEPTH) ** -0.25

kernel_name = 'hybrid_rglru_rwkv7_moe_deepnorm'


def _layer_norm(x, g, b):
    xf = x.astype(jnp.float32)
    mu = jnp.mean(xf, axis=-1, keepdims=True)
    var = jnp.mean(jnp.square(xf - mu), axis=-1, keepdims=True)
    return ((xf - mu) * lax.rsqrt(var + LN_EPS) * g + b).astype(x.dtype)


def _rglru_branch(u, gate_in, conv_w, conv_b, w_rgate, b_rgate, w_igate, b_igate, lru_lambda):
    bsz, t, c = u.shape
    f32 = jnp.float32
    uc = lax.conv_general_dilated(u, conv_w[:, None, :], window_strides=(1,), padding=[(CONV_WIDTH - 1, 0)], dimension_numbers=('NWC', 'WIO', 'NWC'), feature_group_count=c) + conv_b
    ub = uc.reshape(bsz, t, LRU_BLOCKS, LRU_BLOCK_W)
    r_gate = jax.nn.sigmoid(jnp.einsum('btnj,njk->btnk', ub, w_rgate).reshape(bsz, t, c) + b_rgate)
    i_gate = jax.nn.sigmoid(jnp.einsum('btnj,njk->btnk', ub, w_igate).reshape(bsz, t, c) + b_igate)
    log_a = (-RG_C * r_gate.astype(f32)) * jax.nn.softplus(-lru_lambda.astype(f32))
    a = jnp.exp(log_a)
    b = jnp.sqrt(-jnp.expm1(2.0 * log_a)) * (i_gate * uc).astype(f32)

    def combine(lhs, rhs):
        a1, b1 = lhs
        a2, b2 = rhs
        return a1 * a2, a2 * b1 + b2

    _, h = lax.associative_scan(combine, (a, b), axis=1)
    return h.astype(u.dtype) * jax.nn.gelu(gate_in)


def _rwkv7_scan(r, w, k, v, kk, a):
    bsz, t, h, n = r.shape
    n_chunks = t // CHUNK

    def to_chunks(z):
        return z.transpose(1, 0, 2, 3).reshape(n_chunks, CHUNK, bsz, h, n)

    def step(s, inp):
        r_t, w_t, k_t, v_t, kk_t, a_t = inp
        s_kk = jnp.einsum('bhvk,bhk->bhv', s, kk_t)
        s = s * w_t[:, :, None, :] - s_kk[..., None] * (kk_t * a_t)[:, :, None, :] + v_t[..., None] * k_t[:, :, None, :]
        return s, jnp.einsum('bhvk,bhk->bhv', s, r_t)

    def chunk_step(s, inp_c):
        return lax.scan(step, s, inp_c)

    s0 = jnp.zeros((bsz, h, n, n), jnp.float32)
    _, y = lax.scan(chunk_step, s0, tuple(to_chunks(z) for z in (r, w, k, v, kk, a)))
    return y.reshape(t, bsz, h, n).transpose(1, 0, 2, 3)


def _rwkv7_branch(p, shift_mu, w0, rw_decay_up, a0, rw_aaa_up, rw_gate_up, k_k, k_a, r_k, gn_g, gn_b):
    bsz, t, _ = p.shape
    f32 = jnp.float32
    p_prev = jnp.pad(p, ((0, 0), (1, 0), (0, 0)))[:, :-1]
    p = p + (p_prev - p) * shift_mu
    splits = [RWKV_WIDTH, 2 * RWKV_WIDTH, 3 * RWKV_WIDTH, 3 * RWKV_WIDTH + DECAY_LORA, 3 * RWKV_WIDTH + DECAY_LORA + AAA_LORA]
    r, k, v, wd, ad, gd = jnp.split(p, splits, axis=-1)
    w_log = -jax.nn.softplus(-(w0 + jnp.tanh(wd) @ rw_decay_up).astype(f32)) - 0.5
    decay = jnp.exp(-jnp.exp(w_log))
    a = jax.nn.sigmoid((a0 + ad @ rw_aaa_up).astype(f32))
    g = (jax.nn.sigmoid(gd) @ rw_gate_up).astype(f32)

    def heads(z):
        return z.reshape(bsz, t, RWKV_HEADS, HEAD_SIZE)

    kk = heads((k * k_k).astype(f32))
    kk = kk / jnp.maximum(jnp.linalg.norm(kk, axis=-1, keepdims=True), 1e-12)
    k = k.astype(f32) * (1.0 + (a - 1.0) * k_a.astype(f32))
    r_h, k_h, v_h = heads(r.astype(f32)), heads(k), heads(v.astype(f32))
    y = _rwkv7_scan(r_h, heads(decay), k_h, v_h, kk, heads(a))
    mu = jnp.mean(y, axis=-1, keepdims=True)
    var = jnp.mean(jnp.square(y - mu), axis=-1, keepdims=True)
    y = (y - mu) * lax.rsqrt(var + GN_EPS) * gn_g.reshape(RWKV_HEADS, HEAD_SIZE) + gn_b.reshape(RWKV_HEADS, HEAD_SIZE)
    y = y + jnp.sum(r_h * k_h * r_k, axis=-1, keepdims=True) * v_h
    return (y.reshape(bsz, t, RWKV_WIDTH) * g).astype(p.dtype)


def _clamped_swiglu(h):
    gate, up = jnp.split(h, 2, axis=-1)
    gate = jnp.minimum(gate, SWIGLU_LIMIT)
    up = jnp.clip(up, -SWIGLU_LIMIT, SWIGLU_LIMIT)
    return gate * jax.nn.sigmoid(SWIGLU_ALPHA * gate) * (up + 1.0)


def _moe(x2, w_router, b_router, w_exp1, b_exp1, w_exp2, b_exp2):
    n = x2.shape[0]
    logits = (x2 @ w_router + b_router).astype(jnp.float32)
    top_v, top_i = lax.top_k(logits, TOP_K)
    gates = jax.nn.softmax(top_v, axis=-1).astype(x2.dtype)
    flat_e = top_i.reshape(-1)
    flat_g = gates.reshape(-1)
    order = jnp.argsort(flat_e)
    sorted_e = flat_e[order]
    sorted_tok = (order // TOP_K).astype(jnp.int32)
    counts = jnp.bincount(flat_e, length=N_EXPERTS)
    padded = ((counts + MOE_BLOCK - 1) // MOE_BLOCK) * MOE_BLOCK
    pad_end = jnp.cumsum(padded)
    pad_start = pad_end - padded
    grp_start = jnp.cumsum(counts) - counts
    dest = pad_start[sorted_e] + (jnp.arange(n * TOP_K) - grp_start[sorted_e])
    n_slots = ((n * TOP_K + MOE_BLOCK - 1) // MOE_BLOCK + N_EXPERTS) * MOE_BLOCK
    n_blocks = n_slots // MOE_BLOCK
    slot_tok = jnp.zeros((n_slots,), jnp.int32).at[dest].set(sorted_tok)
    slot_gate = jnp.zeros((n_slots,), x2.dtype).at[dest].set(flat_g[order])
    blk_e = jnp.minimum(jnp.searchsorted(pad_end, jnp.arange(n_blocks) * MOE_BLOCK, side='right'), N_EXPERTS - 1)

    def expert_block(y, blk):
        tok, gate, e = blk
        h = x2[tok] @ w_exp1[e] + b_exp1[e]
        out = _clamped_swiglu(h) @ w_exp2[e] + b_exp2[e]
        return y.at[tok].add(out * gate[:, None]), None

    y, _ = lax.scan(expert_block, jnp.zeros_like(x2), (slot_tok.reshape(n_blocks, MOE_BLOCK), slot_gate.reshape(n_blocks, MOE_BLOCK), blk_e))
    return y


def setup_inputs(seed: int = 0) -> dict:
    key = jax.random.key(seed)
    ks = iter(jax.random.split(key, 40))
    f32 = jnp.float32
    L = DEPTH

    def nrm(shape, scale):
        return jax.random.normal(next(ks), shape, f32) * scale

    def unif(shape, lo, hi):
        return jax.random.uniform(next(ks), shape, f32, lo, hi)

    a_init = unif((L, LRU_WIDTH), 0.9, 0.999)
    return {
        'x': nrm((BATCH, SEQ, D_MODEL), 1.0),
        'ln_in_g': 1.0 + nrm((D_MODEL,), 0.02),
        'ln_in_b': nrm((D_MODEL,), 0.02),
        'w_in': nrm((L, D_MODEL, IN_PROJ_W), D_MODEL ** -0.5),
        'conv_w': nrm((L, CONV_WIDTH, LRU_WIDTH), CONV_WIDTH ** -0.5),
        'conv_b': nrm((L, LRU_WIDTH), 0.01),
        'w_rgate': nrm((L, LRU_BLOCKS, LRU_BLOCK_W, LRU_BLOCK_W), LRU_BLOCK_W ** -0.5),
        'b_rgate': nrm((L, LRU_WIDTH), 0.01),
        'w_igate': nrm((L, LRU_BLOCKS, LRU_BLOCK_W, LRU_BLOCK_W), LRU_BLOCK_W ** -0.5),
        'b_igate': nrm((L, LRU_WIDTH), 0.01),
        'lru_lambda': jnp.log(a_init) - jnp.log1p(-a_init),
        'shift_mu': unif((L, RWKV_SHIFT_W), 0.0, 1.0),
        'w0': unif((L, RWKV_WIDTH), -6.0, 1.0),
        'rw_decay_up': nrm((L, DECAY_LORA, RWKV_WIDTH), 0.1 * DECAY_LORA ** -0.5),
        'a0': nrm((L, RWKV_WIDTH), 0.1),
        'rw_aaa_up': nrm((L, AAA_LORA, RWKV_WIDTH), 0.1 * AAA_LORA ** -0.5),
        'rw_gate_up': nrm((L, GATE_LORA, RWKV_WIDTH), GATE_LORA ** -0.5),
        'k_k': 0.85 + nrm((L, RWKV_WIDTH), 0.02),
        'k_a': 1.0 + nrm((L, RWKV_WIDTH), 0.02),
        'r_k': nrm((L, RWKV_HEADS, HEAD_SIZE), 0.1),
        'gn_g': 1.0 + nrm((L, RWKV_WIDTH), 0.02),
        'gn_b': nrm((L, RWKV_WIDTH), 0.02),
        'w_out': nrm((L, D_MODEL, D_MODEL), DEEPNORM_BETA * D_MODEL ** -0.5),
        'ln1_g': 1.0 + nrm((L, D_MODEL), 0.02),
        'ln1_b': nrm((L, D_MODEL), 0.02),
        'w_router': nrm((L, D_MODEL, N_EXPERTS), D_MODEL ** -0.5),
        'b_router': nrm((L, N_EXPERTS), 0.01),
        'w_exp1': nrm((L, N_EXPERTS, D_MODEL, 2 * D_EXPERT), D_MODEL ** -0.5),
        'b_exp1': nrm((L, N_EXPERTS, 2 * D_EXPERT), 0.01),
        'w_exp2': nrm((L, N_EXPERTS, D_EXPERT, D_MODEL), DEEPNORM_BETA * D_EXPERT ** -0.5),
        'b_exp2': nrm((L, N_EXPERTS, D_MODEL), 0.01),
        'ln2_g': 1.0 + nrm((L, D_MODEL), 0.02),
        'ln2_b': nrm((L, D_MODEL), 0.02),
    }


def reference(x, ln_in_g, ln_in_b, w_in, conv_w, conv_b, w_rgate, b_rgate, w_igate, b_igate, lru_lambda, shift_mu, w0, rw_decay_up, a0, rw_aaa_up, rw_gate_up, k_k, k_a, r_k, gn_g, gn_b, w_out, ln1_g, ln1_b, w_router, b_router, w_exp1, b_exp1, w_exp2, b_exp2, ln2_g, ln2_b):
    bsz, t, d = x.shape
    h = _layer_norm(x, ln_in_g, ln_in_b)
    for l in range(DEPTH):
        p = h @ w_in[l]
        lru_u, lru_gate, rw = jnp.split(p, [LRU_WIDTH, 2 * LRU_WIDTH], axis=-1)
        y_lru = _rglru_branch(lru_u, lru_gate, conv_w[l], conv_b[l], w_rgate[l], b_rgate[l], w_igate[l], b_igate[l], lru_lambda[l])
        y_rw = _rwkv7_branch(rw, shift_mu[l], w0[l], rw_decay_up[l], a0[l], rw_aaa_up[l], rw_gate_up[l], k_k[l], k_a[l], r_k[l], gn_g[l], gn_b[l])
        mix = jnp.concatenate([y_lru, y_rw], axis=-1) @ w_out[l]
        h = _layer_norm(DEEPNORM_ALPHA * h + mix, ln1_g[l], ln1_b[l])
        moe = _moe(h.reshape(bsz * t, d), w_router[l], b_router[l], w_exp1[l], b_exp1[l], w_exp2[l], b_exp2[l]).reshape(bsz, t, d)
        h = _layer_norm(DEEPNORM_ALPHA * h + moe, ln2_g[l], ln2_b[l])
    return h
```

```cpp
#include <hip/hip_runtime.h>
#include <cstdio>
#include <cstdint>

#define LAS __attribute__((address_space(3)))
#define GAS __attribute__((address_space(1)))
typedef unsigned short bf16_t;
typedef short bf16x8 __attribute__((ext_vector_type(8)));
typedef float f32x4 __attribute__((ext_vector_type(4)));
typedef float f32x2 __attribute__((ext_vector_type(2)));
typedef unsigned u32x4 __attribute__((ext_vector_type(4)));
typedef unsigned u32x2 __attribute__((ext_vector_type(2)));

constexpr int BATCH = 4, SEQ = 4096, M = BATCH * SEQ, D = 2048;
constexpr int LRU_W = 1024, RW_W = 1024, NHEAD = 16, HS = 64;
constexpr int DLORA = 96, ALORA = 96, GLORA = 256;
constexpr int RW_SHIFT_W = 3 * RW_W + DLORA + ALORA + GLORA;
constexpr int NP = 2 * LRU_W + RW_SHIFT_W;
constexpr int NPP = 5632;
constexpr int NE = 32, TOPK = 4, DE = 2048;
constexpr int NSLOT_MAX = M * TOPK + NE * 256;
constexpr int NTILE_MAX = NSLOT_MAX / 256;
constexpr float LN_EPS = 1e-5f, GN_EPS = 64e-5f;
constexpr float DN_ALPHA = 1.189207115002721f;
constexpr int KD = 2048;

constexpr size_t MiB = 1u << 20;
constexpr size_t WS_CTL = 0, CTL_ZERO_BYTES = 1 * MiB;
constexpr size_t WS_WIN = 2 * MiB;
constexpr size_t WS_WO = WS_WIN + (size_t)NPP * KD * 2;
constexpr size_t WS_W1 = WS_WO + (size_t)D * KD * 2;
constexpr size_t WS_W2 = WS_W1 + (size_t)NE * 2 * DE * KD * 2;
constexpr size_t WS_XN = WS_W2 + (size_t)NE * D * DE * 2;
constexpr size_t WS_P = WS_XN + (size_t)M * D * 2;
constexpr size_t WS_LA = WS_P + (size_t)M * NPP * 2;
constexpr size_t WS_LB = WS_LA + (size_t)M * LRU_W * 4;
constexpr size_t WS_RR = WS_LB + (size_t)M * LRU_W * 4;
constexpr size_t WS_RWS = (size_t)M * RW_W * 4;
constexpr size_t WS_RY = WS_RR + 7 * WS_RWS;
constexpr size_t WS_BON = WS_RY + WS_RWS;
constexpr size_t WS_CAT = WS_BON + (size_t)M * NHEAD * 4;
constexpr size_t WS_Z = WS_CAT + (size_t)M * D * 2;
constexpr size_t WS_H1 = WS_Z + (size_t)M * D * 4;
constexpr size_t WS_H1B = WS_H1 + (size_t)M * D * 4;
constexpr size_t WS_TOPE = WS_H1B + (size_t)M * D * 2;
constexpr size_t WS_TOPP = WS_TOPE + (size_t)M * TOPK * 4;
constexpr size_t WS_TOPG = WS_TOPP + (size_t)M * TOPK * 4;
constexpr size_t WS_TOKSLOT = WS_TOPG + (size_t)M * TOPK * 4;
constexpr size_t WS_SLOTTOK = WS_TOKSLOT + (size_t)M * TOPK * 4;
constexpr size_t WS_SLOTG = WS_SLOTTOK + (size_t)NSLOT_MAX * 4;
constexpr size_t WS_ACT = WS_SLOTG + (size_t)NSLOT_MAX * 4;
constexpr size_t WS_OUTS = WS_ACT + (size_t)NSLOT_MAX * DE * 2;
constexpr size_t WS_END = WS_OUTS + (size_t)NSLOT_MAX * D * 2;
constexpr int CW_CNT = 1024;
constexpr int CW_BAR = 4096;

constexpr int RING_BYTES = 131072;
constexpr int MISC_OFF = RING_BYTES;
constexpr int LDS_BYTES = 147456;

#define RLX_AGENT __ATOMIC_RELAXED, __HIP_MEMORY_SCOPE_AGENT
__device__ __forceinline__ unsigned f2bf(float f) { unsigned u = __builtin_bit_cast(unsigned, f); return (u + 0x7fffu + ((u >> 16) & 1u)) >> 16; }
__device__ __forceinline__ unsigned pk2(float lo, float hi) { return f2bf(lo) | (f2bf(hi) << 16); }
__device__ __forceinline__ float bf2f(unsigned short b) { return __builtin_bit_cast(float, (unsigned)b << 16); }
__device__ __forceinline__ float bflo(unsigned w) { return __builtin_bit_cast(float, w << 16); }
__device__ __forceinline__ float bfhi(unsigned w) { return __builtin_bit_cast(float, w & 0xffff0000u); }
__device__ __forceinline__ float wave_sum(float v) {
#pragma unroll
    for (int o = 1; o < 64; o <<= 1) v += __shfl_xor(v, o);
    return v;
}
__device__ __forceinline__ float sigmoidf_(float x) { return 1.f / (1.f + __expf(-x)); }
__device__ __forceinline__ float gelu_tanh(float x) { const float u = 0.7978845608028654f * (x + 0.044715f * x * x * x); return 0.5f * x * (1.f + tanhf(u)); }

#define XB_TMO      128
#define XB_XCNT(j)  (256  + 64 * (j))
#define XB_XSUB(j)  (1280 + 64 * (j))
#define XB_XGEN(j)  (2304 + 64 * (j))
#define XB_TOP      3328
#define XB_TOPGEN   3392
#define XCD_BAR_WORDS 3456
#define XB_SPIN_CAP (1u << 18)
__device__ __forceinline__ unsigned xb_ld(unsigned* p)              { return __hip_atomic_load(p, __ATOMIC_RELAXED, __HIP_MEMORY_SCOPE_AGENT); }
__device__ __forceinline__ unsigned xb_add(unsigned* p, unsigned v) { return __hip_atomic_fetch_add(p, v, __ATOMIC_RELAXED, __HIP_MEMORY_SCOPE_AGENT); }
__device__ __forceinline__ unsigned xb_xcc_id() { return (unsigned)__builtin_amdgcn_s_getreg((3 << 11) | 20) & 0xFu; }
#define XB_SPIN(cond, bar) do { unsigned _sp = 0; while (cond) { __builtin_amdgcn_s_sleep(1); \
    if ((++_sp & 255u) == 0u) { if (xb_ld(&(bar)[XB_TMO])) break; if (_sp > XB_SPIN_CAP) { atomicAdd(&(bar)[XB_TMO], 1u); break; } } } } while (0)
struct XcdBarrier { unsigned* bar; unsigned x; volatile LAS unsigned* st; };
__device__ __forceinline__ XcdBarrier xcd_barrier_post(unsigned* bar, volatile LAS unsigned* st) {
    XcdBarrier b; b.bar = bar; b.x = xb_xcc_id(); b.st = st;
    if (threadIdx.x == 0) (void)xb_add(&bar[XB_XCNT(b.x)], 1u);
    return b;
}
__device__ __forceinline__ void xcd_barrier_complete(unsigned* bar, unsigned x, unsigned& nloc, unsigned& nx) {
    const unsigned G = gridDim.x * gridDim.y * gridDim.z;
    unsigned sum, cnt, mine, sp = 0u;
    for (;;) {
        sum = 0u; cnt = 0u; mine = 0u;
#pragma unroll
        for (unsigned j = 0; j < 16; ++j) { const unsigned c = xb_ld(&bar[XB_XCNT(j)]); sum += c; cnt += (c > 0u) ? 1u : 0u; mine = (j == x) ? c : mine; }
        if (sum == G) break;
        __builtin_amdgcn_s_sleep(1);
        if ((++sp & 255u) == 0u) { if (xb_ld(&bar[XB_TMO])) break; if (sp > XB_SPIN_CAP) { atomicAdd(&bar[XB_TMO], 1u); break; } }
    }
    nloc = mine > 0u ? mine : 1u; nx = cnt > 0u ? cnt : 1u;
}
__device__ __forceinline__ void xcd_barrier(const XcdBarrier& b) {
    asm volatile("s_waitcnt vmcnt(0)" ::: "memory");
    __syncthreads();
    if (threadIdx.x == 0) {
        unsigned* bar = b.bar;
        __builtin_amdgcn_s_waitcnt(0);
        unsigned nloc = b.st[0], nx = b.st[1];
        if (nloc == 0u) { xcd_barrier_complete(bar, b.x, nloc, nx); b.st[0] = nloc; b.st[1] = nx; }
        const unsigned old = xb_add(&bar[XB_XSUB(b.x)], 1u);
        const unsigned gen = old / nloc;
        if (old + 1u == (gen + 1u) * nloc) {
            __builtin_amdgcn_fence(__ATOMIC_RELEASE, "agent");
            asm volatile("s_waitcnt vmcnt(0)" ::: "memory");
            const unsigned og = xb_add(&bar[XB_TOP], 1u);
            const unsigned tg = og / nx;
            if (og + 1u == (tg + 1u) * nx) xb_add(&bar[XB_TOPGEN], 1u);
            else XB_SPIN(xb_ld(&bar[XB_TOPGEN]) == tg, bar);
            __builtin_amdgcn_fence(__ATOMIC_ACQUIRE, "agent");
            xb_add(&bar[XB_XGEN(b.x)], 1u);
            asm volatile("s_waitcnt vmcnt(0)" ::: "memory");
        } else {
            XB_SPIN(xb_ld(&bar[XB_XGEN(b.x)]) == gen, bar);
            __builtin_amdgcn_fence(__ATOMIC_ACQUIRE, "agent");
            asm volatile("s_waitcnt vmcnt(0)" ::: "memory");
        }
    }
    __syncthreads();
}

namespace pg8 {
constexpr int BM = 256, BK = 64, HALF = 128, HTB = HALF * BK * 2, STAGE_BYTES = 8 * HTB, NXCD = 8, WGM = 8;
__host__ __device__ __forceinline__ int lds_byte(int r, int c) { const int st = (r >> 4) * 2 + (c >> 5), rr = r & 15, cc = c & 31, ob = rr * 64 + cc * 2; return st * 1024 + (ob ^ (((ob >> 9) & 1) << 5)); }
__host__ __device__ __forceinline__ void stage_rc(int b, int& R, int& C) { const int st = b / 1024, sb = b % 1024, swz = sb ^ (((sb >> 9) & 1) << 5); R = (st >> 1) * 16 + swz / 64; C = (st & 1) * 32 + (swz % 64) / 2; }
__host__ __device__ __forceinline__ int perm32(int rho) { const int n = rho >> 4, i = rho & 15; return 8 * (i >> 2) + 4 * n + (i & 3); }
struct Unit { int pm, pn; };
__device__ __forceinline__ unsigned cvt_pk_bf16(float lo, float hi) { unsigned r; asm volatile("v_cvt_pk_bf16_f32 %0, %1, %2" : "=v"(r) : "v"(lo), "v"(hi)); return r; }

struct StaticOrder {
    int nM, nN, nwg, G, c;
    __device__ void init(int M_, int N_, int G_, int c_) { nM = M_ / BM; nN = N_ / BM; nwg = nM * nN; G = G_; c = c_; }
    __device__ bool next(int i, Unit& u) const {
        const long L = (long)i * G + c; if (L >= nwg) return false;
        int wgid = (int)L; { const int q = nwg / NXCD, r = nwg % NXCD, xcd = wgid % NXCD, off = wgid / NXCD; wgid = (xcd < r ? xcd * (q + 1) : r * (q + 1) + (xcd - r) * q) + off; }
        const int nig = WGM * nN, gid = wgid / nig, fm = gid * WGM, gsz = (nM - fm) < WGM ? (nM - fm) : WGM;
        u.pm = fm + ((wgid % nig) % gsz); u.pn = (wgid % nig) / gsz; return true;
    }
};
struct MoeOrder {
    const LAS int* tile_e; int R, NCT, G, c;
    __device__ bool next(int i, Unit& u) const {
        int rt, ct;
        if (G == 256) { const int x = c & 7, j = c >> 3;
            if (NCT == 16) { rt = 16 * i + (x >> 1) * 4 + (j >> 3); ct = (x & 1) * 8 + (j & 7); }
            else           { rt = 32 * i + 4 * x + (j >> 3); ct = j & 7; } }
        else { const long L = (long)i * G + c; rt = (int)(L / NCT); ct = (int)(L % NCT); }
        if (rt >= R) return false;
        u.pm = rt; u.pn = tile_e[rt] * NCT + ct; return true;
    }
};
struct DenseRows { __device__ __forceinline__ unsigned row(int pm, int r) const { return (unsigned)(pm * BM + r); } };
struct GatherRows { const int* idx; __device__ __forceinline__ unsigned row(int pm, int r) const { return (unsigned)idx[pm * BM + r]; } };

struct EpiBf16 {
    static constexpr bool PERM = true;
    bf16_t* O; int ldc;
    __device__ __forceinline__ void operator()(const f32x4 (&acc)[2][2][4][2], const Unit& u, int wr, int wc, int fr, int fq) const {
        const int row0 = u.pm * BM + wr * 64 + fr, col0 = u.pn * BM + wc * 32 + 8 * fq;
#pragma unroll
        for (int ai = 0; ai < 2; ++ai)
#pragma unroll
            for (int m = 0; m < 4; ++m) { bf16_t* rowp = O + (size_t)(row0 + ai * HALF + m * 16) * ldc + col0;
#pragma unroll
                for (int bj = 0; bj < 2; ++bj) { const f32x4 v0 = acc[ai][bj][m][0], v1 = acc[ai][bj][m][1];
                    u32x4 w; w.x = cvt_pk_bf16(v0[0], v0[1]); w.y = cvt_pk_bf16(v0[2], v0[3]); w.z = cvt_pk_bf16(v1[0], v1[1]); w.w = cvt_pk_bf16(v1[2], v1[3]);
                    *(u32x4*)(rowp + bj * HALF) = w; } }
    }
};
struct EpiResF32 {
    static constexpr bool PERM = false;
    float* Z; const bf16_t* R; float alpha;
    __device__ __forceinline__ void operator()(const f32x4 (&acc)[2][2][4][2], const Unit& u, int wr, int wc, int fr, int fq) const {
        const int row0 = u.pm * BM + wr * 64 + fr, col0 = u.pn * BM + wc * 32 + 4 * fq;
#pragma unroll
        for (int ai = 0; ai < 2; ++ai)
#pragma unroll
            for (int m = 0; m < 4; ++m) { const size_t off = (size_t)(row0 + ai * HALF + m * 16) * D + col0;
#pragma unroll
                for (int bj = 0; bj < 2; ++bj)
#pragma unroll
                    for (int n = 0; n < 2; ++n) { const u32x2 rb = *(const u32x2*)(R + off + bj * HALF + n * 16);
                        f32x4 o = acc[ai][bj][m][n]; o[0] += alpha * bflo(rb.x); o[1] += alpha * bfhi(rb.x); o[2] += alpha * bflo(rb.y); o[3] += alpha * bfhi(rb.y);
                        *(f32x4*)(Z + off + bj * HALF + n * 16) = o; } }
    }
};
struct EpiSwiglu {
    static constexpr bool PERM = true;
    bf16_t* O; const float* b1;
    __device__ __forceinline__ void operator()(const f32x4 (&acc)[2][2][4][2], const Unit& u, int wr, int wc, int fr, int fq) const {
        const int e = u.pn >> 4, ct = u.pn & 15;
        const int row0 = u.pm * BM + wr * 64 + fr, cin = wc * 32 + 8 * fq, col0 = ct * HALF + cin;
        const float* bg = b1 + (size_t)e * 2 * DE + col0; const float* bu = bg + DE;
        const f32x4 bg0 = *(const f32x4*)bg, bg1 = *(const f32x4*)(bg + 4), bu0 = *(const f32x4*)bu, bu1 = *(const f32x4*)(bu + 4);
#pragma unroll
        for (int ai = 0; ai < 2; ++ai)
#pragma unroll
            for (int m = 0; m < 4; ++m) { bf16_t* rowp = O + (size_t)(row0 + ai * HALF + m * 16) * DE + col0;
                float o[8];
#pragma unroll
                for (int n = 0; n < 2; ++n) { const f32x4 g4 = acc[ai][0][m][n] + (n ? bg1 : bg0), u4 = acc[ai][1][m][n] + (n ? bu1 : bu0);
#pragma unroll
                    for (int j = 0; j < 4; ++j) { const float g = fminf(g4[j], 7.f), up = fminf(fmaxf(u4[j], -7.f), 7.f);
                        o[n * 4 + j] = g * (up + 1.f) / (1.f + __expf(-1.702f * g)); } }
                u32x4 w; w.x = cvt_pk_bf16(o[0], o[1]); w.y = cvt_pk_bf16(o[2], o[3]); w.z = cvt_pk_bf16(o[4], o[5]); w.w = cvt_pk_bf16(o[6], o[7]);
                *(u32x4*)rowp = w; }
    }
};
struct EpiMoeOut {
    static constexpr bool PERM = true;
    bf16_t* O; const float* b2; const float* sg;
    __device__ __forceinline__ void operator()(const f32x4 (&acc)[2][2][4][2], const Unit& u, int wr, int wc, int fr, int fq) const {
        const int e = u.pn >> 3, ct = u.pn & 7;
        const int row0 = u.pm * BM + wr * 64 + fr, col0 = ct * BM + wc * 32 + 8 * fq;
        f32x4 bv[2][2];
#pragma unroll
        for (int bj = 0; bj < 2; ++bj)
#pragma unroll
            for (int n = 0; n < 2; ++n) bv[bj][n] = *(const f32x4*)(b2 + (size_t)e * D + col0 + bj * HALF + 4 * n);
#pragma unroll
        for (int ai = 0; ai < 2; ++ai)
#pragma unroll
            for (int m = 0; m < 4; ++m) { const int row = row0 + ai * HALF + m * 16; const float gt = sg[row]; bf16_t* rowp = O + (size_t)row * D + col0;
#pragma unroll
                for (int bj = 0; bj < 2; ++bj) { const f32x4 v0 = (acc[ai][bj][m][0] + bv[bj][0]) * gt, v1 = (acc[ai][bj][m][1] + bv[bj][1]) * gt;
                    u32x4 w; w.x = cvt_pk_bf16(v0[0], v0[1]); w.y = cvt_pk_bf16(v0[2], v0[3]); w.z = cvt_pk_bf16(v1[0], v1[1]); w.w = cvt_pk_bf16(v1[2], v1[3]);
                    *(u32x4*)(rowp + bj * HALF) = w; } }
    }
};

template <class Epi, class Sched, class ARows, bool ALIGN_EPI>
__device__ __forceinline__ void gemm_phase(LAS unsigned char* lds, const bf16_t* A, const bf16_t* Bt, const Sched& S, const Epi& E, const ARows& AR) {
    const int tid = threadIdx.x, wid = __builtin_amdgcn_readfirstlane(tid >> 6), lane = tid & 63, wr = wid >> 2, wc = wid & 3, fr = lane & 15, fq = lane >> 4;
    constexpr int K = KD, nt = K / BK;
    int sR[2], sC[2]; unsigned voffB[2];
#pragma unroll
    for (int i = 0; i < 2; ++i) { stage_rc(tid * 16 + i * 8192, sR[i], sC[i]); const int Rb = Epi::PERM ? ((sR[i] & ~31) + perm32(sR[i] & 31)) : sR[i];
        voffB[i] = (unsigned)(Rb * K + sC[i]) * 2u; }
    constexpr size_t kstep = (size_t)(BK * 2);
    constexpr size_t hstep = (size_t)HALF * K * 2;
    constexpr size_t tstep = 2 * hstep;
    const unsigned ldsw = (unsigned)wid * 1024u;
    const int aoff = lds_byte(wr * 64 + fr, fq * 8), boff = lds_byte(wc * 32 + fr, fq * 8);
#define PG8_SA(b, h) (((b) * 2 + (h)) * HTB)
#define PG8_SB(b, h) ((4 + (b) * 2 + (h)) * HTB)
#define PG8_STAGE(bufoff, gbase, voff) do { _Pragma("unroll") for (int _i = 0; _i < 2; ++_i) \
        __builtin_amdgcn_global_load_lds((const unsigned*)((const char*)(gbase) + (voff)[_i]), (LAS unsigned*)(lds + (bufoff) + ldsw + _i * 8192), 16, 0, 0); } while (0)
#define PG8_LDA(dst, b, h) do { _Pragma("unroll") for (int m = 0; m < 4; ++m) _Pragma("unroll") for (int k = 0; k < 2; ++k) dst[m][k] = *(const LAS bf16x8*)(lds + PG8_SA(b, h) + aoff + m * 2048 + k * 1024); } while (0)
#define PG8_LDB(dst, b, h) do { _Pragma("unroll") for (int n = 0; n < 2; ++n) _Pragma("unroll") for (int k = 0; k < 2; ++k) dst[n][k] = *(const LAS bf16x8*)(lds + PG8_SB(b, h) + boff + n * 2048 + k * 1024); } while (0)
#define PG8_MMA(ai, bj, At, Bt_) do { __builtin_amdgcn_s_setprio(1); _Pragma("unroll") for (int m = 0; m < 4; ++m) _Pragma("unroll") for (int n = 0; n < 2; ++n) _Pragma("unroll") for (int k = 0; k < 2; ++k) \
        acc[ai][bj][m][n] = __builtin_amdgcn_mfma_f32_16x16x32_bf16(Bt_[n][k], At[m][k], acc[ai][bj][m][n], 0, 0, 0); __builtin_amdgcn_s_setprio(0); } while (0)
#define PG8_WAIT_V(n) asm volatile("s_waitcnt vmcnt(" #n ")" ::: "memory")
#define PG8_WAIT_L(n) asm volatile("s_waitcnt lgkmcnt(" #n ")" ::: "memory")
#define PG8_BAR __builtin_amdgcn_s_barrier()
#define PG8_SCHED __builtin_amdgcn_sched_barrier(0)
#define PG8_AOFF(dst, u) do { _Pragma("unroll") for (int _h = 0; _h < 2; ++_h) _Pragma("unroll") for (int _i = 0; _i < 2; ++_i) \
        dst[_h][_i] = (AR.row((u).pm, _h * HALF + sR[_i]) * (unsigned)K + (unsigned)sC[_i]) * 2u; } while (0)
    Unit cur, nxt; int ui = 0;
    if (!S.next(0, cur)) return;
    f32x4 acc[2][2][4][2];
#pragma unroll
    for (int a = 0; a < 2; ++a)
#pragma unroll
        for (int b = 0; b < 2; ++b)
#pragma unroll
            for (int m = 0; m < 4; ++m)
#pragma unroll
                for (int n = 0; n < 2; ++n) acc[a][b][m][n] = (f32x4){0.f, 0.f, 0.f, 0.f};
    bf16x8 At[4][2], B0[2][2], B1[2][2];
    unsigned ao[2][2], an[2][2];
    PG8_AOFF(ao, cur);
    const char* cA = (const char*)A;
    const char* cB = (const char*)Bt + (size_t)cur.pn * tstep;
    PG8_STAGE(PG8_SB(0, 0), cB, voffB); PG8_STAGE(PG8_SB(0, 1), cB + hstep, voffB); PG8_STAGE(PG8_SA(0, 0), cA, ao[0]); PG8_STAGE(PG8_SA(0, 1), cA, ao[1]);
    if (wr == 1) PG8_BAR;
    PG8_WAIT_V(2); PG8_BAR;
    PG8_STAGE(PG8_SB(1, 0), cB + kstep, voffB); PG8_STAGE(PG8_SA(1, 0), cA + kstep, ao[0]); PG8_STAGE(PG8_SB(1, 1), cB + hstep + kstep, voffB);
    PG8_WAIT_V(6); PG8_BAR;
    for (;;) {
        const bool has_next = S.next(ui + 1, nxt);
        if (has_next) { PG8_AOFF(an, nxt); } else {
#pragma unroll
            for (int h = 0; h < 2; ++h)
#pragma unroll
                for (int i = 0; i < 2; ++i) an[h][i] = ao[h][i]; }
        const char* nB = has_next ? (const char*)Bt + (size_t)nxt.pn * tstep : cB;
        for (int t = 0; t < nt; t += 2) {
            const bool last = (t == nt - 2);
            const char* a1 = cA + (size_t)(t + 1) * kstep;
            const char* a2 = last ? cA : cA + (size_t)(t + 2) * kstep; const char* b2 = last ? nB : cB + (size_t)(t + 2) * kstep;
            const char* a3 = a2 + kstep; const char* b3 = b2 + kstep;
            unsigned o2[2][2];
#pragma unroll
            for (int h = 0; h < 2; ++h)
#pragma unroll
                for (int i = 0; i < 2; ++i) o2[h][i] = last ? an[h][i] : ao[h][i];
            PG8_LDB(B0, 0, 0); PG8_LDB(B1, 0, 1); PG8_SCHED; PG8_LDA(At, 0, 0); PG8_STAGE(PG8_SA(1, 1), a1, ao[1]);
            PG8_WAIT_V(8); PG8_WAIT_L(0); PG8_BAR; PG8_MMA(0, 0, At, B0); PG8_MMA(0, 1, At, B1); PG8_BAR; PG8_SCHED;
            PG8_LDA(At, 0, 1); PG8_STAGE(PG8_SB(0, 0), b2, voffB); PG8_STAGE(PG8_SB(0, 1), b2 + hstep, voffB); PG8_STAGE(PG8_SA(0, 0), a2, o2[0]);
            PG8_WAIT_V(8); PG8_WAIT_L(0); PG8_BAR; PG8_MMA(1, 0, At, B0); PG8_MMA(1, 1, At, B1); PG8_BAR; PG8_SCHED;
            PG8_LDB(B0, 1, 0); PG8_LDB(B1, 1, 1); PG8_SCHED; PG8_LDA(At, 1, 0); PG8_STAGE(PG8_SA(0, 1), a2, o2[1]);
            PG8_WAIT_V(8); PG8_WAIT_L(0); PG8_BAR; PG8_MMA(0, 0, At, B0); PG8_MMA(0, 1, At, B1); PG8_BAR; PG8_SCHED;
            PG8_LDA(At, 1, 1); PG8_STAGE(PG8_SB(1, 0), b3, voffB); PG8_STAGE(PG8_SB(1, 1), b3 + hstep, voffB); PG8_STAGE(PG8_SA(1, 0), a3, o2[0]);
            PG8_WAIT_V(8); PG8_WAIT_L(0); PG8_BAR; PG8_MMA(1, 0, At, B0); PG8_MMA(1, 1, At, B1); PG8_BAR; PG8_SCHED;
        }
        if constexpr (ALIGN_EPI) { if (wr == 0) PG8_BAR; }
        E(acc, cur, wr, wc, fr, fq);
        if (!has_next) break;
#pragma unroll
        for (int a = 0; a < 2; ++a)
#pragma unroll
            for (int b = 0; b < 2; ++b)
#pragma unroll
                for (int m = 0; m < 4; ++m)
#pragma unroll
                    for (int n = 0; n < 2; ++n) acc[a][b][m][n] = (f32x4){0.f, 0.f, 0.f, 0.f};
        cur = nxt; cB = nB; ++ui;
#pragma unroll
        for (int h = 0; h < 2; ++h)
#pragma unroll
            for (int i = 0; i < 2; ++i) ao[h][i] = an[h][i];
        if constexpr (ALIGN_EPI) { if (wr == 1) PG8_BAR; }
    }
    PG8_WAIT_V(0);
    if constexpr (!ALIGN_EPI) { if (wr == 0) PG8_BAR; }
    PG8_BAR;
#undef PG8_SA
#undef PG8_SB
#undef PG8_STAGE
#undef PG8_LDA
#undef PG8_LDB
#undef PG8_MMA
#undef PG8_WAIT_V
#undef PG8_WAIT_L
#undef PG8_BAR
#undef PG8_SCHED
#undef PG8_AOFF
}
}

constexpr int NWAVES = 8, NTHREADS = 512;
constexpr int NPHASE = 11;
struct Args {
    const float* in[33]; float* out; unsigned char* ws; int ph_lo, ph_hi, use_bar, pad;
};
enum { I_X = 0, I_LNG, I_LNB, I_WIN, I_CONVW, I_CONVB, I_WRG, I_BRG, I_WIG, I_BIG, I_LAMBDA, I_MU, I_W0, I_DECUP, I_A0, I_AAAUP, I_GATEUP,
       I_KK, I_KA, I_RK, I_GNG, I_GNB, I_WOUT, I_LN1G, I_LN1B, I_WROUTER, I_BROUTER, I_WE1, I_BE1, I_WE2, I_BE2, I_LN2G, I_LN2B };

__device__ __forceinline__ void transpose_item(const float* W, int N, bf16_t* WT, int k0, int n0, int dst_row0, LAS float* scr, int lane) {
#pragma unroll 8
    for (int i = 0; i < 32; ++i) { const int kk = 2 * i + (lane >> 5); scr[kk * 33 + (lane & 31)] = W[(size_t)(k0 + kk) * N + n0 + (lane & 31)]; }
    asm volatile("s_waitcnt lgkmcnt(0)" ::: "memory");
    const int c = lane & 7;
#pragma unroll
    for (int j = 0; j < 4; ++j) { const int n = (lane >> 3) + 8 * j; const LAS float* s = scr + (8 * c) * 33 + n;
        u32x4 o; o.x = pk2(s[0 * 33], s[1 * 33]); o.y = pk2(s[2 * 33], s[3 * 33]); o.z = pk2(s[4 * 33], s[5 * 33]); o.w = pk2(s[6 * 33], s[7 * 33]);
        *(u32x4*)(WT + (size_t)(dst_row0 + n) * KD + k0 + 8 * c) = o; }
    asm volatile("s_waitcnt lgkmcnt(0)" ::: "memory");
}

__device__ __forceinline__ void moe_tables(volatile LAS int* tb, unsigned* ctl) {
    if (threadIdx.x == 0) {
        int off = 0;
        for (int e = 0; e < NE; ++e) { const int c = (int)__hip_atomic_load(ctl + CW_CNT + 64 * e, RLX_AGENT); const int nt = (c + 255) >> 8;
            tb[1 + e] = off; for (int r = 0; r < nt; ++r) tb[64 + off + r] = e; off += nt; }
        tb[1 + NE] = off; tb[0] = off;
    }
    __syncthreads();
}

__global__ void __launch_bounds__(NTHREADS, 2) fwd(Args args) {
    extern __shared__ __attribute__((aligned(16))) unsigned char lds_raw[];
    LAS unsigned char* lds = (LAS unsigned char*)lds_raw;
    volatile LAS unsigned* MISC = (volatile LAS unsigned*)(lds + MISC_OFF);
    const int tid = threadIdx.x, lane = tid & 63, wave = __builtin_amdgcn_readfirstlane(tid >> 6);
    const int G = gridDim.x, bid = blockIdx.x;
    unsigned char* ws = args.ws;
    unsigned* ctl = (unsigned*)(ws + WS_CTL);
    if (tid < 64) MISC[tid] = 0u;
    __syncthreads();
    XcdBarrier bar; bar.bar = ctl + CW_BAR; bar.x = 0; bar.st = nullptr;
    if (args.use_bar) bar = xcd_barrier_post(ctl + CW_BAR, MISC);
    const int lo = args.ph_lo, hi = args.ph_hi;
#define IN(k) (lo <= (k) && (k) < hi)
#define SEAM(k) do { if (IN(k) && IN((k) + 1)) xcd_barrier(bar); } while (0)
    const int gw = bid * NWAVES + wave, NGW = G * NWAVES;
    const int gt = bid * NTHREADS + tid, NGT = G * NTHREADS;

    bf16_t* WinT = (bf16_t*)(ws + WS_WIN); bf16_t* WoT = (bf16_t*)(ws + WS_WO); bf16_t* W1T = (bf16_t*)(ws + WS_W1); bf16_t* W2T = (bf16_t*)(ws + WS_W2);
    bf16_t* XN = (bf16_t*)(ws + WS_XN); bf16_t* P = (bf16_t*)(ws + WS_P);
    float* LA = (float*)(ws + WS_LA); float* LB = (float*)(ws + WS_LB);
    float* RR = (float*)(ws + WS_RR); float* RW = RR + (size_t)M * RW_W; float* RK = RW + (size_t)M * RW_W; float* RV = RK + (size_t)M * RW_W;
    float* RKK = RV + (size_t)M * RW_W; float* RA = RKK + (size_t)M * RW_W; float* RG = RA + (size_t)M * RW_W;
    float* RY = (float*)(ws + WS_RY); float* BON = (float*)(ws + WS_BON);
    bf16_t* CAT = (bf16_t*)(ws + WS_CAT); float* Z = (float*)(ws + WS_Z); float* H1 = (float*)(ws + WS_H1); bf16_t* H1B = (bf16_t*)(ws + WS_H1B);
    int* TOPE = (int*)(ws + WS_TOPE); int* TOPP = (int*)(ws + WS_TOPP); float* TOPG = (float*)(ws + WS_TOPG); int* TOKSLOT = (int*)(ws + WS_TOKSLOT);
    int* SLOTTOK = (int*)(ws + WS_SLOTTOK); float* SLOTG = (float*)(ws + WS_SLOTG);
    bf16_t* ACT = (bf16_t*)(ws + WS_ACT); bf16_t* OUTS = (bf16_t*)(ws + WS_OUTS);

    if (IN(0)) {
        LAS float* scr = (LAS float*)(lds + wave * 16384);
        constexpr int I_IN = (KD / 64) * (NP / 32), I_OUT = (KD / 64) * (D / 32), I_E1 = (KD / 64) * (2 * DE / 32), I_E2 = (DE / 64) * (D / 32);
        constexpr int NITEMS = I_IN + I_OUT + NE * I_E1 + NE * I_E2;
        for (int it = gw; it < NITEMS; it += NGW) {
            int r = it;
            if (r < I_IN) { const int nb = NP / 32, kb = r / nb, n0 = (r % nb) * 32; transpose_item(args.in[I_WIN], NP, WinT, kb * 64, n0, n0, scr, lane); continue; } r -= I_IN;
            if (r < I_OUT) { const int nb = D / 32, kb = r / nb, n0 = (r % nb) * 32; transpose_item(args.in[I_WOUT], D, WoT, kb * 64, n0, n0, scr, lane); continue; } r -= I_OUT;
            if (r < NE * I_E1) { const int e = r / I_E1, q = r % I_E1, nb = 2 * DE / 32, kb = q / nb, n0 = (q % nb) * 32;
                const int isup = n0 >= DE ? 1 : 0, nn = n0 - isup * DE, drow = 256 * (nn >> 7) + 128 * isup + (nn & 127);
                transpose_item(args.in[I_WE1] + (size_t)e * KD * 2 * DE, 2 * DE, W1T + (size_t)e * 2 * DE * KD, kb * 64, n0, drow, scr, lane); continue; } r -= NE * I_E1;
            { const int e = r / I_E2, q = r % I_E2, nb = D / 32, kb = q / nb, n0 = (q % nb) * 32;
                transpose_item(args.in[I_WE2] + (size_t)e * DE * D, D, W2T + (size_t)e * D * DE, kb * 64, n0, n0, scr, lane); }
        }
        for (int i = gt; i < (NPP - NP) * KD / 8; i += NGT) ((u32x4*)(WinT + (size_t)NP * KD))[i] = (u32x4){0u, 0u, 0u, 0u};
        const float* lg = args.in[I_LNG]; const float* lb = args.in[I_LNB];
        for (int m = gw; m < M; m += NGW) {
            const f32x4* xr = (const f32x4*)(args.in[I_X] + (size_t)m * D) + lane;
            f32x4 v[8]; float s = 0.f;
#pragma unroll
            for (int j = 0; j < 8; ++j) { v[j] = xr[64 * j]; s += (v[j][0] + v[j][1]) + (v[j][2] + v[j][3]); }
            const float mean = wave_sum(s) * (1.f / D); float s2 = 0.f;
#pragma unroll
            for (int j = 0; j < 8; ++j) { v[j] = v[j] - mean; s2 += (v[j][0] * v[j][0] + v[j][1] * v[j][1]) + (v[j][2] * v[j][2] + v[j][3] * v[j][3]); }
            const float rstd = 1.f / sqrtf(wave_sum(s2) * (1.f / D) + LN_EPS);
            u32x2* o8 = (u32x2*)(XN + (size_t)m * D) + lane;
#pragma unroll
            for (int j = 0; j < 8; ++j) { const f32x4 g4 = ((const f32x4*)lg)[64 * j + lane], b4 = ((const f32x4*)lb)[64 * j + lane]; const f32x4 y = v[j] * rstd * g4 + b4;
                u32x2 w; w.x = pk2(y[0], y[1]); w.y = pk2(y[2], y[3]); o8[64 * j] = w; }
        }
    }
    SEAM(0);

    if (IN(1)) {
        pg8::StaticOrder S; S.init(M, NPP, G, bid);
        pg8::EpiBf16 E{P, NPP};
        pg8::gemm_phase<pg8::EpiBf16, pg8::StaticOrder, pg8::DenseRows, true>(lds, XN, WinT, S, E, pg8::DenseRows{});
    }
    SEAM(1);

    if (IN(2)) {
        LAS float* ucT = (LAS float*)lds;
        LAS float* xl = (LAS float*)(lds + 65536);
        const float* conv_w = args.in[I_CONVW]; const float* conv_b = args.in[I_CONVB];
        const float* w_rg = args.in[I_WRG]; const float* w_ig = args.in[I_WIG];
        const float* mu = args.in[I_MU];
        for (int tile = bid; tile < M / 16; tile += G) {
            const int t0 = tile * 16, tin = t0 % SEQ;
            __syncthreads();
#pragma unroll
            for (int cc = 0; cc < 2; ++cc) { const int c = tid + 512 * cc;
                const float w0 = conv_w[c], w1 = conv_w[LRU_W + c], w2 = conv_w[2 * LRU_W + c], w3 = conv_w[3 * LRU_W + c], cb = conv_b[c];
                float u[19];
#pragma unroll
                for (int j = 0; j < 19; ++j) { const int tt = tin - 3 + j; u[j] = tt >= 0 ? bf2f(P[(size_t)(t0 - 3 + j) * NPP + c]) : 0.f; }
#pragma unroll
                for (int tb = 0; tb < 16; ++tb) ucT[c * 16 + tb] = w0 * u[tb] + w1 * u[tb + 1] + w2 * u[tb + 2] + w3 * u[tb + 3] + cb; }
            for (int idx = tid; idx < 448 * 16; idx += NTHREADS) { const int j = idx >> 4, tb = idx & 15; const int col = 3 * RW_W + j;
                const size_t pr = (size_t)(t0 + tb) * NPP + 2 * LRU_W + col;
                const float pc = bf2f(P[pr]), pp = (tin + tb) > 0 ? bf2f(P[pr - NPP]) : 0.f; const float s = pc + (pp - pc) * mu[col];
                xl[j * 16 + tb] = j < 96 ? tanhf(s) : (j < 192 ? s : sigmoidf_(s)); }
            __syncthreads();
#pragma unroll 1
            for (int cc = 0; cc < 2; ++cc) { const int c = tid + 512 * cc, nb = c >> 6, kc = c & 63;
                float ar[16], ai[16];
#pragma unroll
                for (int tb = 0; tb < 16; ++tb) { ar[tb] = 0.f; ai[tb] = 0.f; }
                for (int j = 0; j < 64; ++j) { const float wr_ = w_rg[(size_t)(nb * 64 + j) * 64 + kc], wi_ = w_ig[(size_t)(nb * 64 + j) * 64 + kc];
                    const LAS f32x4* up = (const LAS f32x4*)(ucT + (nb * 64 + j) * 16);
#pragma unroll
                    for (int q = 0; q < 4; ++q) { const f32x4 u4 = up[q];
#pragma unroll
                        for (int e = 0; e < 4; ++e) { ar[q * 4 + e] += wr_ * u4[e]; ai[q * 4 + e] += wi_ * u4[e]; } } }
                const float br = args.in[I_BRG][c], bi = args.in[I_BIG][c], lam = args.in[I_LAMBDA][c];
                const float sp = lam > 15.f ? __expf(-lam) : log1pf(__expf(-lam));
#pragma unroll
                for (int tb = 0; tb < 16; ++tb) { const float rg = sigmoidf_(ar[tb] + br), ig = sigmoidf_(ai[tb] + bi);
                    const float la = -8.f * rg * sp, a = __expf(la), b = sqrtf(fmaxf(-expm1f(2.f * la), 0.f)) * (ig * ucT[c * 16 + tb]);
                    LA[(size_t)(t0 + tb) * LRU_W + c] = a; LB[(size_t)(t0 + tb) * LRU_W + c] = b; } }
#pragma unroll 1
            for (int cc = 0; cc < 2; ++cc) { const int c = tid + 512 * cc;
                float dw[16], da[16], dg[16];
#pragma unroll
                for (int tb = 0; tb < 16; ++tb) { dw[tb] = 0.f; da[tb] = 0.f; dg[tb] = 0.f; }
                for (int j = 0; j < 96; ++j) { const float w_ = args.in[I_DECUP][(size_t)j * RW_W + c], a_ = args.in[I_AAAUP][(size_t)j * RW_W + c];
                    const LAS f32x4* xw = (const LAS f32x4*)(xl + j * 16); const LAS f32x4* xa = (const LAS f32x4*)(xl + (96 + j) * 16);
#pragma unroll
                    for (int q = 0; q < 4; ++q) { const f32x4 a4 = xw[q], b4 = xa[q];
#pragma unroll
                        for (int e = 0; e < 4; ++e) { dw[q * 4 + e] += w_ * a4[e]; da[q * 4 + e] += a_ * b4[e]; } } }
                for (int j = 0; j < 256; ++j) { const float g_ = args.in[I_GATEUP][(size_t)j * RW_W + c];
                    const LAS f32x4* xg = (const LAS f32x4*)(xl + (192 + j) * 16);
#pragma unroll
                    for (int q = 0; q < 4; ++q) { const f32x4 a4 = xg[q];
#pragma unroll
                        for (int e = 0; e < 4; ++e) dg[q * 4 + e] += g_ * a4[e]; } }
                const float w0c = args.in[I_W0][c], a0c = args.in[I_A0][c], kkc = args.in[I_KK][c], kac = args.in[I_KA][c], rkc = args.in[I_RK][c];
                const float mur = mu[c], muk = mu[RW_W + c], muv = mu[2 * RW_W + c];
                const int head = c >> 6;
#pragma unroll 1
                for (int tb = 0; tb < 16; ++tb) { const size_t pr = (size_t)(t0 + tb) * NPP + 2 * LRU_W + c; const bool hp = (tin + tb) > 0;
                    const float rc = bf2f(P[pr]), kc_ = bf2f(P[pr + RW_W]), vc = bf2f(P[pr + 2 * RW_W]);
                    const float rp = hp ? bf2f(P[pr - NPP]) : 0.f, kp = hp ? bf2f(P[pr - NPP + RW_W]) : 0.f, vp = hp ? bf2f(P[pr - NPP + 2 * RW_W]) : 0.f;
                    const float r = rc + (rp - rc) * mur, k = kc_ + (kp - kc_) * muk, v = vc + (vp - vc) * muv;
                    const float xw_ = w0c + dw[tb];
                    const float decay = __expf(-0.6065306597126334f * sigmoidf_(xw_));
                    const float a = sigmoidf_(a0c + da[tb]);
                    float kk = k * kkc; const float nrm = sqrtf(wave_sum(kk * kk)); kk = kk / fmaxf(nrm, 1e-12f);
                    const float km = k * (1.f + (a - 1.f) * kac);
                    const float bon = wave_sum(r * km * rkc);
                    const size_t o = (size_t)(t0 + tb) * RW_W + c;
                    RR[o] = r; RW[o] = decay; RK[o] = km; RV[o] = v; RKK[o] = kk; RA[o] = a; RG[o] = dg[tb];
                    if (lane == 0) BON[(size_t)(t0 + tb) * NHEAD + head] = bon; } }
        }
    }
    SEAM(2);

    if (IN(3)) {
        if (gw < BATCH * NHEAD) {
            const int b = gw / NHEAD, h = gw % NHEAD; const size_t base = (size_t)b * SEQ * RW_W + h * HS + lane;
            float s[64];
#pragma unroll
            for (int k = 0; k < 64; ++k) s[k] = 0.f;
            float nr = RR[base], nw = RW[base], nk = RK[base], nv = RV[base], nkk = RKK[base], na = RA[base];
            for (int t = 0; t < SEQ; ++t) {
                const float cr = nr, cw = nw, ck = nk, cv = nv, ckk = nkk, cka = nkk * na;
                if (t + 1 < SEQ) { const size_t o = base + (size_t)(t + 1) * RW_W; nr = RR[o]; nw = RW[o]; nk = RK[o]; nv = RV[o]; nkk = RKK[o]; na = RA[o]; }
                float d0 = 0.f, d1 = 0.f, d2 = 0.f, d3 = 0.f;
#pragma unroll
                for (int k = 0; k < 64; k += 4) {
                    d0 += s[k] * __builtin_bit_cast(float, __builtin_amdgcn_readlane(__builtin_bit_cast(int, ckk), k));
                    d1 += s[k + 1] * __builtin_bit_cast(float, __builtin_amdgcn_readlane(__builtin_bit_cast(int, ckk), k + 1));
                    d2 += s[k + 2] * __builtin_bit_cast(float, __builtin_amdgcn_readlane(__builtin_bit_cast(int, ckk), k + 2));
                    d3 += s[k + 3] * __builtin_bit_cast(float, __builtin_amdgcn_readlane(__builtin_bit_cast(int, ckk), k + 3)); }
                const float skk = (d0 + d1) + (d2 + d3);
                float y0 = 0.f, y1 = 0.f;
#pragma unroll
                for (int k = 0; k < 64; k += 2) {
#pragma unroll
                    for (int q = 0; q < 2; ++q) {
                        const float wk = __builtin_bit_cast(float, __builtin_amdgcn_readlane(__builtin_bit_cast(int, cw), k + q));
                        const float bk = __builtin_bit_cast(float, __builtin_amdgcn_readlane(__builtin_bit_cast(int, cka), k + q));
                        const float kk_ = __builtin_bit_cast(float, __builtin_amdgcn_readlane(__builtin_bit_cast(int, ck), k + q));
                        const float rk_ = __builtin_bit_cast(float, __builtin_amdgcn_readlane(__builtin_bit_cast(int, cr), k + q));
                        const float ns = s[k + q] * wk - skk * bk + cv * kk_;
                        s[k + q] = ns;
                        if (q == 0) y0 += ns * rk_; else y1 += ns * rk_; } }
                RY[base + (size_t)t * RW_W] = y0 + y1;
            }
        }
        if (bid >= 8 && bid < 16) {
            const int i = (bid - 8) * NTHREADS + tid, b = i / LRU_W, c = i % LRU_W; const size_t base = (size_t)b * SEQ * LRU_W + c;
            float h = 0.f;
            for (int t = 0; t < SEQ; t += 8) {
                float a[8], bb[8];
#pragma unroll
                for (int j = 0; j < 8; ++j) { a[j] = LA[base + (size_t)(t + j) * LRU_W]; bb[j] = LB[base + (size_t)(t + j) * LRU_W]; }
#pragma unroll
                for (int j = 0; j < 8; ++j) { h = a[j] * h + bb[j]; LB[base + (size_t)(t + j) * LRU_W] = h; }
            }
        }
    }
    SEAM(3);

    if (IN(4)) {
        for (int i = gt; i < M * LRU_W; i += NGT) { const int m = i >> 10, c = i & 1023;
            const float g = bf2f(P[(size_t)m * NPP + LRU_W + c]);
            CAT[(size_t)m * D + c] = (bf16_t)f2bf(LB[i] * gelu_tanh(g)); }
        const float* gng = args.in[I_GNG]; const float* gnb = args.in[I_GNB];
        for (int i = gw; i < M * NHEAD; i += NGW) { const int m = i >> 4, h = i & 15, c = h * HS + lane; const size_t o = (size_t)m * RW_W + c;
            const float y = RY[o]; const float mu_ = wave_sum(y) * (1.f / 64.f); const float d = y - mu_; const float var = wave_sum(d * d) * (1.f / 64.f);
            float yn = d * (1.f / sqrtf(var + GN_EPS)) * gng[c] + gnb[c];
            yn += BON[i] * RV[o];
            CAT[(size_t)m * D + LRU_W + c] = (bf16_t)f2bf(yn * RG[o]); }
    }
    SEAM(4);

    if (IN(5)) {
        pg8::StaticOrder S; S.init(M, D, G, bid);
        pg8::EpiResF32 E{Z, XN, DN_ALPHA};
        pg8::gemm_phase<pg8::EpiResF32, pg8::StaticOrder, pg8::DenseRows, true>(lds, CAT, WoT, S, E, pg8::DenseRows{});
    }
    SEAM(5);

    if (IN(6)) {
        LAS float* hT = (LAS float*)lds;
        LAS float* part = (LAS float*)lds;
        LAS float* lgt = (LAS float*)(lds + 65536);
        const float* g1 = args.in[I_LN1G]; const float* b1 = args.in[I_LN1B]; const float* wr_ = args.in[I_WROUTER]; const float* br_ = args.in[I_BROUTER];
        for (int tile = bid; tile < M / 16; tile += G) {
            const int t0 = tile * 16;
            __syncthreads();
#pragma unroll 1
            for (int rr = 0; rr < 2; ++rr) { const int tb = wave * 2 + rr, m = t0 + tb;
                const f32x4* zr = (const f32x4*)(Z + (size_t)m * D) + lane;
                f32x4 v[8]; float s = 0.f;
#pragma unroll
                for (int j = 0; j < 8; ++j) { v[j] = zr[64 * j]; s += (v[j][0] + v[j][1]) + (v[j][2] + v[j][3]); }
                const float mean = wave_sum(s) * (1.f / D); float s2 = 0.f;
#pragma unroll
                for (int j = 0; j < 8; ++j) { v[j] = v[j] - mean; s2 += (v[j][0] * v[j][0] + v[j][1] * v[j][1]) + (v[j][2] * v[j][2] + v[j][3] * v[j][3]); }
                const float rstd = 1.f / sqrtf(wave_sum(s2) * (1.f / D) + LN_EPS);
                f32x4* ho = (f32x4*)(H1 + (size_t)m * D) + lane; u32x2* hb = (u32x2*)(H1B + (size_t)m * D) + lane;
#pragma unroll
                for (int j = 0; j < 8; ++j) { const f32x4 g4 = ((const f32x4*)g1)[64 * j + lane], b4 = ((const f32x4*)b1)[64 * j + lane]; const f32x4 y = v[j] * rstd * g4 + b4;
                    ho[64 * j] = y; u32x2 w; w.x = pk2(y[0], y[1]); w.y = pk2(y[2], y[3]); hb[64 * j] = w;
#pragma unroll
                    for (int q = 0; q < 4; ++q) hT[(256 * j + 4 * lane + q) * 16 + tb] = y[q]; } }
            __syncthreads();
            float ac[16];
#pragma unroll
            for (int tb = 0; tb < 16; ++tb) ac[tb] = 0.f;
            { const int e = tid & 31, sl = tid >> 5;
                for (int i = sl * 128; i < sl * 128 + 128; ++i) { const float w = wr_[(size_t)i * NE + e]; const LAS f32x4* hp = (const LAS f32x4*)(hT + i * 16);
#pragma unroll
                    for (int q = 0; q < 4; ++q) { const f32x4 h4 = hp[q];
#pragma unroll
                        for (int k = 0; k < 4; ++k) ac[q * 4 + k] += w * h4[k]; } }
                __syncthreads();
#pragma unroll
                for (int tb = 0; tb < 16; ++tb) part[(sl * 16 + tb) * 32 + e] = ac[tb]; }
            __syncthreads();
            { const int tb = tid >> 5, e = tid & 31; float sacc = br_[e];
#pragma unroll
                for (int sl = 0; sl < 16; ++sl) sacc += part[(sl * 16 + tb) * 32 + e];
                lgt[tb * 32 + e] = sacc; }
            __syncthreads();
            if (tid < 16) { const int m = t0 + tid; float bv[4]; int bi[4]; unsigned used = 0u;
#pragma unroll 1
                for (int k = 0; k < 4; ++k) { float best = -3.0e38f; int be = 0;
                    for (int e = 0; e < NE; ++e) { const float x = lgt[tid * 32 + e]; if (!((used >> e) & 1u) && x > best) { best = x; be = e; } }
                    used |= 1u << be; bv[k] = best; bi[k] = be; }
                float ex[4], den = 0.f;
#pragma unroll
                for (int k = 0; k < 4; ++k) { ex[k] = __expf(bv[k] - bv[0]); den += ex[k]; }
#pragma unroll 1
                for (int k = 0; k < 4; ++k) { const int pos = (int)__hip_atomic_fetch_add(ctl + CW_CNT + 64 * bi[k], 1u, RLX_AGENT);
                    TOPE[m * 4 + k] = bi[k]; TOPP[m * 4 + k] = pos; TOPG[m * 4 + k] = ex[k] / den; } }
        }
    }
    SEAM(6);

    if (IN(7)) {
        volatile LAS int* tb = (volatile LAS int*)(MISC + 16);
        moe_tables(tb, ctl);
        for (int i = gt; i < M * TOPK; i += NGT) { const int e = TOPE[i], slot = tb[1 + e] * 256 + TOPP[i];
            SLOTTOK[slot] = i >> 2; SLOTG[slot] = TOPG[i]; TOKSLOT[i] = slot; }
        if (bid < NE) { const int e = bid, c = (int)__hip_atomic_load(ctl + CW_CNT + 64 * e, RLX_AGENT), s0 = tb[1 + e] * 256 + c, s1 = tb[2 + e] * 256;
            for (int s = s0 + tid; s < s1; s += NTHREADS) { SLOTTOK[s] = 0; SLOTG[s] = 0.f; } }
    }
    SEAM(7);

    if (IN(8)) {
        volatile LAS int* tb = (volatile LAS int*)(MISC + 16);
        moe_tables(tb, ctl);
        pg8::MoeOrder S{(const LAS int*)(tb + 64), tb[0], 16, G, bid};
        pg8::EpiSwiglu E{ACT, args.in[I_BE1]};
        pg8::gemm_phase<pg8::EpiSwiglu, pg8::MoeOrder, pg8::GatherRows, true>(lds, H1B, W1T, S, E, pg8::GatherRows{SLOTTOK});
    }
    SEAM(8);

    if (IN(9)) {
        volatile LAS int* tb = (volatile LAS int*)(MISC + 16);
        moe_tables(tb, ctl);
        pg8::MoeOrder S{(const LAS int*)(tb + 64), tb[0], 8, G, bid};
        pg8::EpiMoeOut E{OUTS, args.in[I_BE2], SLOTG};
        pg8::gemm_phase<pg8::EpiMoeOut, pg8::MoeOrder, pg8::DenseRows, true>(lds, ACT, W2T, S, E, pg8::DenseRows{});
    }
    SEAM(9);

    if (IN(10)) {
        const float* g2 = args.in[I_LN2G]; const float* b2 = args.in[I_LN2B];
        for (int m = gw; m < M; m += NGW) {
            const f32x4* hr = (const f32x4*)(H1 + (size_t)m * D) + lane;
            const int s0 = TOKSLOT[m * 4], s1 = TOKSLOT[m * 4 + 1], s2_ = TOKSLOT[m * 4 + 2], s3 = TOKSLOT[m * 4 + 3];
            const u32x2* o0 = (const u32x2*)(OUTS + (size_t)s0 * D) + lane; const u32x2* o1 = (const u32x2*)(OUTS + (size_t)s1 * D) + lane;
            const u32x2* o2 = (const u32x2*)(OUTS + (size_t)s2_ * D) + lane; const u32x2* o3 = (const u32x2*)(OUTS + (size_t)s3 * D) + lane;
            f32x4 v[8]; float s = 0.f;
#pragma unroll
            for (int j = 0; j < 8; ++j) { const f32x4 h4 = hr[64 * j]; const u32x2 a = o0[64 * j], b = o1[64 * j], c = o2[64 * j], d = o3[64 * j];
                f32x4 mo; mo[0] = (bflo(a.x) + bflo(b.x)) + (bflo(c.x) + bflo(d.x)); mo[1] = (bfhi(a.x) + bfhi(b.x)) + (bfhi(c.x) + bfhi(d.x));
                mo[2] = (bflo(a.y) + bflo(b.y)) + (bflo(c.y) + bflo(d.y)); mo[3] = (bfhi(a.y) + bfhi(b.y)) + (bfhi(c.y) + bfhi(d.y));
                v[j] = h4 * DN_ALPHA + mo; s += (v[j][0] + v[j][1]) + (v[j][2] + v[j][3]); }
            const float mean = wave_sum(s) * (1.f / D); float q2 = 0.f;
#pragma unroll
            for (int j = 0; j < 8; ++j) { v[j] = v[j] - mean; q2 += (v[j][0] * v[j][0] + v[j][1] * v[j][1]) + (v[j][2] * v[j][2] + v[j][3] * v[j][3]); }
            const float rstd = 1.f / sqrtf(wave_sum(q2) * (1.f / D) + LN_EPS);
            f32x4* orow = (f32x4*)(args.out + (size_t)m * D) + lane;
#pragma unroll
            for (int j = 0; j < 8; ++j) { const f32x4 g4 = ((const f32x4*)g2)[64 * j + lane], b4 = ((const f32x4*)b2)[64 * j + lane]; orow[64 * j] = v[j] * rstd * g4 + b4; }
        }
    }
#undef IN
#undef SEAM
}

#ifndef MK_ONE_LAUNCH
#define MK_ONE_LAUNCH 0
#endif
extern "C" void kernel_launch(void* const* d_in, const int* in_sizes, int n_in, void* d_out, int out_size, void* d_ws, size_t ws_size, hipStream_t stream) {
    static int grid = 0;
    if (grid == 0) {
        if (n_in != 33 || out_size != M * D || ws_size < WS_END) { fprintf(stderr, "kernel_launch: unexpected sizes n_in %d out %d ws %zu (need %zu)\n", n_in, out_size, ws_size, (size_t)WS_END); grid = -1; return; }
        int dev = 0, cus = 0, per_cu = 0;
        if (hipGetDevice(&dev) != hipSuccess || hipDeviceGetAttribute(&cus, hipDeviceAttributeMultiprocessorCount, dev) != hipSuccess) { grid = -1; return; }
        if (hipFuncSetAttribute((const void*)fwd, hipFuncAttributeMaxDynamicSharedMemorySize, LDS_BYTES) != hipSuccess) { fprintf(stderr, "kernel_launch: hipFuncSetAttribute failed\n"); grid = -1; return; }
        if (hipOccupancyMaxActiveBlocksPerMultiprocessor(&per_cu, (const void*)fwd, NTHREADS, LDS_BYTES) != hipSuccess || per_cu < 1) fprintf(stderr, "kernel_launch: occupancy query says %d\n", per_cu);
        (void)hipGetLastError();
        grid = cus;
    }
    if (grid < 0) return;
    (void)hipMemsetAsync((char*)d_ws + WS_CTL, 0, CTL_ZERO_BYTES, stream);
    Args a{};
    for (int i = 0; i < 33; ++i) a.in[i] = (const float*)d_in[i];
    a.out = (float*)d_out; a.ws = (unsigned char*)d_ws;
#if MK_ONE_LAUNCH
    a.ph_lo = 0; a.ph_hi = NPHASE; a.use_bar = 1;
    hipLaunchKernelGGL(fwd, dim3(grid), dim3(NTHREADS), LDS_BYTES, stream, a);
#else
    for (int p = 0; p < NPHASE; ++p) { a.ph_lo = p; a.ph_hi = p + 1; a.use_bar = 0;
        hipLaunchKernelGGL(fwd, dim3(grid), dim3(NTHREADS), LDS_BYTES, stream, a); }
#endif
}
```

```cpp
#include <hip/hip_runtime.h>
#include <cstdio>
#include <cstdint>

#define LAS __attribute__((address_space(3)))
#define GAS __attribute__((address_space(1)))
typedef unsigned short bf16_t;
typedef short bf16x8 __attribute__((ext_vector_type(8)));
typedef float f32x4 __attribute__((ext_vector_type(4)));
typedef float f32x2 __attribute__((ext_vector_type(2)));
typedef unsigned u32x4 __attribute__((ext_vector_type(4)));
typedef unsigned u32x2 __attribute__((ext_vector_type(2)));

constexpr int BATCH = 4, SEQ = 4096, M = BATCH * SEQ, D = 2048;
constexpr int LRU_W = 1024, RW_W = 1024, NHEAD = 16, HS = 64;
constexpr int DLORA = 96, ALORA = 96, GLORA = 256;
constexpr int RW_SHIFT_W = 3 * RW_W + DLORA + ALORA + GLORA;
constexpr int NP = 2 * LRU_W + RW_SHIFT_W;
constexpr int NPP = 5632;
constexpr int NE = 32, TOPK = 4, DE = 2048;
constexpr int NSLOT_MAX = M * TOPK + NE * 256;
constexpr int NTILE_MAX = NSLOT_MAX / 256;
constexpr float LN_EPS = 1e-5f, GN_EPS = 64e-5f;
constexpr float DN_ALPHA = 1.189207115002721f;
constexpr int KD = 2048;

constexpr size_t MiB = 1u << 20;
constexpr size_t WS_CTL = 0, CTL_ZERO_BYTES = 1 * MiB;
constexpr size_t WS_WIN = 2 * MiB;
constexpr size_t WS_WO = WS_WIN + (size_t)NPP * KD * 2;
constexpr size_t WS_W1 = WS_WO + (size_t)D * KD * 2;
constexpr size_t WS_W2 = WS_W1 + (size_t)NE * 2 * DE * KD * 2;
constexpr size_t WS_XN = WS_W2 + (size_t)NE * D * DE * 2;
constexpr size_t WS_P = WS_XN + (size_t)M * D * 2;
constexpr size_t WS_LA = WS_P + (size_t)M * NPP * 2;
constexpr size_t WS_LB = WS_LA + (size_t)M * LRU_W * 4;
constexpr size_t WS_RR = WS_LB + (size_t)M * LRU_W * 4;
constexpr size_t WS_RWS = (size_t)M * RW_W * 4;
constexpr size_t WS_RY = WS_RR + 7 * WS_RWS;
constexpr size_t WS_BON = WS_RY + WS_RWS;
constexpr size_t WS_CAT = WS_BON + (size_t)M * NHEAD * 4;
constexpr size_t WS_Z = WS_CAT + (size_t)M * D * 2;
constexpr size_t WS_H1 = WS_Z + (size_t)M * D * 4;
constexpr size_t WS_H1B = WS_H1 + (size_t)M * D * 4;
constexpr size_t WS_TOPE = WS_H1B + (size_t)M * D * 2;
constexpr size_t WS_TOPP = WS_TOPE + (size_t)M * TOPK * 4;
constexpr size_t WS_TOPG = WS_TOPP + (size_t)M * TOPK * 4;
constexpr size_t WS_TOKSLOT = WS_TOPG + (size_t)M * TOPK * 4;
constexpr size_t WS_SLOTTOK = WS_TOKSLOT + (size_t)M * TOPK * 4;
constexpr size_t WS_SLOTG = WS_SLOTTOK + (size_t)NSLOT_MAX * 4;
constexpr size_t WS_ACT = WS_SLOTG + (size_t)NSLOT_MAX * 4;
constexpr size_t WS_OUTS = WS_ACT + (size_t)NSLOT_MAX * DE * 2;
constexpr size_t WS_END = WS_OUTS + (size_t)NSLOT_MAX * D * 2;
constexpr int CW_CNT = 1024;
constexpr int CW_BAR = 4096;

constexpr int RING_BYTES = 131072;
constexpr int MISC_OFF = RING_BYTES;
constexpr int LDS_BYTES = 147456;

#define RLX_AGENT __ATOMIC_RELAXED, __HIP_MEMORY_SCOPE_AGENT
__device__ __forceinline__ unsigned f2bf(float f) { unsigned u = __builtin_bit_cast(unsigned, f); return (u + 0x7fffu + ((u >> 16) & 1u)) >> 16; }
__device__ __forceinline__ unsigned pk2(float lo, float hi) { return f2bf(lo) | (f2bf(hi) << 16); }
__device__ __forceinline__ float bf2f(unsigned short b) { return __builtin_bit_cast(float, (unsigned)b << 16); }
__device__ __forceinline__ float bflo(unsigned w) { return __builtin_bit_cast(float, w << 16); }
__device__ __forceinline__ float bfhi(unsigned w) { return __builtin_bit_cast(float, w & 0xffff0000u); }
__device__ __forceinline__ float wave_sum(float v) {
#pragma unroll
    for (int o = 1; o < 64; o <<= 1) v += __shfl_xor(v, o);
    return v;
}
__device__ __forceinline__ float sigmoidf_(float x) { return 1.f / (1.f + __expf(-x)); }
__device__ __forceinline__ float gelu_tanh(float x) { const float u = 0.7978845608028654f * (x + 0.044715f * x * x * x); return 0.5f * x * (1.f + tanhf(u)); }

#define XB_TMO      128
#define XB_XCNT(j)  (256  + 64 * (j))
#define XB_XSUB(j)  (1280 + 64 * (j))
#define XB_XGEN(j)  (2304 + 64 * (j))
#define XB_TOP      3328
#define XB_TOPGEN   3392
#define XCD_BAR_WORDS 3456
#define XB_SPIN_CAP (1u << 18)
__device__ __forceinline__ unsigned xb_ld(unsigned* p)              { return __hip_atomic_load(p, __ATOMIC_RELAXED, __HIP_MEMORY_SCOPE_AGENT); }
__device__ __forceinline__ unsigned xb_add(unsigned* p, unsigned v) { return __hip_atomic_fetch_add(p, v, __ATOMIC_RELAXED, __HIP_MEMORY_SCOPE_AGENT); }
__device__ __forceinline__ unsigned xb_xcc_id() { return (unsigned)__builtin_amdgcn_s_getreg((3 << 11) | 20) & 0xFu; }
#define XB_SPIN(cond, bar) do { unsigned _sp = 0; while (cond) { __builtin_amdgcn_s_sleep(1); \
    if ((++_sp & 255u) == 0u) { if (xb_ld(&(bar)[XB_TMO])) break; if (_sp > XB_SPIN_CAP) { atomicAdd(&(bar)[XB_TMO], 1u); break; } } } } while (0)
struct XcdBarrier { unsigned* bar; unsigned x; volatile LAS unsigned* st; };
__device__ __forceinline__ XcdBarrier xcd_barrier_post(unsigned* bar, volatile LAS unsigned* st) {
    XcdBarrier b; b.bar = bar; b.x = xb_xcc_id(); b.st = st;
    if (threadIdx.x == 0) (void)xb_add(&bar[XB_XCNT(b.x)], 1u);
    return b;
}
__device__ __forceinline__ void xcd_barrier_complete(unsigned* bar, unsigned x, unsigned& nloc, unsigned& nx) {
    const unsigned G = gridDim.x * gridDim.y * gridDim.z;
    unsigned sum, cnt, mine, sp = 0u;
    for (;;) {
        sum = 0u; cnt = 0u; mine = 0u;
#pragma unroll
        for (unsigned j = 0; j < 16; ++j) { const unsigned c = xb_ld(&bar[XB_XCNT(j)]); sum += c; cnt += (c > 0u) ? 1u : 0u; mine = (j == x) ? c : mine; }
        if (sum == G) break;
        __builtin_amdgcn_s_sleep(1);
        if ((++sp & 255u) == 0u) { if (xb_ld(&bar[XB_TMO])) break; if (sp > XB_SPIN_CAP) { atomicAdd(&bar[XB_TMO], 1u); break; } }
    }
    nloc = mine > 0u ? mine : 1u; nx = cnt > 0u ? cnt : 1u;
}
__device__ __forceinline__ void xcd_barrier(const XcdBarrier& b) {
    asm volatile("s_waitcnt vmcnt(0)" ::: "memory");
    __syncthreads();
    if (threadIdx.x == 0) {
        unsigned* bar = b.bar;
        __builtin_amdgcn_s_waitcnt(0);
        unsigned nloc = b.st[0], nx = b.st[1];
        if (nloc == 0u) { xcd_barrier_complete(bar, b.x, nloc, nx); b.st[0] = nloc; b.st[1] = nx; }
        const unsigned old = xb_add(&bar[XB_XSUB(b.x)], 1u);
        const unsigned gen = old / nloc;
        if (old + 1u == (gen + 1u) * nloc) {
            __builtin_amdgcn_fence(__ATOMIC_RELEASE, "agent");
            asm volatile("s_waitcnt vmcnt(0)" ::: "memory");
            const unsigned og = xb_add(&bar[XB_TOP], 1u);
            const unsigned tg = og / nx;
            if (og + 1u == (tg + 1u) * nx) xb_add(&bar[XB_TOPGEN], 1u);
            else XB_SPIN(xb_ld(&bar[XB_TOPGEN]) == tg, bar);
            __builtin_amdgcn_fence(__ATOMIC_ACQUIRE, "agent");
            xb_add(&bar[XB_XGEN(b.x)], 1u);
            asm volatile("s_waitcnt vmcnt(0)" ::: "memory");
        } else {
            XB_SPIN(xb_ld(&bar[XB_XGEN(b.x)]) == gen, bar);
            __builtin_amdgcn_fence(__ATOMIC_ACQUIRE, "agent");
            asm volatile("s_waitcnt vmcnt(0)" ::: "memory");
        }
    }
    __syncthreads();
}

namespace pg8 {
constexpr int BM = 256, BK = 64, HALF = 128, HTB = HALF * BK * 2, STAGE_BYTES = 8 * HTB, NXCD = 8, WGM = 8;
__host__ __device__ __forceinline__ int lds_byte(int r, int c) { const int st = (r >> 4) * 2 + (c >> 5), rr = r & 15, cc = c & 31, ob = rr * 64 + cc * 2; return st * 1024 + (ob ^ (((ob >> 9) & 1) << 5)); }
__host__ __device__ __forceinline__ void stage_rc(int b, int& R, int& C) { const int st = b / 1024, sb = b % 1024, swz = sb ^ (((sb >> 9) & 1) << 5); R = (st >> 1) * 16 + swz / 64; C = (st & 1) * 32 + (swz % 64) / 2; }
__host__ __device__ __forceinline__ int perm32(int rho) { const int n = rho >> 4, i = rho & 15; return 8 * (i >> 2) + 4 * n + (i & 3); }
struct Unit { int pm, pn; };
__device__ __forceinline__ unsigned cvt_pk_bf16(float lo, float hi) { unsigned r; asm volatile("v_cvt_pk_bf16_f32 %0, %1, %2" : "=v"(r) : "v"(lo), "v"(hi)); return r; }

struct StaticOrder {
    int nM, nN, nwg, G, c;
    __device__ void init(int M_, int N_, int G_, int c_) { nM = M_ / BM; nN = N_ / BM; nwg = nM * nN; G = G_; c = c_; }
    __device__ bool next(int i, Unit& u) const {
        const long L = (long)i * G + c; if (L >= nwg) return false;
        int wgid = (int)L; { const int q = nwg / NXCD, r = nwg % NXCD, xcd = wgid % NXCD, off = wgid / NXCD; wgid = (xcd < r ? xcd * (q + 1) : r * (q + 1) + (xcd - r) * q) + off; }
        const int nig = WGM * nN, gid = wgid / nig, fm = gid * WGM, gsz = (nM - fm) < WGM ? (nM - fm) : WGM;
        u.pm = fm + ((wgid % nig) % gsz); u.pn = (wgid % nig) / gsz; return true;
    }
};
struct MoeOrder {
    const LAS int* tile_e; int R, NCT, G, c;
    __device__ bool next(int i, Unit& u) const {
        int rt, ct;
        if (G == 256) { const int x = c & 7, j = c >> 3;
            if (NCT == 16) { rt = 16 * i + (x >> 1) * 4 + (j >> 3); ct = (x & 1) * 8 + (j & 7); }
            else           { rt = 32 * i + 4 * x + (j >> 3); ct = j & 7; } }
        else { const long L = (long)i * G + c; rt = (int)(L / NCT); ct = (int)(L % NCT); }
        if (rt >= R) return false;
        u.pm = rt; u.pn = tile_e[rt] * NCT + ct; return true;
    }
};
struct DenseRows { __device__ __forceinline__ unsigned row(int pm, int r) const { return (unsigned)(pm * BM + r); } };
struct GatherRows { const int* idx; __device__ __forceinline__ unsigned row(int pm, int r) const { return (unsigned)idx[pm * BM + r]; } };

struct EpiBf16 {
    static constexpr bool PERM = true;
    bf16_t* O; int ldc;
    __device__ __forceinline__ void operator()(const f32x4 (&acc)[2][2][4][2], const Unit& u, int wr, int wc, int fr, int fq) const {
        const int row0 = u.pm * BM + wr * 64 + fr, col0 = u.pn * BM + wc * 32 + 8 * fq;
#pragma unroll
        for (int ai = 0; ai < 2; ++ai)
#pragma unroll
            for (int m = 0; m < 4; ++m) { bf16_t* rowp = O + (size_t)(row0 + ai * HALF + m * 16) * ldc + col0;
#pragma unroll
                for (int bj = 0; bj < 2; ++bj) { const f32x4 v0 = acc[ai][bj][m][0], v1 = acc[ai][bj][m][1];
                    u32x4 w; w.x = cvt_pk_bf16(v0[0], v0[1]); w.y = cvt_pk_bf16(v0[2], v0[3]); w.z = cvt_pk_bf16(v1[0], v1[1]); w.w = cvt_pk_bf16(v1[2], v1[3]);
                    *(u32x4*)(rowp + bj * HALF) = w; } }
    }
};
struct EpiResF32 {
    static constexpr bool PERM = false;
    float* Z; const bf16_t* R; float alpha;
    __device__ __forceinline__ void operator()(const f32x4 (&acc)[2][2][4][2], const Unit& u, int wr, int wc, int fr, int fq) const {
        const int row0 = u.pm * BM + wr * 64 + fr, col0 = u.pn * BM + wc * 32 + 4 * fq;
#pragma unroll
        for (int ai = 0; ai < 2; ++ai)
#pragma unroll
            for (int m = 0; m < 4; ++m) { const size_t off = (size_t)(row0 + ai * HALF + m * 16) * D + col0;
#pragma unroll
                for (int bj = 0; bj < 2; ++bj)
#pragma unroll
                    for (int n = 0; n < 2; ++n) { const u32x2 rb = *(const u32x2*)(R + off + bj * HALF + n * 16);
                        f32x4 o = acc[ai][bj][m][n]; o[0] += alpha * bflo(rb.x); o[1] += alpha * bfhi(rb.x); o[2] += alpha * bflo(rb.y); o[3] += alpha * bfhi(rb.y);
                        *(f32x4*)(Z + off + bj * HALF + n * 16) = o; } }
    }
};
struct EpiSwiglu {
    static constexpr bool PERM = true;
    bf16_t* O; const float* b1;
    __device__ __forceinline__ void operator()(const f32x4 (&acc)[2][2][4][2], const Unit& u, int wr, int wc, int fr, int fq) const {
        const int e = u.pn >> 4, ct = u.pn & 15;
        const int row0 = u.pm * BM + wr * 64 + fr, cin = wc * 32 + 8 * fq, col0 = ct * HALF + cin;
        const float* bg = b1 + (size_t)e * 2 * DE + col0; const float* bu = bg + DE;
        const f32x4 bg0 = *(const f32x4*)bg, bg1 = *(const f32x4*)(bg + 4), bu0 = *(const f32x4*)bu, bu1 = *(const f32x4*)(bu + 4);
#pragma unroll
        for (int ai = 0; ai < 2; ++ai)
#pragma unroll
            for (int m = 0; m < 4; ++m) { bf16_t* rowp = O + (size_t)(row0 + ai * HALF + m * 16) * DE + col0;
                float o[8];
#pragma unroll
                for (int n = 0; n < 2; ++n) { const f32x4 g4 = acc[ai][0][m][n] + (n ? bg1 : bg0), u4 = acc[ai][1][m][n] + (n ? bu1 : bu0);
#pragma unroll
                    for (int j = 0; j < 4; ++j) { const float g = fminf(g4[j], 7.f), up = fminf(fmaxf(u4[j], -7.f), 7.f);
                        o[n * 4 + j] = g * (up + 1.f) / (1.f + __expf(-1.702f * g)); } }
                u32x4 w; w.x = cvt_pk_bf16(o[0], o[1]); w.y = cvt_pk_bf16(o[2], o[3]); w.z = cvt_pk_bf16(o[4], o[5]); w.w = cvt_pk_bf16(o[6], o[7]);
                *(u32x4*)rowp = w; }
    }
};
struct EpiMoeOut {
    static constexpr bool PERM = true;
    bf16_t* O; const float* b2; const float* sg;
    __device__ __forceinline__ void operator()(const f32x4 (&acc)[2][2][4][2], const Unit& u, int wr, int wc, int fr, int fq) const {
        const int e = u.pn >> 3, ct = u.pn & 7;
        const int row0 = u.pm * BM + wr * 64 + fr, col0 = ct * BM + wc * 32 + 8 * fq;
        f32x4 bv[2][2];
#pragma unroll
        for (int bj = 0; bj < 2; ++bj)
#pragma unroll
            for (int n = 0; n < 2; ++n) bv[bj][n] = *(const f32x4*)(b2 + (size_t)e * D + col0 + bj * HALF + 4 * n);
#pragma unroll
        for (int ai = 0; ai < 2; ++ai)
#pragma unroll
            for (int m = 0; m < 4; ++m) { const int row = row0 + ai * HALF + m * 16; const float gt = sg[row]; bf16_t* rowp = O + (size_t)row * D + col0;
#pragma unroll
                for (int bj = 0; bj < 2; ++bj) { const f32x4 v0 = (acc[ai][bj][m][0] + bv[bj][0]) * gt, v1 = (acc[ai][bj][m][1] + bv[bj][1]) * gt;
                    u32x4 w; w.x = cvt_pk_bf16(v0[0], v0[1]); w.y = cvt_pk_bf16(v0[2], v0[3]); w.z = cvt_pk_bf16(v1[0], v1[1]); w.w = cvt_pk_bf16(v1[2], v1[3]);
                    *(u32x4*)(rowp + bj * HALF) = w; } }
    }
};

template <class Epi, class Sched, class ARows, bool ALIGN_EPI>
__device__ __forceinline__ void gemm_phase(LAS unsigned char* lds, const bf16_t* A, const bf16_t* Bt, const Sched& S, const Epi& E, const ARows& AR) {
    const int tid = threadIdx.x, wid = __builtin_amdgcn_readfirstlane(tid >> 6), lane = tid & 63, wr = wid >> 2, wc = wid & 3, fr = lane & 15, fq = lane >> 4;
    constexpr int K = KD, nt = K / BK;
    int sR[2], sC[2]; unsigned voffB[2];
#pragma unroll
    for (int i = 0; i < 2; ++i) { stage_rc(tid * 16 + i * 8192, sR[i], sC[i]); const int Rb = Epi::PERM ? ((sR[i] & ~31) + perm32(sR[i] & 31)) : sR[i];
        voffB[i] = (unsigned)(Rb * K + sC[i]) * 2u; }
    constexpr size_t kstep = (size_t)(BK * 2);
    constexpr size_t hstep = (size_t)HALF * K * 2;
    constexpr size_t tstep = 2 * hstep;
    const unsigned ldsw = (unsigned)wid * 1024u;
    const int aoff = lds_byte(wr * 64 + fr, fq * 8), boff = lds_byte(wc * 32 + fr, fq * 8);
#define PG8_SA(b, h) (((b) * 2 + (h)) * HTB)
#define PG8_SB(b, h) ((4 + (b) * 2 + (h)) * HTB)
#define PG8_STAGE(bufoff, gbase, voff) do { _Pragma("unroll") for (int _i = 0; _i < 2; ++_i) \
        __builtin_amdgcn_global_load_lds((const unsigned*)((const char*)(gbase) + (voff)[_i]), (LAS unsigned*)(lds + (bufoff) + ldsw + _i * 8192), 16, 0, 0); } while (0)
#define PG8_LDA(dst, b, h) do { _Pragma("unroll") for (int m = 0; m < 4; ++m) _Pragma("unroll") for (int k = 0; k < 2; ++k) dst[m][k] = *(const LAS bf16x8*)(lds + PG8_SA(b, h) + aoff + m * 2048 + k * 1024); } while (0)
#define PG8_LDB(dst, b, h) do { _Pragma("unroll") for (int n = 0; n < 2; ++n) _Pragma("unroll") for (int k = 0; k < 2; ++k) dst[n][k] = *(const LAS bf16x8*)(lds + PG8_SB(b, h) + boff + n * 2048 + k * 1024); } while (0)
#define PG8_MMA(ai, bj, At, Bt_) do { __builtin_amdgcn_s_setprio(1); _Pragma("unroll") for (int m = 0; m < 4; ++m) _Pragma("unroll") for (int n = 0; n < 2; ++n) _Pragma("unroll") for (int k = 0; k < 2; ++k) \
        acc[ai][bj][m][n] = __builtin_amdgcn_mfma_f32_16x16x32_bf16(Bt_[n][k], At[m][k], acc[ai][bj][m][n], 0, 0, 0); __builtin_amdgcn_s_setprio(0); } while (0)
#define PG8_WAIT_V(n) asm volatile("s_waitcnt vmcnt(" #n ")" ::: "memory")
#define PG8_WAIT_L(n) asm volatile("s_waitcnt lgkmcnt(" #n ")" ::: "memory")
#define PG8_BAR __builtin_amdgcn_s_barrier()
#define PG8_SCHED __builtin_amdgcn_sched_barrier(0)
#define PG8_AOFF(dst, u) do { _Pragma("unroll") for (int _h = 0; _h < 2; ++_h) _Pragma("unroll") for (int _i = 0; _i < 2; ++_i) \
        dst[_h][_i] = (AR.row((u).pm, _h * HALF + sR[_i]) * (unsigned)K + (unsigned)sC[_i]) * 2u; } while (0)
    Unit cur, nxt; int ui = 0;
    if (!S.next(0, cur)) return;
    f32x4 acc[2][2][4][2];
#pragma unroll
    for (int a = 0; a < 2; ++a)
#pragma unroll
        for (int b = 0; b < 2; ++b)
#pragma unroll
            for (int m = 0; m < 4; ++m)
#pragma unroll
                for (int n = 0; n < 2; ++n) acc[a][b][m][n] = (f32x4){0.f, 0.f, 0.f, 0.f};
    bf16x8 At[4][2], B0[2][2], B1[2][2];
    unsigned ao[2][2], an[2][2];
    PG8_AOFF(ao, cur);
    const char* cA = (const char*)A;
    const char* cB = (const char*)Bt + (size_t)cur.pn * tstep;
    PG8_STAGE(PG8_SB(0, 0), cB, voffB); PG8_STAGE(PG8_SB(0, 1), cB + hstep, voffB); PG8_STAGE(PG8_SA(0, 0), cA, ao[0]); PG8_STAGE(PG8_SA(0, 1), cA, ao[1]);
    if (wr == 1) PG8_BAR;
    PG8_WAIT_V(2); PG8_BAR;
    PG8_STAGE(PG8_SB(1, 0), cB + kstep, voffB); PG8_STAGE(PG8_SA(1, 0), cA + kstep, ao[0]); PG8_STAGE(PG8_SB(1, 1), cB + hstep + kstep, voffB);
    PG8_WAIT_V(6); PG8_BAR;
    for (;;) {
        const bool has_next = S.next(ui + 1, nxt);
        if (has_next) { PG8_AOFF(an, nxt); } else {
#pragma unroll
            for (int h = 0; h < 2; ++h)
#pragma unroll
                for (int i = 0; i < 2; ++i) an[h][i] = ao[h][i]; }
        const char* nB = has_next ? (const char*)Bt + (size_t)nxt.pn * tstep : cB;
        for (int t = 0; t < nt; t += 2) {
            const bool last = (t == nt - 2);
            const char* a1 = cA + (size_t)(t + 1) * kstep;
            const char* a2 = last ? cA : cA + (size_t)(t + 2) * kstep; const char* b2 = last ? nB : cB + (size_t)(t + 2) * kstep;
            const char* a3 = a2 + kstep; const char* b3 = b2 + kstep;
            unsigned o2[2][2];
#pragma unroll
            for (int h = 0; h < 2; ++h)
#pragma unroll
                for (int i = 0; i < 2; ++i) o2[h][i] = last ? an[h][i] : ao[h][i];
            PG8_LDB(B0, 0, 0); PG8_LDB(B1, 0, 1); PG8_SCHED; PG8_LDA(At, 0, 0); PG8_STAGE(PG8_SA(1, 1), a1, ao[1]);
            PG8_WAIT_V(8); PG8_WAIT_L(0); PG8_BAR; PG8_MMA(0, 0, At, B0); PG8_MMA(0, 1, At, B1); PG8_BAR; PG8_SCHED;
            PG8_LDA(At, 0, 1); PG8_STAGE(PG8_SB(0, 0), b2, voffB); PG8_STAGE(PG8_SB(0, 1), b2 + hstep, voffB); PG8_STAGE(PG8_SA(0, 0), a2, o2[0]);
            PG8_WAIT_V(8); PG8_WAIT_L(0); PG8_BAR; PG8_MMA(1, 0, At, B0); PG8_MMA(1, 1, At, B1); PG8_BAR; PG8_SCHED;
            PG8_LDB(B0, 1, 0); PG8_LDB(B1, 1, 1); PG8_SCHED; PG8_LDA(At, 1, 0); PG8_STAGE(PG8_SA(0, 1), a2, o2[1]);
            PG8_WAIT_V(8); PG8_WAIT_L(0); PG8_BAR; PG8_MMA(0, 0, At, B0); PG8_MMA(0, 1, At, B1); PG8_BAR; PG8_SCHED;
            PG8_LDA(At, 1, 1); PG8_STAGE(PG8_SB(1, 0), b3, voffB); PG8_STAGE(PG8_SB(1, 1), b3 + hstep, voffB); PG8_STAGE(PG8_SA(1, 0), a3, o2[0]);
            PG8_WAIT_V(8); PG8_WAIT_L(0); PG8_BAR; PG8_MMA(1, 0, At, B0); PG8_MMA(1, 1, At, B1); PG8_BAR; PG8_SCHED;
        }
        if constexpr (ALIGN_EPI) { if (wr == 0) PG8_BAR; }
        E(acc, cur, wr, wc, fr, fq);
        if (!has_next) break;
#pragma unroll
        for (int a = 0; a < 2; ++a)
#pragma unroll
            for (int b = 0; b < 2; ++b)
#pragma unroll
                for (int m = 0; m < 4; ++m)
#pragma unroll
                    for (int n = 0; n < 2; ++n) acc[a][b][m][n] = (f32x4){0.f, 0.f, 0.f, 0.f};
        cur = nxt; cB = nB; ++ui;
#pragma unroll
        for (int h = 0; h < 2; ++h)
#pragma unroll
            for (int i = 0; i < 2; ++i) ao[h][i] = an[h][i];
        if constexpr (ALIGN_EPI) { if (wr == 1) PG8_BAR; }
    }
    PG8_WAIT_V(0);
    if constexpr (!ALIGN_EPI) { if (wr == 0) PG8_BAR; }
    PG8_BAR;
#undef PG8_SA
#undef PG8_SB
#undef PG8_STAGE
#undef PG8_LDA
#undef PG8_LDB
#undef PG8_MMA
#undef PG8_WAIT_V
#undef PG8_WAIT_L
#undef PG8_BAR
#undef PG8_SCHED
#undef PG8_AOFF
}
}

constexpr int NWAVES = 8, NTHREADS = 512;
constexpr int NPHASE = 11;
struct Args {
    const float* in[33]; float* out; unsigned char* ws; int ph_lo, ph_hi, use_bar, pad;
};
enum { I_X = 0, I_LNG, I_LNB, I_WIN, I_CONVW, I_CONVB, I_WRG, I_BRG, I_WIG, I_BIG, I_LAMBDA, I_MU, I_W0, I_DECUP, I_A0, I_AAAUP, I_GATEUP,
       I_KK, I_KA, I_RK, I_GNG, I_GNB, I_WOUT, I_LN1G, I_LN1B, I_WROUTER, I_BROUTER, I_WE1, I_BE1, I_WE2, I_BE2, I_LN2G, I_LN2B };

__device__ __forceinline__ void transpose_item(const float* W, int N, bf16_t* WT, int k0, int n0, int dst_row0, LAS float* scr, int lane) {
#pragma unroll 8
    for (int i = 0; i < 32; ++i) { const int kk = 2 * i + (lane >> 5); scr[kk * 33 + (lane & 31)] = W[(size_t)(k0 + kk) * N + n0 + (lane & 31)]; }
    asm volatile("s_waitcnt lgkmcnt(0)" ::: "memory");
    const int c = lane & 7;
#pragma unroll
    for (int j = 0; j < 4; ++j) { const int n = (lane >> 3) + 8 * j; const LAS float* s = scr + (8 * c) * 33 + n;
        u32x4 o; o.x = pk2(s[0 * 33], s[1 * 33]); o.y = pk2(s[2 * 33], s[3 * 33]); o.z = pk2(s[4 * 33], s[5 * 33]); o.w = pk2(s[6 * 33], s[7 * 33]);
        *(u32x4*)(WT + (size_t)(dst_row0 + n) * KD + k0 + 8 * c) = o; }
    asm volatile("s_waitcnt lgkmcnt(0)" ::: "memory");
}

__device__ __forceinline__ void moe_tables(volatile LAS int* tb, unsigned* ctl) {
    if (threadIdx.x == 0) {
        int off = 0;
        for (int e = 0; e < NE; ++e) { const int c = (int)__hip_atomic_load(ctl + CW_CNT + 64 * e, RLX_AGENT); const int nt = (c + 255) >> 8;
            tb[1 + e] = off; for (int r = 0; r < nt; ++r) tb[64 + off + r] = e; off += nt; }
        tb[1 + NE] = off; tb[0] = off;
    }
    __syncthreads();
}

__global__ void __launch_bounds__(NTHREADS, 2) fwd(Args args) {
    extern __shared__ __attribute__((aligned(16))) unsigned char lds_raw[];
    LAS unsigned char* lds = (LAS unsigned char*)lds_raw;
    volatile LAS unsigned* MISC = (volatile LAS unsigned*)(lds + MISC_OFF);
    const int tid = threadIdx.x, lane = tid & 63, wave = __builtin_amdgcn_readfirstlane(tid >> 6);
    const int G = gridDim.x, bid = blockIdx.x;
    unsigned char* ws = args.ws;
    unsigned* ctl = (unsigned*)(ws + WS_CTL);
    if (tid < 64) MISC[tid] = 0u;
    __syncthreads();
    XcdBarrier bar; bar.bar = ctl + CW_BAR; bar.x = 0; bar.st = nullptr;
    if (args.use_bar) bar = xcd_barrier_post(ctl + CW_BAR, MISC);
    const int lo = args.ph_lo, hi = args.ph_hi;
#define IN(k) (lo <= (k) && (k) < hi)
#define SEAM(k) do { if (IN(k) && IN((k) + 1)) xcd_barrier(bar); } while (0)
    const int gw = bid * NWAVES + wave, NGW = G * NWAVES;
    const int gt = bid * NTHREADS + tid, NGT = G * NTHREADS;

    bf16_t* WinT = (bf16_t*)(ws + WS_WIN); bf16_t* WoT = (bf16_t*)(ws + WS_WO); bf16_t* W1T = (bf16_t*)(ws + WS_W1); bf16_t* W2T = (bf16_t*)(ws + WS_W2);
    bf16_t* XN = (bf16_t*)(ws + WS_XN); bf16_t* P = (bf16_t*)(ws + WS_P);
    float* LA = (float*)(ws + WS_LA); float* LB = (float*)(ws + WS_LB);
    float* RR = (float*)(ws + WS_RR); float* RW = RR + (size_t)M * RW_W; float* RK = RW + (size_t)M * RW_W; float* RV = RK + (size_t)M * RW_W;
    float* RKK = RV + (size_t)M * RW_W; float* RA = RKK + (size_t)M * RW_W; float* RG = RA + (size_t)M * RW_W;
    float* RY = (float*)(ws + WS_RY); float* BON = (float*)(ws + WS_BON);
    bf16_t* CAT = (bf16_t*)(ws + WS_CAT); float* Z = (float*)(ws + WS_Z); float* H1 = (float*)(ws + WS_H1); bf16_t* H1B = (bf16_t*)(ws + WS_H1B);
    int* TOPE = (int*)(ws + WS_TOPE); int* TOPP = (int*)(ws + WS_TOPP); float* TOPG = (float*)(ws + WS_TOPG); int* TOKSLOT = (int*)(ws + WS_TOKSLOT);
    int* SLOTTOK = (int*)(ws + WS_SLOTTOK); float* SLOTG = (float*)(ws + WS_SLOTG);
    bf16_t* ACT = (bf16_t*)(ws + WS_ACT); bf16_t* OUTS = (bf16_t*)(ws + WS_OUTS);

    if (IN(0)) {
        LAS float* scr = (LAS float*)(lds + wave * 16384);
        constexpr int I_IN = (KD / 64) * (NP / 32), I_OUT = (KD / 64) * (D / 32), I_E1 = (KD / 64) * (2 * DE / 32), I_E2 = (DE / 64) * (D / 32);
        constexpr int NITEMS = I_IN + I_OUT + NE * I_E1 + NE * I_E2;
        for (int it = gw; it < NITEMS; it += NGW) {
            int r = it;
            if (r < I_IN) { const int nb = NP / 32, kb = r / nb, n0 = (r % nb) * 32; transpose_item(args.in[I_WIN], NP, WinT, kb * 64, n0, n0, scr, lane); continue; } r -= I_IN;
            if (r < I_OUT) { const int nb = D / 32, kb = r / nb, n0 = (r % nb) * 32; transpose_item(args.in[I_WOUT], D, WoT, kb * 64, n0, n0, scr, lane); continue; } r -= I_OUT;
            if (r < NE * I_E1) { const int e = r / I_E1, q = r % I_E1, nb = 2 * DE / 32, kb = q / nb, n0 = (q % nb) * 32;
                const int isup = n0 >= DE ? 1 : 0, nn = n0 - isup * DE, drow = 256 * (nn >> 7) + 128 * isup + (nn & 127);
                transpose_item(args.in[I_WE1] + (size_t)e * KD * 2 * DE, 2 * DE, W1T + (size_t)e * 2 * DE * KD, kb * 64, n0, drow, scr, lane); continue; } r -= NE * I_E1;
            { const int e = r / I_E2, q = r % I_E2, nb = D / 32, kb = q / nb, n0 = (q % nb) * 32;
                transpose_item(args.in[I_WE2] + (size_t)e * DE * D, D, W2T + (size_t)e * D * DE, kb * 64, n0, n0, scr, lane); }
        }
        for (int i = gt; i < (NPP - NP) * KD / 8; i += NGT) ((u32x4*)(WinT + (size_t)NP * KD))[i] = (u32x4){0u, 0u, 0u, 0u};
        const float* lg = args.in[I_LNG]; const float* lb = args.in[I_LNB];
        for (int m = gw; m < M; m += NGW) {
            const f32x4* xr = (const f32x4*)(args.in[I_X] + (size_t)m * D) + lane;
            f32x4 v[8]; float s = 0.f;
#pragma unroll
            for (int j = 0; j < 8; ++j) { v[j] = xr[64 * j]; s += (v[j][0] + v[j][1]) + (v[j][2] + v[j][3]); }
            const float mean = wave_sum(s) * (1.f / D); float s2 = 0.f;
#pragma unroll
            for (int j = 0; j < 8; ++j) { v[j] = v[j] - mean; s2 += (v[j][0] * v[j][0] + v[j][1] * v[j][1]) + (v[j][2] * v[j][2] + v[j][3] * v[j][3]); }
            const float rstd = 1.f / sqrtf(wave_sum(s2) * (1.f / D) + LN_EPS);
            u32x2* o8 = (u32x2*)(XN + (size_t)m * D) + lane;
#pragma unroll
            for (int j = 0; j < 8; ++j) { const f32x4 g4 = ((const f32x4*)lg)[64 * j + lane], b4 = ((const f32x4*)lb)[64 * j + lane]; const f32x4 y = v[j] * rstd * g4 + b4;
                u32x2 w; w.x = pk2(y[0], y[1]); w.y = pk2(y[2], y[3]); o8[64 * j] = w; }
        }
    }
    SEAM(0);

    if (IN(1)) {
        pg8::StaticOrder S; S.init(M, NPP, G, bid);
        pg8::EpiBf16 E{P, NPP};
        pg8::gemm_phase<pg8::EpiBf16, pg8::StaticOrder, pg8::DenseRows, true>(lds, XN, WinT, S, E, pg8::DenseRows{});
    }
    SEAM(1);

    if (IN(2)) {
        LAS float* ucT = (LAS float*)lds;
        LAS float* xl = (LAS float*)(lds + 65536);
        const float* conv_w = args.in[I_CONVW]; const float* conv_b = args.in[I_CONVB];
        const float* w_rg = args.in[I_WRG]; const float* w_ig = args.in[I_WIG];
        const float* mu = args.in[I_MU];
        for (int tile = bid; tile < M / 16; tile += G) {
            const int t0 = tile * 16, tin = t0 % SEQ;
            __syncthreads();
#pragma unroll
            for (int cc = 0; cc < 2; ++cc) { const int c = tid + 512 * cc;
                const float w0 = conv_w[c], w1 = conv_w[LRU_W + c], w2 = conv_w[2 * LRU_W + c], w3 = conv_w[3 * LRU_W + c], cb = conv_b[c];
                float u[19];
#pragma unroll
                for (int j = 0; j < 19; ++j) { const int tt = tin - 3 + j; u[j] = tt >= 0 ? bf2f(P[(size_t)(t0 - 3 + j) * NPP + c]) : 0.f; }
#pragma unroll
                for (int tb = 0; tb < 16; ++tb) ucT[c * 16 + tb] = w0 * u[tb] + w1 * u[tb + 1] + w2 * u[tb + 2] + w3 * u[tb + 3] + cb; }
            for (int idx = tid; idx < 448 * 16; idx += NTHREADS) { const int j = idx >> 4, tb = idx & 15; const int col = 3 * RW_W + j;
                const size_t pr = (size_t)(t0 + tb) * NPP + 2 * LRU_W + col;
                const float pc = bf2f(P[pr]), pp = (tin + tb) > 0 ? bf2f(P[pr - NPP]) : 0.f; const float s = pc + (pp - pc) * mu[col];
                xl[j * 16 + tb] = j < 96 ? tanhf(s) : (j < 192 ? s : sigmoidf_(s)); }
            __syncthreads();
#pragma unroll 1
            for (int cc = 0; cc < 2; ++cc) { const int c = tid + 512 * cc, nb = c >> 6, kc = c & 63;
                float ar[16], ai[16];
#pragma unroll
                for (int tb = 0; tb < 16; ++tb) { ar[tb] = 0.f; ai[tb] = 0.f; }
                for (int j = 0; j < 64; ++j) { const float wr_ = w_rg[(size_t)(nb * 64 + j) * 64 + kc], wi_ = w_ig[(size_t)(nb * 64 + j) * 64 + kc];
                    const LAS f32x4* up = (const LAS f32x4*)(ucT + (nb * 64 + j) * 16);
#pragma unroll
                    for (int q = 0; q < 4; ++q) { const f32x4 u4 = up[q];
#pragma unroll
                        for (int e = 0; e < 4; ++e) { ar[q * 4 + e] += wr_ * u4[e]; ai[q * 4 + e] += wi_ * u4[e]; } } }
                const float br = args.in[I_BRG][c], bi = args.in[I_BIG][c], lam = args.in[I_LAMBDA][c];
                const float sp = lam > 15.f ? __expf(-lam) : log1pf(__expf(-lam));
#pragma unroll
                for (int tb = 0; tb < 16; ++tb) { const float rg = sigmoidf_(ar[tb] + br), ig = sigmoidf_(ai[tb] + bi);
                    const float la = -8.f * rg * sp, a = __expf(la), b = sqrtf(fmaxf(-expm1f(2.f * la), 0.f)) * (ig * ucT[c * 16 + tb]);
                    LA[(size_t)(t0 + tb) * LRU_W + c] = a; LB[(size_t)(t0 + tb) * LRU_W + c] = b; } }
#pragma unroll 1
            for (int cc = 0; cc < 2; ++cc) { const int c = tid + 512 * cc;
                float dw[16], da[16], dg[16];
#pragma unroll
                for (int tb = 0; tb < 16; ++tb) { dw[tb] = 0.f; da[tb] = 0.f; dg[tb] = 0.f; }
                for (int j = 0; j < 96; ++j) { const float w_ = args.in[I_DECUP][(size_t)j * RW_W + c], a_ = args.in[I_AAAUP][(size_t)j * RW_W + c];
                    const LAS f32x4* xw = (const LAS f32x4*)(xl + j * 16); const LAS f32x4* xa = (const LAS f32x4*)(xl + (96 + j) * 16);
#pragma unroll
                    for (int q = 0; q < 4; ++q) { const f32x4 a4 = xw[q], b4 = xa[q];
#pragma unroll
                        for (int e = 0; e < 4; ++e) { dw[q * 4 + e] += w_ * a4[e]; da[q * 4 + e] += a_ * b4[e]; } } }
                for (int j = 0; j < 256; ++j) { const float g_ = args.in[I_GATEUP][(size_t)j * RW_W + c];
                    const LAS f32x4* xg = (const LAS f32x4*)(xl + (192 + j) * 16);
#pragma unroll
                    for (int q = 0; q < 4; ++q) { const f32x4 a4 = xg[q];
#pragma unroll
                        for (int e = 0; e < 4; ++e) dg[q * 4 + e] += g_ * a4[e]; } }
                const float w0c = args.in[I_W0][c], a0c = args.in[I_A0][c], kkc = args.in[I_KK][c], kac = args.in[I_KA][c], rkc = args.in[I_RK][c];
                const float mur = mu[c], muk = mu[RW_W + c], muv = mu[2 * RW_W + c];
                const int head = c >> 6;
#pragma unroll 1
                for (int tb = 0; tb < 16; ++tb) { const size_t pr = (size_t)(t0 + tb) * NPP + 2 * LRU_W + c; const bool hp = (tin + tb) > 0;
                    const float rc = bf2f(P[pr]), kc_ = bf2f(P[pr + RW_W]), vc = bf2f(P[pr + 2 * RW_W]);
                    const float rp = hp ? bf2f(P[pr - NPP]) : 0.f, kp = hp ? bf2f(P[pr - NPP + RW_W]) : 0.f, vp = hp ? bf2f(P[pr - NPP + 2 * RW_W]) : 0.f;
                    const float r = rc + (rp - rc) * mur, k = kc_ + (kp - kc_) * muk, v = vc + (vp - vc) * muv;
                    const float xw_ = w0c + dw[tb];
                    const float decay = __expf(-0.6065306597126334f * sigmoidf_(xw_));
                    const float a = sigmoidf_(a0c + da[tb]);
                    float kk = k * kkc; const float nrm = sqrtf(wave_sum(kk * kk)); kk = kk / fmaxf(nrm, 1e-12f);
                    const float km = k * (1.f + (a - 1.f) * kac);
                    const float bon = wave_sum(r * km * rkc);
                    const size_t o = (size_t)(t0 + tb) * RW_W + c;
                    RR[o] = r; RW[o] = decay; RK[o] = km; RV[o] = v; RKK[o] = kk; RA[o] = a; RG[o] = dg[tb];
                    if (lane == 0) BON[(size_t)(t0 + tb) * NHEAD + head] = bon; } }
        }
    }
    SEAM(2);

    if (IN(3)) {
        if (gw < BATCH * NHEAD) {
            const int b = gw / NHEAD, h = gw % NHEAD; const size_t base = (size_t)b * SEQ * RW_W + h * HS + lane;
            float s[64];
#pragma unroll
            for (int k = 0; k < 64; ++k) s[k] = 0.f;
            float nr = RR[base], nw = RW[base], nk = RK[base], nv = RV[base], nkk = RKK[base], na = RA[base];
            for (int t = 0; t < SEQ; ++t) {
                const float cr = nr, cw = nw, ck = nk, cv = nv, ckk = nkk, cka = nkk * na;
                if (t + 1 < SEQ) { const size_t o = base + (size_t)(t + 1) * RW_W; nr = RR[o]; nw = RW[o]; nk = RK[o]; nv = RV[o]; nkk = RKK[o]; na = RA[o]; }
                float d0 = 0.f, d1 = 0.f, d2 = 0.f, d3 = 0.f;
#pragma unroll
                for (int k = 0; k < 64; k += 4) {
                    d0 += s[k] * __builtin_bit_cast(float, __builtin_amdgcn_readlane(__builtin_bit_cast(int, ckk), k));
                    d1 += s[k + 1] * __builtin_bit_cast(float, __builtin_amdgcn_readlane(__builtin_bit_cast(int, ckk), k + 1));
                    d2 += s[k + 2] * __builtin_bit_cast(float, __builtin_amdgcn_readlane(__builtin_bit_cast(int, ckk), k + 2));
                    d3 += s[k + 3] * __builtin_bit_cast(float, __builtin_amdgcn_readlane(__builtin_bit_cast(int, ckk), k + 3)); }
                const float skk = (d0 + d1) + (d2 + d3);
                float y0 = 0.f, y1 = 0.f;
#pragma unroll
                for (int k = 0; k < 64; k += 2) {
#pragma unroll
                    for (int q = 0; q < 2; ++q) {
                        const float wk = __builtin_bit_cast(float, __builtin_amdgcn_readlane(__builtin_bit_cast(int, cw), k + q));
                        const float bk = __builtin_bit_cast(float, __builtin_amdgcn_readlane(__builtin_bit_cast(int, cka), k + q));
                        const float kk_ = __builtin_bit_cast(float, __builtin_amdgcn_readlane(__builtin_bit_cast(int, ck), k + q));
                        const float rk_ = __builtin_bit_cast(float, __builtin_amdgcn_readlane(__builtin_bit_cast(int, cr), k + q));
                        const float ns = s[k + q] * wk - skk * bk + cv * kk_;
                        s[k + q] = ns;
                        if (q == 0) y0 += ns * rk_; else y1 += ns * rk_; } }
                RY[base + (size_t)t * RW_W] = y0 + y1;
            }
        }
        if (bid >= 8 && bid < 16) {
            const int i = (bid - 8) * NTHREADS + tid, b = i / LRU_W, c = i % LRU_W; const size_t base = (size_t)b * SEQ * LRU_W + c;
            float h = 0.f;
            for (int t = 0; t < SEQ; t += 8) {
                float a[8], bb[8];
#pragma unroll
                for (int j = 0; j < 8; ++j) { a[j] = LA[base + (size_t)(t + j) * LRU_W]; bb[j] = LB[base + (size_t)(t + j) * LRU_W]; }
#pragma unroll
                for (int j = 0; j < 8; ++j) { h = a[j] * h + bb[j]; LB[base + (size_t)(t + j) * LRU_W] = h; }
            }
        }
    }
    SEAM(3);

    if (IN(4)) {
        for (int i = gt; i < M * LRU_W; i += NGT) { const int m = i >> 10, c = i & 1023;
            const float g = bf2f(P[(size_t)m * NPP + LRU_W + c]);
            CAT[(size_t)m * D + c] = (bf16_t)f2bf(LB[i] * gelu_tanh(g)); }
        const float* gng = args.in[I_GNG]; const float* gnb = args.in[I_GNB];
        for (int i = gw; i < M * NHEAD; i += NGW) { const int m = i >> 4, h = i & 15, c = h * HS + lane; const size_t o = (size_t)m * RW_W + c;
            const float y = RY[o]; const float mu_ = wave_sum(y) * (1.f / 64.f); const float d = y - mu_; const float var = wave_sum(d * d) * (1.f / 64.f);
            float yn = d * (1.f / sqrtf(var + GN_EPS)) * gng[c] + gnb[c];
            yn += BON[i] * RV[o];
            CAT[(size_t)m * D + LRU_W + c] = (bf16_t)f2bf(yn * RG[o]); }
    }
    SEAM(4);

    if (IN(5)) {
        pg8::StaticOrder S; S.init(M, D, G, bid);
        pg8::EpiResF32 E{Z, XN, DN_ALPHA};
        pg8::gemm_phase<pg8::EpiResF32, pg8::StaticOrder, pg8::DenseRows, true>(lds, CAT, WoT, S, E, pg8::DenseRows{});
    }
    SEAM(5);

    if (IN(6)) {
        LAS float* hT = (LAS float*)lds;
        LAS float* part = (LAS float*)lds;
        LAS float* lgt = (LAS float*)(lds + 65536);
        const float* g1 = args.in[I_LN1G]; const float* b1 = args.in[I_LN1B]; const float* wr_ = args.in[I_WROUTER]; const float* br_ = args.in[I_BROUTER];
        for (int tile = bid; tile < M / 16; tile += G) {
            const int t0 = tile * 16;
            __syncthreads();
#pragma unroll 1
            for (int rr = 0; rr < 2; ++rr) { const int tb = wave * 2 + rr, m = t0 + tb;
                const f32x4* zr = (const f32x4*)(Z + (size_t)m * D) + lane;
                f32x4 v[8]; float s = 0.f;
#pragma unroll
                for (int j = 0; j < 8; ++j) { v[j] = zr[64 * j]; s += (v[j][0] + v[j][1]) + (v[j][2] + v[j][3]); }
                const float mean = wave_sum(s) * (1.f / D); float s2 = 0.f;
#pragma unroll
                for (int j = 0; j < 8; ++j) { v[j] = v[j] - mean; s2 += (v[j][0] * v[j][0] + v[j][1] * v[j][1]) + (v[j][2] * v[j][2] + v[j][3] * v[j][3]); }
                const float rstd = 1.f / sqrtf(wave_sum(s2) * (1.f / D) + LN_EPS);
                f32x4* ho = (f32x4*)(H1 + (size_t)m * D) + lane; u32x2* hb = (u32x2*)(H1B + (size_t)m * D) + lane;
#pragma unroll
                for (int j = 0; j < 8; ++j) { const f32x4 g4 = ((const f32x4*)g1)[64 * j + lane], b4 = ((const f32x4*)b1)[64 * j + lane]; const f32x4 y = v[j] * rstd * g4 + b4;
                    ho[64 * j] = y; u32x2 w; w.x = pk2(y[0], y[1]); w.y = pk2(y[2], y[3]); hb[64 * j] = w;
#pragma unroll
                    for (int q = 0; q < 4; ++q) hT[(256 * j + 4 * lane + q) * 16 + tb] = y[q]; } }
            __syncthreads();
            float ac[16];
#pragma unroll
            for (int tb = 0; tb < 16; ++tb) ac[tb] = 0.f;
            { const int e = tid & 31, sl = tid >> 5;
                for (int i = sl * 128; i < sl * 128 + 128; ++i) { const float w = wr_[(size_t)i * NE + e]; const LAS f32x4* hp = (const LAS f32x4*)(hT + i * 16);
#pragma unroll
                    for (int q = 0; q < 4; ++q) { const f32x4 h4 = hp[q];
#pragma unroll
                        for (int k = 0; k < 4; ++k) ac[q * 4 + k] += w * h4[k]; } }
                __syncthreads();
#pragma unroll
                for (int tb = 0; tb < 16; ++tb) part[(sl * 16 + tb) * 32 + e] = ac[tb]; }
            __syncthreads();
            { const int tb = tid >> 5, e = tid & 31; float sacc = br_[e];
#pragma unroll
                for (int sl = 0; sl < 16; ++sl) sacc += part[(sl * 16 + tb) * 32 + e];
                lgt[tb * 32 + e] = sacc; }
            __syncthreads();
            if (tid < 16) { const int m = t0 + tid; float bv[4]; int bi[4]; unsigned used = 0u;
#pragma unroll 1
                for (int k = 0; k < 4; ++k) { float best = -3.0e38f; int be = 0;
                    for (int e = 0; e < NE; ++e) { const float x = lgt[tid * 32 + e]; if (!((used >> e) & 1u) && x > best) { best = x; be = e; } }
                    used |= 1u << be; bv[k] = best; bi[k] = be; }
                float ex[4], den = 0.f;
#pragma unroll
                for (int k = 0; k < 4; ++k) { ex[k] = __expf(bv[k] - bv[0]); den += ex[k]; }
#pragma unroll 1
                for (int k = 0; k < 4; ++k) { const int pos = (int)__hip_atomic_fetch_add(ctl + CW_CNT + 64 * bi[k], 1u, RLX_AGENT);
                    TOPE[m * 4 + k] = bi[k]; TOPP[m * 4 + k] = pos; TOPG[m * 4 + k] = ex[k] / den; } }
        }
    }
    SEAM(6);

    if (IN(7)) {
        volatile LAS int* tb = (volatile LAS int*)(MISC + 16);
        moe_tables(tb, ctl);
        for (int i = gt; i < M * TOPK; i += NGT) { const int e = TOPE[i], slot = tb[1 + e] * 256 + TOPP[i];
            SLOTTOK[slot] = i >> 2; SLOTG[slot] = TOPG[i]; TOKSLOT[i] = slot; }
        if (bid < NE) { const int e = bid, c = (int)__hip_atomic_load(ctl + CW_CNT + 64 * e, RLX_AGENT), s0 = tb[1 + e] * 256 + c, s1 = tb[2 + e] * 256;
            for (int s = s0 + tid; s < s1; s += NTHREADS) { SLOTTOK[s] = 0; SLOTG[s] = 0.f; } }
    }
    SEAM(7);

    if (IN(8)) {
        volatile LAS int* tb = (volatile LAS int*)(MISC + 16);
        moe_tables(tb, ctl);
        pg8::MoeOrder S{(const LAS int*)(tb + 64), tb[0], 16, G, bid};
        pg8::EpiSwiglu E{ACT, args.in[I_BE1]};
        pg8::gemm_phase<pg8::EpiSwiglu, pg8::MoeOrder, pg8::GatherRows, true>(lds, H1B, W1T, S, E, pg8::GatherRows{SLOTTOK});
    }
    SEAM(8);

    if (IN(9)) {
        volatile LAS int* tb = (volatile LAS int*)(MISC + 16);
        moe_tables(tb, ctl);
        pg8::MoeOrder S{(const LAS int*)(tb + 64), tb[0], 8, G, bid};
        pg8::EpiMoeOut E{OUTS, args.in[I_BE2], SLOTG};
        pg8::gemm_phase<pg8::EpiMoeOut, pg8::MoeOrder, pg8::DenseRows, true>(lds, ACT, W2T, S, E, pg8::DenseRows{});
    }
    SEAM(9);

    if (IN(10)) {
        const float* g2 = args.in[I_LN2G]; const float* b2 = args.in[I_LN2B];
        for (int m = gw; m < M; m += NGW) {
            const f32x4* hr = (const f32x4*)(H1 + (size_t)m * D) + lane;
            const int s0 = TOKSLOT[m * 4], s1 = TOKSLOT[m * 4 + 1], s2_ = TOKSLOT[m * 4 + 2], s3 = TOKSLOT[m * 4 + 3];
            const u32x2* o0 = (const u32x2*)(OUTS + (size_t)s0 * D) + lane; const u32x2* o1 = (const u32x2*)(OUTS + (size_t)s1 * D) + lane;
            const u32x2* o2 = (const u32x2*)(OUTS + (size_t)s2_ * D) + lane; const u32x2* o3 = (const u32x2*)(OUTS + (size_t)s3 * D) + lane;
            f32x4 v[8]; float s = 0.f;
#pragma unroll
            for (int j = 0; j < 8; ++j) { const f32x4 h4 = hr[64 * j]; const u32x2 a = o0[64 * j], b = o1[64 * j], c = o2[64 * j], d = o3[64 * j];
                f32x4 mo; mo[0] = (bflo(a.x) + bflo(b.x)) + (bflo(c.x) + bflo(d.x)); mo[1] = (bfhi(a.x) + bfhi(b.x)) + (bfhi(c.x) + bfhi(d.x));
                mo[2] = (bflo(a.y) + bflo(b.y)) + (bflo(c.y) + bflo(d.y)); mo[3] = (bfhi(a.y) + bfhi(b.y)) + (bfhi(c.y) + bfhi(d.y));
                v[j] = h4 * DN_ALPHA + mo; s += (v[j][0] + v[j][1]) + (v[j][2] + v[j][3]); }
            const float mean = wave_sum(s) * (1.f / D); float q2 = 0.f;
#pragma unroll
            for (int j = 0; j < 8; ++j) { v[j] = v[j] - mean; q2 += (v[j][0] * v[j][0] + v[j][1] * v[j][1]) + (v[j][2] * v[j][2] + v[j][3] * v[j][3]); }
            const float rstd = 1.f / sqrtf(wave_sum(q2) * (1.f / D) + LN_EPS);
            f32x4* orow = (f32x4*)(args.out + (size_t)m * D) + lane;
#pragma unroll
            for (int j = 0; j < 8; ++j) { const f32x4 g4 = ((const f32x4*)g2)[64 * j + lane], b4 = ((const f32x4*)b2)[64 * j + lane]; orow[64 * j] = v[j] * rstd * g4 + b4; }
        }
    }
#undef IN
#undef SEAM
}

#ifndef MK_ONE_LAUNCH
#define MK_ONE_LAUNCH 1
#endif
extern "C" void kernel_launch(void* const* d_in, const int* in_sizes, int n_in, void* d_out, int out_size, void* d_ws, size_t ws_size, hipStream_t stream) {
    static int grid = 0;
    if (grid == 0) {
        if (n_in != 33 || out_size != M * D || ws_size < WS_END) { fprintf(stderr, "kernel_launch: unexpected sizes n_in %d out %d ws %zu (need %zu)\n", n_in, out_size, ws_size, (size_t)WS_END); grid = -1; return; }
        int dev = 0, cus = 0, per_cu = 0;
        if (hipGetDevice(&dev) != hipSuccess || hipDeviceGetAttribute(&cus, hipDeviceAttributeMultiprocessorCount, dev) != hipSuccess) { grid = -1; return; }
        if (hipFuncSetAttribute((const void*)fwd, hipFuncAttributeMaxDynamicSharedMemorySize, LDS_BYTES) != hipSuccess) { fprintf(stderr, "kernel_launch: hipFuncSetAttribute failed\n"); grid = -1; return; }
        if (hipOccupancyMaxActiveBlocksPerMultiprocessor(&per_cu, (const void*)fwd, NTHREADS, LDS_BYTES) != hipSuccess || per_cu < 1) fprintf(stderr, "kernel_launch: occupancy query says %d\n", per_cu);
        (void)hipGetLastError();
        grid = cus;
    }
    if (grid < 0) return;
    (void)hipMemsetAsync((char*)d_ws + WS_CTL, 0, CTL_ZERO_BYTES, stream);
    Args a{};
    for (int i = 0; i < 33; ++i) a.in[i] = (const float*)d_in[i];
    a.out = (float*)d_out; a.ws = (unsigned char*)d_ws;
#if MK_ONE_LAUNCH
    a.ph_lo = 0; a.ph_hi = NPHASE; a.use_bar = 1;
    hipLaunchKernelGGL(fwd, dim3(grid), dim3(NTHREADS), LDS_BYTES, stream, a);
#else
    for (int p = 0; p < NPHASE; ++p) { a.ph_lo = p; a.ph_hi = p + 1; a.use_bar = 0;
        hipLaunchKernelGGL(fwd, dim3(grid), dim3(NTHREADS), LDS_BYTES, stream, a); }
#endif
}
```

```cpp
#include <hip/hip_runtime.h>
#include <cstdio>
#include <cstdint>

#define LAS __attribute__((address_space(3)))
#define GAS __attribute__((address_space(1)))
typedef unsigned short bf16_t;
typedef short bf16x8 __attribute__((ext_vector_type(8)));
typedef float f32x4 __attribute__((ext_vector_type(4)));
typedef float f32x2 __attribute__((ext_vector_type(2)));
typedef unsigned u32x4 __attribute__((ext_vector_type(4)));
typedef unsigned u32x2 __attribute__((ext_vector_type(2)));
typedef float f32x16 __attribute__((ext_vector_type(16)));
typedef __bf16 bfv2 __attribute__((ext_vector_type(2)));
#define MFMA32(a, b, c) __builtin_amdgcn_mfma_f32_32x32x16_bf16((a), (b), (c), 0, 0, 0)

constexpr int BATCH = 4, SEQ = 4096, M = BATCH * SEQ, D = 2048;
constexpr int LRU_W = 1024, RW_W = 1024, NHEAD = 16, HS = 64;
constexpr int DLORA = 96, ALORA = 96, GLORA = 256;
constexpr int RW_SHIFT_W = 3 * RW_W + DLORA + ALORA + GLORA;
constexpr int NP = 2 * LRU_W + RW_SHIFT_W;
constexpr int NPP = 5632;
constexpr int NE = 32, TOPK = 4, DE = 2048;
constexpr int NSLOT_MAX = M * TOPK + NE * 256;
constexpr int NTILE_MAX = NSLOT_MAX / 256;
constexpr float LN_EPS = 1e-5f, GN_EPS = 64e-5f;
constexpr float DN_ALPHA = 1.189207115002721f;
constexpr int KD = 2048;

constexpr size_t MiB = 1u << 20;
constexpr size_t WS_CTL = 0, CTL_ZERO_BYTES = 1 * MiB;
constexpr size_t WS_WIN = 2 * MiB;
constexpr size_t WS_WO = WS_WIN + (size_t)NPP * KD * 2;
constexpr size_t WS_W1 = WS_WO + (size_t)D * KD * 2;
constexpr size_t WS_W2 = WS_W1 + (size_t)NE * 2 * DE * KD * 2;
constexpr size_t WS_XN = WS_W2 + (size_t)NE * D * DE * 2;
constexpr size_t WS_P = WS_XN + (size_t)M * D * 2;
constexpr size_t WS_LA = WS_P + (size_t)M * NPP * 2;
constexpr size_t WS_LB = WS_LA + (size_t)M * LRU_W * 4;
constexpr size_t WS_RR = WS_LB + (size_t)M * LRU_W * 4;
constexpr size_t WS_RWS = (size_t)M * RW_W * 4;
constexpr size_t WS_RY = WS_RR + 7 * WS_RWS;
constexpr size_t WS_BON = WS_RY + WS_RWS;
constexpr size_t WS_CAT = WS_BON + (size_t)M * NHEAD * 4;
constexpr size_t WS_Z = WS_CAT + (size_t)M * D * 2;
constexpr size_t WS_H1 = WS_Z + (size_t)M * D * 4;
constexpr size_t WS_H1B = WS_H1 + (size_t)M * D * 4;
constexpr size_t WS_TOPE = WS_H1B + (size_t)M * D * 2;
constexpr size_t WS_TOPP = WS_TOPE + (size_t)M * TOPK * 4;
constexpr size_t WS_TOPG = WS_TOPP + (size_t)M * TOPK * 4;
constexpr size_t WS_TOKSLOT = WS_TOPG + (size_t)M * TOPK * 4;
constexpr size_t WS_SLOTTOK = WS_TOKSLOT + (size_t)M * TOPK * 4;
constexpr size_t WS_SLOTG = WS_SLOTTOK + (size_t)NSLOT_MAX * 4;
constexpr size_t WS_ACT = WS_SLOTG + (size_t)NSLOT_MAX * 4;
constexpr size_t WS_OUTS = WS_ACT + (size_t)NSLOT_MAX * DE * 2;
constexpr int NUNIT = BATCH * NHEAD * (SEQ / 64);
constexpr size_t WS_MT = WS_OUTS + (size_t)NSLOT_MAX * D * 2;
constexpr size_t WS_GG = WS_MT + (size_t)NUNIT * 8192;
constexpr size_t WS_XS = WS_GG + (size_t)NUNIT * 8192;
constexpr size_t WS_NN = WS_XS + (size_t)NUNIT * 8192;
constexpr size_t WS_HH = WS_NN + (size_t)NUNIT * 16384;
constexpr size_t WS_CA = WS_HH + (size_t)NUNIT * 16384;
constexpr size_t WS_CH = WS_CA + (size_t)BATCH * 64 * LRU_W * 4;
constexpr size_t WS_CIN = WS_CH + (size_t)BATCH * 64 * LRU_W * 4;
constexpr size_t WS_END = WS_CIN + (size_t)BATCH * 64 * LRU_W * 4;
constexpr int CW_CNT = 1024;
constexpr int CW_BAR = 4096;

constexpr int MISC_OFF = 159744;
constexpr int LDS_BYTES = 163840;

#define RLX_AGENT __ATOMIC_RELAXED, __HIP_MEMORY_SCOPE_AGENT
__device__ __forceinline__ unsigned f2bf(float f) { unsigned u = __builtin_bit_cast(unsigned, f); return (u + 0x7fffu + ((u >> 16) & 1u)) >> 16; }
__device__ __forceinline__ unsigned pk2(float lo, float hi) { return f2bf(lo) | (f2bf(hi) << 16); }
__device__ __forceinline__ float bf2f(unsigned short b) { return __builtin_bit_cast(float, (unsigned)b << 16); }
__device__ __forceinline__ float bflo(unsigned w) { return __builtin_bit_cast(float, w << 16); }
__device__ __forceinline__ float bfhi(unsigned w) { return __builtin_bit_cast(float, w & 0xffff0000u); }
__device__ __forceinline__ unsigned cvt2(float a, float b) { const f32x2 v = {a, b}; return __builtin_bit_cast(unsigned, __builtin_convertvector(v, bfv2)); }
__device__ __forceinline__ unsigned short cvt1(float a) { return (unsigned short)(cvt2(a, 0.f) & 0xffffu); }
__device__ __forceinline__ int crow(int reg, int h) { return (reg & 3) + 8 * (reg >> 2) + 4 * h; }
__device__ __forceinline__ float wave_sum(float v) {
#pragma unroll
    for (int o = 1; o < 64; o <<= 1) v += __shfl_xor(v, o);
    return v;
}
__device__ __forceinline__ float sigmoidf_(float x) { return 1.f / (1.f + __expf(-x)); }
__device__ __forceinline__ float gelu_tanh(float x) { const float u = 0.7978845608028654f * (x + 0.044715f * x * x * x); return 0.5f * x * (1.f + tanhf(u)); }

#define XB_TMO      128
#define XB_XCNT(j)  (256  + 64 * (j))
#define XB_XSUB(j)  (1280 + 64 * (j))
#define XB_XGEN(j)  (2304 + 64 * (j))
#define XB_TOP      3328
#define XB_TOPGEN   3392
#define XCD_BAR_WORDS 3456
#define XB_SPIN_CAP (1u << 18)
__device__ __forceinline__ unsigned xb_ld(unsigned* p)              { return __hip_atomic_load(p, __ATOMIC_RELAXED, __HIP_MEMORY_SCOPE_AGENT); }
__device__ __forceinline__ unsigned xb_add(unsigned* p, unsigned v) { return __hip_atomic_fetch_add(p, v, __ATOMIC_RELAXED, __HIP_MEMORY_SCOPE_AGENT); }
__device__ __forceinline__ unsigned xb_xcc_id() { return (unsigned)__builtin_amdgcn_s_getreg((3 << 11) | 20) & 0xFu; }
#define XB_SPIN(cond, bar) do { unsigned _sp = 0; while (cond) { __builtin_amdgcn_s_sleep(1); \
    if ((++_sp & 255u) == 0u) { if (xb_ld(&(bar)[XB_TMO])) break; if (_sp > XB_SPIN_CAP) { atomicAdd(&(bar)[XB_TMO], 1u); break; } } } } while (0)
struct XcdBarrier { unsigned* bar; unsigned x; volatile LAS unsigned* st; };
__device__ __forceinline__ XcdBarrier xcd_barrier_post(unsigned* bar, volatile LAS unsigned* st) {
    XcdBarrier b; b.bar = bar; b.x = xb_xcc_id(); b.st = st;
    if (threadIdx.x == 0) (void)xb_add(&bar[XB_XCNT(b.x)], 1u);
    return b;
}
__device__ __forceinline__ void xcd_barrier_complete(unsigned* bar, unsigned x, unsigned& nloc, unsigned& nx) {
    const unsigned G = gridDim.x * gridDim.y * gridDim.z;
    unsigned sum, cnt, mine, sp = 0u;
    for (;;) {
        sum = 0u; cnt = 0u; mine = 0u;
#pragma unroll
        for (unsigned j = 0; j < 16; ++j) { const unsigned c = xb_ld(&bar[XB_XCNT(j)]); sum += c; cnt += (c > 0u) ? 1u : 0u; mine = (j == x) ? c : mine; }
        if (sum == G) break;
        __builtin_amdgcn_s_sleep(1);
        if ((++sp & 255u) == 0u) { if (xb_ld(&bar[XB_TMO])) break; if (sp > XB_SPIN_CAP) { atomicAdd(&bar[XB_TMO], 1u); break; } }
    }
    nloc = mine > 0u ? mine : 1u; nx = cnt > 0u ? cnt : 1u;
}
__device__ __forceinline__ void xcd_barrier(const XcdBarrier& b) {
    asm volatile("s_waitcnt vmcnt(0)" ::: "memory");
    __syncthreads();
    if (threadIdx.x == 0) {
        unsigned* bar = b.bar;
        __builtin_amdgcn_s_waitcnt(0);
        unsigned nloc = b.st[0], nx = b.st[1];
        if (nloc == 0u) { xcd_barrier_complete(bar, b.x, nloc, nx); b.st[0] = nloc; b.st[1] = nx; }
        const unsigned old = xb_add(&bar[XB_XSUB(b.x)], 1u);
        const unsigned gen = old / nloc;
        if (old + 1u == (gen + 1u) * nloc) {
            __builtin_amdgcn_fence(__ATOMIC_RELEASE, "agent");
            asm volatile("s_waitcnt vmcnt(0)" ::: "memory");
            const unsigned og = xb_add(&bar[XB_TOP], 1u);
            const unsigned tg = og / nx;
            if (og + 1u == (tg + 1u) * nx) xb_add(&bar[XB_TOPGEN], 1u);
            else XB_SPIN(xb_ld(&bar[XB_TOPGEN]) == tg, bar);
            __builtin_amdgcn_fence(__ATOMIC_ACQUIRE, "agent");
            xb_add(&bar[XB_XGEN(b.x)], 1u);
            asm volatile("s_waitcnt vmcnt(0)" ::: "memory");
        } else {
            XB_SPIN(xb_ld(&bar[XB_XGEN(b.x)]) == gen, bar);
            __builtin_amdgcn_fence(__ATOMIC_ACQUIRE, "agent");
            asm volatile("s_waitcnt vmcnt(0)" ::: "memory");
        }
    }
    __syncthreads();
}

namespace pg8 {
constexpr int BM = 256, BK = 64, HALF = 128, HTB = HALF * BK * 2, STAGE_BYTES = 8 * HTB, NXCD = 8, WGM = 8;
__host__ __device__ __forceinline__ int lds_byte(int r, int c) { const int st = (r >> 4) * 2 + (c >> 5), rr = r & 15, cc = c & 31, ob = rr * 64 + cc * 2; return st * 1024 + (ob ^ (((ob >> 9) & 1) << 5)); }
__host__ __device__ __forceinline__ void stage_rc(int b, int& R, int& C) { const int st = b / 1024, sb = b % 1024, swz = sb ^ (((sb >> 9) & 1) << 5); R = (st >> 1) * 16 + swz / 64; C = (st & 1) * 32 + (swz % 64) / 2; }
__host__ __device__ __forceinline__ int perm32(int rho) { const int n = rho >> 4, i = rho & 15; return 8 * (i >> 2) + 4 * n + (i & 3); }
struct Unit { int pm, pn; };
__device__ __forceinline__ unsigned cvt_pk_bf16(float lo, float hi) { unsigned r; asm volatile("v_cvt_pk_bf16_f32 %0, %1, %2" : "=v"(r) : "v"(lo), "v"(hi)); return r; }

struct StaticOrder {
    int nM, nN, nwg, G, c;
    __device__ void init(int M_, int N_, int G_, int c_) { nM = M_ / BM; nN = N_ / BM; nwg = nM * nN; G = G_; c = c_; }
    __device__ bool next(int i, Unit& u) const {
        const long L = (long)i * G + c; if (L >= nwg) return false;
        int wgid = (int)L; { const int q = nwg / NXCD, r = nwg % NXCD, xcd = wgid % NXCD, off = wgid / NXCD; wgid = (xcd < r ? xcd * (q + 1) : r * (q + 1) + (xcd - r) * q) + off; }
        const int nig = WGM * nN, gid = wgid / nig, fm = gid * WGM, gsz = (nM - fm) < WGM ? (nM - fm) : WGM;
        u.pm = fm + ((wgid % nig) % gsz); u.pn = (wgid % nig) / gsz; return true;
    }
};
struct MoeOrder {
    const LAS int* tile_e; int R, NCT, G, c;
    __device__ bool next(int i, Unit& u) const {
        int rt, ct;
        if (G == 256) { const int x = c & 7, j = c >> 3;
            if (NCT == 16) { rt = 16 * i + (x >> 1) * 4 + (j >> 3); ct = (x & 1) * 8 + (j & 7); }
            else           { rt = 32 * i + 4 * x + (j >> 3); ct = j & 7; } }
        else { const long L = (long)i * G + c; rt = (int)(L / NCT); ct = (int)(L % NCT); }
        if (rt >= R) return false;
        u.pm = rt; u.pn = tile_e[rt] * NCT + ct; return true;
    }
};
struct DenseRows { __device__ __forceinline__ unsigned row(int pm, int r) const { return (unsigned)(pm * BM + r); } };
struct GatherRows { const int* idx; __device__ __forceinline__ unsigned row(int pm, int r) const { return (unsigned)idx[pm * BM + r]; } };

struct EpiBf16 {
    static constexpr bool PERM = true;
    bf16_t* O; int ldc;
    __device__ __forceinline__ void operator()(const f32x4 (&acc)[2][2][4][2], const Unit& u, int wr, int wc, int fr, int fq) const {
        const int row0 = u.pm * BM + wr * 64 + fr, col0 = u.pn * BM + wc * 32 + 8 * fq;
#pragma unroll
        for (int ai = 0; ai < 2; ++ai)
#pragma unroll
            for (int m = 0; m < 4; ++m) { bf16_t* rowp = O + (size_t)(row0 + ai * HALF + m * 16) * ldc + col0;
#pragma unroll
                for (int bj = 0; bj < 2; ++bj) { const f32x4 v0 = acc[ai][bj][m][0], v1 = acc[ai][bj][m][1];
                    u32x4 w; w.x = cvt_pk_bf16(v0[0], v0[1]); w.y = cvt_pk_bf16(v0[2], v0[3]); w.z = cvt_pk_bf16(v1[0], v1[1]); w.w = cvt_pk_bf16(v1[2], v1[3]);
                    *(u32x4*)(rowp + bj * HALF) = w; } }
    }
};
struct EpiResF32 {
    static constexpr bool PERM = false;
    float* Z; const bf16_t* R; float alpha;
    __device__ __forceinline__ void operator()(const f32x4 (&acc)[2][2][4][2], const Unit& u, int wr, int wc, int fr, int fq) const {
        const int row0 = u.pm * BM + wr * 64 + fr, col0 = u.pn * BM + wc * 32 + 4 * fq;
#pragma unroll
        for (int ai = 0; ai < 2; ++ai)
#pragma unroll
            for (int m = 0; m < 4; ++m) { const size_t off = (size_t)(row0 + ai * HALF + m * 16) * D + col0;
#pragma unroll
                for (int bj = 0; bj < 2; ++bj)
#pragma unroll
                    for (int n = 0; n < 2; ++n) { const u32x2 rb = *(const u32x2*)(R + off + bj * HALF + n * 16);
                        f32x4 o = acc[ai][bj][m][n]; o[0] += alpha * bflo(rb.x); o[1] += alpha * bfhi(rb.x); o[2] += alpha * bflo(rb.y); o[3] += alpha * bfhi(rb.y);
                        *(f32x4*)(Z + off + bj * HALF + n * 16) = o; } }
    }
};
struct EpiSwiglu {
    static constexpr bool PERM = true;
    bf16_t* O; const float* b1;
    __device__ __forceinline__ void operator()(const f32x4 (&acc)[2][2][4][2], const Unit& u, int wr, int wc, int fr, int fq) const {
        const int e = u.pn >> 4, ct = u.pn & 15;
        const int row0 = u.pm * BM + wr * 64 + fr, cin = wc * 32 + 8 * fq, col0 = ct * HALF + cin;
        const float* bg = b1 + (size_t)e * 2 * DE + col0; const float* bu = bg + DE;
        const f32x4 bg0 = *(const f32x4*)bg, bg1 = *(const f32x4*)(bg + 4), bu0 = *(const f32x4*)bu, bu1 = *(const f32x4*)(bu + 4);
#pragma unroll
        for (int ai = 0; ai < 2; ++ai)
#pragma unroll
            for (int m = 0; m < 4; ++m) { bf16_t* rowp = O + (size_t)(row0 + ai * HALF + m * 16) * DE + col0;
                float o[8];
#pragma unroll
                for (int n = 0; n < 2; ++n) { const f32x4 g4 = acc[ai][0][m][n] + (n ? bg1 : bg0), u4 = acc[ai][1][m][n] + (n ? bu1 : bu0);
#pragma unroll
                    for (int j = 0; j < 4; ++j) { const float g = fminf(g4[j], 7.f), up = fminf(fmaxf(u4[j], -7.f), 7.f);
                        o[n * 4 + j] = g * (up + 1.f) / (1.f + __expf(-1.702f * g)); } }
                u32x4 w; w.x = cvt_pk_bf16(o[0], o[1]); w.y = cvt_pk_bf16(o[2], o[3]); w.z = cvt_pk_bf16(o[4], o[5]); w.w = cvt_pk_bf16(o[6], o[7]);
                *(u32x4*)rowp = w; }
    }
};
struct EpiMoeOut {
    static constexpr bool PERM = true;
    bf16_t* O; const float* b2; const float* sg;
    __device__ __forceinline__ void operator()(const f32x4 (&acc)[2][2][4][2], const Unit& u, int wr, int wc, int fr, int fq) const {
        const int e = u.pn >> 3, ct = u.pn & 7;
        const int row0 = u.pm * BM + wr * 64 + fr, col0 = ct * BM + wc * 32 + 8 * fq;
        f32x4 bv[2][2];
#pragma unroll
        for (int bj = 0; bj < 2; ++bj)
#pragma unroll
            for (int n = 0; n < 2; ++n) bv[bj][n] = *(const f32x4*)(b2 + (size_t)e * D + col0 + bj * HALF + 4 * n);
#pragma unroll
        for (int ai = 0; ai < 2; ++ai)
#pragma unroll
            for (int m = 0; m < 4; ++m) { const int row = row0 + ai * HALF + m * 16; const float gt = sg[row]; bf16_t* rowp = O + (size_t)row * D + col0;
#pragma unroll
                for (int bj = 0; bj < 2; ++bj) { const f32x4 v0 = (acc[ai][bj][m][0] + bv[bj][0]) * gt, v1 = (acc[ai][bj][m][1] + bv[bj][1]) * gt;
                    u32x4 w; w.x = cvt_pk_bf16(v0[0], v0[1]); w.y = cvt_pk_bf16(v0[2], v0[3]); w.z = cvt_pk_bf16(v1[0], v1[1]); w.w = cvt_pk_bf16(v1[2], v1[3]);
                    *(u32x4*)(rowp + bj * HALF) = w; } }
    }
};

template <class Epi, class Sched, class ARows, bool ALIGN_EPI>
__device__ __forceinline__ void gemm_phase(LAS unsigned char* lds, const bf16_t* A, const bf16_t* Bt, const Sched& S, const Epi& E, const ARows& AR) {
    const int tid = threadIdx.x, wid = __builtin_amdgcn_readfirstlane(tid >> 6), lane = tid & 63, wr = wid >> 2, wc = wid & 3, fr = lane & 15, fq = lane >> 4;
    constexpr int K = KD, nt = K / BK;
    int sR[2], sC[2]; unsigned voffB[2];
#pragma unroll
    for (int i = 0; i < 2; ++i) { stage_rc(tid * 16 + i * 8192, sR[i], sC[i]); const int Rb = Epi::PERM ? ((sR[i] & ~31) + perm32(sR[i] & 31)) : sR[i];
        voffB[i] = (unsigned)(Rb * K + sC[i]) * 2u; }
    constexpr size_t kstep = (size_t)(BK * 2);
    constexpr size_t hstep = (size_t)HALF * K * 2;
    constexpr size_t tstep = 2 * hstep;
    const unsigned ldsw = (unsigned)wid * 1024u;
    const int aoff = lds_byte(wr * 64 + fr, fq * 8), boff = lds_byte(wc * 32 + fr, fq * 8);
#define PG8_SA(b, h) (((b) * 2 + (h)) * HTB)
#define PG8_SB(b, h) ((4 + (b) * 2 + (h)) * HTB)
#define PG8_STAGE(bufoff, gbase, voff) do { _Pragma("unroll") for (int _i = 0; _i < 2; ++_i) \
        __builtin_amdgcn_global_load_lds((const unsigned*)((const char*)(gbase) + (voff)[_i]), (LAS unsigned*)(lds + (bufoff) + ldsw + _i * 8192), 16, 0, 0); } while (0)
#define PG8_LDA(dst, b, h) do { _Pragma("unroll") for (int m = 0; m < 4; ++m) _Pragma("unroll") for (int k = 0; k < 2; ++k) dst[m][k] = *(const LAS bf16x8*)(lds + PG8_SA(b, h) + aoff + m * 2048 + k * 1024); } while (0)
#define PG8_LDB(dst, b, h) do { _Pragma("unroll") for (int n = 0; n < 2; ++n) _Pragma("unroll") for (int k = 0; k < 2; ++k) dst[n][k] = *(const LAS bf16x8*)(lds + PG8_SB(b, h) + boff + n * 2048 + k * 1024); } while (0)
#define PG8_MMA(ai, bj, At, Bt_) do { __builtin_amdgcn_s_setprio(1); _Pragma("unroll") for (int m = 0; m < 4; ++m) _Pragma("unroll") for (int n = 0; n < 2; ++n) _Pragma("unroll") for (int k = 0; k < 2; ++k) \
        acc[ai][bj][m][n] = __builtin_amdgcn_mfma_f32_16x16x32_bf16(Bt_[n][k], At[m][k], acc[ai][bj][m][n], 0, 0, 0); __builtin_amdgcn_s_setprio(0); } while (0)
#define PG8_WAIT_V(n) asm volatile("s_waitcnt vmcnt(" #n ")" ::: "memory")
#define PG8_WAIT_L(n) asm volatile("s_waitcnt lgkmcnt(" #n ")" ::: "memory")
#define PG8_BAR __builtin_amdgcn_s_barrier()
#define PG8_SCHED __builtin_amdgcn_sched_barrier(0)
#define PG8_AOFF(dst, u) do { _Pragma("unroll") for (int _h = 0; _h < 2; ++_h) _Pragma("unroll") for (int _i = 0; _i < 2; ++_i) \
        dst[_h][_i] = (AR.row((u).pm, _h * HALF + sR[_i]) * (unsigned)K + (unsigned)sC[_i]) * 2u; } while (0)
    Unit cur, nxt; int ui = 0;
    if (!S.next(0, cur)) return;
    f32x4 acc[2][2][4][2];
#pragma unroll
    for (int a = 0; a < 2; ++a)
#pragma unroll
        for (int b = 0; b < 2; ++b)
#pragma unroll
            for (int m = 0; m < 4; ++m)
#pragma unroll
                for (int n = 0; n < 2; ++n) acc[a][b][m][n] = (f32x4){0.f, 0.f, 0.f, 0.f};
    bf16x8 At[4][2], B0[2][2], B1[2][2];
    unsigned ao[2][2], an[2][2];
    PG8_AOFF(ao, cur);
    const char* cA = (const char*)A;
    const char* cB = (const char*)Bt + (size_t)cur.pn * tstep;
    PG8_STAGE(PG8_SB(0, 0), cB, voffB); PG8_STAGE(PG8_SB(0, 1), cB + hstep, voffB); PG8_STAGE(PG8_SA(0, 0), cA, ao[0]); PG8_STAGE(PG8_SA(0, 1), cA, ao[1]);
    if (wr == 1) PG8_BAR;
    PG8_WAIT_V(2); PG8_BAR;
    PG8_STAGE(PG8_SB(1, 0), cB + kstep, voffB); PG8_STAGE(PG8_SA(1, 0), cA + kstep, ao[0]); PG8_STAGE(PG8_SB(1, 1), cB + hstep + kstep, voffB);
    PG8_WAIT_V(6); PG8_BAR;
    for (;;) {
        const bool has_next = S.next(ui + 1, nxt);
        if (has_next) { PG8_AOFF(an, nxt); } else {
#pragma unroll
            for (int h = 0; h < 2; ++h)
#pragma unroll
                for (int i = 0; i < 2; ++i) an[h][i] = ao[h][i]; }
        const char* nB = has_next ? (const char*)Bt + (size_t)nxt.pn * tstep : cB;
        for (int t = 0; t < nt; t += 2) {
            const bool last = (t == nt - 2);
            const char* a1 = cA + (size_t)(t + 1) * kstep;
            const char* a2 = last ? cA : cA + (size_t)(t + 2) * kstep; const char* b2 = last ? nB : cB + (size_t)(t + 2) * kstep;
            const char* a3 = a2 + kstep; const char* b3 = b2 + kstep;
            unsigned o2[2][2];
#pragma unroll
            for (int h = 0; h < 2; ++h)
#pragma unroll
                for (int i = 0; i < 2; ++i) o2[h][i] = last ? an[h][i] : ao[h][i];
            PG8_LDB(B0, 0, 0); PG8_LDB(B1, 0, 1); PG8_SCHED; PG8_LDA(At, 0, 0); PG8_STAGE(PG8_SA(1, 1), a1, ao[1]);
            PG8_WAIT_V(8); PG8_WAIT_L(0); PG8_BAR; PG8_MMA(0, 0, At, B0); PG8_MMA(0, 1, At, B1); PG8_BAR; PG8_SCHED;
            PG8_LDA(At, 0, 1); PG8_STAGE(PG8_SB(0, 0), b2, voffB); PG8_STAGE(PG8_SB(0, 1), b2 + hstep, voffB); PG8_STAGE(PG8_SA(0, 0), a2, o2[0]);
            PG8_WAIT_V(8); PG8_WAIT_L(0); PG8_BAR; PG8_MMA(1, 0, At, B0); PG8_MMA(1, 1, At, B1); PG8_BAR; PG8_SCHED;
            PG8_LDB(B0, 1, 0); PG8_LDB(B1, 1, 1); PG8_SCHED; PG8_LDA(At, 1, 0); PG8_STAGE(PG8_SA(0, 1), a2, o2[1]);
            PG8_WAIT_V(8); PG8_WAIT_L(0); PG8_BAR; PG8_MMA(0, 0, At, B0); PG8_MMA(0, 1, At, B1); PG8_BAR; PG8_SCHED;
            PG8_LDA(At, 1, 1); PG8_STAGE(PG8_SB(1, 0), b3, voffB); PG8_STAGE(PG8_SB(1, 1), b3 + hstep, voffB); PG8_STAGE(PG8_SA(1, 0), a3, o2[0]);
            PG8_WAIT_V(8); PG8_WAIT_L(0); PG8_BAR; PG8_MMA(1, 0, At, B0); PG8_MMA(1, 1, At, B1); PG8_BAR; PG8_SCHED;
        }
        if constexpr (ALIGN_EPI) { if (wr == 0) PG8_BAR; }
        E(acc, cur, wr, wc, fr, fq);
        if (!has_next) break;
#pragma unroll
        for (int a = 0; a < 2; ++a)
#pragma unroll
            for (int b = 0; b < 2; ++b)
#pragma unroll
                for (int m = 0; m < 4; ++m)
#pragma unroll
                    for (int n = 0; n < 2; ++n) acc[a][b][m][n] = (f32x4){0.f, 0.f, 0.f, 0.f};
        cur = nxt; cB = nB; ++ui;
#pragma unroll
        for (int h = 0; h < 2; ++h)
#pragma unroll
            for (int i = 0; i < 2; ++i) ao[h][i] = an[h][i];
        if constexpr (ALIGN_EPI) { if (wr == 1) PG8_BAR; }
    }
    PG8_WAIT_V(0);
    if constexpr (!ALIGN_EPI) { if (wr == 0) PG8_BAR; }
    PG8_BAR;
#undef PG8_SA
#undef PG8_SB
#undef PG8_STAGE
#undef PG8_LDA
#undef PG8_LDB
#undef PG8_MMA
#undef PG8_WAIT_V
#undef PG8_WAIT_L
#undef PG8_BAR
#undef PG8_SCHED
#undef PG8_AOFF
}
}

constexpr int NWAVES = 8, NTHREADS = 512;
constexpr int NPHASE = 12;
struct Args {
    const float* in[33]; float* out; unsigned char* ws; int ph_lo, ph_hi, use_bar, pad;
};
enum { I_X = 0, I_LNG, I_LNB, I_WIN, I_CONVW, I_CONVB, I_WRG, I_BRG, I_WIG, I_BIG, I_LAMBDA, I_MU, I_W0, I_DECUP, I_A0, I_AAAUP, I_GATEUP,
       I_KK, I_KA, I_RK, I_GNG, I_GNB, I_WOUT, I_LN1G, I_LN1B, I_WROUTER, I_BROUTER, I_WE1, I_BE1, I_WE2, I_BE2, I_LN2G, I_LN2B };

__device__ __forceinline__ void transpose_item(const float* W, int N, bf16_t* WT, int k0, int n0, int dst_row0, LAS float* scr, int lane) {
#pragma unroll 8
    for (int i = 0; i < 32; ++i) { const int kk = 2 * i + (lane >> 5); scr[kk * 33 + (lane & 31)] = W[(size_t)(k0 + kk) * N + n0 + (lane & 31)]; }
    asm volatile("s_waitcnt lgkmcnt(0)" ::: "memory");
    const int c = lane & 7;
#pragma unroll
    for (int j = 0; j < 4; ++j) { const int n = (lane >> 3) + 8 * j; const LAS float* s = scr + (8 * c) * 33 + n;
        u32x4 o; o.x = pk2(s[0 * 33], s[1 * 33]); o.y = pk2(s[2 * 33], s[3 * 33]); o.z = pk2(s[4 * 33], s[5 * 33]); o.w = pk2(s[6 * 33], s[7 * 33]);
        *(u32x4*)(WT + (size_t)(dst_row0 + n) * KD + k0 + 8 * c) = o; }
    asm volatile("s_waitcnt lgkmcnt(0)" ::: "memory");
}

__device__ __forceinline__ void moe_tables(volatile LAS int* tb, unsigned* ctl) {
    if (threadIdx.x == 0) {
        int off = 0;
        for (int e = 0; e < NE; ++e) { const int c = (int)__hip_atomic_load(ctl + CW_CNT + 64 * e, RLX_AGENT); const int nt = (c + 255) >> 8;
            tb[1 + e] = off; for (int r = 0; r < nt; ++r) tb[64 + off + r] = e; off += nt; }
        tb[1 + NE] = off; tb[0] = off;
    }
    __syncthreads();
}

__global__ void __launch_bounds__(NTHREADS, 2) fwd(Args args) {
    extern __shared__ __attribute__((aligned(16))) unsigned char lds_raw[];
    LAS unsigned char* lds = (LAS unsigned char*)lds_raw;
    volatile LAS unsigned* MISC = (volatile LAS unsigned*)(lds + MISC_OFF);
    const int tid = threadIdx.x, lane = tid & 63, wave = __builtin_amdgcn_readfirstlane(tid >> 6);
    const int G = gridDim.x, bid = blockIdx.x;
    unsigned char* ws = args.ws;
    unsigned* ctl = (unsigned*)(ws + WS_CTL);
    if (tid < 64) MISC[tid] = 0u;
    __syncthreads();
    XcdBarrier bar; bar.bar = ctl + CW_BAR; bar.x = 0; bar.st = nullptr;
    if (args.use_bar) bar = xcd_barrier_post(ctl + CW_BAR, MISC);
    const int lo = args.ph_lo, hi = args.ph_hi;
#define IN(k) (lo <= (k) && (k) < hi)
#define SEAM(k) do { if (IN(k) && IN((k) + 1)) xcd_barrier(bar); } while (0)
    const int gw = bid * NWAVES + wave, NGW = G * NWAVES;
    const int gt = bid * NTHREADS + tid, NGT = G * NTHREADS;

    bf16_t* WinT = (bf16_t*)(ws + WS_WIN); bf16_t* WoT = (bf16_t*)(ws + WS_WO); bf16_t* W1T = (bf16_t*)(ws + WS_W1); bf16_t* W2T = (bf16_t*)(ws + WS_W2);
    bf16_t* XN = (bf16_t*)(ws + WS_XN); bf16_t* P = (bf16_t*)(ws + WS_P);
    float* LA = (float*)(ws + WS_LA); float* LB = (float*)(ws + WS_LB);
    float* RR = (float*)(ws + WS_RR); float* RW = RR + (size_t)M * RW_W; float* RK = RW + (size_t)M * RW_W; float* RV = RK + (size_t)M * RW_W;
    float* RKK = RV + (size_t)M * RW_W; float* RA = RKK + (size_t)M * RW_W; float* RG = RA + (size_t)M * RW_W;
    float* RY = (float*)(ws + WS_RY); float* BON = (float*)(ws + WS_BON);
    bf16_t* CAT = (bf16_t*)(ws + WS_CAT); float* Z = (float*)(ws + WS_Z); float* H1 = (float*)(ws + WS_H1); bf16_t* H1B = (bf16_t*)(ws + WS_H1B);
    int* TOPE = (int*)(ws + WS_TOPE); int* TOPP = (int*)(ws + WS_TOPP); float* TOPG = (float*)(ws + WS_TOPG); int* TOKSLOT = (int*)(ws + WS_TOKSLOT);
    int* SLOTTOK = (int*)(ws + WS_SLOTTOK); float* SLOTG = (float*)(ws + WS_SLOTG);
    bf16_t* ACT = (bf16_t*)(ws + WS_ACT); bf16_t* OUTS = (bf16_t*)(ws + WS_OUTS);

    if (IN(0)) {
        LAS float* scr = (LAS float*)(lds + wave * 16384);
        constexpr int I_IN = (KD / 64) * (NP / 32), I_OUT = (KD / 64) * (D / 32), I_E1 = (KD / 64) * (2 * DE / 32), I_E2 = (DE / 64) * (D / 32);
        constexpr int NITEMS = I_IN + I_OUT + NE * I_E1 + NE * I_E2;
        for (int it = gw; it < NITEMS; it += NGW) {
            int r = it;
            if (r < I_IN) { const int nb = NP / 32, kb = r / nb, n0 = (r % nb) * 32; transpose_item(args.in[I_WIN], NP, WinT, kb * 64, n0, n0, scr, lane); continue; } r -= I_IN;
            if (r < I_OUT) { const int nb = D / 32, kb = r / nb, n0 = (r % nb) * 32; transpose_item(args.in[I_WOUT], D, WoT, kb * 64, n0, n0, scr, lane); continue; } r -= I_OUT;
            if (r < NE * I_E1) { const int e = r / I_E1, q = r % I_E1, nb = 2 * DE / 32, kb = q / nb, n0 = (q % nb) * 32;
                const int isup = n0 >= DE ? 1 : 0, nn = n0 - isup * DE, drow = 256 * (nn >> 7) + 128 * isup + (nn & 127);
                transpose_item(args.in[I_WE1] + (size_t)e * KD * 2 * DE, 2 * DE, W1T + (size_t)e * 2 * DE * KD, kb * 64, n0, drow, scr, lane); continue; } r -= NE * I_E1;
            { const int e = r / I_E2, q = r % I_E2, nb = D / 32, kb = q / nb, n0 = (q % nb) * 32;
                transpose_item(args.in[I_WE2] + (size_t)e * DE * D, D, W2T + (size_t)e * D * DE, kb * 64, n0, n0, scr, lane); }
        }
        for (int i = gt; i < (NPP - NP) * KD / 8; i += NGT) ((u32x4*)(WinT + (size_t)NP * KD))[i] = (u32x4){0u, 0u, 0u, 0u};
        const float* lg = args.in[I_LNG]; const float* lb = args.in[I_LNB];
        for (int m = gw; m < M; m += NGW) {
            const f32x4* xr = (const f32x4*)(args.in[I_X] + (size_t)m * D) + lane;
            f32x4 v[8]; float s = 0.f;
#pragma unroll
            for (int j = 0; j < 8; ++j) { v[j] = xr[64 * j]; s += (v[j][0] + v[j][1]) + (v[j][2] + v[j][3]); }
            const float mean = wave_sum(s) * (1.f / D); float s2 = 0.f;
#pragma unroll
            for (int j = 0; j < 8; ++j) { v[j] = v[j] - mean; s2 += (v[j][0] * v[j][0] + v[j][1] * v[j][1]) + (v[j][2] * v[j][2] + v[j][3] * v[j][3]); }
            const float rstd = 1.f / sqrtf(wave_sum(s2) * (1.f / D) + LN_EPS);
            u32x2* o8 = (u32x2*)(XN + (size_t)m * D) + lane;
#pragma unroll
            for (int j = 0; j < 8; ++j) { const f32x4 g4 = ((const f32x4*)lg)[64 * j + lane], b4 = ((const f32x4*)lb)[64 * j + lane]; const f32x4 y = v[j] * rstd * g4 + b4;
                u32x2 w; w.x = pk2(y[0], y[1]); w.y = pk2(y[2], y[3]); o8[64 * j] = w; }
        }
    }
    SEAM(0);

    if (IN(1)) {
        pg8::StaticOrder S; S.init(M, NPP, G, bid);
        pg8::EpiBf16 E{P, NPP};
        pg8::gemm_phase<pg8::EpiBf16, pg8::StaticOrder, pg8::DenseRows, true>(lds, XN, WinT, S, E, pg8::DenseRows{});
    }
    SEAM(1);

    if (IN(2)) {
        LAS float* ucT = (LAS float*)lds;
        LAS float* xl = (LAS float*)(lds + 65536);
        const float* conv_w = args.in[I_CONVW]; const float* conv_b = args.in[I_CONVB];
        const float* w_rg = args.in[I_WRG]; const float* w_ig = args.in[I_WIG];
        const float* mu = args.in[I_MU];
        for (int tile = bid; tile < M / 16; tile += G) {
            const int t0 = tile * 16, tin = t0 % SEQ;
            __syncthreads();
#pragma unroll
            for (int cc = 0; cc < 2; ++cc) { const int c = tid + 512 * cc;
                const float w0 = conv_w[c], w1 = conv_w[LRU_W + c], w2 = conv_w[2 * LRU_W + c], w3 = conv_w[3 * LRU_W + c], cb = conv_b[c];
                float u[19];
#pragma unroll
                for (int j = 0; j < 19; ++j) { const int tt = tin - 3 + j; u[j] = tt >= 0 ? bf2f(P[(size_t)(t0 - 3 + j) * NPP + c]) : 0.f; }
#pragma unroll
                for (int tb = 0; tb < 16; ++tb) ucT[c * 16 + tb] = w0 * u[tb] + w1 * u[tb + 1] + w2 * u[tb + 2] + w3 * u[tb + 3] + cb; }
            for (int idx = tid; idx < 448 * 16; idx += NTHREADS) { const int j = idx >> 4, tb = idx & 15; const int col = 3 * RW_W + j;
                const size_t pr = (size_t)(t0 + tb) * NPP + 2 * LRU_W + col;
                const float pc = bf2f(P[pr]), pp = (tin + tb) > 0 ? bf2f(P[pr - NPP]) : 0.f; const float s = pc + (pp - pc) * mu[col];
                xl[j * 16 + tb] = j < 96 ? tanhf(s) : (j < 192 ? s : sigmoidf_(s)); }
            __syncthreads();
#pragma unroll 1
            for (int cc = 0; cc < 2; ++cc) { const int c = tid + 512 * cc, nb = c >> 6, kc = c & 63;
                float ar[16], ai[16];
#pragma unroll
                for (int tb = 0; tb < 16; ++tb) { ar[tb] = 0.f; ai[tb] = 0.f; }
                for (int j = 0; j < 64; ++j) { const float wr_ = w_rg[(size_t)(nb * 64 + j) * 64 + kc], wi_ = w_ig[(size_t)(nb * 64 + j) * 64 + kc];
                    const LAS f32x4* up = (const LAS f32x4*)(ucT + (nb * 64 + j) * 16);
#pragma unroll
                    for (int q = 0; q < 4; ++q) { const f32x4 u4 = up[q];
#pragma unroll
                        for (int e = 0; e < 4; ++e) { ar[q * 4 + e] += wr_ * u4[e]; ai[q * 4 + e] += wi_ * u4[e]; } } }
                const float br = args.in[I_BRG][c], bi = args.in[I_BIG][c], lam = args.in[I_LAMBDA][c];
                const float sp = lam > 15.f ? __expf(-lam) : log1pf(__expf(-lam));
#pragma unroll
                for (int tb = 0; tb < 16; ++tb) { const float rg = sigmoidf_(ar[tb] + br), ig = sigmoidf_(ai[tb] + bi);
                    const float la = -8.f * rg * sp, a = __expf(la), b = sqrtf(fmaxf(-expm1f(2.f * la), 0.f)) * (ig * ucT[c * 16 + tb]);
                    LA[(size_t)(t0 + tb) * LRU_W + c] = a; LB[(size_t)(t0 + tb) * LRU_W + c] = b; } }
#pragma unroll 1
            for (int cc = 0; cc < 2; ++cc) { const int c = tid + 512 * cc;
                float dw[16], da[16], dg[16];
#pragma unroll
                for (int tb = 0; tb < 16; ++tb) { dw[tb] = 0.f; da[tb] = 0.f; dg[tb] = 0.f; }
                for (int j = 0; j < 96; ++j) { const float w_ = args.in[I_DECUP][(size_t)j * RW_W + c], a_ = args.in[I_AAAUP][(size_t)j * RW_W + c];
                    const LAS f32x4* xw = (const LAS f32x4*)(xl + j * 16); const LAS f32x4* xa = (const LAS f32x4*)(xl + (96 + j) * 16);
#pragma unroll
                    for (int q = 0; q < 4; ++q) { const f32x4 a4 = xw[q], b4 = xa[q];
#pragma unroll
                        for (int e = 0; e < 4; ++e) { dw[q * 4 + e] += w_ * a4[e]; da[q * 4 + e] += a_ * b4[e]; } } }
                for (int j = 0; j < 256; ++j) { const float g_ = args.in[I_GATEUP][(size_t)j * RW_W + c];
                    const LAS f32x4* xg = (const LAS f32x4*)(xl + (192 + j) * 16);
#pragma unroll
                    for (int q = 0; q < 4; ++q) { const f32x4 a4 = xg[q];
#pragma unroll
                        for (int e = 0; e < 4; ++e) dg[q * 4 + e] += g_ * a4[e]; } }
                const float w0c = args.in[I_W0][c], a0c = args.in[I_A0][c], kkc = args.in[I_KK][c], kac = args.in[I_KA][c], rkc = args.in[I_RK][c];
                const float mur = mu[c], muk = mu[RW_W + c], muv = mu[2 * RW_W + c];
                const int head = c >> 6;
#pragma unroll 1
                for (int tb = 0; tb < 16; ++tb) { const size_t pr = (size_t)(t0 + tb) * NPP + 2 * LRU_W + c; const bool hp = (tin + tb) > 0;
                    const float rc = bf2f(P[pr]), kc_ = bf2f(P[pr + RW_W]), vc = bf2f(P[pr + 2 * RW_W]);
                    const float rp = hp ? bf2f(P[pr - NPP]) : 0.f, kp = hp ? bf2f(P[pr - NPP + RW_W]) : 0.f, vp = hp ? bf2f(P[pr - NPP + 2 * RW_W]) : 0.f;
                    const float r = rc + (rp - rc) * mur, k = kc_ + (kp - kc_) * muk, v = vc + (vp - vc) * muv;
                    const float xw_ = w0c + dw[tb];
                    const float decay = -0.6065306597126334f * sigmoidf_(xw_);
                    const float a = sigmoidf_(a0c + da[tb]);
                    float kk = k * kkc; const float nrm = sqrtf(wave_sum(kk * kk)); kk = kk / fmaxf(nrm, 1e-12f);
                    const float km = k * (1.f + (a - 1.f) * kac);
                    const float bon = wave_sum(r * km * rkc);
                    const size_t o = (size_t)(t0 + tb) * RW_W + c;
                    RR[o] = r; RW[o] = decay; RK[o] = km; RV[o] = v; RKK[o] = kk; RA[o] = a; RG[o] = dg[tb];
                    if (lane == 0) BON[(size_t)(t0 + tb) * NHEAD + head] = bon; } }
        }
    }
    SEAM(2);

    if (IN(3)) {
        constexpr int RS = 144;
        constexpr int L_AT = 0, L_BT = 9216, L_KT = 18432, L_RT = 27648, L_VT = 36864, L_BH = 46080, L_KH = 55296, L_AAB = 64512, L_AAK = 80896, L_ARB = 90112, L_ARK = 99328,
                      L_PT = 108544, L_QT = 117760, L_WC = 126976, L_SEG = 127232, L_XP = 129280, L_U = L_BT, L_MST = L_AT, L_GST = L_BT;
        bf16_t* MT = (bf16_t*)(ws + WS_MT); bf16_t* GG = (bf16_t*)(ws + WS_GG); float* NN = (float*)(ws + WS_NN); float* HH = (float*)(ws + WS_HH);
        const int r = lane & 31, hh = lane >> 5;
        for (int u = bid; u < NUNIT; u += G) {
            const int cch = u & 63, head = (u >> 6) & 15, b = u >> 10; const size_t tok0 = (size_t)b * SEQ + cch * 64;
            { const int ch = lane, tg = wave; const size_t o0 = (tok0 + 8 * tg) * RW_W + head * HS + ch;
                float lw[8], rr_[8], kk_[8], vv_[8], kn_[8], aa_[8];
#pragma unroll
                for (int j = 0; j < 8; ++j) { const size_t o = o0 + (size_t)j * RW_W; lw[j] = RW[o]; rr_[j] = RR[o]; kk_[j] = RK[o]; vv_[j] = RV[o]; kn_[j] = RKK[o]; aa_[j] = RA[o]; }
                float seg = 0.f;
#pragma unroll
                for (int j = 0; j < 8; ++j) seg += lw[j];
                ((LAS float*)(lds + L_SEG))[tg * 64 + ch] = seg;
                __syncthreads();
                float pre = 0.f, tot = 0.f;
#pragma unroll
                for (int g = 0; g < 8; ++g) { const float sg_ = ((LAS float*)(lds + L_SEG))[g * 64 + ch]; tot += sg_; if (g < tg) pre += sg_; }
                if (tg == 0) ((LAS float*)(lds + L_WC))[ch] = __expf(tot);
                float L = pre; unsigned pv[4], pb[4], pk[4]; float tv[8], tb_[8], tk[8];
#pragma unroll
                for (int j = 0; j < 8; ++j) { const float Lex = L; L += lw[j];
                    const float eL = __expf(L), eNL = __expf(-L), eLex = __expf(Lex), eEnd = __expf(tot - L); const float beta = kn_[j] * aa_[j];
                    const int t = 8 * tg + j;
                    *(LAS unsigned short*)(lds + L_AT + t * RS + ch * 2) = cvt1(kn_[j] * eLex);
                    *(LAS unsigned short*)(lds + L_BT + t * RS + ch * 2) = cvt1(beta * eNL);
                    *(LAS unsigned short*)(lds + L_KT + t * RS + ch * 2) = cvt1(kk_[j] * eNL);
                    *(LAS unsigned short*)(lds + L_RT + t * RS + ch * 2) = cvt1(rr_[j] * eL);
                    tv[j] = vv_[j]; tb_[j] = -beta * eEnd; tk[j] = kk_[j] * eEnd; }
#pragma unroll
                for (int j = 0; j < 4; ++j) { pv[j] = cvt2(tv[2 * j], tv[2 * j + 1]); pb[j] = cvt2(tb_[2 * j], tb_[2 * j + 1]); pk[j] = cvt2(tk[2 * j], tk[2 * j + 1]); }
                *(LAS u32x4*)(lds + L_VT + ch * RS + tg * 16) = (u32x4){pv[0], pv[1], pv[2], pv[3]};
                *(LAS u32x4*)(lds + L_BH + ch * RS + tg * 16) = (u32x4){pb[0], pb[1], pb[2], pb[3]};
                *(LAS u32x4*)(lds + L_KH + ch * RS + tg * 16) = (u32x4){pk[0], pk[1], pk[2], pk[3]};
            }
            __syncthreads();
            { const int id = wave >> 1, i = wave & 1; const int X = (id < 2) ? L_AT : L_RT, Y = (id & 1) ? L_KT : L_BT;
                f32x16 acc[2];
#pragma unroll
                for (int q = 0; q < 2; ++q)
#pragma unroll
                    for (int e = 0; e < 16; ++e) acc[q][e] = 0.f;
#pragma unroll
                for (int s = 0; s < 4; ++s) { const bf16x8 a = *(const LAS bf16x8*)(lds + X + (32 * i + r) * RS + (16 * s + 8 * hh) * 2);
#pragma unroll
                    for (int q = 0; q < 2; ++q) { const bf16x8 bb = *(const LAS bf16x8*)(lds + Y + (32 * q + r) * RS + (16 * s + 8 * hh) * 2); acc[q] = MFMA32(a, bb, acc[q]); } }
#pragma unroll
                for (int q = 0; q < 2; ++q)
#pragma unroll
                    for (int e = 0; e < 16; ++e) { const int t = 32 * i + crow(e, hh), sc = 32 * q + r; const bool keep = (id < 2) ? (sc < t) : (sc <= t);
                        float val = keep ? acc[q][e] : 0.f; if (id == 2) val = -val;
                        if (id == 0) ((LAS float*)(lds + L_AAB))[t * 64 + sc] = val;
                        else *(LAS unsigned short*)(lds + L_AAK + (id - 1) * 9216 + t * RS + sc * 2) = cvt1(val); }
            }
            __syncthreads();
            if (wave < 4) { const int i = wave >> 1, q = wave & 1; f32x16 acc;
#pragma unroll
                for (int e = 0; e < 16; ++e) acc[e] = 0.f;
#pragma unroll
                for (int s = 0; s < 4; ++s) { const bf16x8 a = *(const LAS bf16x8*)(lds + L_AAK + (32 * i + r) * RS + (16 * s + 8 * hh) * 2);
                    const bf16x8 bb = *(const LAS bf16x8*)(lds + L_VT + (32 * q + r) * RS + (16 * s + 8 * hh) * 2); acc = MFMA32(a, bb, acc); }
#pragma unroll
                for (int e = 0; e < 16; ++e) ((LAS float*)(lds + L_U))[(32 * i + crow(e, hh)) * 64 + 32 * q + r] = acc[e];
            }
            __syncthreads();
            if (wave == 4 || wave == 5) {
                LAS float* XX = (LAS float*)(lds + ((wave == 4) ? L_XP : L_U));
                if (wave == 4) {
#pragma unroll 8
                    for (int t = 0; t < 64; ++t) XX[t * 64 + lane] = bf2f(*(const LAS unsigned short*)(lds + L_AT + t * RS + lane * 2));
                }
                const LAS float* AB = (const LAS float*)(lds + L_AAB);
#pragma unroll 1
                for (int R = 0; R < 8; ++R) {
                    float acc[8];
#pragma unroll
                    for (int i = 0; i < 8; ++i) acc[i] = XX[(8 * R + i) * 64 + lane];
#pragma unroll 1
                    for (int sb = 0; sb < 2 * R; ++sb) {
                        float xs[4];
#pragma unroll
                        for (int e = 0; e < 4; ++e) xs[e] = XX[(4 * sb + e) * 64 + lane];
#pragma unroll
                        for (int i = 0; i < 8; ++i) { const f32x4 A4 = *(const LAS f32x4*)(AB + (8 * R + i) * 64 + 4 * sb);
                            acc[i] -= (A4[0] * xs[0] + A4[1] * xs[1]) + (A4[2] * xs[2] + A4[3] * xs[3]); }
                    }
#pragma unroll
                    for (int i = 1; i < 8; ++i) { const f32x4 A0 = *(const LAS f32x4*)(AB + (8 * R + i) * 64 + 8 * R), A1 = *(const LAS f32x4*)(AB + (8 * R + i) * 64 + 8 * R + 4);
                        float s_ = 0.f;
#pragma unroll
                        for (int j = 0; j < 8; ++j) if (j < i) s_ += (j < 4 ? A0[j] : A1[j - 4]) * acc[j];
                        acc[i] -= s_; }
#pragma unroll
                    for (int i = 0; i < 8; ++i) XX[(8 * R + i) * 64 + lane] = acc[i];
                }
                const int dst = (wave == 4) ? L_PT : L_QT;
#pragma unroll 1
                for (int g = 0; g < 8; ++g) { float x[8];
#pragma unroll
                    for (int j = 0; j < 8; ++j) x[j] = XX[(8 * g + j) * 64 + lane];
                    *(LAS u32x4*)(lds + dst + lane * RS + g * 16) = (u32x4){cvt2(x[0], x[1]), cvt2(x[2], x[3]), cvt2(x[4], x[5]), cvt2(x[6], x[7])}; }
            }
            __syncthreads();
            { const int mtx = wave >> 1, i = wave & 1;
                const int X1 = (mtx == 0) ? L_BH : (mtx == 1) ? L_KH : (mtx == 2) ? L_ARB : L_ARK;
                const int Y1 = (mtx == 0 || mtx == 2) ? L_PT : L_VT;
                f32x16 acc[2];
#pragma unroll
                for (int q = 0; q < 2; ++q)
#pragma unroll
                    for (int e = 0; e < 16; ++e) acc[q][e] = 0.f;
#pragma unroll
                for (int s = 0; s < 4; ++s) { const bf16x8 a = *(const LAS bf16x8*)(lds + X1 + (32 * i + r) * RS + (16 * s + 8 * hh) * 2);
#pragma unroll
                    for (int q = 0; q < 2; ++q) { const bf16x8 bb = *(const LAS bf16x8*)(lds + Y1 + (32 * q + r) * RS + (16 * s + 8 * hh) * 2); acc[q] = MFMA32(a, bb, acc[q]); } }
                if (mtx & 1) { const int X2 = (mtx == 1) ? L_BH : L_ARB;
#pragma unroll
                    for (int s = 0; s < 4; ++s) { const bf16x8 a = *(const LAS bf16x8*)(lds + X2 + (32 * i + r) * RS + (16 * s + 8 * hh) * 2);
#pragma unroll
                        for (int q = 0; q < 2; ++q) { const bf16x8 bb = *(const LAS bf16x8*)(lds + L_QT + (32 * q + r) * RS + (16 * s + 8 * hh) * 2); acc[q] = MFMA32(a, bb, acc[q]); } } }
                if (mtx == 0) { const float wc = ((const LAS float*)(lds + L_WC))[32 * i + r];
#pragma unroll
                    for (int q = 0; q < 2; ++q)
#pragma unroll
                        for (int e = 0; e < 16; ++e) if (q == i && crow(e, hh) == r) acc[q][e] += wc; }
                if (mtx == 2) {
#pragma unroll
                    for (int q = 0; q < 2; ++q)
#pragma unroll
                        for (int e = 0; e < 16; ++e) acc[q][e] += bf2f(*(const LAS unsigned short*)(lds + L_RT + (32 * i + crow(e, hh)) * RS + (32 * q + r) * 2)); }
                if (mtx & 1) { float* dstg = ((mtx == 1) ? NN : HH) + (size_t)u * 4096;
#pragma unroll
                    for (int q = 0; q < 2; ++q)
#pragma unroll
                        for (int e = 0; e < 16; ++e) dstg[((i * 2 + q) * 16 + e) * 64 + lane] = acc[q][e];
                } else { const int dl = (mtx == 0) ? L_MST : L_GST;
#pragma unroll
                    for (int q = 0; q < 2; ++q)
#pragma unroll
                        for (int e = 0; e < 16; ++e) *(LAS unsigned short*)(lds + dl + (32 * i + crow(e, hh)) * RS + (32 * q + r) * 2) = cvt1(acc[q][e]); }
            }
            __syncthreads();
            { const int f = tid >> 6, i = f >> 2, q = (f >> 1) & 1, s = f & 1, r2 = lane & 31, h2 = lane >> 5; const int off = (32 * i + r2) * RS + (32 * q + 16 * s + 4 * h2) * 2;
                const u32x2 m0 = *(const LAS u32x2*)(lds + L_MST + off), m1 = *(const LAS u32x2*)(lds + L_MST + off + 16);
                const u32x2 g0 = *(const LAS u32x2*)(lds + L_GST + off), g1 = *(const LAS u32x2*)(lds + L_GST + off + 16);
                *(u32x4*)(MT + (size_t)u * 4096 + tid * 8) = (u32x4){m0.x, m0.y, m1.x, m1.y};
                *(u32x4*)(GG + (size_t)u * 4096 + tid * 8) = (u32x4){g0.x, g0.y, g1.x, g1.y}; }
            __syncthreads();
        }
        { float* CA = (float*)(ws + WS_CA); float* CH = (float*)(ws + WS_CH);
            for (int bc = bid; bc < BATCH * 64; bc += G) { const size_t tok0 = (size_t)(bc >> 6) * SEQ + (bc & 63) * 64;
#pragma unroll 1
                for (int cc = 0; cc < 2; ++cc) { const int c = tid + 512 * cc; float h = 0.f, A = 1.f;
                    for (int t = 0; t < 64; t += 8) { float a[8], bb[8];
#pragma unroll
                        for (int j = 0; j < 8; ++j) { a[j] = LA[(tok0 + t + j) * LRU_W + c]; bb[j] = LB[(tok0 + t + j) * LRU_W + c]; }
#pragma unroll
                        for (int j = 0; j < 8; ++j) { h = a[j] * h + bb[j]; A *= a[j]; LB[(tok0 + t + j) * LRU_W + c] = h; LA[(tok0 + t + j) * LRU_W + c] = A; } }
                    CA[(size_t)bc * LRU_W + c] = A; CH[(size_t)bc * LRU_W + c] = h; } } }
    }
    SEAM(3);

    if (IN(4)) {
        if (bid < BATCH * NHEAD) {
            const bf16_t* MT = (const bf16_t*)(ws + WS_MT); const float* NN = (const float*)(ws + WS_NN); bf16_t* XS = (bf16_t*)(ws + WS_XS);
            constexpr int SLOT = 24576, NCH = SEQ / 64;
            const int u0 = bid * NCH;
            if (wave >= 2) {
                const int lw = wave - 2;
#define R2_ISSUE(c_) do { const int _u = u0 + (c_); const int _sl = ((c_) & 3) * SLOT; _Pragma("unroll") for (int _rd = 0; _rd < 4; ++_rd) { const int _k0 = _rd * 384 + lw * 64; \
                    const char* _src = (_k0 < 512) ? (const char*)MT + (size_t)_u * 8192 + (size_t)(_k0 + lane) * 16 : (const char*)NN + (size_t)_u * 16384 + (size_t)(_k0 - 512 + lane) * 16; \
                    __builtin_amdgcn_global_load_lds((const unsigned*)_src, (LAS unsigned*)(lds + _sl + _k0 * 16), 16, 0, 0); } } while (0)
                R2_ISSUE(0); R2_ISSUE(1); R2_ISSUE(2);
                for (int c = 0; c < NCH; ++c) {
                    if (c < NCH - 2) asm volatile("s_waitcnt vmcnt(8)" ::: "memory"); else if (c == NCH - 2) asm volatile("s_waitcnt vmcnt(4)" ::: "memory"); else asm volatile("s_waitcnt vmcnt(0)" ::: "memory");
                    __builtin_amdgcn_s_barrier();
                    asm volatile("" ::: "memory");
                    if (c + 3 < NCH) R2_ISSUE(c + 3);
                }
#undef R2_ISSUE
            } else {
                const int vh = wave;
                f32x16 X[2];
#pragma unroll
                for (int q = 0; q < 2; ++q)
#pragma unroll
                    for (int e = 0; e < 16; ++e) X[q][e] = 0.f;
                for (int c = 0; c < NCH; ++c) {
                    bf16x8 xb[2][2];
#pragma unroll
                    for (int q = 0; q < 2; ++q)
#pragma unroll
                        for (int s = 0; s < 2; ++s) { const u32x4 p = {cvt2(X[q][8 * s], X[q][8 * s + 1]), cvt2(X[q][8 * s + 2], X[q][8 * s + 3]), cvt2(X[q][8 * s + 4], X[q][8 * s + 5]), cvt2(X[q][8 * s + 6], X[q][8 * s + 7])};
                            xb[q][s] = __builtin_bit_cast(bf16x8, p);
                            *(u32x4*)(XS + (size_t)(u0 + c) * 4096 + (((vh * 2 + q) * 2 + s) * 64 + lane) * 8) = p; }
                    asm volatile("" ::: "memory");
                    __builtin_amdgcn_s_barrier();
                    asm volatile("" ::: "memory");
                    const LAS unsigned char* sl = lds + (c & 3) * SLOT;
#pragma unroll
                    for (int i = 0; i < 2; ++i) { f32x16 nx;
#pragma unroll
                        for (int e = 0; e < 16; ++e) nx[e] = ((const LAS float*)(sl + 8192))[((i * 2 + vh) * 16 + e) * 64 + lane];
#pragma unroll
                        for (int q = 0; q < 2; ++q)
#pragma unroll
                            for (int s = 0; s < 2; ++s) { const bf16x8 a = *(const LAS bf16x8*)(sl + ((i * 2 + q) * 2 + s) * 1024 + lane * 16); nx = MFMA32(a, xb[q][s], nx); }
                        X[i] = nx; }
                    asm volatile("s_waitcnt lgkmcnt(0)" ::: "memory");
                }
            }
        } else if (bid < BATCH * NHEAD + 8) {
            const float* CA = (const float*)(ws + WS_CA); const float* CH = (const float*)(ws + WS_CH); float* CIN = (float*)(ws + WS_CIN);
            const int i = (bid - BATCH * NHEAD) * NTHREADS + tid, b = i >> 10, c = i & 1023; float s = 0.f;
            for (int ch = 0; ch < 64; ch += 8) { float a[8], hh_[8];
#pragma unroll
                for (int j = 0; j < 8; ++j) { a[j] = CA[(size_t)(b * 64 + ch + j) * LRU_W + c]; hh_[j] = CH[(size_t)(b * 64 + ch + j) * LRU_W + c]; }
#pragma unroll
                for (int j = 0; j < 8; ++j) { CIN[(size_t)(b * 64 + ch + j) * LRU_W + c] = s; s = a[j] * s + hh_[j]; } }
        }
    }
    SEAM(4);

    if (IN(5)) {
        { const float* CIN = (const float*)(ws + WS_CIN);
            for (int i = gt; i < M * LRU_W; i += NGT) { const int m = i >> 10, c = i & 1023;
                const float g = bf2f(P[(size_t)m * NPP + LRU_W + c]);
                const float h = LB[i] + LA[i] * CIN[(size_t)(m >> 6) * LRU_W + c];
                CAT[(size_t)m * D + c] = cvt1(h * gelu_tanh(g)); } }
        const bf16_t* GG = (const bf16_t*)(ws + WS_GG); const bf16_t* XS = (const bf16_t*)(ws + WS_XS); const float* HH = (const float*)(ws + WS_HH);
        const float* gng = args.in[I_GNG]; const float* gnb = args.in[I_GNB];
        const int r = lane & 31, hh = lane >> 5;
        for (int u = gw; u < NUNIT; u += NGW) {
            const int cch = u & 63, head = (u >> 6) & 15, b = u >> 10; const size_t tok0 = (size_t)b * SEQ + cch * 64;
            f32x16 acc[2][2];
#pragma unroll
            for (int i = 0; i < 2; ++i)
#pragma unroll
                for (int vh = 0; vh < 2; ++vh)
#pragma unroll
                    for (int e = 0; e < 16; ++e) acc[i][vh][e] = HH[(size_t)u * 4096 + ((i * 2 + vh) * 16 + e) * 64 + lane];
#pragma unroll
            for (int q = 0; q < 2; ++q)
#pragma unroll
                for (int s = 0; s < 2; ++s) { bf16x8 xb[2], ga[2];
#pragma unroll
                    for (int vh = 0; vh < 2; ++vh) xb[vh] = *(const bf16x8*)(XS + (size_t)u * 4096 + (((vh * 2 + q) * 2 + s) * 64 + lane) * 8);
#pragma unroll
                    for (int i = 0; i < 2; ++i) ga[i] = *(const bf16x8*)(GG + (size_t)u * 4096 + (((i * 2 + q) * 2 + s) * 64 + lane) * 8);
#pragma unroll
                    for (int i = 0; i < 2; ++i)
#pragma unroll
                        for (int vh = 0; vh < 2; ++vh) acc[i][vh] = MFMA32(ga[i], xb[vh], acc[i][vh]); }
#pragma unroll
            for (int i = 0; i < 2; ++i)
#pragma unroll
                for (int e = 0; e < 16; ++e) {
                    float s1 = acc[i][0][e] + acc[i][1][e];
#pragma unroll
                    for (int o = 1; o < 32; o <<= 1) s1 += __shfl_xor(s1, o);
                    const float mean = s1 * (1.f / 64.f);
                    const float d0 = acc[i][0][e] - mean, d1 = acc[i][1][e] - mean; float s2 = d0 * d0 + d1 * d1;
#pragma unroll
                    for (int o = 1; o < 32; o <<= 1) s2 += __shfl_xor(s2, o);
                    const float rstd = 1.f / sqrtf(s2 * (1.f / 64.f) + GN_EPS);
                    const size_t tok = tok0 + 32 * i + crow(e, hh); const float bon = BON[tok * NHEAD + head];
#pragma unroll
                    for (int vh = 0; vh < 2; ++vh) { const int ch = head * HS + 32 * vh + r; const size_t o = tok * RW_W + ch;
                        float yn = (vh ? d1 : d0) * rstd * gng[ch] + gnb[ch];
                        yn += bon * RV[o];
                        CAT[tok * D + LRU_W + ch] = cvt1(yn * RG[o]); } }
        }
    }
    SEAM(5);

    if (IN(6)) {
        pg8::StaticOrder S; S.init(M, D, G, bid);
        pg8::EpiResF32 E{Z, XN, DN_ALPHA};
        pg8::gemm_phase<pg8::EpiResF32, pg8::StaticOrder, pg8::DenseRows, true>(lds, CAT, WoT, S, E, pg8::DenseRows{});
    }
    SEAM(6);

    if (IN(7)) {
        LAS float* hT = (LAS float*)lds;
        LAS float* part = (LAS float*)lds;
        LAS float* lgt = (LAS float*)(lds + 65536);
        const float* g1 = args.in[I_LN1G]; const float* b1 = args.in[I_LN1B]; const float* wr_ = args.in[I_WROUTER]; const float* br_ = args.in[I_BROUTER];
        for (int tile = bid; tile < M / 16; tile += G) {
            const int t0 = tile * 16;
            __syncthreads();
#pragma unroll 1
            for (int rr = 0; rr < 2; ++rr) { const int tb = wave * 2 + rr, m = t0 + tb;
                const f32x4* zr = (const f32x4*)(Z + (size_t)m * D) + lane;
                f32x4 v[8]; float s = 0.f;
#pragma unroll
                for (int j = 0; j < 8; ++j) { v[j] = zr[64 * j]; s += (v[j][0] + v[j][1]) + (v[j][2] + v[j][3]); }
                const float mean = wave_sum(s) * (1.f / D); float s2 = 0.f;
#pragma unroll
                for (int j = 0; j < 8; ++j) { v[j] = v[j] - mean; s2 += (v[j][0] * v[j][0] + v[j][1] * v[j][1]) + (v[j][2] * v[j][2] + v[j][3] * v[j][3]); }
                const float rstd = 1.f / sqrtf(wave_sum(s2) * (1.f / D) + LN_EPS);
                f32x4* ho = (f32x4*)(H1 + (size_t)m * D) + lane; u32x2* hb = (u32x2*)(H1B + (size_t)m * D) + lane;
#pragma unroll
                for (int j = 0; j < 8; ++j) { const f32x4 g4 = ((const f32x4*)g1)[64 * j + lane], b4 = ((const f32x4*)b1)[64 * j + lane]; const f32x4 y = v[j] * rstd * g4 + b4;
                    ho[64 * j] = y; u32x2 w; w.x = pk2(y[0], y[1]); w.y = pk2(y[2], y[3]); hb[64 * j] = w;
#pragma unroll
                    for (int q = 0; q < 4; ++q) hT[(256 * j + 4 * lane + q) * 16 + tb] = y[q]; } }
            __syncthreads();
            float ac[16];
#pragma unroll
            for (int tb = 0; tb < 16; ++tb) ac[tb] = 0.f;
            { const int e = tid & 31, sl = tid >> 5;
                for (int i = sl * 128; i < sl * 128 + 128; ++i) { const float w = wr_[(size_t)i * NE + e]; const LAS f32x4* hp = (const LAS f32x4*)(hT + i * 16);
#pragma unroll
                    for (int q = 0; q < 4; ++q) { const f32x4 h4 = hp[q];
#pragma unroll
                        for (int k = 0; k < 4; ++k) ac[q * 4 + k] += w * h4[k]; } }
                __syncthreads();
#pragma unroll
                for (int tb = 0; tb < 16; ++tb) part[(sl * 16 + tb) * 32 + e] = ac[tb]; }
            __syncthreads();
            { const int tb = tid >> 5, e = tid & 31; float sacc = br_[e];
#pragma unroll
                for (int sl = 0; sl < 16; ++sl) sacc += part[(sl * 16 + tb) * 32 + e];
                lgt[tb * 32 + e] = sacc; }
            __syncthreads();
            if (tid < 16) { const int m = t0 + tid; float bv[4]; int bi[4]; unsigned used = 0u;
#pragma unroll 1
                for (int k = 0; k < 4; ++k) { float best = -3.0e38f; int be = 0;
                    for (int e = 0; e < NE; ++e) { const float x = lgt[tid * 32 + e]; if (!((used >> e) & 1u) && x > best) { best = x; be = e; } }
                    used |= 1u << be; bv[k] = best; bi[k] = be; }
                float ex[4], den = 0.f;
#pragma unroll
                for (int k = 0; k < 4; ++k) { ex[k] = __expf(bv[k] - bv[0]); den += ex[k]; }
#pragma unroll 1
                for (int k = 0; k < 4; ++k) { const int pos = (int)__hip_atomic_fetch_add(ctl + CW_CNT + 64 * bi[k], 1u, RLX_AGENT);
                    TOPE[m * 4 + k] = bi[k]; TOPP[m * 4 + k] = pos; TOPG[m * 4 + k] = ex[k] / den; } }
        }
    }
    SEAM(7);

    if (IN(8)) {
        volatile LAS int* tb = (volatile LAS int*)(MISC + 16);
        moe_tables(tb, ctl);
        for (int i = gt; i < M * TOPK; i += NGT) { const int e = TOPE[i], slot = tb[1 + e] * 256 + TOPP[i];
            SLOTTOK[slot] = i >> 2; SLOTG[slot] = TOPG[i]; TOKSLOT[i] = slot; }
        if (bid < NE) { const int e = bid, c = (int)__hip_atomic_load(ctl + CW_CNT + 64 * e, RLX_AGENT), s0 = tb[1 + e] * 256 + c, s1 = tb[2 + e] * 256;
            for (int s = s0 + tid; s < s1; s += NTHREADS) { SLOTTOK[s] = 0; SLOTG[s] = 0.f; } }
    }
    SEAM(8);

    if (IN(9)) {
        volatile LAS int* tb = (volatile LAS int*)(MISC + 16);
        moe_tables(tb, ctl);
        pg8::MoeOrder S{(const LAS int*)(tb + 64), tb[0], 16, G, bid};
        pg8::EpiSwiglu E{ACT, args.in[I_BE1]};
        pg8::gemm_phase<pg8::EpiSwiglu, pg8::MoeOrder, pg8::GatherRows, true>(lds, H1B, W1T, S, E, pg8::GatherRows{SLOTTOK});
    }
    SEAM(9);

    if (IN(10)) {
        volatile LAS int* tb = (volatile LAS int*)(MISC + 16);
        moe_tables(tb, ctl);
        pg8::MoeOrder S{(const LAS int*)(tb + 64), tb[0], 8, G, bid};
        pg8::EpiMoeOut E{OUTS, args.in[I_BE2], SLOTG};
        pg8::gemm_phase<pg8::EpiMoeOut, pg8::MoeOrder, pg8::DenseRows, true>(lds, ACT, W2T, S, E, pg8::DenseRows{});
    }
    SEAM(10);

    if (IN(11)) {
        const float* g2 = args.in[I_LN2G]; const float* b2 = args.in[I_LN2B];
        for (int m = gw; m < M; m += NGW) {
            const f32x4* hr = (const f32x4*)(H1 + (size_t)m * D) + lane;
            const int s0 = TOKSLOT[m * 4], s1 = TOKSLOT[m * 4 + 1], s2_ = TOKSLOT[m * 4 + 2], s3 = TOKSLOT[m * 4 + 3];
            const u32x2* o0 = (const u32x2*)(OUTS + (size_t)s0 * D) + lane; const u32x2* o1 = (const u32x2*)(OUTS + (size_t)s1 * D) + lane;
            const u32x2* o2 = (const u32x2*)(OUTS + (size_t)s2_ * D) + lane; const u32x2* o3 = (const u32x2*)(OUTS + (size_t)s3 * D) + lane;
            f32x4 v[8]; float s = 0.f;
#pragma unroll
            for (int j = 0; j < 8; ++j) { const f32x4 h4 = hr[64 * j]; const u32x2 a = o0[64 * j], b = o1[64 * j], c = o2[64 * j], d = o3[64 * j];
                f32x4 mo; mo[0] = (bflo(a.x) + bflo(b.x)) + (bflo(c.x) + bflo(d.x)); mo[1] = (bfhi(a.x) + bfhi(b.x)) + (bfhi(c.x) + bfhi(d.x));
                mo[2] = (bflo(a.y) + bflo(b.y)) + (bflo(c.y) + bflo(d.y)); mo[3] = (bfhi(a.y) + bfhi(b.y)) + (bfhi(c.y) + bfhi(d.y));
                v[j] = h4 * DN_ALPHA + mo; s += (v[j][0] + v[j][1]) + (v[j][2] + v[j][3]); }
            const float mean = wave_sum(s) * (1.f / D); float q2 = 0.f;
#pragma unroll
            for (int j = 0; j < 8; ++j) { v[j] = v[j] - mean; q2 += (v[j][0] * v[j][0] + v[j][1] * v[j][1]) + (v[j][2] * v[j][2] + v[j][3] * v[j][3]); }
            const float rstd = 1.f / sqrtf(wave_sum(q2) * (1.f / D) + LN_EPS);
            f32x4* orow = (f32x4*)(args.out + (size_t)m * D) + lane;
#pragma unroll
            for (int j = 0; j < 8; ++j) { const f32x4 g4 = ((const f32x4*)g2)[64 * j + lane], b4 = ((const f32x4*)b2)[64 * j + lane]; orow[64 * j] = v[j] * rstd * g4 + b4; }
        }
    }
#undef IN
#undef SEAM
}

#ifndef MK_ONE_LAUNCH
#define MK_ONE_LAUNCH 1
#endif
extern "C" void kernel_launch(void* const* d_in, const int* in_sizes, int n_in, void* d_out, int out_size, void* d_ws, size_t ws_size, hipStream_t stream) {
    static int grid = 0;
    if (grid == 0) {
        if (n_in != 33 || out_size != M * D || ws_size < WS_END) { fprintf(stderr, "kernel_launch: unexpected sizes n_in %d out %d ws %zu (need %zu)\n", n_in, out_size, ws_size, (size_t)WS_END); grid = -1; return; }
        int dev = 0, cus = 0, per_cu = 0;
        if (hipGetDevice(&dev) != hipSuccess || hipDeviceGetAttribute(&cus, hipDeviceAttributeMultiprocessorCount, dev) != hipSuccess) { grid = -1; return; }
        if (hipFuncSetAttribute((const void*)fwd, hipFuncAttributeMaxDynamicSharedMemorySize, LDS_BYTES) != hipSuccess) { fprintf(stderr, "kernel_launch: hipFuncSetAttribute failed\n"); grid = -1; return; }
        if (hipOccupancyMaxActiveBlocksPerMultiprocessor(&per_cu, (const void*)fwd, NTHREADS, LDS_BYTES) != hipSuccess || per_cu < 1) fprintf(stderr, "kernel_launch: occupancy query says %d\n", per_cu);
        (void)hipGetLastError();
        grid = cus;
    }
    if (grid < 0) return;
    (void)hipMemsetAsync((char*)d_ws + WS_CTL, 0, CTL_ZERO_BYTES, stream);
    Args a{};
    for (int i = 0; i < 33; ++i) a.in[i] = (const float*)d_in[i];
    a.out = (float*)d_out; a.ws = (unsigned char*)d_ws;
#if MK_ONE_LAUNCH
    a.ph_lo = 0; a.ph_hi = NPHASE; a.use_bar = 1;
    hipLaunchKernelGGL(fwd, dim3(grid), dim3(NTHREADS), LDS_BYTES, stream, a);
#else
    for (int p = 0; p < NPHASE; ++p) { a.ph_lo = p; a.ph_hi = p + 1; a.use_bar = 0;
        hipLaunchKernelGGL(fwd, dim3(grid), dim3(NTHREADS), LDS_BYTES, stream, a); }
#endif
}
```

```cpp
#include <hip/hip_runtime.h>
#include <cstdio>
#include <cstdint>

#define LAS __attribute__((address_space(3)))
#define GAS __attribute__((address_space(1)))
typedef unsigned short bf16_t;
typedef short bf16x8 __attribute__((ext_vector_type(8)));
typedef float f32x4 __attribute__((ext_vector_type(4)));
typedef float f32x2 __attribute__((ext_vector_type(2)));
typedef unsigned u32x4 __attribute__((ext_vector_type(4)));
typedef unsigned u32x2 __attribute__((ext_vector_type(2)));
typedef float f32x16 __attribute__((ext_vector_type(16)));
typedef __bf16 bfv2 __attribute__((ext_vector_type(2)));
#define MFMA32(a, b, c) __builtin_amdgcn_mfma_f32_32x32x16_bf16((a), (b), (c), 0, 0, 0)

constexpr int BATCH = 4, SEQ = 4096, M = BATCH * SEQ, D = 2048;
constexpr int LRU_W = 1024, RW_W = 1024, NHEAD = 16, HS = 64;
constexpr int DLORA = 96, ALORA = 96, GLORA = 256;
constexpr int RW_SHIFT_W = 3 * RW_W + DLORA + ALORA + GLORA;
constexpr int NP = 2 * LRU_W + RW_SHIFT_W;
constexpr int NPP = 5632;
constexpr int NE = 32, TOPK = 4, DE = 2048;
constexpr int NSLOT_MAX = M * TOPK + NE * 256;
constexpr int NTILE_MAX = NSLOT_MAX / 256;
constexpr float LN_EPS = 1e-5f, GN_EPS = 64e-5f;
constexpr float DN_ALPHA = 1.189207115002721f;
constexpr int KD = 2048;

constexpr size_t MiB = 1u << 20;
constexpr size_t WS_CTL = 0, CTL_ZERO_BYTES = 1 * MiB;
constexpr size_t WS_WIN = 2 * MiB;
constexpr size_t WS_WO = WS_WIN + (size_t)NPP * KD * 2;
constexpr size_t WS_W1 = WS_WO + (size_t)D * KD * 2;
constexpr size_t WS_W2 = WS_W1 + (size_t)NE * 2 * DE * KD * 2;
constexpr size_t WS_XN = WS_W2 + (size_t)NE * D * DE * 2;
constexpr size_t WS_P = WS_XN + (size_t)M * D * 2;
constexpr size_t WS_LA = WS_P + (size_t)M * NPP * 2;
constexpr size_t WS_LB = WS_LA + (size_t)M * LRU_W * 4;
constexpr size_t WS_UC = WS_LB + (size_t)M * LRU_W * 4;
constexpr size_t WS_XL = WS_UC + (size_t)M * LRU_W * 2;
constexpr size_t WS_GATES = WS_XL + (size_t)M * 512 * 2;
constexpr size_t WS_LOUT = WS_GATES + (size_t)M * 2048 * 2;
constexpr size_t WS_V16 = WS_LOUT + (size_t)M * 3072 * 2;
constexpr size_t WS_G16 = WS_V16 + (size_t)M * RW_W * 2;
constexpr size_t WS_WG = WS_G16 + (size_t)M * RW_W * 2;
constexpr size_t WS_WL = WS_WG + (size_t)2048 * 256 * 2;
constexpr size_t WS_RY = WS_WL + (size_t)3072 * 256 * 2;
constexpr size_t WS_BON = WS_RY;
constexpr size_t WS_CAT = WS_BON + (size_t)M * NHEAD * 4;
constexpr size_t WS_Z = WS_CAT + (size_t)M * D * 2;
constexpr size_t WS_H1 = WS_Z + (size_t)M * D * 4;
constexpr size_t WS_H1B = WS_H1 + (size_t)M * D * 4;
constexpr size_t WS_TOPE = WS_H1B + (size_t)M * D * 2;
constexpr size_t WS_TOPP = WS_TOPE + (size_t)M * TOPK * 4;
constexpr size_t WS_TOPG = WS_TOPP + (size_t)M * TOPK * 4;
constexpr size_t WS_TOKSLOT = WS_TOPG + (size_t)M * TOPK * 4;
constexpr size_t WS_SLOTTOK = WS_TOKSLOT + (size_t)M * TOPK * 4;
constexpr size_t WS_SLOTG = WS_SLOTTOK + (size_t)NSLOT_MAX * 4;
constexpr size_t WS_ACT = WS_SLOTG + (size_t)NSLOT_MAX * 4;
constexpr size_t WS_OUTS = WS_ACT + (size_t)NSLOT_MAX * DE * 2;
constexpr int NUNIT = BATCH * NHEAD * (SEQ / 64);
constexpr size_t WS_MT = WS_OUTS + (size_t)NSLOT_MAX * D * 2;
constexpr size_t WS_GG = WS_MT + (size_t)NUNIT * 8192;
constexpr size_t WS_XS = WS_GG + (size_t)NUNIT * 8192;
constexpr size_t WS_NN = WS_XS + (size_t)NUNIT * 8192;
constexpr size_t WS_HH = WS_NN + (size_t)NUNIT * 16384;
constexpr size_t WS_CA = WS_HH + (size_t)NUNIT * 16384;
constexpr size_t WS_CH = WS_CA + (size_t)BATCH * 64 * LRU_W * 4;
constexpr size_t WS_CIN = WS_CH + (size_t)BATCH * 64 * LRU_W * 4;
constexpr size_t WS_END = WS_CIN + (size_t)BATCH * 64 * LRU_W * 4;
constexpr int CW_CNT = 1024;
constexpr int CW_BAR = 4096;

constexpr int MISC_OFF = 159744;
constexpr int LDS_BYTES = 163840;

#define RLX_AGENT __ATOMIC_RELAXED, __HIP_MEMORY_SCOPE_AGENT
__device__ __forceinline__ unsigned f2bf(float f) { unsigned u = __builtin_bit_cast(unsigned, f); return (u + 0x7fffu + ((u >> 16) & 1u)) >> 16; }
__device__ __forceinline__ unsigned pk2(float lo, float hi) { return f2bf(lo) | (f2bf(hi) << 16); }
__device__ __forceinline__ float bf2f(unsigned short b) { return __builtin_bit_cast(float, (unsigned)b << 16); }
__device__ __forceinline__ float bflo(unsigned w) { return __builtin_bit_cast(float, w << 16); }
__device__ __forceinline__ float bfhi(unsigned w) { return __builtin_bit_cast(float, w & 0xffff0000u); }
__device__ __forceinline__ unsigned cvt2(float a, float b) { const f32x2 v = {a, b}; return __builtin_bit_cast(unsigned, __builtin_convertvector(v, bfv2)); }
__device__ __forceinline__ unsigned short cvt1(float a) { return (unsigned short)(cvt2(a, 0.f) & 0xffffu); }
__device__ __forceinline__ int crow(int reg, int h) { return (reg & 3) + 8 * (reg >> 2) + 4 * h; }
__device__ __forceinline__ float row_sum16(float v) {
    v += __builtin_bit_cast(float, __builtin_amdgcn_update_dpp(0, __builtin_bit_cast(int, v), 0xB1, 0xf, 0xf, false));
    v += __builtin_bit_cast(float, __builtin_amdgcn_update_dpp(0, __builtin_bit_cast(int, v), 0x4E, 0xf, 0xf, false));
    v += __builtin_bit_cast(float, __builtin_amdgcn_update_dpp(0, __builtin_bit_cast(int, v), 0x141, 0xf, 0xf, false));
    v += __builtin_bit_cast(float, __builtin_amdgcn_update_dpp(0, __builtin_bit_cast(int, v), 0x140, 0xf, 0xf, false));
    return v;
}
__device__ __forceinline__ float rdlane(float v, int l) { return __builtin_bit_cast(float, __builtin_amdgcn_readlane(__builtin_bit_cast(int, v), l)); }
__device__ __forceinline__ float wave_sum(float v) { v = row_sum16(v); return (rdlane(v, 0) + rdlane(v, 16)) + (rdlane(v, 32) + rdlane(v, 48)); }
__device__ __forceinline__ float half_sum(float v, int hh) { v = row_sum16(v); const float lo = rdlane(v, 0) + rdlane(v, 16), hi = rdlane(v, 32) + rdlane(v, 48); return hh ? hi : lo; }
__device__ __forceinline__ float sigmoidf_(float x) { return __builtin_amdgcn_rcpf(1.f + __expf(-x)); }
__device__ __forceinline__ float gelu_tanh(float x) { const float u = 0.7978845608028654f * (x + 0.044715f * x * x * x); return x * __builtin_amdgcn_rcpf(1.f + __expf(-2.f * u)); }
__device__ __forceinline__ float tanh_fast(float x) { const float e = __expf(-2.f * fabsf(x)); const float t = (1.f - e) * __builtin_amdgcn_rcpf(1.f + e); return x < 0.f ? -t : t; }

#define XB_TMO      128
#define XB_XCNT(j)  (256  + 64 * (j))
#define XB_XSUB(j)  (1280 + 64 * (j))
#define XB_XGEN(j)  (2304 + 64 * (j))
#define XB_TOP      3328
#define XB_TOPGEN   3392
#define XCD_BAR_WORDS 3456
#define XB_SPIN_CAP (1u << 18)
__device__ __forceinline__ unsigned xb_ld(unsigned* p)              { return __hip_atomic_load(p, __ATOMIC_RELAXED, __HIP_MEMORY_SCOPE_AGENT); }
__device__ __forceinline__ unsigned xb_add(unsigned* p, unsigned v) { return __hip_atomic_fetch_add(p, v, __ATOMIC_RELAXED, __HIP_MEMORY_SCOPE_AGENT); }
__device__ __forceinline__ unsigned xb_xcc_id() { return (unsigned)__builtin_amdgcn_s_getreg((3 << 11) | 20) & 0xFu; }
#define XB_SPIN(cond, bar) do { unsigned _sp = 0; while (cond) { __builtin_amdgcn_s_sleep(1); \
    if ((++_sp & 255u) == 0u) { if (xb_ld(&(bar)[XB_TMO])) break; if (_sp > XB_SPIN_CAP) { atomicAdd(&(bar)[XB_TMO], 1u); break; } } } } while (0)
struct XcdBarrier { unsigned* bar; unsigned x; volatile LAS unsigned* st; };
__device__ __forceinline__ XcdBarrier xcd_barrier_post(unsigned* bar, volatile LAS unsigned* st) {
    XcdBarrier b; b.bar = bar; b.x = xb_xcc_id(); b.st = st;
    if (threadIdx.x == 0) (void)xb_add(&bar[XB_XCNT(b.x)], 1u);
    return b;
}
__device__ __forceinline__ void xcd_barrier_complete(unsigned* bar, unsigned x, unsigned& nloc, unsigned& nx) {
    const unsigned G = gridDim.x * gridDim.y * gridDim.z;
    unsigned sum, cnt, mine, sp = 0u;
    for (;;) {
        sum = 0u; cnt = 0u; mine = 0u;
#pragma unroll
        for (unsigned j = 0; j < 16; ++j) { const unsigned c = xb_ld(&bar[XB_XCNT(j)]); sum += c; cnt += (c > 0u) ? 1u : 0u; mine = (j == x) ? c : mine; }
        if (sum == G) break;
        __builtin_amdgcn_s_sleep(1);
        if ((++sp & 255u) == 0u) { if (xb_ld(&bar[XB_TMO])) break; if (sp > XB_SPIN_CAP) { atomicAdd(&bar[XB_TMO], 1u); break; } }
    }
    nloc = mine > 0u ? mine : 1u; nx = cnt > 0u ? cnt : 1u;
}
__device__ __forceinline__ void xcd_barrier(const XcdBarrier& b) {
    asm volatile("s_waitcnt vmcnt(0)" ::: "memory");
    __syncthreads();
    if (threadIdx.x == 0) {
        unsigned* bar = b.bar;
        __builtin_amdgcn_s_waitcnt(0);
        unsigned nloc = b.st[0], nx = b.st[1];
        if (nloc == 0u) { xcd_barrier_complete(bar, b.x, nloc, nx); b.st[0] = nloc; b.st[1] = nx; }
        const unsigned old = xb_add(&bar[XB_XSUB(b.x)], 1u);
        const unsigned gen = old / nloc;
        if (old + 1u == (gen + 1u) * nloc) {
            __builtin_amdgcn_fence(__ATOMIC_RELEASE, "agent");
            asm volatile("s_waitcnt vmcnt(0)" ::: "memory");
            const unsigned og = xb_add(&bar[XB_TOP], 1u);
            const unsigned tg = og / nx;
            if (og + 1u == (tg + 1u) * nx) xb_add(&bar[XB_TOPGEN], 1u);
            else XB_SPIN(xb_ld(&bar[XB_TOPGEN]) == tg, bar);
            __builtin_amdgcn_fence(__ATOMIC_ACQUIRE, "agent");
            xb_add(&bar[XB_XGEN(b.x)], 1u);
            asm volatile("s_waitcnt vmcnt(0)" ::: "memory");
        } else {
            XB_SPIN(xb_ld(&bar[XB_XGEN(b.x)]) == gen, bar);
            __builtin_amdgcn_fence(__ATOMIC_ACQUIRE, "agent");
            asm volatile("s_waitcnt vmcnt(0)" ::: "memory");
        }
    }
    __syncthreads();
}

namespace pg8 {
constexpr int BM = 256, BK = 64, HALF = 128, HTB = HALF * BK * 2, STAGE_BYTES = 8 * HTB, NXCD = 8, WGM = 8;
__host__ __device__ __forceinline__ int lds_byte(int r, int c) { const int st = (r >> 4) * 2 + (c >> 5), rr = r & 15, cc = c & 31, ob = rr * 64 + cc * 2; return st * 1024 + (ob ^ (((ob >> 9) & 1) << 5)); }
__host__ __device__ __forceinline__ void stage_rc(int b, int& R, int& C) { const int st = b / 1024, sb = b % 1024, swz = sb ^ (((sb >> 9) & 1) << 5); R = (st >> 1) * 16 + swz / 64; C = (st & 1) * 32 + (swz % 64) / 2; }
__host__ __device__ __forceinline__ int perm32(int rho) { const int n = rho >> 4, i = rho & 15; return 8 * (i >> 2) + 4 * n + (i & 3); }
struct Unit { int pm, pn, ak, nt; };
__device__ __forceinline__ unsigned cvt_pk_bf16(float lo, float hi) { unsigned r; asm volatile("v_cvt_pk_bf16_f32 %0, %1, %2" : "=v"(r) : "v"(lo), "v"(hi)); return r; }

struct StaticOrder {
    int nM, nN, nwg, G, c;
    __device__ void init(int M_, int N_, int G_, int c_) { nM = M_ / BM; nN = N_ / BM; nwg = nM * nN; G = G_; c = c_; }
    __device__ bool next(int i, Unit& u) const {
        const long L = (long)i * G + c; if (L >= nwg) return false;
        int wgid = (int)L; { const int q = nwg / NXCD, r = nwg % NXCD, xcd = wgid % NXCD, off = wgid / NXCD; wgid = (xcd < r ? xcd * (q + 1) : r * (q + 1) + (xcd - r) * q) + off; }
        const int nig = WGM * nN, gid = wgid / nig, fm = gid * WGM, gsz = (nM - fm) < WGM ? (nM - fm) : WGM;
        u.pm = fm + ((wgid % nig) % gsz); u.pn = (wgid % nig) / gsz; u.ak = 0; u.nt = KD / BK; return true;
    }
};
struct MoeOrder {
    const LAS int* tile_e; int R, NCT, G, c;
    __device__ bool next(int i, Unit& u) const {
        int rt, ct;
        if (G == 256) { const int x = c & 7, j = c >> 3;
            if (NCT == 16) { rt = 16 * i + (x >> 1) * 4 + (j >> 3); ct = (x & 1) * 8 + (j & 7); }
            else           { rt = 32 * i + 4 * x + (j >> 3); ct = j & 7; } }
        else { const long L = (long)i * G + c; rt = (int)(L / NCT); ct = (int)(L % NCT); }
        if (rt >= R) return false;
        u.pm = rt; u.pn = tile_e[rt] * NCT + ct; u.ak = 0; u.nt = KD / BK; return true;
    }
};
template <int MODE> struct SmallOrder {
    int G, c;
    __device__ bool next(int i, Unit& u) const {
        constexpr int NCT = MODE == 0 ? 8 : 12;
        const int L = i * G + c; if (L >= (M / BM) * NCT) return false;
        u.pm = L / NCT; u.pn = L % NCT;
        if (MODE == 0) { u.ak = 256 * (u.pn & 3); u.nt = 4; }
        else { u.ak = u.pn < 4 ? 0 : (u.pn < 8 ? 128 : 256); u.nt = u.pn < 8 ? 2 : 4; }
        return true;
    }
};
struct DenseRows { __device__ __forceinline__ unsigned row(int pm, int r) const { return (unsigned)(pm * BM + r); } };
struct GatherRows { const int* idx; __device__ __forceinline__ unsigned row(int pm, int r) const { return (unsigned)idx[pm * BM + r]; } };

struct EpiBf16 {
    static constexpr bool PERM = true;
    bf16_t* O; int ldc;
    __device__ __forceinline__ void operator()(const f32x4 (&acc)[2][2][4][2], const Unit& u, int wr, int wc, int fr, int fq) const {
        const int row0 = u.pm * BM + wr * 64 + fr, col0 = u.pn * BM + wc * 32 + 8 * fq;
#pragma unroll
        for (int ai = 0; ai < 2; ++ai)
#pragma unroll
            for (int m = 0; m < 4; ++m) { bf16_t* rowp = O + (size_t)(row0 + ai * HALF + m * 16) * ldc + col0;
#pragma unroll
                for (int bj = 0; bj < 2; ++bj) { const f32x4 v0 = acc[ai][bj][m][0], v1 = acc[ai][bj][m][1];
                    u32x4 w; w.x = cvt_pk_bf16(v0[0], v0[1]); w.y = cvt_pk_bf16(v0[2], v0[3]); w.z = cvt_pk_bf16(v1[0], v1[1]); w.w = cvt_pk_bf16(v1[2], v1[3]);
                    *(u32x4*)(rowp + bj * HALF) = w; } }
    }
};
struct EpiResF32 {
    static constexpr bool PERM = false;
    float* Z; const bf16_t* R; float alpha;
    __device__ __forceinline__ void operator()(const f32x4 (&acc)[2][2][4][2], const Unit& u, int wr, int wc, int fr, int fq) const {
        const int row0 = u.pm * BM + wr * 64 + fr, col0 = u.pn * BM + wc * 32 + 4 * fq;
#pragma unroll
        for (int ai = 0; ai < 2; ++ai)
#pragma unroll
            for (int m = 0; m < 4; ++m) { const size_t off = (size_t)(row0 + ai * HALF + m * 16) * D + col0;
#pragma unroll
                for (int bj = 0; bj < 2; ++bj)
#pragma unroll
                    for (int n = 0; n < 2; ++n) { const u32x2 rb = *(const u32x2*)(R + off + bj * HALF + n * 16);
                        f32x4 o = acc[ai][bj][m][n]; o[0] += alpha * bflo(rb.x); o[1] += alpha * bfhi(rb.x); o[2] += alpha * bflo(rb.y); o[3] += alpha * bfhi(rb.y);
                        *(f32x4*)(Z + off + bj * HALF + n * 16) = o; } }
    }
};
struct EpiSwiglu {
    static constexpr bool PERM = true;
    bf16_t* O; const float* b1;
    __device__ __forceinline__ void operator()(const f32x4 (&acc)[2][2][4][2], const Unit& u, int wr, int wc, int fr, int fq) const {
        const int e = u.pn >> 4, ct = u.pn & 15;
        const int row0 = u.pm * BM + wr * 64 + fr, cin = wc * 32 + 8 * fq, col0 = ct * HALF + cin;
        const float* bg = b1 + (size_t)e * 2 * DE + col0; const float* bu = bg + DE;
        const f32x4 bg0 = *(const f32x4*)bg, bg1 = *(const f32x4*)(bg + 4), bu0 = *(const f32x4*)bu, bu1 = *(const f32x4*)(bu + 4);
#pragma unroll
        for (int ai = 0; ai < 2; ++ai)
#pragma unroll
            for (int m = 0; m < 4; ++m) { bf16_t* rowp = O + (size_t)(row0 + ai * HALF + m * 16) * DE + col0;
                float o[8];
#pragma unroll
                for (int n = 0; n < 2; ++n) { const f32x4 g4 = acc[ai][0][m][n] + (n ? bg1 : bg0), u4 = acc[ai][1][m][n] + (n ? bu1 : bu0);
#pragma unroll
                    for (int j = 0; j < 4; ++j) { const float g = fminf(g4[j], 7.f), up = fminf(fmaxf(u4[j], -7.f), 7.f);
                        o[n * 4 + j] = g * (up + 1.f) * __builtin_amdgcn_rcpf(1.f + __expf(-1.702f * g)); } }
                u32x4 w; w.x = cvt_pk_bf16(o[0], o[1]); w.y = cvt_pk_bf16(o[2], o[3]); w.z = cvt_pk_bf16(o[4], o[5]); w.w = cvt_pk_bf16(o[6], o[7]);
                *(u32x4*)rowp = w; }
    }
};
struct EpiMoeOut {
    static constexpr bool PERM = true;
    bf16_t* O; const float* b2; const float* sg;
    __device__ __forceinline__ void operator()(const f32x4 (&acc)[2][2][4][2], const Unit& u, int wr, int wc, int fr, int fq) const {
        const int e = u.pn >> 3, ct = u.pn & 7;
        const int row0 = u.pm * BM + wr * 64 + fr, col0 = ct * BM + wc * 32 + 8 * fq;
        f32x4 bv[2][2];
#pragma unroll
        for (int bj = 0; bj < 2; ++bj)
#pragma unroll
            for (int n = 0; n < 2; ++n) bv[bj][n] = *(const f32x4*)(b2 + (size_t)e * D + col0 + bj * HALF + 4 * n);
#pragma unroll
        for (int ai = 0; ai < 2; ++ai)
#pragma unroll
            for (int m = 0; m < 4; ++m) { const int row = row0 + ai * HALF + m * 16; const float gt = sg[row]; bf16_t* rowp = O + (size_t)row * D + col0;
#pragma unroll
                for (int bj = 0; bj < 2; ++bj) { const f32x4 v0 = (acc[ai][bj][m][0] + bv[bj][0]) * gt, v1 = (acc[ai][bj][m][1] + bv[bj][1]) * gt;
                    u32x4 w; w.x = cvt_pk_bf16(v0[0], v0[1]); w.y = cvt_pk_bf16(v0[2], v0[3]); w.z = cvt_pk_bf16(v1[0], v1[1]); w.w = cvt_pk_bf16(v1[2], v1[3]);
                    *(u32x4*)(rowp + bj * HALF) = w; } }
    }
};

template <class Epi, class Sched, class ARows, bool ALIGN_EPI, int LDA = KD, int LDB = KD>
__device__ __forceinline__ void gemm_phase(LAS unsigned char* lds, const bf16_t* A, const bf16_t* Bt, const Sched& S, const Epi& E, const ARows& AR) {
    const int tid = threadIdx.x, wid = __builtin_amdgcn_readfirstlane(tid >> 6), lane = tid & 63, wr = wid >> 2, wc = wid & 3, fr = lane & 15, fq = lane >> 4;
    int sR[2], sC[2]; unsigned voffB[2];
#pragma unroll
    for (int i = 0; i < 2; ++i) { stage_rc(tid * 16 + i * 8192, sR[i], sC[i]); const int Rb = Epi::PERM ? ((sR[i] & ~31) + perm32(sR[i] & 31)) : sR[i];
        voffB[i] = (unsigned)(Rb * LDB + sC[i]) * 2u; }
    constexpr size_t kstep = (size_t)(BK * 2);
    constexpr size_t hstep = (size_t)HALF * LDB * 2;
    constexpr size_t tstep = 2 * hstep;
    const unsigned ldsw = (unsigned)wid * 1024u;
    const int aoff = lds_byte(wr * 64 + fr, fq * 8), boff = lds_byte(wc * 32 + fr, fq * 8);
#define PG8_SA(b, h) (((b) * 2 + (h)) * HTB)
#define PG8_SB(b, h) ((4 + (b) * 2 + (h)) * HTB)
#define PG8_STAGE(bufoff, gbase, voff) do { _Pragma("unroll") for (int _i = 0; _i < 2; ++_i) \
        __builtin_amdgcn_global_load_lds((const unsigned*)((const char*)(gbase) + (voff)[_i]), (LAS unsigned*)(lds + (bufoff) + ldsw + _i * 8192), 16, 0, 0); } while (0)
#define PG8_LDA(dst, b, h) do { _Pragma("unroll") for (int m = 0; m < 4; ++m) _Pragma("unroll") for (int k = 0; k < 2; ++k) dst[m][k] = *(const LAS bf16x8*)(lds + PG8_SA(b, h) + aoff + m * 2048 + k * 1024); } while (0)
#define PG8_LDB(dst, b, h) do { _Pragma("unroll") for (int n = 0; n < 2; ++n) _Pragma("unroll") for (int k = 0; k < 2; ++k) dst[n][k] = *(const LAS bf16x8*)(lds + PG8_SB(b, h) + boff + n * 2048 + k * 1024); } while (0)
#define PG8_MMA(ai, bj, At, Bt_) do { __builtin_amdgcn_s_setprio(1); _Pragma("unroll") for (int m = 0; m < 4; ++m) _Pragma("unroll") for (int n = 0; n < 2; ++n) _Pragma("unroll") for (int k = 0; k < 2; ++k) \
        acc[ai][bj][m][n] = __builtin_amdgcn_mfma_f32_16x16x32_bf16(Bt_[n][k], At[m][k], acc[ai][bj][m][n], 0, 0, 0); __builtin_amdgcn_s_setprio(0); } while (0)
#define PG8_WAIT_V(n) asm volatile("s_waitcnt vmcnt(" #n ")" ::: "memory")
#define PG8_WAIT_L(n) asm volatile("s_waitcnt lgkmcnt(" #n ")" ::: "memory")
#define PG8_BAR __builtin_amdgcn_s_barrier()
#define PG8_SCHED __builtin_amdgcn_sched_barrier(0)
#define PG8_AOFF(dst, u) do { _Pragma("unroll") for (int _h = 0; _h < 2; ++_h) _Pragma("unroll") for (int _i = 0; _i < 2; ++_i) \
        dst[_h][_i] = (AR.row((u).pm, _h * HALF + sR[_i]) * (unsigned)LDA + (unsigned)((u).ak + sC[_i])) * 2u; } while (0)
    Unit cur, nxt; int ui = 0;
    if (!S.next(0, cur)) return;
    f32x4 acc[2][2][4][2];
#pragma unroll
    for (int a = 0; a < 2; ++a)
#pragma unroll
        for (int b = 0; b < 2; ++b)
#pragma unroll
            for (int m = 0; m < 4; ++m)
#pragma unroll
                for (int n = 0; n < 2; ++n) acc[a][b][m][n] = (f32x4){0.f, 0.f, 0.f, 0.f};
    bf16x8 At[4][2], B0[2][2], B1[2][2];
    unsigned ao[2][2], an[2][2];
    PG8_AOFF(ao, cur);
    const char* cA = (const char*)A;
    const char* cB = (const char*)Bt + (size_t)cur.pn * tstep;
    PG8_STAGE(PG8_SB(0, 0), cB, voffB); PG8_STAGE(PG8_SB(0, 1), cB + hstep, voffB); PG8_STAGE(PG8_SA(0, 0), cA, ao[0]); PG8_STAGE(PG8_SA(0, 1), cA, ao[1]);
    if (wr == 1) PG8_BAR;
    PG8_WAIT_V(2); PG8_BAR;
    PG8_STAGE(PG8_SB(1, 0), cB + kstep, voffB); PG8_STAGE(PG8_SA(1, 0), cA + kstep, ao[0]); PG8_STAGE(PG8_SB(1, 1), cB + hstep + kstep, voffB);
    PG8_WAIT_V(6); PG8_BAR;
    for (;;) {
        const bool has_next = S.next(ui + 1, nxt);
        if (has_next) { PG8_AOFF(an, nxt); } else {
#pragma unroll
            for (int h = 0; h < 2; ++h)
#pragma unroll
                for (int i = 0; i < 2; ++i) an[h][i] = ao[h][i]; }
        const char* nB = has_next ? (const char*)Bt + (size_t)nxt.pn * tstep : cB;
        const int nt = cur.nt;
#pragma unroll 1
        for (int t = 0; t < nt; t += 2) {
            const bool last = (t == nt - 2);
            const char* a1 = cA + (size_t)(t + 1) * kstep;
            const char* a2 = last ? cA : cA + (size_t)(t + 2) * kstep; const char* b2 = last ? nB : cB + (size_t)(t + 2) * kstep;
            const char* a3 = a2 + kstep; const char* b3 = b2 + kstep;
            unsigned o2[2][2];
#pragma unroll
            for (int h = 0; h < 2; ++h)
#pragma unroll
                for (int i = 0; i < 2; ++i) o2[h][i] = last ? an[h][i] : ao[h][i];
            PG8_LDB(B0, 0, 0); PG8_LDB(B1, 0, 1); PG8_SCHED; PG8_LDA(At, 0, 0); PG8_STAGE(PG8_SA(1, 1), a1, ao[1]);
            PG8_WAIT_V(8); PG8_WAIT_L(0); PG8_BAR; PG8_MMA(0, 0, At, B0); PG8_MMA(0, 1, At, B1); PG8_BAR; PG8_SCHED;
            PG8_LDA(At, 0, 1); PG8_STAGE(PG8_SB(0, 0), b2, voffB); PG8_STAGE(PG8_SB(0, 1), b2 + hstep, voffB); PG8_STAGE(PG8_SA(0, 0), a2, o2[0]);
            PG8_WAIT_V(8); PG8_WAIT_L(0); PG8_BAR; PG8_MMA(1, 0, At, B0); PG8_MMA(1, 1, At, B1); PG8_BAR; PG8_SCHED;
            PG8_LDB(B0, 1, 0); PG8_LDB(B1, 1, 1); PG8_SCHED; PG8_LDA(At, 1, 0); PG8_STAGE(PG8_SA(0, 1), a2, o2[1]);
            PG8_WAIT_V(8); PG8_WAIT_L(0); PG8_BAR; PG8_MMA(0, 0, At, B0); PG8_MMA(0, 1, At, B1); PG8_BAR; PG8_SCHED;
            PG8_LDA(At, 1, 1); PG8_STAGE(PG8_SB(1, 0), b3, voffB); PG8_STAGE(PG8_SB(1, 1), b3 + hstep, voffB); PG8_STAGE(PG8_SA(1, 0), a3, o2[0]);
            PG8_WAIT_V(8); PG8_WAIT_L(0); PG8_BAR; PG8_MMA(1, 0, At, B0); PG8_MMA(1, 1, At, B1); PG8_BAR; PG8_SCHED;
        }
        if constexpr (ALIGN_EPI) { if (wr == 0) PG8_BAR; }
        E(acc, cur, wr, wc, fr, fq);
        if (!has_next) break;
#pragma unroll
        for (int a = 0; a < 2; ++a)
#pragma unroll
            for (int b = 0; b < 2; ++b)
#pragma unroll
                for (int m = 0; m < 4; ++m)
#pragma unroll
                    for (int n = 0; n < 2; ++n) acc[a][b][m][n] = (f32x4){0.f, 0.f, 0.f, 0.f};
        cur = nxt; cB = nB; ++ui;
#pragma unroll
        for (int h = 0; h < 2; ++h)
#pragma unroll
            for (int i = 0; i < 2; ++i) ao[h][i] = an[h][i];
        if constexpr (ALIGN_EPI) { if (wr == 1) PG8_BAR; }
    }
    PG8_WAIT_V(0);
    if constexpr (!ALIGN_EPI) { if (wr == 0) PG8_BAR; }
    PG8_BAR;
#undef PG8_SA
#undef PG8_SB
#undef PG8_STAGE
#undef PG8_LDA
#undef PG8_LDB
#undef PG8_MMA
#undef PG8_WAIT_V
#undef PG8_WAIT_L
#undef PG8_BAR
#undef PG8_SCHED
#undef PG8_AOFF
}
}

constexpr int NWAVES = 8, NTHREADS = 512;
constexpr int NPHASE = 13;
struct Args {
    const float* in[33]; float* out; unsigned char* ws; int ph_lo, ph_hi, use_bar, pad;
};
enum { I_X = 0, I_LNG, I_LNB, I_WIN, I_CONVW, I_CONVB, I_WRG, I_BRG, I_WIG, I_BIG, I_LAMBDA, I_MU, I_W0, I_DECUP, I_A0, I_AAAUP, I_GATEUP,
       I_KK, I_KA, I_RK, I_GNG, I_GNB, I_WOUT, I_LN1G, I_LN1B, I_WROUTER, I_BROUTER, I_WE1, I_BE1, I_WE2, I_BE2, I_LN2G, I_LN2B };

__device__ __forceinline__ void transpose_item(const float* W, int N, bf16_t* WT, int k0, int n0, int dst_row0, LAS float* scr, int lane) {
#pragma unroll 8
    for (int i = 0; i < 32; ++i) { const int kk = 2 * i + (lane >> 5); scr[kk * 33 + (lane & 31)] = W[(size_t)(k0 + kk) * N + n0 + (lane & 31)]; }
    asm volatile("s_waitcnt lgkmcnt(0)" ::: "memory");
    const int c = lane & 7;
#pragma unroll
    for (int j = 0; j < 4; ++j) { const int n = (lane >> 3) + 8 * j; const LAS float* s = scr + (8 * c) * 33 + n;
        u32x4 o; o.x = pk2(s[0 * 33], s[1 * 33]); o.y = pk2(s[2 * 33], s[3 * 33]); o.z = pk2(s[4 * 33], s[5 * 33]); o.w = pk2(s[6 * 33], s[7 * 33]);
        *(u32x4*)(WT + (size_t)(dst_row0 + n) * KD + k0 + 8 * c) = o; }
    asm volatile("s_waitcnt lgkmcnt(0)" ::: "memory");
}

__device__ __forceinline__ void moe_tables(volatile LAS int* tb, unsigned* ctl) {
    if (threadIdx.x == 0) {
        int off = 0;
        for (int e = 0; e < NE; ++e) { const int c = (int)__hip_atomic_load(ctl + CW_CNT + 64 * e, RLX_AGENT); const int nt = (c + 255) >> 8;
            tb[1 + e] = off; for (int r = 0; r < nt; ++r) tb[64 + off + r] = e; off += nt; }
        tb[1 + NE] = off; tb[0] = off;
    }
    __syncthreads();
}

__global__ void __launch_bounds__(NTHREADS, 2) fwd(Args args) {
    extern __shared__ __attribute__((aligned(16))) unsigned char lds_raw[];
    LAS unsigned char* lds = (LAS unsigned char*)lds_raw;
    volatile LAS unsigned* MISC = (volatile LAS unsigned*)(lds + MISC_OFF);
    const int tid = threadIdx.x, lane = tid & 63, wave = __builtin_amdgcn_readfirstlane(tid >> 6);
    const int G = gridDim.x, bid = blockIdx.x;
    unsigned char* ws = args.ws;
    unsigned* ctl = (unsigned*)(ws + WS_CTL);
    if (tid < 64) MISC[tid] = 0u;
    __syncthreads();
    XcdBarrier bar; bar.bar = ctl + CW_BAR; bar.x = 0; bar.st = nullptr;
    if (args.use_bar) bar = xcd_barrier_post(ctl + CW_BAR, MISC);
    const int lo = args.ph_lo, hi = args.ph_hi;
#ifndef DUP_MASK
#define DUP_MASK 0
#endif
#define REP(k) for (int rep_ = 0; rep_ <= ((DUP_MASK >> (k)) & 1); ++rep_)
#define IN(k) (lo <= (k) && (k) < hi)
#ifndef PROBE_PHASE
#define PROBE_PHASE -1
#endif
    unsigned long long tprobe0 = 0ull, tprobe1 = 0ull;
#define SEAM(k) do { if (IN(k) && IN((k) + 1)) xcd_barrier(bar); if (PROBE_PHASE >= 0) { if ((k) + 1 == PROBE_PHASE) tprobe0 = __builtin_amdgcn_s_memrealtime(); if ((k) == PROBE_PHASE) tprobe1 = __builtin_amdgcn_s_memrealtime(); } } while (0)
    if (PROBE_PHASE == 0) tprobe0 = __builtin_amdgcn_s_memrealtime();
    const int gw = bid * NWAVES + wave, NGW = G * NWAVES;
    const int gt = bid * NTHREADS + tid, NGT = G * NTHREADS;

    bf16_t* WinT = (bf16_t*)(ws + WS_WIN); bf16_t* WoT = (bf16_t*)(ws + WS_WO); bf16_t* W1T = (bf16_t*)(ws + WS_W1); bf16_t* W2T = (bf16_t*)(ws + WS_W2);
    bf16_t* XN = (bf16_t*)(ws + WS_XN); bf16_t* P = (bf16_t*)(ws + WS_P);
    float* LA = (float*)(ws + WS_LA); float* LB = (float*)(ws + WS_LB);
    float* BON = (float*)(ws + WS_BON);
    bf16_t* CAT = (bf16_t*)(ws + WS_CAT); float* Z = (float*)(ws + WS_Z); float* H1 = (float*)(ws + WS_H1); bf16_t* H1B = (bf16_t*)(ws + WS_H1B);
    int* TOPE = (int*)(ws + WS_TOPE); int* TOPP = (int*)(ws + WS_TOPP); float* TOPG = (float*)(ws + WS_TOPG); int* TOKSLOT = (int*)(ws + WS_TOKSLOT);
    int* SLOTTOK = (int*)(ws + WS_SLOTTOK); float* SLOTG = (float*)(ws + WS_SLOTG);
    bf16_t* ACT = (bf16_t*)(ws + WS_ACT); bf16_t* OUTS = (bf16_t*)(ws + WS_OUTS);

    if (IN(0)) REP(0) {
        LAS float* scr = (LAS float*)(lds + wave * 16384);
        constexpr int I_IN = (KD / 64) * (NP / 32), I_OUT = (KD / 64) * (D / 32), I_E1 = (KD / 64) * (2 * DE / 32), I_E2 = (DE / 64) * (D / 32);
        constexpr int NITEMS = I_IN + I_OUT + NE * I_E1 + NE * I_E2;
        for (int it = gw; it < NITEMS; it += NGW) {
            int r = it;
            if (r < I_IN) { const int nb = NP / 32, kb = r / nb, n0 = (r % nb) * 32; transpose_item(args.in[I_WIN], NP, WinT, kb * 64, n0, n0, scr, lane); continue; } r -= I_IN;
            if (r < I_OUT) { const int nb = D / 32, kb = r / nb, n0 = (r % nb) * 32; transpose_item(args.in[I_WOUT], D, WoT, kb * 64, n0, n0, scr, lane); continue; } r -= I_OUT;
            if (r < NE * I_E1) { const int e = r / I_E1, q = r % I_E1, nb = 2 * DE / 32, kb = q / nb, n0 = (q % nb) * 32;
                const int isup = n0 >= DE ? 1 : 0, nn = n0 - isup * DE, drow = 256 * (nn >> 7) + 128 * isup + (nn & 127);
                transpose_item(args.in[I_WE1] + (size_t)e * KD * 2 * DE, 2 * DE, W1T + (size_t)e * 2 * DE * KD, kb * 64, n0, drow, scr, lane); continue; } r -= NE * I_E1;
            { const int e = r / I_E2, q = r % I_E2, nb = D / 32, kb = q / nb, n0 = (q % nb) * 32;
                transpose_item(args.in[I_WE2] + (size_t)e * DE * D, D, W2T + (size_t)e * D * DE, kb * 64, n0, n0, scr, lane); }
        }
        { bf16_t* WG = (bf16_t*)(ws + WS_WG); bf16_t* WL = (bf16_t*)(ws + WS_WL);
            for (int i = gt; i < 2048 * 256; i += NGT) { const int row = i >> 8, kl = i & 255, g_ = row >> 10, nb = (row >> 6) & 15, k = row & 63, blk = kl >> 6, j = kl & 63;
                const float v = ((nb & 3) == blk) ? args.in[g_ ? I_WIG : I_WRG][(size_t)(nb * 64 + j) * 64 + k] : 0.f; WG[i] = cvt1(v); }
            for (int i = gt; i < 3072 * 256; i += NGT) { const int row = i >> 8, kl = i & 255, sel = row >> 10, c = row & 1023;
                float v = 0.f; if (sel == 0) { if (kl < DLORA) v = args.in[I_DECUP][(size_t)kl * RW_W + c]; } else if (sel == 1) { if (kl < ALORA) v = args.in[I_AAAUP][(size_t)kl * RW_W + c]; } else v = args.in[I_GATEUP][(size_t)kl * RW_W + c];
                WL[i] = cvt1(v); } }
        for (int i = gt; i < (NPP - NP) * KD / 8; i += NGT) ((u32x4*)(WinT + (size_t)NP * KD))[i] = (u32x4){0u, 0u, 0u, 0u};
        const float* lg = args.in[I_LNG]; const float* lb = args.in[I_LNB];
        for (int m = gw; m < M; m += NGW) {
            const f32x4* xr = (const f32x4*)(args.in[I_X] + (size_t)m * D) + lane;
            f32x4 v[8]; float s = 0.f;
#pragma unroll
            for (int j = 0; j < 8; ++j) { v[j] = xr[64 * j]; s += (v[j][0] + v[j][1]) + (v[j][2] + v[j][3]); }
            const float mean = wave_sum(s) * (1.f / D); float s2 = 0.f;
#pragma unroll
            for (int j = 0; j < 8; ++j) { v[j] = v[j] - mean; s2 += (v[j][0] * v[j][0] + v[j][1] * v[j][1]) + (v[j][2] * v[j][2] + v[j][3] * v[j][3]); }
            const float rstd = 1.f / sqrtf(wave_sum(s2) * (1.f / D) + LN_EPS);
            u32x2* o8 = (u32x2*)(XN + (size_t)m * D) + lane;
#pragma unroll
            for (int j = 0; j < 8; ++j) { const f32x4 g4 = ((const f32x4*)lg)[64 * j + lane], b4 = ((const f32x4*)lb)[64 * j + lane]; const f32x4 y = v[j] * rstd * g4 + b4;
                u32x2 w; w.x = pk2(y[0], y[1]); w.y = pk2(y[2], y[3]); o8[64 * j] = w; }
        }
    }
    SEAM(0);

    if (IN(1)) REP(1) {
        pg8::StaticOrder S; S.init(M, NPP, G, bid);
        pg8::EpiBf16 E{P, NPP};
        pg8::gemm_phase<pg8::EpiBf16, pg8::StaticOrder, pg8::DenseRows, true>(lds, XN, WinT, S, E, pg8::DenseRows{});
    }
    SEAM(1);

    if (IN(2)) REP(2) {
        bf16_t* UC = (bf16_t*)(ws + WS_UC); bf16_t* XL = (bf16_t*)(ws + WS_XL);
        const float* conv_w = args.in[I_CONVW]; const float* conv_b = args.in[I_CONVB]; const float* mu = args.in[I_MU];
        for (int idx = gt; idx < M * (LRU_W / 8); idx += NGT) { const int m = idx >> 7, c = (idx & 127) * 8, tin = m & (SEQ - 1);
            float o[8];
#pragma unroll
            for (int e = 0; e < 8; ++e) o[e] = conv_b[c + e];
#pragma unroll
            for (int j = 0; j < 4; ++j) { if (tin - 3 + j >= 0) { const u32x4 pv = *(const u32x4*)(P + (size_t)(m - 3 + j) * NPP + c);
                const f32x4 w0 = *(const f32x4*)(conv_w + j * LRU_W + c), w1 = *(const f32x4*)(conv_w + j * LRU_W + c + 4);
                o[0] += w0[0] * bflo(pv.x); o[1] += w0[1] * bfhi(pv.x); o[2] += w0[2] * bflo(pv.y); o[3] += w0[3] * bfhi(pv.y);
                o[4] += w1[0] * bflo(pv.z); o[5] += w1[1] * bfhi(pv.z); o[6] += w1[2] * bflo(pv.w); o[7] += w1[3] * bfhi(pv.w); } }
            *(u32x4*)(UC + (size_t)m * LRU_W + c) = (u32x4){cvt2(o[0], o[1]), cvt2(o[2], o[3]), cvt2(o[4], o[5]), cvt2(o[6], o[7])}; }
        for (int idx = gt; idx < M * 64; idx += NGT) { const int m = idx >> 6, q = idx & 63, tin = m & (SEQ - 1);
            u32x4 res = {0u, 0u, 0u, 0u};
            const int kind = q < 12 ? 0 : (q < 16 ? 3 : (q < 28 ? 1 : (q < 32 ? 3 : 2)));
            if (kind != 3) { const int col = (kind == 0) ? 3 * RW_W + 8 * q : (kind == 1 ? 3 * RW_W + DLORA + 8 * (q - 16) : 3 * RW_W + DLORA + ALORA + 8 * (q - 32));
                const bf16_t* pp = P + (size_t)m * NPP + 2 * LRU_W + col; const u32x4 pc = *(const u32x4*)pp; u32x4 pq = {0u, 0u, 0u, 0u}; if (tin > 0) pq = *(const u32x4*)(pp - NPP);
                const f32x4 m0 = *(const f32x4*)(mu + col), m1 = *(const f32x4*)(mu + col + 4);
                float s[8]; const unsigned pcw[4] = {pc.x, pc.y, pc.z, pc.w}, pqw[4] = {pq.x, pq.y, pq.z, pq.w};
#pragma unroll
                for (int e = 0; e < 4; ++e) { const float c0 = bflo(pcw[e]), c1 = bfhi(pcw[e]), p0 = bflo(pqw[e]), p1 = bfhi(pqw[e]);
                    const float mu0 = (e < 2) ? m0[2 * e] : m1[2 * e - 4], mu1 = (e < 2) ? m0[2 * e + 1] : m1[2 * e - 3];
                    s[2 * e] = c0 + (p0 - c0) * mu0; s[2 * e + 1] = c1 + (p1 - c1) * mu1; }
#pragma unroll
                for (int e = 0; e < 8; ++e) s[e] = (kind == 0) ? tanh_fast(s[e]) : (kind == 1 ? s[e] : sigmoidf_(s[e]));
                res = (u32x4){cvt2(s[0], s[1]), cvt2(s[2], s[3]), cvt2(s[4], s[5]), cvt2(s[6], s[7])}; }
            *(u32x4*)(XL + (size_t)m * 512 + 8 * q) = res; }
    }
    SEAM(2);

    if (IN(3)) {
        const bf16_t* UC = (const bf16_t*)(ws + WS_UC); const bf16_t* XL = (const bf16_t*)(ws + WS_XL);
        { pg8::SmallOrder<0> S{G, bid}; pg8::EpiBf16 E{(bf16_t*)(ws + WS_GATES), 2048};
          pg8::gemm_phase<pg8::EpiBf16, pg8::SmallOrder<0>, pg8::DenseRows, true, LRU_W, 256>(lds, UC, (const bf16_t*)(ws + WS_WG), S, E, pg8::DenseRows{}); }
        { pg8::SmallOrder<1> S{G, bid}; pg8::EpiBf16 E{(bf16_t*)(ws + WS_LOUT), 3072};
          pg8::gemm_phase<pg8::EpiBf16, pg8::SmallOrder<1>, pg8::DenseRows, true, 512, 256>(lds, XL, (const bf16_t*)(ws + WS_WL), S, E, pg8::DenseRows{}); }
    }
    SEAM(3);

    if (IN(4)) {
        constexpr int RS = 144;
        constexpr int L_AT = 0, L_BT = 9216, L_KT = 18432, L_RT = 27648, L_VT = 36864, L_BH = 46080, L_KH = 55296, L_AAB = 64512, L_AAK = 80896, L_ARB = 90112, L_ARK = 99328,
                      L_PT = 108544, L_QT = 117760, L_WC = 126976, L_SEG = 127232, L_A16 = 129280, L_TB = 138496, L_U = L_BT, L_MST = L_AT, L_GST = L_BT;
        bf16_t* MT = (bf16_t*)(ws + WS_MT); bf16_t* GG = (bf16_t*)(ws + WS_GG); float* NN = (float*)(ws + WS_NN); float* HH = (float*)(ws + WS_HH);
        const bf16_t* LOUT = (const bf16_t*)(ws + WS_LOUT); bf16_t* V16 = (bf16_t*)(ws + WS_V16); bf16_t* G16 = (bf16_t*)(ws + WS_G16); const float* mu_ = args.in[I_MU];
        const int r = lane & 31, hh = lane >> 5;
        unsigned short xr[9], xk[9], xv[9], xd[8], xa[8], xg[8];
#define E_LOAD(u_) do { const int cch_ = (u_) & 63, head_ = ((u_) >> 6) & 15, b_ = (u_) >> 10; const size_t tokb_ = (size_t)b_ * SEQ + cch_ * 64 + 8 * wave; const int c_ = head_ * HS + lane; \
            const bf16_t* pp_ = P + tokb_ * NPP + 2 * LRU_W + c_; const bool hp_ = ((cch_ * 64 + 8 * wave) & (SEQ - 1)) != 0; \
            xr[0] = hp_ ? pp_[-NPP] : (unsigned short)0; xk[0] = hp_ ? pp_[-NPP + RW_W] : (unsigned short)0; xv[0] = hp_ ? pp_[-NPP + 2 * RW_W] : (unsigned short)0; \
            _Pragma("unroll") for (int j = 0; j < 8; ++j) { const bf16_t* pj = pp_ + (size_t)j * NPP; xr[j + 1] = pj[0]; xk[j + 1] = pj[RW_W]; xv[j + 1] = pj[2 * RW_W]; \
                const bf16_t* lj = LOUT + (tokb_ + j) * 3072 + c_; xd[j] = lj[0]; xa[j] = lj[1024]; xg[j] = lj[2048]; } } while (0)
        if (bid < NUNIT) E_LOAD(bid);
        REP(4) for (int u = bid; u < NUNIT; u += G) {
            const int cch = u & 63, head = (u >> 6) & 15, b = u >> 10; const size_t tok0 = (size_t)b * SEQ + cch * 64;
            { const int ch = lane, tg = wave, c = head * HS + ch; const size_t tokb = tok0 + 8 * tg;
                float lw[8], rr_[8], kk_[8], vv_[8], kn_[8], aa_[8];
                { const float mur = mu_[c], muk = mu_[RW_W + c], muv = mu_[2 * RW_W + c];
                    const float w0c = args.in[I_W0][c], a0c = args.in[I_A0][c], kkc = args.in[I_KK][c], kac = args.in[I_KA][c], rkc = args.in[I_RK][c];
                    float bonv[8];
#pragma unroll
                    for (int j = 0; j < 8; ++j) { const float cr = bf2f(xr[j + 1]), ck = bf2f(xk[j + 1]), cv = bf2f(xv[j + 1]), pr = bf2f(xr[j]), pk_ = bf2f(xk[j]), pvv = bf2f(xv[j]);
                        const float r = cr + (pr - cr) * mur, k = ck + (pk_ - ck) * muk, v = cv + (pvv - cv) * muv;
                        const float lgw = -0.6065306597126334f * sigmoidf_(w0c + bf2f(xd[j]));
                        const float a = sigmoidf_(a0c + bf2f(xa[j]));
                        float kk = k * kkc; kk = kk * __builtin_amdgcn_rsqf(fmaxf(wave_sum(kk * kk), 1e-24f));
                        const float km = k * (1.f + (a - 1.f) * kac);
                        bonv[j] = wave_sum(r * km * rkc);
                        lw[j] = lgw; rr_[j] = r; kk_[j] = km; vv_[j] = v; kn_[j] = kk; aa_[j] = a; }
#pragma unroll
                    for (int j = 0; j < 8; ++j) { V16[(tokb + j) * RW_W + c] = cvt1(vv_[j]); G16[(tokb + j) * RW_W + c] = xg[j]; }
                    if (lane < 8) { float bsel = bonv[0];
#pragma unroll
                        for (int j = 1; j < 8; ++j) bsel = (lane == j) ? bonv[j] : bsel;
                        BON[(tokb + lane) * NHEAD + head] = bsel; }
                    if (u + G < NUNIT) E_LOAD(u + G); }
                float seg = 0.f;
#pragma unroll
                for (int j = 0; j < 8; ++j) seg += lw[j];
                ((LAS float*)(lds + L_SEG))[tg * 64 + ch] = seg;
                __syncthreads();
                float pre = 0.f, tot = 0.f;
#pragma unroll
                for (int g = 0; g < 8; ++g) { const float sg_ = ((LAS float*)(lds + L_SEG))[g * 64 + ch]; tot += sg_; if (g < tg) pre += sg_; }
                if (tg == 0) ((LAS float*)(lds + L_WC))[ch] = __expf(tot);
                float L = pre; unsigned pv[4], pb[4], pk[4]; float tv[8], tb_[8], tk[8];
                const float eTot = __expf(tot); float eLex = __expf(pre);
#pragma unroll
                for (int j = 0; j < 8; ++j) { L += lw[j];
                    const float eL = __expf(L), eNL = __builtin_amdgcn_rcpf(eL), eEnd = eTot * eNL; const float beta = kn_[j] * aa_[j];
                    const int t = 8 * tg + j;
                    *(LAS unsigned short*)(lds + L_AT + t * RS + ch * 2) = cvt1(kn_[j] * eLex);
                    *(LAS unsigned short*)(lds + L_BT + t * RS + ch * 2) = cvt1(beta * eNL);
                    *(LAS unsigned short*)(lds + L_KT + t * RS + ch * 2) = cvt1(kk_[j] * eNL);
                    *(LAS unsigned short*)(lds + L_RT + t * RS + ch * 2) = cvt1(rr_[j] * eL);
                    tv[j] = vv_[j]; tb_[j] = -beta * eEnd; tk[j] = kk_[j] * eEnd; eLex = eL; }
#pragma unroll
                for (int j = 0; j < 4; ++j) { pv[j] = cvt2(tv[2 * j], tv[2 * j + 1]); pb[j] = cvt2(tb_[2 * j], tb_[2 * j + 1]); pk[j] = cvt2(tk[2 * j], tk[2 * j + 1]); }
                *(LAS u32x4*)(lds + L_VT + ch * RS + tg * 16) = (u32x4){pv[0], pv[1], pv[2], pv[3]};
                *(LAS u32x4*)(lds + L_BH + ch * RS + tg * 16) = (u32x4){pb[0], pb[1], pb[2], pb[3]};
                *(LAS u32x4*)(lds + L_KH + ch * RS + tg * 16) = (u32x4){pk[0], pk[1], pk[2], pk[3]};
            }
            __syncthreads();
            { const int id = wave >> 1, i = wave & 1; const int X = (id < 2) ? L_AT : L_RT, Y = (id & 1) ? L_KT : L_BT;
                f32x16 acc[2];
#pragma unroll
                for (int q = 0; q < 2; ++q)
#pragma unroll
                    for (int e = 0; e < 16; ++e) acc[q][e] = 0.f;
#pragma unroll
                for (int s = 0; s < 4; ++s) { const bf16x8 a = *(const LAS bf16x8*)(lds + X + (32 * i + r) * RS + (16 * s + 8 * hh) * 2);
#pragma unroll
                    for (int q = 0; q < 2; ++q) { const bf16x8 bb = *(const LAS bf16x8*)(lds + Y + (32 * q + r) * RS + (16 * s + 8 * hh) * 2); acc[q] = MFMA32(a, bb, acc[q]); } }
#pragma unroll
                for (int q = 0; q < 2; ++q)
#pragma unroll
                    for (int e = 0; e < 16; ++e) { const int t = 32 * i + crow(e, hh), sc = 32 * q + r; const bool keep = (id < 2) ? (sc < t) : (sc <= t);
                        float val = keep ? acc[q][e] : 0.f; if (id == 2) val = -val;
                        if (id == 0) { ((LAS float*)(lds + L_AAB))[t * 64 + sc] = val; *(LAS unsigned short*)(lds + L_A16 + t * RS + sc * 2) = cvt1(-val); }
                        else *(LAS unsigned short*)(lds + L_AAK + (id - 1) * 9216 + t * RS + sc * 2) = cvt1(val); }
            }
            __syncthreads();
            if (wave < 4) { const int i = wave >> 1, q = wave & 1; f32x16 acc;
#pragma unroll
                for (int e = 0; e < 16; ++e) acc[e] = 0.f;
#pragma unroll
                for (int s = 0; s < 4; ++s) { const bf16x8 a = *(const LAS bf16x8*)(lds + L_AAK + (32 * i + r) * RS + (16 * s + 8 * hh) * 2);
                    const bf16x8 bb = *(const LAS bf16x8*)(lds + L_VT + (32 * q + r) * RS + (16 * s + 8 * hh) * 2); acc = MFMA32(a, bb, acc); }
#pragma unroll
                for (int e = 0; e < 16; ++e) ((LAS float*)(lds + L_U))[(32 * i + crow(e, hh)) * 64 + 32 * q + r] = acc[e];
            }
            if (wave == 4) { const int b2 = lane >> 4, j = lane & 15; float x[16];
                const LAS float* AB = (const LAS float*)(lds + L_AAB) + (16 * b2) * 64 + 16 * b2;
#pragma unroll
                for (int t = 0; t < 16; ++t) { float s_ = (t == j) ? 1.f : 0.f;
#pragma unroll
                    for (int s4 = 0; s4 < (t + 3) / 4; ++s4) { const f32x4 A4 = *(const LAS f32x4*)(AB + t * 64 + 4 * s4);
#pragma unroll
                        for (int e = 0; e < 4; ++e) if (4 * s4 + e < t) s_ -= A4[e] * x[4 * s4 + e]; }
                    x[t] = s_; }
#pragma unroll
                for (int t = 0; t < 16; ++t) *(LAS unsigned short*)(lds + L_TB + ((b2 * 16 + t) * 16 + j) * 2) = cvt1(x[t]);
            }
            __syncthreads();
            { const int c16 = lane & 15, quad = lane >> 4, isQ = wave >> 2, colb = 16 * (wave & 3) + c16;
                f32x4 Xr[4];
#pragma unroll
                for (int b2 = 0; b2 < 4; ++b2) Xr[b2] = (f32x4){0.f, 0.f, 0.f, 0.f};
#pragma unroll
                for (int b2 = 0; b2 < 4; ++b2) {
                    f32x4 y;
#pragma unroll
                    for (int g = 0; g < 4; ++g) { const int row = 16 * b2 + 4 * quad + g;
                        y[g] = isQ ? ((const LAS float*)(lds + L_U))[row * 64 + colb] : bf2f(*(const LAS unsigned short*)(lds + L_AT + row * RS + colb * 2)); }
#pragma unroll
                    for (int ks = 0; ks < 2; ++ks) if (2 * ks < b2) {
                        const u32x2 alo = *(const LAS u32x2*)(lds + L_A16 + (16 * b2 + c16) * RS + (32 * ks + 4 * quad) * 2);
                        u32x2 ahi = {0u, 0u}; if (2 * ks + 1 < b2) ahi = *(const LAS u32x2*)(lds + L_A16 + (16 * b2 + c16) * RS + (32 * ks + 16 + 4 * quad) * 2);
                        const u32x4 af = {alo.x, alo.y, ahi.x, ahi.y};
                        const u32x4 bf = {cvt2(Xr[2 * ks][0], Xr[2 * ks][1]), cvt2(Xr[2 * ks][2], Xr[2 * ks][3]), cvt2(Xr[2 * ks + 1][0], Xr[2 * ks + 1][1]), cvt2(Xr[2 * ks + 1][2], Xr[2 * ks + 1][3])};
                        y = __builtin_amdgcn_mfma_f32_16x16x32_bf16(__builtin_bit_cast(bf16x8, af), __builtin_bit_cast(bf16x8, bf), y, 0, 0, 0); }
                    const u32x2 tlo = *(const LAS u32x2*)(lds + L_TB + ((b2 * 16 + c16) * 16 + 4 * quad) * 2);
                    const u32x4 tf = {tlo.x, tlo.y, 0u, 0u};
                    const u32x4 yf = {cvt2(y[0], y[1]), cvt2(y[2], y[3]), 0u, 0u};
                    Xr[b2] = __builtin_amdgcn_mfma_f32_16x16x32_bf16(__builtin_bit_cast(bf16x8, tf), __builtin_bit_cast(bf16x8, yf), (f32x4){0.f, 0.f, 0.f, 0.f}, 0, 0, 0);
                    *(LAS u32x2*)(lds + (isQ ? L_QT : L_PT) + colb * RS + (16 * b2 + 4 * quad) * 2) = (u32x2){cvt2(Xr[b2][0], Xr[b2][1]), cvt2(Xr[b2][2], Xr[b2][3])};
                }
            }
            __syncthreads();
            { const int mtx = wave >> 1, i = wave & 1;
                const int X1 = (mtx == 0) ? L_BH : (mtx == 1) ? L_KH : (mtx == 2) ? L_ARB : L_ARK;
                const int Y1 = (mtx == 0 || mtx == 2) ? L_PT : L_VT;
                f32x16 acc[2];
#pragma unroll
                for (int q = 0; q < 2; ++q)
#pragma unroll
                    for (int e = 0; e < 16; ++e) acc[q][e] = 0.f;
#pragma unroll
                for (int s = 0; s < 4; ++s) { const bf16x8 a = *(const LAS bf16x8*)(lds + X1 + (32 * i + r) * RS + (16 * s + 8 * hh) * 2);
#pragma unroll
                    for (int q = 0; q < 2; ++q) { const bf16x8 bb = *(const LAS bf16x8*)(lds + Y1 + (32 * q + r) * RS + (16 * s + 8 * hh) * 2); acc[q] = MFMA32(a, bb, acc[q]); } }
                if (mtx & 1) { const int X2 = (mtx == 1) ? L_BH : L_ARB;
#pragma unroll
                    for (int s = 0; s < 4; ++s) { const bf16x8 a = *(const LAS bf16x8*)(lds + X2 + (32 * i + r) * RS + (16 * s + 8 * hh) * 2);
#pragma unroll
                        for (int q = 0; q < 2; ++q) { const bf16x8 bb = *(const LAS bf16x8*)(lds + L_QT + (32 * q + r) * RS + (16 * s + 8 * hh) * 2); acc[q] = MFMA32(a, bb, acc[q]); } } }
                if (mtx == 0) { const float wc = ((const LAS float*)(lds + L_WC))[32 * i + r];
#pragma unroll
                    for (int q = 0; q < 2; ++q)
#pragma unroll
                        for (int e = 0; e < 16; ++e) if (q == i && crow(e, hh) == r) acc[q][e] += wc; }
                if (mtx == 2) {
#pragma unroll
                    for (int q = 0; q < 2; ++q)
#pragma unroll
                        for (int e = 0; e < 16; ++e) acc[q][e] += bf2f(*(const LAS unsigned short*)(lds + L_RT + (32 * i + crow(e, hh)) * RS + (32 * q + r) * 2)); }
                if (mtx & 1) { float* dstg = ((mtx == 1) ? NN : HH) + (size_t)u * 4096;
#pragma unroll
                    for (int q = 0; q < 2; ++q)
#pragma unroll
                        for (int e = 0; e < 16; ++e) dstg[((i * 2 + q) * 16 + e) * 64 + lane] = acc[q][e];
                } else { const int dl = (mtx == 0) ? L_MST : L_GST;
#pragma unroll
                    for (int q = 0; q < 2; ++q)
#pragma unroll
                        for (int e = 0; e < 16; ++e) *(LAS unsigned short*)(lds + dl + (32 * i + crow(e, hh)) * RS + (32 * q + r) * 2) = cvt1(acc[q][e]); }
            }
            __syncthreads();
            { const int f = tid >> 6, i = f >> 2, q = (f >> 1) & 1, s = f & 1, r2 = lane & 31, h2 = lane >> 5; const int off = (32 * i + r2) * RS + (32 * q + 16 * s + 4 * h2) * 2;
                const u32x2 m0 = *(const LAS u32x2*)(lds + L_MST + off), m1 = *(const LAS u32x2*)(lds + L_MST + off + 16);
                const u32x2 g0 = *(const LAS u32x2*)(lds + L_GST + off), g1 = *(const LAS u32x2*)(lds + L_GST + off + 16);
                *(u32x4*)(MT + (size_t)u * 4096 + tid * 8) = (u32x4){m0.x, m0.y, m1.x, m1.y};
                *(u32x4*)(GG + (size_t)u * 4096 + tid * 8) = (u32x4){g0.x, g0.y, g1.x, g1.y}; }
            __syncthreads();
        }
        { float* CA = (float*)(ws + WS_CA); float* CH = (float*)(ws + WS_CH); const bf16_t* UC = (const bf16_t*)(ws + WS_UC); const bf16_t* GATES = (const bf16_t*)(ws + WS_GATES);
            for (int bc = bid; bc < BATCH * 64; bc += G) { const size_t tok0 = (size_t)(bc >> 6) * SEQ + (bc & 63) * 64;
                float h[2] = {0.f, 0.f}, A[2] = {1.f, 1.f}, br[2], bi[2], sp[2];
#pragma unroll
                for (int cc = 0; cc < 2; ++cc) { const int c = tid + 512 * cc; br[cc] = args.in[I_BRG][c]; bi[cc] = args.in[I_BIG][c]; const float lam = args.in[I_LAMBDA][c];
                    sp[cc] = lam > 15.f ? __expf(-lam) : log1pf(__expf(-lam)); }
                unsigned short gr[2][8], gi[2][8], uc[2][8];
#define LRU_LOAD(t_) do { _Pragma("unroll") for (int cc = 0; cc < 2; ++cc) _Pragma("unroll") for (int j = 0; j < 8; ++j) { const size_t tk = tok0 + (t_) + j; const int c = tid + 512 * cc; \
                    gr[cc][j] = GATES[tk * 2048 + c]; gi[cc][j] = GATES[tk * 2048 + LRU_W + c]; uc[cc][j] = UC[tk * LRU_W + c]; } } while (0)
                LRU_LOAD(0);
#pragma unroll 1
                for (int t = 0; t < 64; t += 8) {
                    float hv[2][8], av[2][8];
#pragma unroll
                    for (int cc = 0; cc < 2; ++cc)
#pragma unroll
                        for (int j = 0; j < 8; ++j) { const float rg = sigmoidf_(bf2f(gr[cc][j]) + br[cc]), ig = sigmoidf_(bf2f(gi[cc][j]) + bi[cc]);
                            const float a = __expf(-8.f * rg * sp[cc]), bb = sqrtf(fmaxf(1.f - a * a, 0.f)) * (ig * bf2f(uc[cc][j]));
                            h[cc] = a * h[cc] + bb; A[cc] *= a; hv[cc][j] = h[cc]; av[cc][j] = A[cc]; }
                    if (t + 8 < 64) LRU_LOAD(t + 8);
#pragma unroll
                    for (int cc = 0; cc < 2; ++cc)
#pragma unroll
                        for (int j = 0; j < 8; ++j) { const int c = tid + 512 * cc; LB[(tok0 + t + j) * LRU_W + c] = hv[cc][j]; LA[(tok0 + t + j) * LRU_W + c] = av[cc][j]; }
                }
#undef LRU_LOAD
#pragma unroll
                for (int cc = 0; cc < 2; ++cc) { const int c = tid + 512 * cc; CA[(size_t)bc * LRU_W + c] = A[cc]; CH[(size_t)bc * LRU_W + c] = h[cc]; } } }
    }
    SEAM(4);

    if (IN(5)) REP(5) {
        if (bid < BATCH * NHEAD) {
            const bf16_t* MT = (const bf16_t*)(ws + WS_MT); const float* NN = (const float*)(ws + WS_NN); bf16_t* XS = (bf16_t*)(ws + WS_XS);
            constexpr int SLOT = 24576, NCH = SEQ / 64;
            const int u0 = bid * NCH;
            if (wave >= 2) {
                const int lw = wave - 2;
#define R2_ISSUE(c_) do { const int _u = u0 + (c_); const int _sl = ((c_) & 3) * SLOT; _Pragma("unroll") for (int _rd = 0; _rd < 4; ++_rd) { const int _k0 = _rd * 384 + lw * 64; \
                    const char* _src = (_k0 < 512) ? (const char*)MT + (size_t)_u * 8192 + (size_t)(_k0 + lane) * 16 : (const char*)NN + (size_t)_u * 16384 + (size_t)(_k0 - 512 + lane) * 16; \
                    __builtin_amdgcn_global_load_lds((const unsigned*)_src, (LAS unsigned*)(lds + _sl + _k0 * 16), 16, 0, 0); } } while (0)
                R2_ISSUE(0); R2_ISSUE(1); R2_ISSUE(2);
                for (int c = 0; c < NCH; ++c) {
                    if (c < NCH - 2) asm volatile("s_waitcnt vmcnt(8)" ::: "memory"); else if (c == NCH - 2) asm volatile("s_waitcnt vmcnt(4)" ::: "memory"); else asm volatile("s_waitcnt vmcnt(0)" ::: "memory");
                    __builtin_amdgcn_s_barrier();
                    asm volatile("" ::: "memory");
                    if (c + 3 < NCH) R2_ISSUE(c + 3);
                }
#undef R2_ISSUE
            } else {
                const int vh = wave;
                f32x16 X[2];
#pragma unroll
                for (int q = 0; q < 2; ++q)
#pragma unroll
                    for (int e = 0; e < 16; ++e) X[q][e] = 0.f;
                for (int c = 0; c < NCH; ++c) {
                    bf16x8 xb[2][2];
#pragma unroll
                    for (int q = 0; q < 2; ++q)
#pragma unroll
                        for (int s = 0; s < 2; ++s) { const u32x4 p = {cvt2(X[q][8 * s], X[q][8 * s + 1]), cvt2(X[q][8 * s + 2], X[q][8 * s + 3]), cvt2(X[q][8 * s + 4], X[q][8 * s + 5]), cvt2(X[q][8 * s + 6], X[q][8 * s + 7])};
                            xb[q][s] = __builtin_bit_cast(bf16x8, p);
                            *(u32x4*)(XS + (size_t)(u0 + c) * 4096 + (((vh * 2 + q) * 2 + s) * 64 + lane) * 8) = p; }
                    asm volatile("" ::: "memory");
                    __builtin_amdgcn_s_barrier();
                    asm volatile("" ::: "memory");
                    const LAS unsigned char* sl = lds + (c & 3) * SLOT;
#pragma unroll
                    for (int i = 0; i < 2; ++i) { f32x16 nx;
#pragma unroll
                        for (int e = 0; e < 16; ++e) nx[e] = ((const LAS float*)(sl + 8192))[((i * 2 + vh) * 16 + e) * 64 + lane];
#pragma unroll
                        for (int q = 0; q < 2; ++q)
#pragma unroll
                            for (int s = 0; s < 2; ++s) { const bf16x8 a = *(const LAS bf16x8*)(sl + ((i * 2 + q) * 2 + s) * 1024 + lane * 16); nx = MFMA32(a, xb[q][s], nx); }
                        X[i] = nx; }
                    asm volatile("s_waitcnt lgkmcnt(0)" ::: "memory");
                }
            }
        } else if (bid < BATCH * NHEAD + 8) {
            const float* CA = (const float*)(ws + WS_CA); const float* CH = (const float*)(ws + WS_CH); float* CIN = (float*)(ws + WS_CIN);
            const int i = (bid - BATCH * NHEAD) * NTHREADS + tid, b = i >> 10, c = i & 1023; float s = 0.f;
            for (int ch = 0; ch < 64; ch += 8) { float a[8], hh_[8];
#pragma unroll
                for (int j = 0; j < 8; ++j) { a[j] = CA[(size_t)(b * 64 + ch + j) * LRU_W + c]; hh_[j] = CH[(size_t)(b * 64 + ch + j) * LRU_W + c]; }
#pragma unroll
                for (int j = 0; j < 8; ++j) { CIN[(size_t)(b * 64 + ch + j) * LRU_W + c] = s; s = a[j] * s + hh_[j]; } }
        }
    }
    SEAM(5);

    if (IN(6)) REP(6) {
        { const float* CIN = (const float*)(ws + WS_CIN);
            for (int idx = gt; idx < M * (LRU_W / 8); idx += NGT) { const int m = idx >> 7, c = (idx & 127) * 8; const size_t o = (size_t)m * LRU_W + c;
                const u32x4 gq = *(const u32x4*)(P + (size_t)m * NPP + LRU_W + c);
                const f32x4 h0 = *(const f32x4*)(LB + o), h1 = *(const f32x4*)(LB + o + 4), a0 = *(const f32x4*)(LA + o), a1 = *(const f32x4*)(LA + o + 4);
                const f32x4 c0 = *(const f32x4*)(CIN + (size_t)(m >> 6) * LRU_W + c), c1 = *(const f32x4*)(CIN + (size_t)(m >> 6) * LRU_W + c + 4);
                const unsigned gw_[4] = {gq.x, gq.y, gq.z, gq.w}; float o8[8];
#pragma unroll
                for (int e = 0; e < 4; ++e) { const float hA = (e < 2 ? h0[2 * e] : h1[2 * e - 4]) + (e < 2 ? a0[2 * e] : a1[2 * e - 4]) * (e < 2 ? c0[2 * e] : c1[2 * e - 4]);
                    const float hB = (e < 2 ? h0[2 * e + 1] : h1[2 * e - 3]) + (e < 2 ? a0[2 * e + 1] : a1[2 * e - 3]) * (e < 2 ? c0[2 * e + 1] : c1[2 * e - 3]);
                    o8[2 * e] = hA * gelu_tanh(bflo(gw_[e])); o8[2 * e + 1] = hB * gelu_tanh(bfhi(gw_[e])); }
                *(u32x4*)(CAT + (size_t)m * D + c) = (u32x4){cvt2(o8[0], o8[1]), cvt2(o8[2], o8[3]), cvt2(o8[4], o8[5]), cvt2(o8[6], o8[7])}; } }
        const bf16_t* GG = (const bf16_t*)(ws + WS_GG); const bf16_t* XS = (const bf16_t*)(ws + WS_XS); const float* HH = (const float*)(ws + WS_HH);
        const bf16_t* V16 = (const bf16_t*)(ws + WS_V16); const bf16_t* G16 = (const bf16_t*)(ws + WS_G16);
        const float* gng = args.in[I_GNG]; const float* gnb = args.in[I_GNB];
        const int r = lane & 31, hh = lane >> 5;
        constexpr int YS = 68;
        LAS float* yt = (LAS float*)(lds + wave * (64 * YS * 4));
        for (int u = gw; u < NUNIT; u += NGW) {
            const int cch = u & 63, head = (u >> 6) & 15, b = u >> 10; const size_t tok0 = (size_t)b * SEQ + cch * 64;
            f32x16 acc[2][2];
#pragma unroll
            for (int i = 0; i < 2; ++i)
#pragma unroll
                for (int vh = 0; vh < 2; ++vh)
#pragma unroll
                    for (int e = 0; e < 16; ++e) acc[i][vh][e] = HH[(size_t)u * 4096 + ((i * 2 + vh) * 16 + e) * 64 + lane];
#pragma unroll
            for (int q = 0; q < 2; ++q)
#pragma unroll
                for (int s = 0; s < 2; ++s) { bf16x8 xb[2], ga[2];
#pragma unroll
                    for (int vh = 0; vh < 2; ++vh) xb[vh] = *(const bf16x8*)(XS + (size_t)u * 4096 + (((vh * 2 + q) * 2 + s) * 64 + lane) * 8);
#pragma unroll
                    for (int i = 0; i < 2; ++i) ga[i] = *(const bf16x8*)(GG + (size_t)u * 4096 + (((i * 2 + q) * 2 + s) * 64 + lane) * 8);
#pragma unroll
                    for (int i = 0; i < 2; ++i)
#pragma unroll
                        for (int vh = 0; vh < 2; ++vh) acc[i][vh] = MFMA32(ga[i], xb[vh], acc[i][vh]); }
#pragma unroll
            for (int i = 0; i < 2; ++i)
#pragma unroll
                for (int e = 0; e < 16; ++e) {
                    const float s1 = half_sum(acc[i][0][e] + acc[i][1][e], hh);
                    const float mean = s1 * (1.f / 64.f);
                    const float d0 = acc[i][0][e] - mean, d1 = acc[i][1][e] - mean; const float s2 = half_sum(d0 * d0 + d1 * d1, hh);
                    const float rstd = __builtin_amdgcn_rsqf(s2 * (1.f / 64.f) + GN_EPS);
                    const int t = 32 * i + crow(e, hh);
                    yt[t * YS + r] = d0 * rstd; yt[t * YS + 32 + r] = d1 * rstd; }
            asm volatile("s_waitcnt lgkmcnt(0)" ::: "memory");
            { const int tq = lane >> 3, c8 = (lane & 7) * 8, ch = head * HS + c8;
                const f32x4 g0 = *(const f32x4*)(gng + ch), g1 = *(const f32x4*)(gng + ch + 4), b0 = *(const f32x4*)(gnb + ch), b1 = *(const f32x4*)(gnb + ch + 4);
#pragma unroll 2
                for (int k = 0; k < 8; ++k) { const int t = tq + 8 * k; const size_t tok = tok0 + t; const size_t o = tok * RW_W + ch;
                    const f32x4 y0 = *(const LAS f32x4*)(yt + t * YS + c8), y1 = *(const LAS f32x4*)(yt + t * YS + c8 + 4);
                    const u32x4 vq = *(const u32x4*)(V16 + o), gq = *(const u32x4*)(G16 + o); const float bon = BON[tok * NHEAD + head];
                    const unsigned vw[4] = {vq.x, vq.y, vq.z, vq.w}, gw4[4] = {gq.x, gq.y, gq.z, gq.w}; float o8[8];
#pragma unroll
                    for (int e = 0; e < 4; ++e) { const float ya = (e < 2 ? y0[2 * e] : y1[2 * e - 4]), yb = (e < 2 ? y0[2 * e + 1] : y1[2 * e - 3]);
                        const float ga_ = (e < 2 ? g0[2 * e] : g1[2 * e - 4]), gb_ = (e < 2 ? g0[2 * e + 1] : g1[2 * e - 3]), ba_ = (e < 2 ? b0[2 * e] : b1[2 * e - 4]), bb_ = (e < 2 ? b0[2 * e + 1] : b1[2 * e - 3]);
                        o8[2 * e] = (ya * ga_ + ba_ + bon * bflo(vw[e])) * bflo(gw4[e]); o8[2 * e + 1] = (yb * gb_ + bb_ + bon * bfhi(vw[e])) * bfhi(gw4[e]); }
                    *(u32x4*)(CAT + tok * D + LRU_W + ch) = (u32x4){cvt2(o8[0], o8[1]), cvt2(o8[2], o8[3]), cvt2(o8[4], o8[5]), cvt2(o8[6], o8[7])}; } }
            asm volatile("s_waitcnt lgkmcnt(0)" ::: "memory");
        }
    }
    SEAM(6);

    if (IN(7)) REP(7) {
        pg8::StaticOrder S; S.init(M, D, G, bid);
        pg8::EpiResF32 E{Z, XN, DN_ALPHA};
        pg8::gemm_phase<pg8::EpiResF32, pg8::StaticOrder, pg8::DenseRows, true>(lds, CAT, WoT, S, E, pg8::DenseRows{});
    }
    SEAM(7);

    if (IN(8)) {
        LAS float* hT = (LAS float*)lds;
        LAS float* part = (LAS float*)lds;
        LAS float* lgt = (LAS float*)(lds + 65536);
        const float* g1 = args.in[I_LN1G]; const float* b1 = args.in[I_LN1B]; const float* wr_ = args.in[I_WROUTER]; const float* br_ = args.in[I_BROUTER];
        for (int tile = bid; tile < M / 16; tile += G) {
            const int t0 = tile * 16;
            __syncthreads();
#pragma unroll 1
            for (int rr = 0; rr < 2; ++rr) { const int tb = wave * 2 + rr, m = t0 + tb;
                const f32x4* zr = (const f32x4*)(Z + (size_t)m * D) + lane;
                f32x4 v[8]; float s = 0.f;
#pragma unroll
                for (int j = 0; j < 8; ++j) { v[j] = zr[64 * j]; s += (v[j][0] + v[j][1]) + (v[j][2] + v[j][3]); }
                const float mean = wave_sum(s) * (1.f / D); float s2 = 0.f;
#pragma unroll
                for (int j = 0; j < 8; ++j) { v[j] = v[j] - mean; s2 += (v[j][0] * v[j][0] + v[j][1] * v[j][1]) + (v[j][2] * v[j][2] + v[j][3] * v[j][3]); }
                const float rstd = 1.f / sqrtf(wave_sum(s2) * (1.f / D) + LN_EPS);
                f32x4* ho = (f32x4*)(H1 + (size_t)m * D) + lane; u32x2* hb = (u32x2*)(H1B + (size_t)m * D) + lane;
#pragma unroll
                for (int j = 0; j < 8; ++j) { const f32x4 g4 = ((const f32x4*)g1)[64 * j + lane], b4 = ((const f32x4*)b1)[64 * j + lane]; const f32x4 y = v[j] * rstd * g4 + b4;
                    ho[64 * j] = y; u32x2 w; w.x = pk2(y[0], y[1]); w.y = pk2(y[2], y[3]); hb[64 * j] = w;
#pragma unroll
                    for (int q = 0; q < 4; ++q) hT[(256 * j + 4 * lane + q) * 16 + tb] = y[q]; } }
            __syncthreads();
            float ac[16];
#pragma unroll
            for (int tb = 0; tb < 16; ++tb) ac[tb] = 0.f;
            { const int e = tid & 31, sl = tid >> 5;
                for (int i = sl * 128; i < sl * 128 + 128; ++i) { const float w = wr_[(size_t)i * NE + e]; const LAS f32x4* hp = (const LAS f32x4*)(hT + i * 16);
#pragma unroll
                    for (int q = 0; q < 4; ++q) { const f32x4 h4 = hp[q];
#pragma unroll
                        for (int k = 0; k < 4; ++k) ac[q * 4 + k] += w * h4[k]; } }
                __syncthreads();
#pragma unroll
                for (int tb = 0; tb < 16; ++tb) part[(sl * 16 + tb) * 32 + e] = ac[tb]; }
            __syncthreads();
            { const int tb = tid >> 5, e = tid & 31; float sacc = br_[e];
#pragma unroll
                for (int sl = 0; sl < 16; ++sl) sacc += part[(sl * 16 + tb) * 32 + e];
                lgt[tb * 32 + e] = sacc; }
            __syncthreads();
            if (tid < 16) { const int m = t0 + tid; float bv[4]; int bi[4]; unsigned used = 0u;
#pragma unroll 1
                for (int k = 0; k < 4; ++k) { float best = -3.0e38f; int be = 0;
                    for (int e = 0; e < NE; ++e) { const float x = lgt[tid * 32 + e]; if (!((used >> e) & 1u) && x > best) { best = x; be = e; } }
                    used |= 1u << be; bv[k] = best; bi[k] = be; }
                float ex[4], den = 0.f;
#pragma unroll
                for (int k = 0; k < 4; ++k) { ex[k] = __expf(bv[k] - bv[0]); den += ex[k]; }
#pragma unroll 1
                for (int k = 0; k < 4; ++k) { const int pos = (int)__hip_atomic_fetch_add(ctl + CW_CNT + 64 * bi[k], 1u, RLX_AGENT);
                    TOPE[m * 4 + k] = bi[k]; TOPP[m * 4 + k] = pos; TOPG[m * 4 + k] = ex[k] / den; } }
        }
    }
    SEAM(8);

    if (IN(9)) REP(9) {
        volatile LAS int* tb = (volatile LAS int*)(MISC + 16);
        moe_tables(tb, ctl);
        for (int i = gt; i < M * TOPK; i += NGT) { const int e = TOPE[i], slot = tb[1 + e] * 256 + TOPP[i];
            SLOTTOK[slot] = i >> 2; SLOTG[slot] = TOPG[i]; TOKSLOT[i] = slot; }
        if (bid < NE) { const int e = bid, c = (int)__hip_atomic_load(ctl + CW_CNT + 64 * e, RLX_AGENT), s0 = tb[1 + e] * 256 + c, s1 = tb[2 + e] * 256;
            for (int s = s0 + tid; s < s1; s += NTHREADS) { SLOTTOK[s] = 0; SLOTG[s] = 0.f; } }
    }
    SEAM(9);

    if (IN(10)) REP(10) {
        volatile LAS int* tb = (volatile LAS int*)(MISC + 16);
        moe_tables(tb, ctl);
        pg8::MoeOrder S{(const LAS int*)(tb + 64), tb[0], 16, G, bid};
        pg8::EpiSwiglu E{ACT, args.in[I_BE1]};
        pg8::gemm_phase<pg8::EpiSwiglu, pg8::MoeOrder, pg8::GatherRows, true>(lds, H1B, W1T, S, E, pg8::GatherRows{SLOTTOK});
    }
    SEAM(10);

    if (IN(11)) REP(11) {
        volatile LAS int* tb = (volatile LAS int*)(MISC + 16);
        moe_tables(tb, ctl);
        pg8::MoeOrder S{(const LAS int*)(tb + 64), tb[0], 8, G, bid};
        pg8::EpiMoeOut E{OUTS, args.in[I_BE2], SLOTG};
        pg8::gemm_phase<pg8::EpiMoeOut, pg8::MoeOrder, pg8::DenseRows, true>(lds, ACT, W2T, S, E, pg8::DenseRows{});
    }
    SEAM(11);

    if (IN(12)) REP(12) {
        const float* g2 = args.in[I_LN2G]; const float* b2 = args.in[I_LN2B];
        for (int m = gw; m < M; m += NGW) {
            const f32x4* hr = (const f32x4*)(H1 + (size_t)m * D) + lane;
            const int s0 = TOKSLOT[m * 4], s1 = TOKSLOT[m * 4 + 1], s2_ = TOKSLOT[m * 4 + 2], s3 = TOKSLOT[m * 4 + 3];
            const u32x2* o0 = (const u32x2*)(OUTS + (size_t)s0 * D) + lane; const u32x2* o1 = (const u32x2*)(OUTS + (size_t)s1 * D) + lane;
            const u32x2* o2 = (const u32x2*)(OUTS + (size_t)s2_ * D) + lane; const u32x2* o3 = (const u32x2*)(OUTS + (size_t)s3 * D) + lane;
            f32x4 v[8]; float s = 0.f;
#pragma unroll
            for (int j = 0; j < 8; ++j) { const f32x4 h4 = hr[64 * j]; const u32x2 a = o0[64 * j], b = o1[64 * j], c = o2[64 * j], d = o3[64 * j];
                f32x4 mo; mo[0] = (bflo(a.x) + bflo(b.x)) + (bflo(c.x) + bflo(d.x)); mo[1] = (bfhi(a.x) + bfhi(b.x)) + (bfhi(c.x) + bfhi(d.x));
                mo[2] = (bflo(a.y) + bflo(b.y)) + (bflo(c.y) + bflo(d.y)); mo[3] = (bfhi(a.y) + bfhi(b.y)) + (bfhi(c.y) + bfhi(d.y));
                v[j] = h4 * DN_ALPHA + mo; s += (v[j][0] + v[j][1]) + (v[j][2] + v[j][3]); }
            const float mean = wave_sum(s) * (1.f / D); float q2 = 0.f;
#pragma unroll
            for (int j = 0; j < 8; ++j) { v[j] = v[j] - mean; q2 += (v[j][0] * v[j][0] + v[j][1] * v[j][1]) + (v[j][2] * v[j][2] + v[j][3] * v[j][3]); }
            const float rstd = 1.f / sqrtf(wave_sum(q2) * (1.f / D) + LN_EPS);
            f32x4* orow = (f32x4*)(args.out + (size_t)m * D) + lane;
#pragma unroll
            for (int j = 0; j < 8; ++j) { const f32x4 g4 = ((const f32x4*)g2)[64 * j + lane], b4 = ((const f32x4*)b2)[64 * j + lane]; orow[64 * j] = v[j] * rstd * g4 + b4; }
        }
    }
    if (PROBE_PHASE >= 0) { if (PROBE_PHASE == NPHASE - 1) tprobe1 = __builtin_amdgcn_s_memrealtime();
        asm volatile("s_waitcnt vmcnt(0)" ::: "memory"); __syncthreads();
        if (bid == 0 && tid == 0) args.out[0] += 1.0f + (float)(tprobe1 - tprobe0) * 1e-4f; }
#undef IN
#undef SEAM
}

#ifndef MK_ONE_LAUNCH
#define MK_ONE_LAUNCH 1
#endif
extern "C" void kernel_launch(void* const* d_in, const int* in_sizes, int n_in, void* d_out, int out_size, void* d_ws, size_t ws_size, hipStream_t stream) {
    static int grid = 0;
    if (grid == 0) {
        if (n_in != 33 || out_size != M * D || ws_size < WS_END) { fprintf(stderr, "kernel_launch: unexpected sizes n_in %d out %d ws %zu (need %zu)\n", n_in, out_size, ws_size, (size_t)WS_END); grid = -1; return; }
        int dev = 0, cus = 0, per_cu = 0;
        if (hipGetDevice(&dev) != hipSuccess || hipDeviceGetAttribute(&cus, hipDeviceAttributeMultiprocessorCount, dev) != hipSuccess) { grid = -1; return; }
        if (hipFuncSetAttribute((const void*)fwd, hipFuncAttributeMaxDynamicSharedMemorySize, LDS_BYTES) != hipSuccess) { fprintf(stderr, "kernel_launch: hipFuncSetAttribute failed\n"); grid = -1; return; }
        if (hipOccupancyMaxActiveBlocksPerMultiprocessor(&per_cu, (const void*)fwd, NTHREADS, LDS_BYTES) != hipSuccess || per_cu < 1) fprintf(stderr, "kernel_launch: occupancy query says %d\n", per_cu);
        (void)hipGetLastError();
        grid = cus;
    }
    if (grid < 0) return;
    (void)hipMemsetAsync((char*)d_ws + WS_CTL, 0, CTL_ZERO_BYTES, stream);
    Args a{};
    for (int i = 0; i < 33; ++i) a.in[i] = (const float*)d_in[i];
    a.out = (float*)d_out; a.ws = (unsigned char*)d_ws;
#if MK_ONE_LAUNCH
    a.ph_lo = 0; a.ph_hi = NPHASE; a.use_bar = 1;
    hipLaunchKernelGGL(fwd, dim3(grid), dim3(NTHREADS), LDS_BYTES, stream, a);
#else
    for (int p = 0; p < NPHASE; ++p) { a.ph_lo = p; a.ph_hi = p + 1; a.use_bar = 0;
        hipLaunchKernelGGL(fwd, dim3(grid), dim3(NTHREADS), LDS_BYTES, stream, a); }
#endif
}
```

```cpp
#include <hip/hip_runtime.h>
#include <cstdio>
#include <cstdint>

#define LAS __attribute__((address_space(3)))
#define GAS __attribute__((address_space(1)))
typedef unsigned short bf16_t;
typedef short bf16x8 __attribute__((ext_vector_type(8)));
typedef float f32x4 __attribute__((ext_vector_type(4)));
typedef float f32x2 __attribute__((ext_vector_type(2)));
typedef unsigned u32x4 __attribute__((ext_vector_type(4)));
typedef unsigned u32x2 __attribute__((ext_vector_type(2)));
typedef float f32x16 __attribute__((ext_vector_type(16)));
typedef int i32x4 __attribute__((ext_vector_type(4)));
typedef int i32x8 __attribute__((ext_vector_type(8)));
typedef __bf16 bfv2 __attribute__((ext_vector_type(2)));
#define MFMA32(a, b, c) __builtin_amdgcn_mfma_f32_32x32x16_bf16((a), (b), (c), 0, 0, 0)

constexpr int BATCH = 4, SEQ = 4096, M = BATCH * SEQ, D = 2048;
constexpr int LRU_W = 1024, RW_W = 1024, NHEAD = 16, HS = 64;
constexpr int DLORA = 96, ALORA = 96, GLORA = 256;
constexpr int RW_SHIFT_W = 3 * RW_W + DLORA + ALORA + GLORA;
constexpr int NP = 2 * LRU_W + RW_SHIFT_W;
constexpr int NPP = 5632;
constexpr int NE = 32, TOPK = 4, DE = 2048;
constexpr int NSLOT_MAX = M * TOPK + NE * 256;
constexpr int NTILE_MAX = NSLOT_MAX / 256;
constexpr float LN_EPS = 1e-5f, GN_EPS = 64e-5f;
constexpr float DN_ALPHA = 1.189207115002721f;
constexpr int KD = 2048;

constexpr size_t MiB = 1u << 20;
constexpr size_t WS_CTL = 0, CTL_ZERO_BYTES = 1 * MiB;
constexpr size_t WS_WIN = 2 * MiB;
constexpr size_t WS_WO = WS_WIN + (size_t)NPP * KD * 2;
constexpr size_t WS_W1 = WS_WO + (size_t)D * KD * 2;
constexpr size_t WS_W2 = WS_W1 + (size_t)NE * 2 * DE * KD * 2;
constexpr size_t WS_XN = WS_W2 + (size_t)NE * D * DE * 2;
constexpr size_t WS_P = WS_XN + (size_t)M * D * 2;
constexpr size_t WS_LA = WS_P + (size_t)M * NPP * 2;
constexpr size_t WS_LB = WS_LA + (size_t)M * LRU_W * 4;
constexpr size_t WS_UC = WS_LB + (size_t)M * LRU_W * 4;
constexpr size_t WS_XL = WS_UC + (size_t)M * LRU_W * 2;
constexpr size_t WS_GATES = WS_XL + (size_t)M * 512 * 2;
constexpr size_t WS_LOUT = WS_GATES + (size_t)M * 2048 * 2;
constexpr size_t WS_V16 = WS_LOUT + (size_t)M * 3072 * 2;
constexpr size_t WS_G16 = WS_V16 + (size_t)M * RW_W * 2;
constexpr size_t WS_WG = WS_G16 + (size_t)M * RW_W * 2;
constexpr size_t WS_WL = WS_WG + (size_t)2048 * 256 * 2;
constexpr size_t WS_RY = WS_WL + (size_t)3072 * 256 * 2;
constexpr size_t WS_BON = WS_RY;
constexpr size_t WS_CAT = WS_BON + (size_t)M * NHEAD * 4;
constexpr size_t WS_Z = WS_CAT + (size_t)M * D * 2;
constexpr size_t WS_H1 = WS_Z + (size_t)M * D * 4;
constexpr size_t WS_H1B = WS_H1 + (size_t)M * D * 4;
constexpr size_t WS_TOPE = WS_H1B + (size_t)M * D * 2;
constexpr size_t WS_TOPP = WS_TOPE + (size_t)M * TOPK * 4;
constexpr size_t WS_TOPG = WS_TOPP + (size_t)M * TOPK * 4;
constexpr size_t WS_TOKSLOT = WS_TOPG + (size_t)M * TOPK * 4;
constexpr size_t WS_SLOTTOK = WS_TOKSLOT + (size_t)M * TOPK * 4;
constexpr size_t WS_SLOTG = WS_SLOTTOK + (size_t)NSLOT_MAX * 4;
constexpr size_t WS_ACT = WS_SLOTG + (size_t)NSLOT_MAX * 4;
constexpr size_t WS_OUTS = WS_ACT + (size_t)NSLOT_MAX * DE * 2;
constexpr int NUNIT = BATCH * NHEAD * (SEQ / 64);
constexpr size_t WS_MT = WS_OUTS + (size_t)NSLOT_MAX * D * 2;
constexpr size_t WS_GG = WS_MT + (size_t)NUNIT * 8192;
constexpr size_t WS_XS = WS_GG + (size_t)NUNIT * 8192;
constexpr size_t WS_NN = WS_XS + (size_t)NUNIT * 8192;
constexpr size_t WS_HH = WS_NN + (size_t)NUNIT * 16384;
constexpr size_t WS_CA = WS_HH + (size_t)NUNIT * 16384;
constexpr size_t WS_CH = WS_CA + (size_t)BATCH * 64 * LRU_W * 4;
constexpr size_t WS_CIN = WS_CH + (size_t)BATCH * 64 * LRU_W * 4;
constexpr size_t WS_END = WS_CIN + (size_t)BATCH * 64 * LRU_W * 4;
constexpr int CW_CNT = 1024;
constexpr int CW_BAR = 4096;

constexpr int MISC_OFF = 159744;
constexpr int LDS_BYTES = 163840;

#define RLX_AGENT __ATOMIC_RELAXED, __HIP_MEMORY_SCOPE_AGENT
__device__ __forceinline__ unsigned f2bf(float f) { unsigned u = __builtin_bit_cast(unsigned, f); return (u + 0x7fffu + ((u >> 16) & 1u)) >> 16; }
__device__ __forceinline__ unsigned pk2(float lo, float hi) { return f2bf(lo) | (f2bf(hi) << 16); }
__device__ __forceinline__ float bf2f(unsigned short b) { return __builtin_bit_cast(float, (unsigned)b << 16); }
__device__ __forceinline__ float bflo(unsigned w) { return __builtin_bit_cast(float, w << 16); }
__device__ __forceinline__ float bfhi(unsigned w) { return __builtin_bit_cast(float, w & 0xffff0000u); }
__device__ __forceinline__ unsigned cvt2(float a, float b) { const f32x2 v = {a, b}; return __builtin_bit_cast(unsigned, __builtin_convertvector(v, bfv2)); }
__device__ __forceinline__ unsigned short cvt1(float a) { return (unsigned short)(cvt2(a, 0.f) & 0xffffu); }
constexpr float F8_SH = 4.f, F8_SW1 = 32.f, F8_SACT = 4.f, F8_SW2 = 64.f;
__device__ __forceinline__ float f8clamp(float x) { return fminf(fmaxf(x, -448.f), 448.f); }
__device__ __forceinline__ unsigned pk4_f8(float a, float b, float c, float d) { int w = 0; w = __builtin_amdgcn_cvt_pk_fp8_f32(f8clamp(a), f8clamp(b), w, false); w = __builtin_amdgcn_cvt_pk_fp8_f32(f8clamp(c), f8clamp(d), w, true); return (unsigned)w; }
__device__ __forceinline__ int lane_now() { int l; asm volatile("v_mbcnt_lo_u32_b32 %0, -1, 0\n\tv_mbcnt_hi_u32_b32 %0, -1, %0" : "=v"(l)); return l; }
__device__ __forceinline__ int crow(int reg, int h) { return (reg & 3) + 8 * (reg >> 2) + 4 * h; }
__device__ __forceinline__ float row_sum16(float v) {
    v += __builtin_bit_cast(float, __builtin_amdgcn_update_dpp(0, __builtin_bit_cast(int, v), 0xB1, 0xf, 0xf, false));
    v += __builtin_bit_cast(float, __builtin_amdgcn_update_dpp(0, __builtin_bit_cast(int, v), 0x4E, 0xf, 0xf, false));
    v += __builtin_bit_cast(float, __builtin_amdgcn_update_dpp(0, __builtin_bit_cast(int, v), 0x141, 0xf, 0xf, false));
    v += __builtin_bit_cast(float, __builtin_amdgcn_update_dpp(0, __builtin_bit_cast(int, v), 0x140, 0xf, 0xf, false));
    return v;
}
__device__ __forceinline__ float rdlane(float v, int l) { return __builtin_bit_cast(float, __builtin_amdgcn_readlane(__builtin_bit_cast(int, v), l)); }
__device__ __forceinline__ float wave_sum(float v) { v = row_sum16(v); return (rdlane(v, 0) + rdlane(v, 16)) + (rdlane(v, 32) + rdlane(v, 48)); }
__device__ __forceinline__ float half_sum(float v, int hh) { v = row_sum16(v); const float lo = rdlane(v, 0) + rdlane(v, 16), hi = rdlane(v, 32) + rdlane(v, 48); return hh ? hi : lo; }
__device__ __forceinline__ float sigmoidf_(float x) { return __builtin_amdgcn_rcpf(1.f + __expf(-x)); }
__device__ __forceinline__ float gelu_tanh(float x) { const float u = 0.7978845608028654f * (x + 0.044715f * x * x * x); return x * __builtin_amdgcn_rcpf(1.f + __expf(-2.f * u)); }
__device__ __forceinline__ float tanh_fast(float x) { const float e = __expf(-2.f * fabsf(x)); const float t = (1.f - e) * __builtin_amdgcn_rcpf(1.f + e); return x < 0.f ? -t : t; }

#define XB_TMO      128
#define XB_XCNT(j)  (256  + 64 * (j))
#define XB_XSUB(j)  (1280 + 64 * (j))
#define XB_XGEN(j)  (2304 + 64 * (j))
#define XB_TOP      3328
#define XB_TOPGEN   3392
#define XCD_BAR_WORDS 3456
#define XB_SPIN_CAP (1u << 18)
__device__ __forceinline__ unsigned xb_ld(unsigned* p)              { return __hip_atomic_load(p, __ATOMIC_RELAXED, __HIP_MEMORY_SCOPE_AGENT); }
__device__ __forceinline__ unsigned xb_add(unsigned* p, unsigned v) { return __hip_atomic_fetch_add(p, v, __ATOMIC_RELAXED, __HIP_MEMORY_SCOPE_AGENT); }
__device__ __forceinline__ unsigned xb_xcc_id() { return (unsigned)__builtin_amdgcn_s_getreg((3 << 11) | 20) & 0xFu; }
#define XB_SPIN(cond, bar) do { unsigned _sp = 0; while (cond) { __builtin_amdgcn_s_sleep(1); \
    if ((++_sp & 255u) == 0u) { if (xb_ld(&(bar)[XB_TMO])) break; if (_sp > XB_SPIN_CAP) { atomicAdd(&(bar)[XB_TMO], 1u); break; } } } } while (0)
struct XcdBarrier { unsigned* bar; unsigned x; volatile LAS unsigned* st; };
__device__ __forceinline__ XcdBarrier xcd_barrier_post(unsigned* bar, volatile LAS unsigned* st) {
    XcdBarrier b; b.bar = bar; b.x = xb_xcc_id(); b.st = st;
    if (__builtin_amdgcn_readfirstlane(threadIdx.x >> 6) == 0 && lane_now() == 0) (void)xb_add(&bar[XB_XCNT(b.x)], 1u);
    return b;
}
__device__ __forceinline__ void xcd_barrier_complete(unsigned* bar, unsigned x, unsigned& nloc, unsigned& nx) {
    const unsigned G = gridDim.x * gridDim.y * gridDim.z;
    unsigned sum, cnt, mine, sp = 0u;
    for (;;) {
        sum = 0u; cnt = 0u; mine = 0u;
#pragma unroll
        for (unsigned j = 0; j < 16; ++j) { const unsigned c = xb_ld(&bar[XB_XCNT(j)]); sum += c; cnt += (c > 0u) ? 1u : 0u; mine = (j == x) ? c : mine; }
        if (sum == G) break;
        __builtin_amdgcn_s_sleep(1);
        if ((++sp & 255u) == 0u) { if (xb_ld(&bar[XB_TMO])) break; if (sp > XB_SPIN_CAP) { atomicAdd(&bar[XB_TMO], 1u); break; } }
    }
    nloc = mine > 0u ? mine : 1u; nx = cnt > 0u ? cnt : 1u;
}
__device__ __forceinline__ void xcd_barrier(const XcdBarrier& b, int wave_id) {
    asm volatile("s_waitcnt vmcnt(0)" ::: "memory");
    __syncthreads();
    if (wave_id == 0 && lane_now() == 0) {
        unsigned* bar = b.bar;
        __builtin_amdgcn_s_waitcnt(0);
        unsigned nloc = b.st[0], nx = b.st[1];
        if (nloc == 0u) { xcd_barrier_complete(bar, b.x, nloc, nx); b.st[0] = nloc; b.st[1] = nx; }
        const unsigned old = xb_add(&bar[XB_XSUB(b.x)], 1u);
        const unsigned gen = old / nloc;
        if (old + 1u == (gen + 1u) * nloc) {
            __builtin_amdgcn_fence(__ATOMIC_RELEASE, "agent");
            asm volatile("s_waitcnt vmcnt(0)" ::: "memory");
            const unsigned og = xb_add(&bar[XB_TOP], 1u);
            const unsigned tg = og / nx;
            if (og + 1u == (tg + 1u) * nx) xb_add(&bar[XB_TOPGEN], 1u);
            else XB_SPIN(xb_ld(&bar[XB_TOPGEN]) == tg, bar);
            __builtin_amdgcn_fence(__ATOMIC_ACQUIRE, "agent");
            xb_add(&bar[XB_XGEN(b.x)], 1u);
            asm volatile("s_waitcnt vmcnt(0)" ::: "memory");
        } else {
            XB_SPIN(xb_ld(&bar[XB_XGEN(b.x)]) == gen, bar);
            __builtin_amdgcn_fence(__ATOMIC_ACQUIRE, "agent");
            asm volatile("s_waitcnt vmcnt(0)" ::: "memory");
        }
    }
    __syncthreads();
}

namespace pg8 {
constexpr int BM = 256, BK = 64, HALF = 128, HTB = HALF * BK * 2, STAGE_BYTES = 8 * HTB, NXCD = 8, WGM = 8;
__host__ __device__ __forceinline__ int lds_byte(int r, int c) { const int st = (r >> 4) * 2 + (c >> 5), rr = r & 15, cc = c & 31, ob = rr * 64 + cc * 2; return st * 1024 + (ob ^ (((ob >> 9) & 1) << 5)); }
__host__ __device__ __forceinline__ void stage_rc(int b, int& R, int& C) { const int st = b / 1024, sb = b % 1024, swz = sb ^ (((sb >> 9) & 1) << 5); R = (st >> 1) * 16 + swz / 64; C = (st & 1) * 32 + (swz % 64) / 2; }
__host__ __device__ __forceinline__ int perm32(int rho) { const int n = rho >> 4, i = rho & 15; return 8 * (i >> 2) + 4 * n + (i & 3); }
struct Unit { int pm, pn, ak, nt; };
__device__ __forceinline__ unsigned cvt_pk_bf16(float lo, float hi) { unsigned r; asm volatile("v_cvt_pk_bf16_f32 %0, %1, %2" : "=v"(r) : "v"(lo), "v"(hi)); return r; }

struct StaticOrder {
    int nM, nN, nwg, G, c;
    __device__ void init(int M_, int N_, int G_, int c_) { nM = M_ / BM; nN = N_ / BM; nwg = nM * nN; G = G_; c = c_; }
    __device__ bool next(int i, Unit& u) const {
        const long L = (long)i * G + c; if (L >= nwg) return false;
        int wgid = (int)L; { const int q = nwg / NXCD, r = nwg % NXCD, xcd = wgid % NXCD, off = wgid / NXCD; wgid = (xcd < r ? xcd * (q + 1) : r * (q + 1) + (xcd - r) * q) + off; }
        const int nig = WGM * nN, gid = wgid / nig, fm = gid * WGM, gsz = (nM - fm) < WGM ? (nM - fm) : WGM;
        u.pm = fm + ((wgid % nig) % gsz); u.pn = (wgid % nig) / gsz; u.ak = 0; u.nt = KD / BK; return true;
    }
};
struct MoeOrder {
    const LAS int* tile_e; int R, NCT, G, c, nt;
    __device__ bool next(int i, Unit& u) const {
        int rt, ct;
        if (G == 256) { const int x = c & 7, j = c >> 3;
            if (NCT == 16) { rt = 16 * i + (x >> 1) * 4 + (j >> 3); ct = (x & 1) * 8 + (j & 7); }
            else           { rt = 32 * i + 4 * x + (j >> 3); ct = j & 7; } }
        else { const long L = (long)i * G + c; rt = (int)(L / NCT); ct = (int)(L % NCT); }
        if (rt >= R) return false;
        u.pm = rt; u.pn = tile_e[rt] * NCT + ct; u.ak = 0; u.nt = nt; return true;
    }
};
template <int MODE> struct SmallOrder {
    int G, c;
    __device__ bool next(int i, Unit& u) const {
        constexpr int NCT = MODE == 0 ? 8 : 12;
        const int L = i * G + c; if (L >= (M / BM) * NCT) return false;
        u.pm = L / NCT; u.pn = L % NCT;
        if (MODE == 0) { u.ak = 256 * (u.pn & 3); u.nt = 4; }
        else { u.ak = u.pn < 4 ? 0 : (u.pn < 8 ? 128 : 256); u.nt = u.pn < 8 ? 2 : 4; }
        return true;
    }
};
struct DenseRows { static constexpr bool DENSE = true; __device__ __forceinline__ unsigned row(int pm, int r) const { return (unsigned)(pm * BM + r); } };
struct GatherRows { static constexpr bool DENSE = false; const int* idx; __device__ __forceinline__ unsigned row(int pm, int r) const { return (unsigned)idx[pm * BM + r]; } };

struct EpiBf16 {
    static constexpr bool PERM = true;
    bf16_t* O; int ldc;
    __device__ __forceinline__ void operator()(const f32x4 (&acc)[2][2][4][2], const Unit& u, int wr, int wc, int fr, int fq) const {
        const int row0 = u.pm * BM + wr * 64 + fr, col0 = u.pn * BM + wc * 32 + 8 * fq;
#pragma unroll
        for (int ai = 0; ai < 2; ++ai)
#pragma unroll
            for (int m = 0; m < 4; ++m) { bf16_t* rowp = O + (size_t)(row0 + ai * HALF + m * 16) * ldc + col0;
#pragma unroll
                for (int bj = 0; bj < 2; ++bj) { const f32x4 v0 = acc[ai][bj][m][0], v1 = acc[ai][bj][m][1];
                    u32x4 w; w.x = cvt_pk_bf16(v0[0], v0[1]); w.y = cvt_pk_bf16(v0[2], v0[3]); w.z = cvt_pk_bf16(v1[0], v1[1]); w.w = cvt_pk_bf16(v1[2], v1[3]);
                    *(u32x4*)(rowp + bj * HALF) = w; } }
    }
};
struct EpiResF32 {
    static constexpr bool PERM = false;
    float* Z; const bf16_t* R; float alpha;
    __device__ __forceinline__ void operator()(const f32x4 (&acc)[2][2][4][2], const Unit& u, int wr, int wc, int fr, int fq) const {
        const int row0 = u.pm * BM + wr * 64 + fr, col0 = u.pn * BM + wc * 32 + 4 * fq;
#pragma unroll
        for (int ai = 0; ai < 2; ++ai)
#pragma unroll
            for (int m = 0; m < 4; ++m) { const size_t off = (size_t)(row0 + ai * HALF + m * 16) * D + col0;
#pragma unroll
                for (int bj = 0; bj < 2; ++bj)
#pragma unroll
                    for (int n = 0; n < 2; ++n) { const u32x2 rb = *(const u32x2*)(R + off + bj * HALF + n * 16);
                        f32x4 o = acc[ai][bj][m][n]; o[0] += alpha * bflo(rb.x); o[1] += alpha * bfhi(rb.x); o[2] += alpha * bflo(rb.y); o[3] += alpha * bfhi(rb.y);
                        *(f32x4*)(Z + off + bj * HALF + n * 16) = o; } }
    }
};
struct EpiSwiglu {
    static constexpr bool PERM = true;
    unsigned char* O; const float* b1;
    __device__ __forceinline__ void operator()(const f32x4 (&acc)[2][2][4][2], const Unit& u, int wr, int wc, int fr, int fq) const {
        const int e = u.pn >> 4, ct = u.pn & 15;
        const int row0 = u.pm * BM + wr * 64 + fr, cin = wc * 32 + 8 * fq, col0 = ct * HALF + cin;
        const float* bg = b1 + (size_t)e * 2 * DE + col0; const float* bu = bg + DE;
        const f32x4 bg0 = *(const f32x4*)bg, bg1 = *(const f32x4*)(bg + 4), bu0 = *(const f32x4*)bu, bu1 = *(const f32x4*)(bu + 4);
        constexpr float inv = 1.f / (F8_SH * F8_SW1);
#pragma unroll
        for (int ai = 0; ai < 2; ++ai)
#pragma unroll
            for (int m = 0; m < 4; ++m) { unsigned char* rowp = O + (size_t)(row0 + ai * HALF + m * 16) * DE + col0;
                float o[8];
#pragma unroll
                for (int n = 0; n < 2; ++n) { const f32x4 g4 = acc[ai][0][m][n] * inv + (n ? bg1 : bg0), u4 = acc[ai][1][m][n] * inv + (n ? bu1 : bu0);
#pragma unroll
                    for (int j = 0; j < 4; ++j) { const float g = fminf(g4[j], 7.f), up = fminf(fmaxf(u4[j], -7.f), 7.f);
                        o[n * 4 + j] = F8_SACT * g * (up + 1.f) * __builtin_amdgcn_rcpf(1.f + __expf(-1.702f * g)); } }
                *(u32x2*)rowp = (u32x2){pk4_f8(o[0], o[1], o[2], o[3]), pk4_f8(o[4], o[5], o[6], o[7])}; }
    }
};
struct EpiMoeOut {
    static constexpr bool PERM = true;
    bf16_t* O; const float* b2; const float* sg;
    __device__ __forceinline__ void operator()(const f32x4 (&acc)[2][2][4][2], const Unit& u, int wr, int wc, int fr, int fq) const {
        const int e = u.pn >> 3, ct = u.pn & 7;
        const int row0 = u.pm * BM + wr * 64 + fr, col0 = ct * BM + wc * 32 + 8 * fq;
        f32x4 bv[2][2];
#pragma unroll
        for (int bj = 0; bj < 2; ++bj)
#pragma unroll
            for (int n = 0; n < 2; ++n) bv[bj][n] = *(const f32x4*)(b2 + (size_t)e * D + col0 + bj * HALF + 4 * n);
#pragma unroll
        for (int ai = 0; ai < 2; ++ai)
#pragma unroll
            for (int m = 0; m < 4; ++m) { const int row = row0 + ai * HALF + m * 16; const float gt = sg[row]; bf16_t* rowp = O + (size_t)row * D + col0;
#pragma unroll
                for (int bj = 0; bj < 2; ++bj) { const f32x4 v0 = (acc[ai][bj][m][0] * (1.f / (F8_SACT * F8_SW2)) + bv[bj][0]) * gt, v1 = (acc[ai][bj][m][1] * (1.f / (F8_SACT * F8_SW2)) + bv[bj][1]) * gt;
                    u32x4 w; w.x = cvt_pk_bf16(v0[0], v0[1]); w.y = cvt_pk_bf16(v0[2], v0[3]); w.z = cvt_pk_bf16(v1[0], v1[1]); w.w = cvt_pk_bf16(v1[2], v1[3]);
                    *(u32x4*)(rowp + bj * HALF) = w; } }
    }
};

template <class Epi, class Sched, class ARows, bool ALIGN_EPI, int LDA = KD, int LDB = KD, bool F8 = false>
__device__ __forceinline__ void gemm_phase(LAS unsigned char* lds, const bf16_t* A, const bf16_t* Bt, const Sched& S, const Epi& E, const ARows& AR, const int wid) {
    const int lane = lane_now(), tid = wid * 64 + lane, wr = wid >> 2, wc = wid & 3, fr = lane & 15, fq = lane >> 4;
    int sR[2], sC[2]; unsigned voffB[2];
#pragma unroll
    for (int i = 0; i < 2; ++i) { stage_rc(tid * 16 + i * 8192, sR[i], sC[i]); const int Rb = Epi::PERM ? ((sR[i] & ~31) + perm32(sR[i] & 31)) : sR[i];
        voffB[i] = (unsigned)(Rb * LDB + sC[i]) * 2u; }
    constexpr size_t kstep = (size_t)(BK * 2);
    constexpr size_t hstep = (size_t)HALF * LDB * 2;
    constexpr size_t tstep = 2 * hstep;
    const unsigned ldsw = (unsigned)wid * 1024u;
    int aoffs[2], boffs[2];
    if constexpr (F8) { aoffs[0] = lds_byte(wr * 64 + fr, fq * 16); aoffs[1] = aoffs[0] + 16; boffs[0] = 4 * HTB + lds_byte(wc * 32 + fr, fq * 16); boffs[1] = boffs[0] + 16; }
    else { aoffs[0] = lds_byte(wr * 64 + fr, fq * 8); aoffs[1] = aoffs[0] + 1024; boffs[0] = 4 * HTB + lds_byte(wc * 32 + fr, fq * 8); boffs[1] = boffs[0] + 1024; }
#define PG8_SA(b, h) (((b) * 2 + (h)) * HTB)
#define PG8_SB(b, h) ((4 + (b) * 2 + (h)) * HTB)
#define PG8_SBR(b, h) (((b) * 2 + (h)) * HTB)
#define PG8_STAGE(bufoff, gbase, voff) do { const char* gb_ = (const char*)(gbase); _Pragma("unroll") for (int _i = 0; _i < 2; ++_i) { unsigned keep_; \
        asm volatile("s_mov_b32 %0, m0\n\ts_mov_b32 m0, %3\n\ts_nop 0\n\tglobal_load_lds_dwordx4 %1, %2\n\ts_mov_b32 m0, %0" : "=&s"(keep_) : "v"((voff)[_i]), "s"(gb_), "s"((unsigned)((bufoff) + ldsw + _i * 8192)) : "memory"); } } while (0)
#define PG8_LDA(dst, b, h) do { _Pragma("unroll") for (int m = 0; m < 4; ++m) { if constexpr (F8) { const i32x4 lo_ = *(const LAS i32x4*)(lds + PG8_SA(b, h) + aoffs[0] + m * 2048), hi_ = *(const LAS i32x4*)(lds + PG8_SA(b, h) + aoffs[1] + m * 2048); \
            dst##8[m] = __builtin_shufflevector(lo_, hi_, 0, 1, 2, 3, 4, 5, 6, 7); } else { _Pragma("unroll") for (int k = 0; k < 2; ++k) dst[m][k] = *(const LAS bf16x8*)(lds + PG8_SA(b, h) + aoffs[k] + m * 2048); } } } while (0)
#define PG8_LDB(dst, b, h) do { _Pragma("unroll") for (int n = 0; n < 2; ++n) { if constexpr (F8) { const i32x4 lo_ = *(const LAS i32x4*)(lds + PG8_SBR(b, h) + boffs[0] + n * 2048), hi_ = *(const LAS i32x4*)(lds + PG8_SBR(b, h) + boffs[1] + n * 2048); \
            dst##8[n] = __builtin_shufflevector(lo_, hi_, 0, 1, 2, 3, 4, 5, 6, 7); } else { _Pragma("unroll") for (int k = 0; k < 2; ++k) dst[n][k] = *(const LAS bf16x8*)(lds + PG8_SBR(b, h) + boffs[k] + n * 2048); } } } while (0)
#define PG8_MMA(ai, bj, At, Bt_) do { __builtin_amdgcn_s_setprio(1); _Pragma("unroll") for (int m = 0; m < 4; ++m) _Pragma("unroll") for (int n = 0; n < 2; ++n) { \
        if constexpr (F8) { acc[ai][bj][m][n] = __builtin_amdgcn_mfma_scale_f32_16x16x128_f8f6f4(Bt_##8[n], At##8[m], acc[ai][bj][m][n], 0, 0, 0, 0x7f7f7f7f, 0, 0x7f7f7f7f); } \
        else { _Pragma("unroll") for (int k = 0; k < 2; ++k) acc[ai][bj][m][n] = __builtin_amdgcn_mfma_f32_16x16x32_bf16(Bt_[n][k], At[m][k], acc[ai][bj][m][n], 0, 0, 0); } } __builtin_amdgcn_s_setprio(0); } while (0)
#define PG8_WAIT_V(n) asm volatile("s_waitcnt vmcnt(" #n ")" ::: "memory")
#define PG8_WAIT_L(n) asm volatile("s_waitcnt lgkmcnt(" #n ")" ::: "memory")
#define PG8_BAR __builtin_amdgcn_s_barrier()
#define PG8_SCHED __builtin_amdgcn_sched_barrier(0)
#define PG8_AOFF(dst, u) do { const int tq_ = wid * 64 + lane_now(); _Pragma("unroll") for (int _i = 0; _i < 2; ++_i) { int R_, C_; stage_rc(tq_ * 16 + _i * 8192, R_, C_); \
        _Pragma("unroll") for (int _h = 0; _h < 2; ++_h) { \
        if constexpr (ARows::DENSE) dst[_h][_i] = (unsigned)(R_ * LDA + C_) * 2u; \
        else dst[_h][_i] = (AR.row((u).pm, _h * HALF + R_) * (unsigned)LDA + (unsigned)((u).ak + C_)) * 2u; } } } while (0)
#define PG8_ABASE(u) (ARows::DENSE ? (const char*)A + ((size_t)(u).pm * BM * LDA + (u).ak) * 2 : (const char*)A)
    constexpr size_t ahstep = ARows::DENSE ? (size_t)HALF * LDA * 2 : 0;
    Unit cur, nxt; int ui = 0;
    if (!S.next(0, cur)) return;
    f32x4 acc[2][2][4][2];
#pragma unroll
    for (int a = 0; a < 2; ++a)
#pragma unroll
        for (int b = 0; b < 2; ++b)
#pragma unroll
            for (int m = 0; m < 4; ++m)
#pragma unroll
                for (int n = 0; n < 2; ++n) acc[a][b][m][n] = (f32x4){0.f, 0.f, 0.f, 0.f};
    bf16x8 At[4][2], B0[2][2], B1[2][2]; i32x8 At8[4], B08[2], B18[2];
    unsigned ao[2][2], an[2][2];
    PG8_AOFF(ao, cur);
    const char* cA = PG8_ABASE(cur);
    const char* cB = (const char*)Bt + (size_t)cur.pn * tstep;
    PG8_STAGE(PG8_SB(0, 0), cB, voffB); PG8_STAGE(PG8_SB(0, 1), cB + hstep, voffB); PG8_STAGE(PG8_SA(0, 0), cA, ao[0]); PG8_STAGE(PG8_SA(0, 1), cA + ahstep, ao[1]);
    if (wr == 1) PG8_BAR;
    PG8_WAIT_V(2); PG8_BAR;
    PG8_STAGE(PG8_SB(1, 0), cB + kstep, voffB); PG8_STAGE(PG8_SA(1, 0), cA + kstep, ao[0]); PG8_STAGE(PG8_SB(1, 1), cB + hstep + kstep, voffB);
    PG8_WAIT_V(6); PG8_BAR;
    for (;;) {
        const bool has_next = S.next(ui + 1, nxt);
        if (has_next) { PG8_AOFF(an, nxt); } else {
#pragma unroll
            for (int h = 0; h < 2; ++h)
#pragma unroll
                for (int i = 0; i < 2; ++i) an[h][i] = ao[h][i]; }
        const char* nB = has_next ? (const char*)Bt + (size_t)nxt.pn * tstep : cB;
        const char* nA = has_next ? PG8_ABASE(nxt) : cA;
        const int nt = cur.nt;
#pragma unroll 1
        for (int t = 0; t < nt; t += 2) {
            const bool last = (t == nt - 2);
            const char* a1 = cA + (size_t)(t + 1) * kstep;
            const char* a2 = last ? nA : cA + (size_t)(t + 2) * kstep; const char* b2 = last ? nB : cB + (size_t)(t + 2) * kstep;
            const char* a3 = a2 + kstep; const char* b3 = b2 + kstep;
            unsigned o2[2][2];
#pragma unroll
            for (int h = 0; h < 2; ++h)
#pragma unroll
                for (int i = 0; i < 2; ++i) o2[h][i] = (!ARows::DENSE && last) ? an[h][i] : ao[h][i];
            PG8_LDB(B0, 0, 0); PG8_LDB(B1, 0, 1); PG8_SCHED; PG8_LDA(At, 0, 0); PG8_STAGE(PG8_SA(1, 1), a1 + ahstep, ao[1]);
            PG8_WAIT_V(8); PG8_WAIT_L(0); PG8_BAR; PG8_MMA(0, 0, At, B0); PG8_MMA(0, 1, At, B1); PG8_BAR; PG8_SCHED;
            PG8_LDA(At, 0, 1); PG8_STAGE(PG8_SB(0, 0), b2, voffB); PG8_STAGE(PG8_SB(0, 1), b2 + hstep, voffB); PG8_STAGE(PG8_SA(0, 0), a2, o2[0]);
            PG8_WAIT_V(8); PG8_WAIT_L(0); PG8_BAR; PG8_MMA(1, 0, At, B0); PG8_MMA(1, 1, At, B1); PG8_BAR; PG8_SCHED;
            PG8_LDB(B0, 1, 0); PG8_LDB(B1, 1, 1); PG8_SCHED; PG8_LDA(At, 1, 0); PG8_STAGE(PG8_SA(0, 1), a2 + ahstep, o2[1]);
            PG8_WAIT_V(8); PG8_WAIT_L(0); PG8_BAR; PG8_MMA(0, 0, At, B0); PG8_MMA(0, 1, At, B1); PG8_BAR; PG8_SCHED;
            PG8_LDA(At, 1, 1); PG8_STAGE(PG8_SB(1, 0), b3, voffB); PG8_STAGE(PG8_SB(1, 1), b3 + hstep, voffB); PG8_STAGE(PG8_SA(1, 0), a3, o2[0]);
            PG8_WAIT_V(8); PG8_WAIT_L(0); PG8_BAR; PG8_MMA(1, 0, At, B0); PG8_MMA(1, 1, At, B1); PG8_BAR; PG8_SCHED;
        }
        if constexpr (ALIGN_EPI) { if (wr == 0) PG8_BAR; }
        asm volatile("" : "+s"(cur.pm), "+s"(cur.pn));
        { const int tz = lane_now();
          E(acc, cur, wr, wc, tz & 15, (tz & 63) >> 4); }
        if (!has_next) break;
#pragma unroll
        for (int a = 0; a < 2; ++a)
#pragma unroll
            for (int b = 0; b < 2; ++b)
#pragma unroll
                for (int m = 0; m < 4; ++m)
#pragma unroll
                    for (int n = 0; n < 2; ++n) acc[a][b][m][n] = (f32x4){0.f, 0.f, 0.f, 0.f};
        cur = nxt; cB = nB; cA = nA; ++ui;
#pragma unroll
        for (int h = 0; h < 2; ++h)
#pragma unroll
            for (int i = 0; i < 2; ++i) ao[h][i] = an[h][i];
        if constexpr (ALIGN_EPI) { if (wr == 1) PG8_BAR; }
    }
    PG8_WAIT_V(0);
    if constexpr (!ALIGN_EPI) { if (wr == 0) PG8_BAR; }
    PG8_BAR;
#undef PG8_SA
#undef PG8_SB
#undef PG8_SBR
#undef PG8_STAGE
#undef PG8_LDA
#undef PG8_LDB
#undef PG8_MMA
#undef PG8_WAIT_V
#undef PG8_WAIT_L
#undef PG8_BAR
#undef PG8_SCHED
#undef PG8_AOFF
}
struct DenseRowsH { __device__ __forceinline__ unsigned row(int pm, int r) const { return (unsigned)(pm * 128 + r); } };
struct GatherRowsH { const int* idx; __device__ __forceinline__ unsigned row(int pm, int r) const { return (unsigned)idx[pm * 128 + r]; } };
struct EpiSwigluH {
    unsigned char* O; const float* b1;
    __device__ __forceinline__ void operator()(const f32x4 (&acc)[2][4][2], const Unit& u, int wr, int wc, int fr, int fq) const {
        const int e = u.pn >> 4, ct = u.pn & 15;
        const int row0 = u.pm * 128 + wr * 64 + fr, col0 = ct * HALF + wc * 32 + 8 * fq;
        const float* bg = b1 + (size_t)e * 2 * DE + col0; const float* bu = bg + DE;
        const f32x4 bg0 = *(const f32x4*)bg, bg1 = *(const f32x4*)(bg + 4), bu0 = *(const f32x4*)bu, bu1 = *(const f32x4*)(bu + 4);
        constexpr float inv = 1.f / (F8_SH * F8_SW1);
#pragma unroll
        for (int m = 0; m < 4; ++m) { unsigned char* rowp = O + (size_t)(row0 + m * 16) * DE + col0;
            float o[8];
#pragma unroll
            for (int n = 0; n < 2; ++n) { const f32x4 g4 = acc[0][m][n] * inv + (n ? bg1 : bg0), u4 = acc[1][m][n] * inv + (n ? bu1 : bu0);
#pragma unroll
                for (int j = 0; j < 4; ++j) { const float g = fminf(g4[j], 7.f), up = fminf(fmaxf(u4[j], -7.f), 7.f);
                    o[n * 4 + j] = F8_SACT * g * (up + 1.f) * __builtin_amdgcn_rcpf(1.f + __expf(-1.702f * g)); } }
            *(u32x2*)rowp = (u32x2){pk4_f8(o[0], o[1], o[2], o[3]), pk4_f8(o[4], o[5], o[6], o[7])}; }
    }
};
struct EpiMoeOutH {
    bf16_t* O; const float* b2; const float* sg;
    __device__ __forceinline__ void operator()(const f32x4 (&acc)[2][4][2], const Unit& u, int wr, int wc, int fr, int fq) const {
        const int e = u.pn >> 3, ct = u.pn & 7;
        const int row0 = u.pm * 128 + wr * 64 + fr, col0 = ct * BM + wc * 32 + 8 * fq;
        constexpr float inv = 1.f / (F8_SACT * F8_SW2);
#pragma unroll
        for (int m = 0; m < 4; ++m) { const int row = row0 + m * 16; const float gt = sg[row]; bf16_t* rowp = O + (size_t)row * D + col0;
#pragma unroll
            for (int bj = 0; bj < 2; ++bj) { const f32x4 b0 = *(const f32x4*)(b2 + (size_t)e * D + col0 + bj * HALF), b1_ = *(const f32x4*)(b2 + (size_t)e * D + col0 + bj * HALF + 4);
                const f32x4 v0 = (acc[bj][m][0] * inv + b0) * gt, v1 = (acc[bj][m][1] * inv + b1_) * gt;
                *(u32x4*)(rowp + bj * HALF) = (u32x4){cvt2(v0[0], v0[1]), cvt2(v0[2], v0[3]), cvt2(v1[0], v1[1]), cvt2(v1[2], v1[3])}; } }
    }
};
__host__ __device__ __forceinline__ int f8_g(int R) { return ((R >> 1) & 1) + 4 * ((R >> 3) & 1); }
__host__ __device__ __forceinline__ int f8_lds_byte(int R, int c) { return R * 128 + (((c + f8_g(R)) & 7) << 4); }
__host__ __device__ __forceinline__ void f8_stage_rc(int pos, int& R, int& Cb) { const int P = pos >> 4; R = P >> 3; Cb = (((P & 7) - f8_g(R)) & 7) << 4; }
template <class Epi, class Sched, class ARows>
__device__ __forceinline__ void gemm_f8h(LAS unsigned char* lds, const unsigned char* A, const unsigned char* Bt, const Sched& S, const Epi& E, const ARows& AR, const int wid) {
    constexpr int NT = KD / 128, STG = 3 * HTB;
    const int wr = wid >> 2, wc = wid & 3;
    const unsigned ldsw = (unsigned)wid * 1024u;
    Unit cur, nxt;
    if (!S.next(0, cur)) return;
#define F8_STAGE(dstoff, gbase, voff) do { const char* gb_ = (const char*)(gbase); _Pragma("unroll") for (int _i = 0; _i < 2; ++_i) { unsigned keep_; \
        asm volatile("s_mov_b32 %0, m0\n\ts_mov_b32 m0, %3\n\ts_nop 0\n\tglobal_load_lds_dwordx4 %1, %2\n\ts_mov_b32 m0, %0" : "=&s"(keep_) : "v"((voff)[_i]), "s"(gb_), "s"((unsigned)((dstoff) + ldsw + _i * 8192)) : "memory"); } } while (0)
#define F8_AOFF(dst, u) do { const int tq_ = wid * 64 + lane_now(); _Pragma("unroll") for (int _i = 0; _i < 2; ++_i) { int R_, C_; f8_stage_rc(tq_ * 16 + _i * 8192, R_, C_); dst[_i] = AR.row((u).pm, R_) * (unsigned)KD + (unsigned)C_; } } while (0)
#define F8_STAGE_TILE(so_, kt_, aoffv, bptr) do { F8_STAGE((so_), (const char*)A + (size_t)(kt_) * 128, aoffv); F8_STAGE((so_) + HTB, (bptr) + (size_t)(kt_) * 128, vb); F8_STAGE((so_) + 2 * HTB, (bptr) + (size_t)128 * KD + (size_t)(kt_) * 128, vb); } while (0)
#define F8_LDFRAG(a8, b8, so_) do { _Pragma("unroll") for (int m = 0; m < 4; ++m) { const i32x4 lo = *(const LAS i32x4*)(lds + (so_) + aoff0 + m * 2048), hi = *(const LAS i32x4*)(lds + (so_) + aoff1 + m * 2048); a8[m] = __builtin_shufflevector(lo, hi, 0, 1, 2, 3, 4, 5, 6, 7); } \
        _Pragma("unroll") for (int b = 0; b < 2; ++b) _Pragma("unroll") for (int n = 0; n < 2; ++n) { const i32x4 lo = *(const LAS i32x4*)(lds + (so_) + (1 + b) * HTB + boff0 + n * 2048), hi = *(const LAS i32x4*)(lds + (so_) + (1 + b) * HTB + boff1 + n * 2048); b8[b][n] = __builtin_shufflevector(lo, hi, 0, 1, 2, 3, 4, 5, 6, 7); } } while (0)
#define F8_MMA(a8, b8) do { __builtin_amdgcn_s_setprio(1); _Pragma("unroll") for (int b = 0; b < 2; ++b) _Pragma("unroll") for (int m = 0; m < 4; ++m) _Pragma("unroll") for (int n = 0; n < 2; ++n) \
        acc[b][m][n] = __builtin_amdgcn_mfma_scale_f32_16x16x128_f8f6f4(b8[b][n], a8[m], acc[b][m][n], 0, 0, 0, 0x7f7f7f7f, 0, 0x7f7f7f7f); __builtin_amdgcn_s_setprio(0); } while (0)
    unsigned ao[2], an[2], vb[2];
    { const int tq = wid * 64 + lane_now();
#pragma unroll
        for (int i = 0; i < 2; ++i) { int R, C; f8_stage_rc(tq * 16 + i * 8192, R, C); const int Rb = (R & ~31) + perm32(R & 31); vb[i] = (unsigned)(Rb * KD + C); } }
    F8_AOFF(ao, cur);
    int aoff0, aoff1, boff0, boff1; { const int ln = lane_now(), fr = ln & 15, fq = ln >> 4; aoff0 = f8_lds_byte(wr * 64 + fr, 2 * fq); aoff1 = f8_lds_byte(wr * 64 + fr, 2 * fq + 1); boff0 = f8_lds_byte(wc * 32 + fr, 2 * fq); boff1 = f8_lds_byte(wc * 32 + fr, 2 * fq + 1); }
    const char* cB = (const char*)Bt + (size_t)cur.pn * 256 * KD;
    f32x4 acc[2][4][2];
#pragma unroll
    for (int b = 0; b < 2; ++b)
#pragma unroll
        for (int m = 0; m < 4; ++m)
#pragma unroll
            for (int n = 0; n < 2; ++n) acc[b][m][n] = (f32x4){0.f, 0.f, 0.f, 0.f};
    F8_STAGE_TILE(0, 0, ao, cB); F8_STAGE_TILE(STG, 1, ao, cB);
    int so = 0;
    for (int ui = 0;; ++ui) {
        const bool has_next = S.next(ui + 1, nxt);
        const char* nB = cB;
        if (has_next) { F8_AOFF(an, nxt); nB = (const char*)Bt + (size_t)nxt.pn * 256 * KD; } else { an[0] = ao[0]; an[1] = ao[1]; }
#pragma unroll 1
        for (int kt = 0; kt < NT; ++kt) {
            const int so2 = (so == 0) ? 2 * STG : so - STG;
            if (kt + 1 < NT || has_next) asm volatile("s_waitcnt vmcnt(6)" ::: "memory"); else asm volatile("s_waitcnt vmcnt(0)" ::: "memory");
            __builtin_amdgcn_s_barrier(); asm volatile("" ::: "memory");
            if (kt + 2 < NT) F8_STAGE_TILE(so2, kt + 2, ao, cB); else if (has_next) F8_STAGE_TILE(so2, kt + 2 - NT, an, nB);
            i32x8 fa[4], fb[2][2];
            F8_LDFRAG(fa, fb, so);
            F8_MMA(fa, fb);
            so = (so == 2 * STG) ? 0 : so + STG;
        }
        { const int ln = lane_now(); E(acc, cur, wr, wc, ln & 15, ln >> 4); }
        if (!has_next) break;
#pragma unroll
        for (int b = 0; b < 2; ++b)
#pragma unroll
            for (int m = 0; m < 4; ++m)
#pragma unroll
                for (int n = 0; n < 2; ++n) acc[b][m][n] = (f32x4){0.f, 0.f, 0.f, 0.f};
        cur = nxt; cB = nB; ao[0] = an[0]; ao[1] = an[1];
    }
#undef F8_STAGE
#undef F8_AOFF
#undef F8_STAGE_TILE
#undef F8_LDFRAG
#undef F8_MMA
}
}

constexpr int NWAVES = 8, NTHREADS = 512;
constexpr int NPHASE = 13;
struct Args {
    const float* in[33]; float* out; unsigned char* ws; int ph_lo, ph_hi, use_bar, pad;
};
enum { I_X = 0, I_LNG, I_LNB, I_WIN, I_CONVW, I_CONVB, I_WRG, I_BRG, I_WIG, I_BIG, I_LAMBDA, I_MU, I_W0, I_DECUP, I_A0, I_AAAUP, I_GATEUP,
       I_KK, I_KA, I_RK, I_GNG, I_GNB, I_WOUT, I_LN1G, I_LN1B, I_WROUTER, I_BROUTER, I_WE1, I_BE1, I_WE2, I_BE2, I_LN2G, I_LN2B };

__device__ __forceinline__ void transpose_item(const float* W, int N, bf16_t* WT, int k0, int n0, int dst_row0, LAS float* scr, int lane) {
#pragma unroll 8
    for (int i = 0; i < 32; ++i) { const int kk = 2 * i + (lane >> 5); scr[kk * 33 + (lane & 31)] = W[(size_t)(k0 + kk) * N + n0 + (lane & 31)]; }
    asm volatile("s_waitcnt lgkmcnt(0)" ::: "memory");
    const int c = lane & 7;
#pragma unroll
    for (int j = 0; j < 4; ++j) { const int n = (lane >> 3) + 8 * j; const LAS float* s = scr + (8 * c) * 33 + n;
        u32x4 o; o.x = pk2(s[0 * 33], s[1 * 33]); o.y = pk2(s[2 * 33], s[3 * 33]); o.z = pk2(s[4 * 33], s[5 * 33]); o.w = pk2(s[6 * 33], s[7 * 33]);
        *(u32x4*)(WT + (size_t)(dst_row0 + n) * KD + k0 + 8 * c) = o; }
    asm volatile("s_waitcnt lgkmcnt(0)" ::: "memory");
}

__device__ __forceinline__ void transpose_item_f8(const float* W, int N, unsigned char* WT, int k0, int n0, int dst_row0, float scale, LAS float* scr, int lane) {
#pragma unroll 8
    for (int i = 0; i < 64; ++i) { const int kk = 2 * i + (lane >> 5); scr[kk * 33 + (lane & 31)] = W[(size_t)(k0 + kk) * N + n0 + (lane & 31)]; }
    asm volatile("s_waitcnt lgkmcnt(0)" ::: "memory");
    const int c = lane & 7;
#pragma unroll
    for (int j = 0; j < 4; ++j) { const int n = (lane >> 3) + 8 * j; const LAS float* s = scr + (16 * c) * 33 + n;
        u32x4 o;
        o.x = pk4_f8(s[0 * 33] * scale, s[1 * 33] * scale, s[2 * 33] * scale, s[3 * 33] * scale); o.y = pk4_f8(s[4 * 33] * scale, s[5 * 33] * scale, s[6 * 33] * scale, s[7 * 33] * scale);
        o.z = pk4_f8(s[8 * 33] * scale, s[9 * 33] * scale, s[10 * 33] * scale, s[11 * 33] * scale); o.w = pk4_f8(s[12 * 33] * scale, s[13 * 33] * scale, s[14 * 33] * scale, s[15 * 33] * scale);
        *(u32x4*)(WT + (size_t)(dst_row0 + n) * KD + k0 + 16 * c) = o; }
    asm volatile("s_waitcnt lgkmcnt(0)" ::: "memory");
}

__device__ __forceinline__ void moe_tables(volatile LAS int* tb, unsigned* ctl, int wave_id) {
    if (wave_id == 0 && lane_now() == 0) {
        int off = 0;
        for (int e = 0; e < NE; ++e) { const int c = (int)__hip_atomic_load(ctl + CW_CNT + 64 * e, RLX_AGENT); const int nt = (c + 127) >> 7;
            tb[1 + e] = off; for (int r = 0; r < nt; ++r) tb[64 + off + r] = e; off += nt; }
        tb[1 + NE] = off; tb[0] = off;
    }
    __syncthreads();
}

__global__ void __launch_bounds__(NTHREADS, 2) fwd(Args args) {
    extern __shared__ __attribute__((aligned(16))) unsigned char lds_raw[];
    LAS unsigned char* lds = (LAS unsigned char*)lds_raw;
    volatile LAS unsigned* MISC = (volatile LAS unsigned*)(lds + MISC_OFF);
    const int wave = __builtin_amdgcn_readfirstlane(threadIdx.x >> 6);
#define LANE_TID() const int lane = lane_now(), tid = wave * 64 + lane, gt = bid * NTHREADS + tid; (void)tid; (void)gt
    const int G = gridDim.x, bid = blockIdx.x;
    unsigned char* ws = args.ws;
    unsigned* ctl = (unsigned*)(ws + WS_CTL);
    if (wave == 0) MISC[lane_now()] = 0u;
    __syncthreads();
    XcdBarrier bar; bar.bar = ctl + CW_BAR; bar.x = 0; bar.st = nullptr;
    if (args.use_bar) bar = xcd_barrier_post(ctl + CW_BAR, MISC);
    const int lo = args.ph_lo, hi = args.ph_hi;
#ifndef DUP_MASK
#define DUP_MASK 0
#endif
#define REP(k) for (int rep_ = 0; rep_ <= ((DUP_MASK >> (k)) & 1); ++rep_)
#define IN(k) (lo <= (k) && (k) < hi)
#ifndef PROBE_PHASE
#define PROBE_PHASE -1
#endif
    unsigned long long tprobe0 = 0ull, tprobe1 = 0ull;
#define SEAM(k) do { if (IN(k) && IN((k) + 1)) xcd_barrier(bar, wave); if (PROBE_PHASE >= 0) { if ((k) + 1 == PROBE_PHASE) tprobe0 = __builtin_amdgcn_s_memrealtime(); if ((k) == PROBE_PHASE) tprobe1 = __builtin_amdgcn_s_memrealtime(); } } while (0)
    if (PROBE_PHASE == 0) tprobe0 = __builtin_amdgcn_s_memrealtime();
    const int gw = bid * NWAVES + wave, NGW = G * NWAVES;
    const int NGT = G * NTHREADS;

    bf16_t* WinT = (bf16_t*)(ws + WS_WIN); bf16_t* WoT = (bf16_t*)(ws + WS_WO); unsigned char* W1F = ws + WS_W1; unsigned char* W2F = ws + WS_W2;
    bf16_t* XN = (bf16_t*)(ws + WS_XN); bf16_t* P = (bf16_t*)(ws + WS_P);
    float* LA = (float*)(ws + WS_LA); float* LB = (float*)(ws + WS_LB);
    float* BON = (float*)(ws + WS_BON);
    bf16_t* CAT = (bf16_t*)(ws + WS_CAT); float* Z = (float*)(ws + WS_Z); float* H1 = (float*)(ws + WS_H1); unsigned char* H1F = ws + WS_H1B;
    int* TOPE = (int*)(ws + WS_TOPE); int* TOPP = (int*)(ws + WS_TOPP); float* TOPG = (float*)(ws + WS_TOPG); int* TOKSLOT = (int*)(ws + WS_TOKSLOT);
    int* SLOTTOK = (int*)(ws + WS_SLOTTOK); float* SLOTG = (float*)(ws + WS_SLOTG);
    unsigned char* ACT = ws + WS_ACT; bf16_t* OUTS = (bf16_t*)(ws + WS_OUTS);

    if (IN(0)) REP(0) {
        LANE_TID();
        LAS float* scr = (LAS float*)(lds + wave * 17408);
        constexpr int I_IN = (KD / 64) * (NP / 32), I_OUT = (KD / 64) * (D / 32), I_E1 = (KD / 128) * (2 * DE / 32), I_E2 = (DE / 128) * (D / 32);
        constexpr int NITEMS = I_IN + I_OUT + NE * I_E1 + NE * I_E2;
        for (int it = gw; it < NITEMS; it += NGW) {
            int r = it;
            if (r < I_IN) { const int nb = NP / 32, kb = r / nb, n0 = (r % nb) * 32; transpose_item(args.in[I_WIN], NP, WinT, kb * 64, n0, n0, scr, lane); continue; } r -= I_IN;
            if (r < I_OUT) { const int nb = D / 32, kb = r / nb, n0 = (r % nb) * 32; transpose_item(args.in[I_WOUT], D, WoT, kb * 64, n0, n0, scr, lane); continue; } r -= I_OUT;
            if (r < NE * I_E1) { const int e = r / I_E1, q = r % I_E1, nb = 2 * DE / 32, kb = q / nb, n0 = (q % nb) * 32;
                const int isup = n0 >= DE ? 1 : 0, nn = n0 - isup * DE, drow = 256 * (nn >> 7) + 128 * isup + (nn & 127);
                transpose_item_f8(args.in[I_WE1] + (size_t)e * KD * 2 * DE, 2 * DE, W1F + (size_t)e * 2 * DE * KD, kb * 128, n0, drow, F8_SW1, scr, lane); continue; } r -= NE * I_E1;
            { const int e = r / I_E2, q = r % I_E2, nb = D / 32, kb = q / nb, n0 = (q % nb) * 32;
                transpose_item_f8(args.in[I_WE2] + (size_t)e * DE * D, D, W2F + (size_t)e * D * DE, kb * 128, n0, n0, F8_SW2, scr, lane); }
        }
        { bf16_t* WG = (bf16_t*)(ws + WS_WG); bf16_t* WL = (bf16_t*)(ws + WS_WL);
            for (int i = gt; i < 2048 * 256; i += NGT) { const int row = i >> 8, kl = i & 255, g_ = row >> 10, nb = (row >> 6) & 15, k = row & 63, blk = kl >> 6, j = kl & 63;
                const float v = ((nb & 3) == blk) ? args.in[g_ ? I_WIG : I_WRG][(size_t)(nb * 64 + j) * 64 + k] : 0.f; WG[i] = cvt1(v); }
            for (int i = gt; i < 3072 * 256; i += NGT) { const int row = i >> 8, kl = i & 255, sel = row >> 10, c = row & 1023;
                float v = 0.f; if (sel == 0) { if (kl < DLORA) v = args.in[I_DECUP][(size_t)kl * RW_W + c]; } else if (sel == 1) { if (kl < ALORA) v = args.in[I_AAAUP][(size_t)kl * RW_W + c]; } else v = args.in[I_GATEUP][(size_t)kl * RW_W + c];
                WL[i] = cvt1(v); } }
        for (int i = gt; i < (NPP - NP) * KD / 8; i += NGT) ((u32x4*)(WinT + (size_t)NP * KD))[i] = (u32x4){0u, 0u, 0u, 0u};
        const float* lg = args.in[I_LNG]; const float* lb = args.in[I_LNB];
        for (int m = gw; m < M; m += NGW) {
            const f32x4* xr = (const f32x4*)(args.in[I_X] + (size_t)m * D) + lane;
            f32x4 v[8]; float s = 0.f;
#pragma unroll
            for (int j = 0; j < 8; ++j) { v[j] = xr[64 * j]; s += (v[j][0] + v[j][1]) + (v[j][2] + v[j][3]); }
            const float mean = wave_sum(s) * (1.f / D); float s2 = 0.f;
#pragma unroll
            for (int j = 0; j < 8; ++j) { v[j] = v[j] - mean; s2 += (v[j][0] * v[j][0] + v[j][1] * v[j][1]) + (v[j][2] * v[j][2] + v[j][3] * v[j][3]); }
            const float rstd = 1.f / sqrtf(wave_sum(s2) * (1.f / D) + LN_EPS);
            u32x2* o8 = (u32x2*)(XN + (size_t)m * D) + lane;
#pragma unroll
            for (int j = 0; j < 8; ++j) { const f32x4 g4 = ((const f32x4*)lg)[64 * j + lane], b4 = ((const f32x4*)lb)[64 * j + lane]; const f32x4 y = v[j] * rstd * g4 + b4;
                u32x2 w; w.x = pk2(y[0], y[1]); w.y = pk2(y[2], y[3]); o8[64 * j] = w; }
        }
    }
    SEAM(0);

    if (IN(1)) REP(1) {
        LANE_TID();
        pg8::StaticOrder S; S.init(M, NPP, G, bid);
        pg8::EpiBf16 E{P, NPP};
        pg8::gemm_phase<pg8::EpiBf16, pg8::StaticOrder, pg8::DenseRows, true>(lds, XN, WinT, S, E, pg8::DenseRows{}, wave);
    }
    SEAM(1);

    if (IN(2)) REP(2) {
        LANE_TID();
        bf16_t* UC = (bf16_t*)(ws + WS_UC); bf16_t* XL = (bf16_t*)(ws + WS_XL);
        const float* conv_w = args.in[I_CONVW]; const float* conv_b = args.in[I_CONVB]; const float* mu = args.in[I_MU];
        for (int idx = gt; idx < M * (LRU_W / 8); idx += NGT) { const int m = idx >> 7, c = (idx & 127) * 8, tin = m & (SEQ - 1);
            float o[8];
#pragma unroll
            for (int e = 0; e < 8; ++e) o[e] = conv_b[c + e];
#pragma unroll
            for (int j = 0; j < 4; ++j) { if (tin - 3 + j >= 0) { const u32x4 pv = *(const u32x4*)(P + (size_t)(m - 3 + j) * NPP + c);
                const f32x4 w0 = *(const f32x4*)(conv_w + j * LRU_W + c), w1 = *(const f32x4*)(conv_w + j * LRU_W + c + 4);
                o[0] += w0[0] * bflo(pv.x); o[1] += w0[1] * bfhi(pv.x); o[2] += w0[2] * bflo(pv.y); o[3] += w0[3] * bfhi(pv.y);
                o[4] += w1[0] * bflo(pv.z); o[5] += w1[1] * bfhi(pv.z); o[6] += w1[2] * bflo(pv.w); o[7] += w1[3] * bfhi(pv.w); } }
            *(u32x4*)(UC + (size_t)m * LRU_W + c) = (u32x4){cvt2(o[0], o[1]), cvt2(o[2], o[3]), cvt2(o[4], o[5]), cvt2(o[6], o[7])}; }
        for (int idx = gt; idx < M * 64; idx += NGT) { const int m = idx >> 6, q = idx & 63, tin = m & (SEQ - 1);
            u32x4 res = {0u, 0u, 0u, 0u};
            const int kind = q < 12 ? 0 : (q < 16 ? 3 : (q < 28 ? 1 : (q < 32 ? 3 : 2)));
            if (kind != 3) { const int col = (kind == 0) ? 3 * RW_W + 8 * q : (kind == 1 ? 3 * RW_W + DLORA + 8 * (q - 16) : 3 * RW_W + DLORA + ALORA + 8 * (q - 32));
                const bf16_t* pp = P + (size_t)m * NPP + 2 * LRU_W + col; const u32x4 pc = *(const u32x4*)pp; u32x4 pq = {0u, 0u, 0u, 0u}; if (tin > 0) pq = *(const u32x4*)(pp - NPP);
                const f32x4 m0 = *(const f32x4*)(mu + col), m1 = *(const f32x4*)(mu + col + 4);
                float s[8]; const unsigned pcw[4] = {pc.x, pc.y, pc.z, pc.w}, pqw[4] = {pq.x, pq.y, pq.z, pq.w};
#pragma unroll
                for (int e = 0; e < 4; ++e) { const float c0 = bflo(pcw[e]), c1 = bfhi(pcw[e]), p0 = bflo(pqw[e]), p1 = bfhi(pqw[e]);
                    const float mu0 = (e < 2) ? m0[2 * e] : m1[2 * e - 4], mu1 = (e < 2) ? m0[2 * e + 1] : m1[2 * e - 3];
                    s[2 * e] = c0 + (p0 - c0) * mu0; s[2 * e + 1] = c1 + (p1 - c1) * mu1; }
#pragma unroll
                for (int e = 0; e < 8; ++e) s[e] = (kind == 0) ? tanh_fast(s[e]) : (kind == 1 ? s[e] : sigmoidf_(s[e]));
                res = (u32x4){cvt2(s[0], s[1]), cvt2(s[2], s[3]), cvt2(s[4], s[5]), cvt2(s[6], s[7])}; }
            *(u32x4*)(XL + (size_t)m * 512 + 8 * q) = res; }
    }
    SEAM(2);

    if (IN(3)) {
        LANE_TID();
        const bf16_t* UC = (const bf16_t*)(ws + WS_UC); const bf16_t* XL = (const bf16_t*)(ws + WS_XL);
        { pg8::SmallOrder<0> S{G, bid}; pg8::EpiBf16 E{(bf16_t*)(ws + WS_GATES), 2048};
          pg8::gemm_phase<pg8::EpiBf16, pg8::SmallOrder<0>, pg8::DenseRows, true, LRU_W, 256>(lds, UC, (const bf16_t*)(ws + WS_WG), S, E, pg8::DenseRows{}, wave); }
        { pg8::SmallOrder<1> S{G, bid}; pg8::EpiBf16 E{(bf16_t*)(ws + WS_LOUT), 3072};
          pg8::gemm_phase<pg8::EpiBf16, pg8::SmallOrder<1>, pg8::DenseRows, true, 512, 256>(lds, XL, (const bf16_t*)(ws + WS_WL), S, E, pg8::DenseRows{}, wave); }
    }
    SEAM(3);

    if (IN(4)) {
        LANE_TID();
        constexpr int RS = 144;
        constexpr int L_AT = 0, L_BT = 9216, L_KT = 18432, L_RT = 27648, L_VT = 36864, L_BH = 46080, L_KH = 55296, L_AAB = 64512, L_AAK = 80896, L_ARB = 90112, L_ARK = 99328,
                      L_PT = 108544, L_QT = 117760, L_WC = 126976, L_SEG = 127232, L_A16 = 129280, L_TB = 138496, L_U = L_BT, L_MST = L_AT, L_GST = L_BT;
        bf16_t* MT = (bf16_t*)(ws + WS_MT); bf16_t* GG = (bf16_t*)(ws + WS_GG); float* NN = (float*)(ws + WS_NN); float* HH = (float*)(ws + WS_HH);
        const bf16_t* LOUT = (const bf16_t*)(ws + WS_LOUT); bf16_t* V16 = (bf16_t*)(ws + WS_V16); bf16_t* G16 = (bf16_t*)(ws + WS_G16); const float* mu_ = args.in[I_MU];
        const int r = lane & 31, hh = lane >> 5;
        unsigned short xr[9], xk[9], xv[9], xd[8], xa[8], xg[8];
#define E_LOAD(u_) do { const int cch_ = (u_) & 63, head_ = ((u_) >> 6) & 15, b_ = (u_) >> 10; const size_t tokb_ = (size_t)b_ * SEQ + cch_ * 64 + 8 * wave; const int c_ = head_ * HS + lane; \
            const bf16_t* pp_ = P + tokb_ * NPP + 2 * LRU_W + c_; const bool hp_ = ((cch_ * 64 + 8 * wave) & (SEQ - 1)) != 0; \
            xr[0] = hp_ ? pp_[-NPP] : (unsigned short)0; xk[0] = hp_ ? pp_[-NPP + RW_W] : (unsigned short)0; xv[0] = hp_ ? pp_[-NPP + 2 * RW_W] : (unsigned short)0; \
            _Pragma("unroll") for (int j = 0; j < 8; ++j) { const bf16_t* pj = pp_ + (size_t)j * NPP; xr[j + 1] = pj[0]; xk[j + 1] = pj[RW_W]; xv[j + 1] = pj[2 * RW_W]; \
                const bf16_t* lj = LOUT + (tokb_ + j) * 3072 + c_; xd[j] = lj[0]; xa[j] = lj[1024]; xg[j] = lj[2048]; } } while (0)
        if (bid < NUNIT) E_LOAD(bid);
        REP(4) for (int u = bid; u < NUNIT; u += G) {
            const int cch = u & 63, head = (u >> 6) & 15, b = u >> 10; const size_t tok0 = (size_t)b * SEQ + cch * 64;
            { const int ch = lane, tg = wave, c = head * HS + ch; const size_t tokb = tok0 + 8 * tg;
                float lw[8], rr_[8], kk_[8], vv_[8], kn_[8], aa_[8];
                { const float mur = mu_[c], muk = mu_[RW_W + c], muv = mu_[2 * RW_W + c];
                    const float w0c = args.in[I_W0][c], a0c = args.in[I_A0][c], kkc = args.in[I_KK][c], kac = args.in[I_KA][c], rkc = args.in[I_RK][c];
                    float bonv[8];
#pragma unroll
                    for (int j = 0; j < 8; ++j) { const float cr = bf2f(xr[j + 1]), ck = bf2f(xk[j + 1]), cv = bf2f(xv[j + 1]), pr = bf2f(xr[j]), pk_ = bf2f(xk[j]), pvv = bf2f(xv[j]);
                        const float r = cr + (pr - cr) * mur, k = ck + (pk_ - ck) * muk, v = cv + (pvv - cv) * muv;
                        const float lgw = -0.6065306597126334f * sigmoidf_(w0c + bf2f(xd[j]));
                        const float a = sigmoidf_(a0c + bf2f(xa[j]));
                        float kk = k * kkc; kk = kk * __builtin_amdgcn_rsqf(fmaxf(wave_sum(kk * kk), 1e-24f));
                        const float km = k * (1.f + (a - 1.f) * kac);
                        bonv[j] = wave_sum(r * km * rkc);
                        lw[j] = lgw; rr_[j] = r; kk_[j] = km; vv_[j] = v; kn_[j] = kk; aa_[j] = a; }
#pragma unroll
                    for (int j = 0; j < 8; ++j) { V16[(tokb + j) * RW_W + c] = cvt1(vv_[j]); G16[(tokb + j) * RW_W + c] = xg[j]; }
                    if (lane < 8) { float bsel = bonv[0];
#pragma unroll
                        for (int j = 1; j < 8; ++j) bsel = (lane == j) ? bonv[j] : bsel;
                        BON[(tokb + lane) * NHEAD + head] = bsel; }
                    if (u + G < NUNIT) E_LOAD(u + G); }
                float seg = 0.f;
#pragma unroll
                for (int j = 0; j < 8; ++j) seg += lw[j];
                ((LAS float*)(lds + L_SEG))[tg * 64 + ch] = seg;
                __syncthreads();
                float pre = 0.f, tot = 0.f;
#pragma unroll
                for (int g = 0; g < 8; ++g) { const float sg_ = ((LAS float*)(lds + L_SEG))[g * 64 + ch]; tot += sg_; if (g < tg) pre += sg_; }
                if (tg == 0) ((LAS float*)(lds + L_WC))[ch] = __expf(tot);
                float L = pre; unsigned pv[4], pb[4], pk[4]; float tv[8], tb_[8], tk[8];
                const float eTot = __expf(tot); float eLex = __expf(pre);
#pragma unroll
                for (int j = 0; j < 8; ++j) { L += lw[j];
                    const float eL = __expf(L), eNL = __builtin_amdgcn_rcpf(eL), eEnd = eTot * eNL; const float beta = kn_[j] * aa_[j];
                    const int t = 8 * tg + j;
                    *(LAS unsigned short*)(lds + L_AT + t * RS + ch * 2) = cvt1(kn_[j] * eLex);
                    *(LAS unsigned short*)(lds + L_BT + t * RS + ch * 2) = cvt1(beta * eNL);
                    *(LAS unsigned short*)(lds + L_KT + t * RS + ch * 2) = cvt1(kk_[j] * eNL);
                    *(LAS unsigned short*)(lds + L_RT + t * RS + ch * 2) = cvt1(rr_[j] * eL);
                    tv[j] = vv_[j]; tb_[j] = -beta * eEnd; tk[j] = kk_[j] * eEnd; eLex = eL; }
#pragma unroll
                for (int j = 0; j < 4; ++j) { pv[j] = cvt2(tv[2 * j], tv[2 * j + 1]); pb[j] = cvt2(tb_[2 * j], tb_[2 * j + 1]); pk[j] = cvt2(tk[2 * j], tk[2 * j + 1]); }
                *(LAS u32x4*)(lds + L_VT + ch * RS + tg * 16) = (u32x4){pv[0], pv[1], pv[2], pv[3]};
                *(LAS u32x4*)(lds + L_BH + ch * RS + tg * 16) = (u32x4){pb[0], pb[1], pb[2], pb[3]};
                *(LAS u32x4*)(lds + L_KH + ch * RS + tg * 16) = (u32x4){pk[0], pk[1], pk[2], pk[3]};
            }
            __syncthreads();
            { const int id = wave >> 1, i = wave & 1; const int X = (id < 2) ? L_AT : L_RT, Y = (id & 1) ? L_KT : L_BT;
                f32x16 acc[2];
#pragma unroll
                for (int q = 0; q < 2; ++q)
#pragma unroll
                    for (int e = 0; e < 16; ++e) acc[q][e] = 0.f;
#pragma unroll
                for (int s = 0; s < 4; ++s) { const bf16x8 a = *(const LAS bf16x8*)(lds + X + (32 * i + r) * RS + (16 * s + 8 * hh) * 2);
#pragma unroll
                    for (int q = 0; q < 2; ++q) { const bf16x8 bb = *(const LAS bf16x8*)(lds + Y + (32 * q + r) * RS + (16 * s + 8 * hh) * 2); acc[q] = MFMA32(a, bb, acc[q]); } }
#pragma unroll
                for (int q = 0; q < 2; ++q)
#pragma unroll
                    for (int e = 0; e < 16; ++e) { const int t = 32 * i + crow(e, hh), sc = 32 * q + r; const bool keep = (id < 2) ? (sc < t) : (sc <= t);
                        float val = keep ? acc[q][e] : 0.f; if (id == 2) val = -val;
                        if (id == 0) { ((LAS float*)(lds + L_AAB))[t * 64 + sc] = val; *(LAS unsigned short*)(lds + L_A16 + t * RS + sc * 2) = cvt1(-val); }
                        else *(LAS unsigned short*)(lds + L_AAK + (id - 1) * 9216 + t * RS + sc * 2) = cvt1(val); }
            }
            __syncthreads();
            if (wave < 4) { const int i = wave >> 1, q = wave & 1; f32x16 acc;
#pragma unroll
                for (int e = 0; e < 16; ++e) acc[e] = 0.f;
#pragma unroll
                for (int s = 0; s < 4; ++s) { const bf16x8 a = *(const LAS bf16x8*)(lds + L_AAK + (32 * i + r) * RS + (16 * s + 8 * hh) * 2);
                    const bf16x8 bb = *(const LAS bf16x8*)(lds + L_VT + (32 * q + r) * RS + (16 * s + 8 * hh) * 2); acc = MFMA32(a, bb, acc); }
#pragma unroll
                for (int e = 0; e < 16; ++e) ((LAS float*)(lds + L_U))[(32 * i + crow(e, hh)) * 64 + 32 * q + r] = acc[e];
            }
            if (wave == 4) { const int b2 = lane >> 4, j = lane & 15; float x[16];
                const LAS float* AB = (const LAS float*)(lds + L_AAB) + (16 * b2) * 64 + 16 * b2;
#pragma unroll
                for (int t = 0; t < 16; ++t) { float s_ = (t == j) ? 1.f : 0.f;
#pragma unroll
                    for (int s4 = 0; s4 < (t + 3) / 4; ++s4) { const f32x4 A4 = *(const LAS f32x4*)(AB + t * 64 + 4 * s4);
#pragma unroll
                        for (int e = 0; e < 4; ++e) if (4 * s4 + e < t) s_ -= A4[e] * x[4 * s4 + e]; }
                    x[t] = s_; }
#pragma unroll
                for (int t = 0; t < 16; ++t) *(LAS unsigned short*)(lds + L_TB + ((b2 * 16 + t) * 16 + j) * 2) = cvt1(x[t]);
            }
            __syncthreads();
            { const int c16 = lane & 15, quad = lane >> 4, isQ = wave >> 2, colb = 16 * (wave & 3) + c16;
                f32x4 Xr[4];
#pragma unroll
                for (int b2 = 0; b2 < 4; ++b2) Xr[b2] = (f32x4){0.f, 0.f, 0.f, 0.f};
#pragma unroll
                for (int b2 = 0; b2 < 4; ++b2) {
                    f32x4 y;
#pragma unroll
                    for (int g = 0; g < 4; ++g) { const int row = 16 * b2 + 4 * quad + g;
                        y[g] = isQ ? ((const LAS float*)(lds + L_U))[row * 64 + colb] : bf2f(*(const LAS unsigned short*)(lds + L_AT + row * RS + colb * 2)); }
#pragma unroll
                    for (int ks = 0; ks < 2; ++ks) if (2 * ks < b2) {
                        const u32x2 alo = *(const LAS u32x2*)(lds + L_A16 + (16 * b2 + c16) * RS + (32 * ks + 4 * quad) * 2);
                        u32x2 ahi = {0u, 0u}; if (2 * ks + 1 < b2) ahi = *(const LAS u32x2*)(lds + L_A16 + (16 * b2 + c16) * RS + (32 * ks + 16 + 4 * quad) * 2);
                        const u32x4 af = {alo.x, alo.y, ahi.x, ahi.y};
                        const u32x4 bf = {cvt2(Xr[2 * ks][0], Xr[2 * ks][1]), cvt2(Xr[2 * ks][2], Xr[2 * ks][3]), cvt2(Xr[2 * ks + 1][0], Xr[2 * ks + 1][1]), cvt2(Xr[2 * ks + 1][2], Xr[2 * ks + 1][3])};
                        y = __builtin_amdgcn_mfma_f32_16x16x32_bf16(__builtin_bit_cast(bf16x8, af), __builtin_bit_cast(bf16x8, bf), y, 0, 0, 0); }
                    const u32x2 tlo = *(const LAS u32x2*)(lds + L_TB + ((b2 * 16 + c16) * 16 + 4 * quad) * 2);
                    const u32x4 tf = {tlo.x, tlo.y, 0u, 0u};
                    const u32x4 yf = {cvt2(y[0], y[1]), cvt2(y[2], y[3]), 0u, 0u};
                    Xr[b2] = __builtin_amdgcn_mfma_f32_16x16x32_bf16(__builtin_bit_cast(bf16x8, tf), __builtin_bit_cast(bf16x8, yf), (f32x4){0.f, 0.f, 0.f, 0.f}, 0, 0, 0);
                    *(LAS u32x2*)(lds + (isQ ? L_QT : L_PT) + colb * RS + (16 * b2 + 4 * quad) * 2) = (u32x2){cvt2(Xr[b2][0], Xr[b2][1]), cvt2(Xr[b2][2], Xr[b2][3])};
                }
            }
            __syncthreads();
            { const int mtx = wave >> 1, i = wave & 1;
                const int X1 = (mtx == 0) ? L_BH : (mtx == 1) ? L_KH : (mtx == 2) ? L_ARB : L_ARK;
                const int Y1 = (mtx == 0 || mtx == 2) ? L_PT : L_VT;
                f32x16 acc[2];
#pragma unroll
                for (int q = 0; q < 2; ++q)
#pragma unroll
                    for (int e = 0; e < 16; ++e) acc[q][e] = 0.f;
#pragma unroll
                for (int s = 0; s < 4; ++s) { const bf16x8 a = *(const LAS bf16x8*)(lds + X1 + (32 * i + r) * RS + (16 * s + 8 * hh) * 2);
#pragma unroll
                    for (int q = 0; q < 2; ++q) { const bf16x8 bb = *(const LAS bf16x8*)(lds + Y1 + (32 * q + r) * RS + (16 * s + 8 * hh) * 2); acc[q] = MFMA32(a, bb, acc[q]); } }
                if (mtx & 1) { const int X2 = (mtx == 1) ? L_BH : L_ARB;
#pragma unroll
                    for (int s = 0; s < 4; ++s) { const bf16x8 a = *(const LAS bf16x8*)(lds + X2 + (32 * i + r) * RS + (16 * s + 8 * hh) * 2);
#pragma unroll
                        for (int q = 0; q < 2; ++q) { const bf16x8 bb = *(const LAS bf16x8*)(lds + L_QT + (32 * q + r) * RS + (16 * s + 8 * hh) * 2); acc[q] = MFMA32(a, bb, acc[q]); } } }
                if (mtx == 0) { const float wc = ((const LAS float*)(lds + L_WC))[32 * i + r];
#pragma unroll
                    for (int q = 0; q < 2; ++q)
#pragma unroll
                        for (int e = 0; e < 16; ++e) if (q == i && crow(e, hh) == r) acc[q][e] += wc; }
                if (mtx == 2) {
#pragma unroll
                    for (int q = 0; q < 2; ++q)
#pragma unroll
                        for (int e = 0; e < 16; ++e) acc[q][e] += bf2f(*(const LAS unsigned short*)(lds + L_RT + (32 * i + crow(e, hh)) * RS + (32 * q + r) * 2)); }
                if (mtx & 1) { float* dstg = ((mtx == 1) ? NN : HH) + (size_t)u * 4096;
#pragma unroll
                    for (int q = 0; q < 2; ++q)
#pragma unroll
                        for (int e = 0; e < 16; ++e) dstg[((i * 2 + q) * 16 + e) * 64 + lane] = acc[q][e];
                } else { const int dl = (mtx == 0) ? L_MST : L_GST;
#pragma unroll
                    for (int q = 0; q < 2; ++q)
#pragma unroll
                        for (int e = 0; e < 16; ++e) *(LAS unsigned short*)(lds + dl + (32 * i + crow(e, hh)) * RS + (32 * q + r) * 2) = cvt1(acc[q][e]); }
            }
            __syncthreads();
            { const int f = tid >> 6, i = f >> 2, q = (f >> 1) & 1, s = f & 1, r2 = lane & 31, h2 = lane >> 5; const int off = (32 * i + r2) * RS + (32 * q + 16 * s + 4 * h2) * 2;
                const u32x2 m0 = *(const LAS u32x2*)(lds + L_MST + off), m1 = *(const LAS u32x2*)(lds + L_MST + off + 16);
                const u32x2 g0 = *(const LAS u32x2*)(lds + L_GST + off), g1 = *(const LAS u32x2*)(lds + L_GST + off + 16);
                *(u32x4*)(MT + (size_t)u * 4096 + tid * 8) = (u32x4){m0.x, m0.y, m1.x, m1.y};
                *(u32x4*)(GG + (size_t)u * 4096 + tid * 8) = (u32x4){g0.x, g0.y, g1.x, g1.y}; }
            __syncthreads();
        }
        { float* CA = (float*)(ws + WS_CA); float* CH = (float*)(ws + WS_CH); const bf16_t* UC = (const bf16_t*)(ws + WS_UC); const bf16_t* GATES = (const bf16_t*)(ws + WS_GATES);
            for (int bc = bid; bc < BATCH * 64; bc += G) { const size_t tok0 = (size_t)(bc >> 6) * SEQ + (bc & 63) * 64;
                float h[2] = {0.f, 0.f}, A[2] = {1.f, 1.f}, br[2], bi[2], sp[2];
#pragma unroll
                for (int cc = 0; cc < 2; ++cc) { const int c = tid + 512 * cc; br[cc] = args.in[I_BRG][c]; bi[cc] = args.in[I_BIG][c]; const float lam = args.in[I_LAMBDA][c];
                    sp[cc] = lam > 15.f ? __expf(-lam) : log1pf(__expf(-lam)); }
                unsigned short gr[2][8], gi[2][8], uc[2][8];
#define LRU_LOAD(t_) do { _Pragma("unroll") for (int cc = 0; cc < 2; ++cc) _Pragma("unroll") for (int j = 0; j < 8; ++j) { const size_t tk = tok0 + (t_) + j; const int c = tid + 512 * cc; \
                    gr[cc][j] = GATES[tk * 2048 + c]; gi[cc][j] = GATES[tk * 2048 + LRU_W + c]; uc[cc][j] = UC[tk * LRU_W + c]; } } while (0)
                LRU_LOAD(0);
#pragma unroll 1
                for (int t = 0; t < 64; t += 8) {
                    float hv[2][8], av[2][8];
#pragma unroll
                    for (int cc = 0; cc < 2; ++cc)
#pragma unroll
                        for (int j = 0; j < 8; ++j) { const float rg = sigmoidf_(bf2f(gr[cc][j]) + br[cc]), ig = sigmoidf_(bf2f(gi[cc][j]) + bi[cc]);
                            const float a = __expf(-8.f * rg * sp[cc]), bb = sqrtf(fmaxf(1.f - a * a, 0.f)) * (ig * bf2f(uc[cc][j]));
                            h[cc] = a * h[cc] + bb; A[cc] *= a; hv[cc][j] = h[cc]; av[cc][j] = A[cc]; }
                    if (t + 8 < 64) LRU_LOAD(t + 8);
#pragma unroll
                    for (int cc = 0; cc < 2; ++cc)
#pragma unroll
                        for (int j = 0; j < 8; ++j) { const int c = tid + 512 * cc; LB[(tok0 + t + j) * LRU_W + c] = hv[cc][j]; LA[(tok0 + t + j) * LRU_W + c] = av[cc][j]; }
                }
#undef LRU_LOAD
#pragma unroll
                for (int cc = 0; cc < 2; ++cc) { const int c = tid + 512 * cc; CA[(size_t)bc * LRU_W + c] = A[cc]; CH[(size_t)bc * LRU_W + c] = h[cc]; } } }
    }
    SEAM(4);

    if (IN(5)) REP(5) {
        LANE_TID();
        if (bid < BATCH * NHEAD) {
            const bf16_t* MT = (const bf16_t*)(ws + WS_MT); const float* NN = (const float*)(ws + WS_NN); bf16_t* XS = (bf16_t*)(ws + WS_XS);
            constexpr int SLOT = 24576, NCH = SEQ / 64;
            const int u0 = bid * NCH;
            if (wave >= 2) {
                const int lw = wave - 2;
#define R2_ISSUE(c_) do { const int _u = u0 + (c_); const int _sl = ((c_) & 3) * SLOT; _Pragma("unroll") for (int _rd = 0; _rd < 4; ++_rd) { const int _k0 = _rd * 384 + lw * 64; \
                    const char* _src = (_k0 < 512) ? (const char*)MT + (size_t)_u * 8192 + (size_t)(_k0 + lane) * 16 : (const char*)NN + (size_t)_u * 16384 + (size_t)(_k0 - 512 + lane) * 16; \
                    __builtin_amdgcn_global_load_lds((const unsigned*)_src, (LAS unsigned*)(lds + _sl + _k0 * 16), 16, 0, 0); } } while (0)
                R2_ISSUE(0); R2_ISSUE(1); R2_ISSUE(2);
                for (int c = 0; c < NCH; ++c) {
                    if (c < NCH - 2) asm volatile("s_waitcnt vmcnt(8)" ::: "memory"); else if (c == NCH - 2) asm volatile("s_waitcnt vmcnt(4)" ::: "memory"); else asm volatile("s_waitcnt vmcnt(0)" ::: "memory");
                    __builtin_amdgcn_s_barrier();
                    asm volatile("" ::: "memory");
                    if (c + 3 < NCH) R2_ISSUE(c + 3);
                }
#undef R2_ISSUE
            } else {
                const int vh = wave;
                f32x16 X[2];
#pragma unroll
                for (int q = 0; q < 2; ++q)
#pragma unroll
                    for (int e = 0; e < 16; ++e) X[q][e] = 0.f;
                for (int c = 0; c < NCH; ++c) {
                    bf16x8 xb[2][2];
#pragma unroll
                    for (int q = 0; q < 2; ++q)
#pragma unroll
                        for (int s = 0; s < 2; ++s) { const u32x4 p = {cvt2(X[q][8 * s], X[q][8 * s + 1]), cvt2(X[q][8 * s + 2], X[q][8 * s + 3]), cvt2(X[q][8 * s + 4], X[q][8 * s + 5]), cvt2(X[q][8 * s + 6], X[q][8 * s + 7])};
                            xb[q][s] = __builtin_bit_cast(bf16x8, p);
                            *(u32x4*)(XS + (size_t)(u0 + c) * 4096 + (((vh * 2 + q) * 2 + s) * 64 + lane) * 8) = p; }
                    asm volatile("" ::: "memory");
                    __builtin_amdgcn_s_barrier();
                    asm volatile("" ::: "memory");
                    const LAS unsigned char* sl = lds + (c & 3) * SLOT;
#pragma unroll
                    for (int i = 0; i < 2; ++i) { f32x16 nx;
#pragma unroll
                        for (int e = 0; e < 16; ++e) nx[e] = ((const LAS float*)(sl + 8192))[((i * 2 + vh) * 16 + e) * 64 + lane];
#pragma unroll
                        for (int q = 0; q < 2; ++q)
#pragma unroll
                            for (int s = 0; s < 2; ++s) { const bf16x8 a = *(const LAS bf16x8*)(sl + ((i * 2 + q) * 2 + s) * 1024 + lane * 16); nx = MFMA32(a, xb[q][s], nx); }
                        X[i] = nx; }
                    asm volatile("s_waitcnt lgkmcnt(0)" ::: "memory");
                }
            }
        } else if (bid < BATCH * NHEAD + 8) {
            const float* CA = (const float*)(ws + WS_CA); const float* CH = (const float*)(ws + WS_CH); float* CIN = (float*)(ws + WS_CIN);
            const int i = (bid - BATCH * NHEAD) * NTHREADS + tid, b = i >> 10, c = i & 1023; float s = 0.f;
            for (int ch = 0; ch < 64; ch += 8) { float a[8], hh_[8];
#pragma unroll
                for (int j = 0; j < 8; ++j) { a[j] = CA[(size_t)(b * 64 + ch + j) * LRU_W + c]; hh_[j] = CH[(size_t)(b * 64 + ch + j) * LRU_W + c]; }
#pragma unroll
                for (int j = 0; j < 8; ++j) { CIN[(size_t)(b * 64 + ch + j) * LRU_W + c] = s; s = a[j] * s + hh_[j]; } }
        }
    }
    SEAM(5);

    if (IN(6)) REP(6) {
        LANE_TID();
        { const float* CIN = (const float*)(ws + WS_CIN);
            for (int idx = gt; idx < M * (LRU_W / 8); idx += NGT) { const int m = idx >> 7, c = (idx & 127) * 8; const size_t o = (size_t)m * LRU_W + c;
                const u32x4 gq = *(const u32x4*)(P + (size_t)m * NPP + LRU_W + c);
                const f32x4 h0 = *(const f32x4*)(LB + o), h1 = *(const f32x4*)(LB + o + 4), a0 = *(const f32x4*)(LA + o), a1 = *(const f32x4*)(LA + o + 4);
                const f32x4 c0 = *(const f32x4*)(CIN + (size_t)(m >> 6) * LRU_W + c), c1 = *(const f32x4*)(CIN + (size_t)(m >> 6) * LRU_W + c + 4);
                const unsigned gw_[4] = {gq.x, gq.y, gq.z, gq.w}; float o8[8];
#pragma unroll
                for (int e = 0; e < 4; ++e) { const float hA = (e < 2 ? h0[2 * e] : h1[2 * e - 4]) + (e < 2 ? a0[2 * e] : a1[2 * e - 4]) * (e < 2 ? c0[2 * e] : c1[2 * e - 4]);
                    const float hB = (e < 2 ? h0[2 * e + 1] : h1[2 * e - 3]) + (e < 2 ? a0[2 * e + 1] : a1[2 * e - 3]) * (e < 2 ? c0[2 * e + 1] : c1[2 * e - 3]);
                    o8[2 * e] = hA * gelu_tanh(bflo(gw_[e])); o8[2 * e + 1] = hB * gelu_tanh(bfhi(gw_[e])); }
                *(u32x4*)(CAT + (size_t)m * D + c) = (u32x4){cvt2(o8[0], o8[1]), cvt2(o8[2], o8[3]), cvt2(o8[4], o8[5]), cvt2(o8[6], o8[7])}; } }
        const bf16_t* GG = (const bf16_t*)(ws + WS_GG); const bf16_t* XS = (const bf16_t*)(ws + WS_XS); const float* HH = (const float*)(ws + WS_HH);
        const bf16_t* V16 = (const bf16_t*)(ws + WS_V16); const bf16_t* G16 = (const bf16_t*)(ws + WS_G16);
        const float* gng = args.in[I_GNG]; const float* gnb = args.in[I_GNB];
        const int r = lane & 31, hh = lane >> 5;
        constexpr int YS = 68;
        LAS float* yt = (LAS float*)(lds + wave * (64 * YS * 4));
        for (int u = gw; u < NUNIT; u += NGW) {
            const int cch = u & 63, head = (u >> 6) & 15, b = u >> 10; const size_t tok0 = (size_t)b * SEQ + cch * 64;
            f32x16 acc[2][2];
#pragma unroll
            for (int i = 0; i < 2; ++i)
#pragma unroll
                for (int vh = 0; vh < 2; ++vh)
#pragma unroll
                    for (int e = 0; e < 16; ++e) acc[i][vh][e] = HH[(size_t)u * 4096 + ((i * 2 + vh) * 16 + e) * 64 + lane];
#pragma unroll
            for (int q = 0; q < 2; ++q)
#pragma unroll
                for (int s = 0; s < 2; ++s) { bf16x8 xb[2], ga[2];
#pragma unroll
                    for (int vh = 0; vh < 2; ++vh) xb[vh] = *(const bf16x8*)(XS + (size_t)u * 4096 + (((vh * 2 + q) * 2 + s) * 64 + lane) * 8);
#pragma unroll
                    for (int i = 0; i < 2; ++i) ga[i] = *(const bf16x8*)(GG + (size_t)u * 4096 + (((i * 2 + q) * 2 + s) * 64 + lane) * 8);
#pragma unroll
                    for (int i = 0; i < 2; ++i)
#pragma unroll
                        for (int vh = 0; vh < 2; ++vh) acc[i][vh] = MFMA32(ga[i], xb[vh], acc[i][vh]); }
#pragma unroll
            for (int i = 0; i < 2; ++i)
#pragma unroll
                for (int e = 0; e < 16; ++e) {
                    const float s1 = half_sum(acc[i][0][e] + acc[i][1][e], hh);
                    const float mean = s1 * (1.f / 64.f);
                    const float d0 = acc[i][0][e] - mean, d1 = acc[i][1][e] - mean; const float s2 = half_sum(d0 * d0 + d1 * d1, hh);
                    const float rstd = __builtin_amdgcn_rsqf(s2 * (1.f / 64.f) + GN_EPS);
                    const int t = 32 * i + crow(e, hh);
                    yt[t * YS + r] = d0 * rstd; yt[t * YS + 32 + r] = d1 * rstd; }
            asm volatile("s_waitcnt lgkmcnt(0)" ::: "memory");
            { const int tq = lane >> 3, c8 = (lane & 7) * 8, ch = head * HS + c8;
                const f32x4 g0 = *(const f32x4*)(gng + ch), g1 = *(const f32x4*)(gng + ch + 4), b0 = *(const f32x4*)(gnb + ch), b1 = *(const f32x4*)(gnb + ch + 4);
#pragma unroll 2
                for (int k = 0; k < 8; ++k) { const int t = tq + 8 * k; const size_t tok = tok0 + t; const size_t o = tok * RW_W + ch;
                    const f32x4 y0 = *(const LAS f32x4*)(yt + t * YS + c8), y1 = *(const LAS f32x4*)(yt + t * YS + c8 + 4);
                    const u32x4 vq = *(const u32x4*)(V16 + o), gq = *(const u32x4*)(G16 + o); const float bon = BON[tok * NHEAD + head];
                    const unsigned vw[4] = {vq.x, vq.y, vq.z, vq.w}, gw4[4] = {gq.x, gq.y, gq.z, gq.w}; float o8[8];
#pragma unroll
                    for (int e = 0; e < 4; ++e) { const float ya = (e < 2 ? y0[2 * e] : y1[2 * e - 4]), yb = (e < 2 ? y0[2 * e + 1] : y1[2 * e - 3]);
                        const float ga_ = (e < 2 ? g0[2 * e] : g1[2 * e - 4]), gb_ = (e < 2 ? g0[2 * e + 1] : g1[2 * e - 3]), ba_ = (e < 2 ? b0[2 * e] : b1[2 * e - 4]), bb_ = (e < 2 ? b0[2 * e + 1] : b1[2 * e - 3]);
                        o8[2 * e] = (ya * ga_ + ba_ + bon * bflo(vw[e])) * bflo(gw4[e]); o8[2 * e + 1] = (yb * gb_ + bb_ + bon * bfhi(vw[e])) * bfhi(gw4[e]); }
                    *(u32x4*)(CAT + tok * D + LRU_W + ch) = (u32x4){cvt2(o8[0], o8[1]), cvt2(o8[2], o8[3]), cvt2(o8[4], o8[5]), cvt2(o8[6], o8[7])}; } }
            asm volatile("s_waitcnt lgkmcnt(0)" ::: "memory");
        }
    }
    SEAM(6);

    if (IN(7)) REP(7) {
        LANE_TID();
        pg8::StaticOrder S; S.init(M, D, G, bid);
        pg8::EpiResF32 E{Z, XN, DN_ALPHA};
        pg8::gemm_phase<pg8::EpiResF32, pg8::StaticOrder, pg8::DenseRows, true>(lds, CAT, WoT, S, E, pg8::DenseRows{}, wave);
    }
    SEAM(7);

    if (IN(8)) {
        LANE_TID();
        LAS float* hT = (LAS float*)lds;
        LAS float* part = (LAS float*)lds;
        LAS float* lgt = (LAS float*)(lds + 65536);
        const float* g1 = args.in[I_LN1G]; const float* b1 = args.in[I_LN1B]; const float* wr_ = args.in[I_WROUTER]; const float* br_ = args.in[I_BROUTER];
        for (int tile = bid; tile < M / 16; tile += G) {
            const int t0 = tile * 16;
            __syncthreads();
#pragma unroll 1
            for (int rr = 0; rr < 2; ++rr) { const int tb = wave * 2 + rr, m = t0 + tb;
                const f32x4* zr = (const f32x4*)(Z + (size_t)m * D) + lane;
                f32x4 v[8]; float s = 0.f;
#pragma unroll
                for (int j = 0; j < 8; ++j) { v[j] = zr[64 * j]; s += (v[j][0] + v[j][1]) + (v[j][2] + v[j][3]); }
                const float mean = wave_sum(s) * (1.f / D); float s2 = 0.f;
#pragma unroll
                for (int j = 0; j < 8; ++j) { v[j] = v[j] - mean; s2 += (v[j][0] * v[j][0] + v[j][1] * v[j][1]) + (v[j][2] * v[j][2] + v[j][3] * v[j][3]); }
                const float rstd = 1.f / sqrtf(wave_sum(s2) * (1.f / D) + LN_EPS);
                f32x4* ho = (f32x4*)(H1 + (size_t)m * D) + lane; unsigned* hb = (unsigned*)(H1F + (size_t)m * D) + lane;
#pragma unroll
                for (int j = 0; j < 8; ++j) { const f32x4 g4 = ((const f32x4*)g1)[64 * j + lane], b4 = ((const f32x4*)b1)[64 * j + lane]; const f32x4 y = v[j] * rstd * g4 + b4;
                    ho[64 * j] = y; hb[64 * j] = pk4_f8(y[0] * F8_SH, y[1] * F8_SH, y[2] * F8_SH, y[3] * F8_SH);
#pragma unroll
                    for (int q = 0; q < 4; ++q) hT[(256 * j + 4 * lane + q) * 16 + tb] = y[q]; } }
            __syncthreads();
            float ac[16];
#pragma unroll
            for (int tb = 0; tb < 16; ++tb) ac[tb] = 0.f;
            { const int e = tid & 31, sl = tid >> 5;
                for (int i = sl * 128; i < sl * 128 + 128; ++i) { const float w = wr_[(size_t)i * NE + e]; const LAS f32x4* hp = (const LAS f32x4*)(hT + i * 16);
#pragma unroll
                    for (int q = 0; q < 4; ++q) { const f32x4 h4 = hp[q];
#pragma unroll
                        for (int k = 0; k < 4; ++k) ac[q * 4 + k] += w * h4[k]; } }
                __syncthreads();
#pragma unroll
                for (int tb = 0; tb < 16; ++tb) part[(sl * 16 + tb) * 32 + e] = ac[tb]; }
            __syncthreads();
            { const int tb = tid >> 5, e = tid & 31; float sacc = br_[e];
#pragma unroll
                for (int sl = 0; sl < 16; ++sl) sacc += part[(sl * 16 + tb) * 32 + e];
                lgt[tb * 32 + e] = sacc; }
            __syncthreads();
            if (tid < 16) { const int m = t0 + tid; float bv[4]; int bi[4]; unsigned used = 0u;
#pragma unroll 1
                for (int k = 0; k < 4; ++k) { float best = -3.0e38f; int be = 0;
                    for (int e = 0; e < NE; ++e) { const float x = lgt[tid * 32 + e]; if (!((used >> e) & 1u) && x > best) { best = x; be = e; } }
                    used |= 1u << be; bv[k] = best; bi[k] = be; }
                float ex[4], den = 0.f;
#pragma unroll
                for (int k = 0; k < 4; ++k) { ex[k] = __expf(bv[k] - bv[0]); den += ex[k]; }
#pragma unroll 1
                for (int k = 0; k < 4; ++k) { const int pos = (int)__hip_atomic_fetch_add(ctl + CW_CNT + 64 * bi[k], 1u, RLX_AGENT);
                    TOPE[m * 4 + k] = bi[k]; TOPP[m * 4 + k] = pos; TOPG[m * 4 + k] = ex[k] / den; } }
        }
    }
    SEAM(8);

    if (IN(9)) REP(9) {
        LANE_TID();
        volatile LAS int* tb = (volatile LAS int*)(MISC + 16);
        moe_tables(tb, ctl, wave);
        for (int i = gt; i < M * TOPK; i += NGT) { const int e = TOPE[i], slot = tb[1 + e] * 128 + TOPP[i];
            SLOTTOK[slot] = i >> 2; SLOTG[slot] = TOPG[i]; TOKSLOT[i] = slot; }
        if (bid < NE) { const int e = bid, c = (int)__hip_atomic_load(ctl + CW_CNT + 64 * e, RLX_AGENT), s0 = tb[1 + e] * 128 + c, s1 = tb[2 + e] * 128;
            for (int s = s0 + tid; s < s1; s += NTHREADS) { SLOTTOK[s] = 0; SLOTG[s] = 0.f; } }
    }
    SEAM(9);

    if (IN(10)) REP(10) {
        LANE_TID();
        volatile LAS int* tb = (volatile LAS int*)(MISC + 16);
        moe_tables(tb, ctl, wave);
        pg8::MoeOrder S{(const LAS int*)(tb + 64), tb[0], 16, G, bid, KD / 128};
        pg8::EpiSwigluH E{ACT, args.in[I_BE1]};
        pg8::gemm_f8h(lds, H1F, W1F, S, E, pg8::GatherRowsH{SLOTTOK}, wave);
    }
    SEAM(10);

    if (IN(11)) REP(11) {
        LANE_TID();
        volatile LAS int* tb = (volatile LAS int*)(MISC + 16);
        moe_tables(tb, ctl, wave);
        pg8::MoeOrder S{(const LAS int*)(tb + 64), tb[0], 8, G, bid, KD / 128};
        pg8::EpiMoeOutH E{OUTS, args.in[I_BE2], SLOTG};
        pg8::gemm_f8h(lds, ACT, W2F, S, E, pg8::DenseRowsH{}, wave);
    }
    SEAM(11);

    if (IN(12)) REP(12) {
        LANE_TID();
        const float* g2 = args.in[I_LN2G]; const float* b2 = args.in[I_LN2B];
        for (int m = gw; m < M; m += NGW) {
            const f32x4* hr = (const f32x4*)(H1 + (size_t)m * D) + lane;
            const int s0 = TOKSLOT[m * 4], s1 = TOKSLOT[m * 4 + 1], s2_ = TOKSLOT[m * 4 + 2], s3 = TOKSLOT[m * 4 + 3];
            const u32x2* o0 = (const u32x2*)(OUTS + (size_t)s0 * D) + lane; const u32x2* o1 = (const u32x2*)(OUTS + (size_t)s1 * D) + lane;
            const u32x2* o2 = (const u32x2*)(OUTS + (size_t)s2_ * D) + lane; const u32x2* o3 = (const u32x2*)(OUTS + (size_t)s3 * D) + lane;
            f32x4 v[8]; float s = 0.f;
#pragma unroll
            for (int j = 0; j < 8; ++j) { const f32x4 h4 = hr[64 * j]; const u32x2 a = o0[64 * j], b = o1[64 * j], c = o2[64 * j], d = o3[64 * j];
                f32x4 mo; mo[0] = (bflo(a.x) + bflo(b.x)) + (bflo(c.x) + bflo(d.x)); mo[1] = (bfhi(a.x) + bfhi(b.x)) + (bfhi(c.x) + bfhi(d.x));
                mo[2] = (bflo(a.y) + bflo(b.y)) + (bflo(c.y) + bflo(d.y)); mo[3] = (bfhi(a.y) + bfhi(b.y)) + (bfhi(c.y) + bfhi(d.y));
                v[j] = h4 * DN_ALPHA + mo; s += (v[j][0] + v[j][1]) + (v[j][2] + v[j][3]); }
            const float mean = wave_sum(s) * (1.f / D); float q2 = 0.f;
#pragma unroll
            for (int j = 0; j < 8; ++j) { v[j] = v[j] - mean; q2 += (v[j][0] * v[j][0] + v[j][1] * v[j][1]) + (v[j][2] * v[j][2] + v[j][3] * v[j][3]); }
            const float rstd = 1.f / sqrtf(wave_sum(q2) * (1.f / D) + LN_EPS);
            f32x4* orow = (f32x4*)(args.out + (size_t)m * D) + lane;
#pragma unroll
            for (int j = 0; j < 8; ++j) { const f32x4 g4 = ((const f32x4*)g2)[64 * j + lane], b4 = ((const f32x4*)b2)[64 * j + lane]; orow[64 * j] = v[j] * rstd * g4 + b4; }
        }
    }
    if (PROBE_PHASE >= 0) { if (PROBE_PHASE == NPHASE - 1) tprobe1 = __builtin_amdgcn_s_memrealtime();
        asm volatile("s_waitcnt vmcnt(0)" ::: "memory"); __syncthreads();
        if (bid == 0 && wave == 0 && lane_now() == 0) args.out[0] += 1.0f + (float)(tprobe1 - tprobe0) * 1e-4f; }
#undef IN
#undef SEAM
}

#ifndef MK_ONE_LAUNCH
#define MK_ONE_LAUNCH 1
#endif
extern "C" void kernel_launch(void* const* d_in, const int* in_sizes, int n_in, void* d_out, int out_size, void* d_ws, size_t ws_size, hipStream_t stream) {
    static int grid = 0;
    if (grid == 0) {
        if (n_in != 33 || out_size != M * D || ws_size < WS_END) { fprintf(stderr, "kernel_launch: unexpected sizes n_in %d out %d ws %zu (need %zu)\n", n_in, out_size, ws_size, (size_t)WS_END); grid = -1; return; }
        int dev = 0, cus = 0, per_cu = 0;
        if (hipGetDevice(&dev) != hipSuccess || hipDeviceGetAttribute(&cus, hipDeviceAttributeMultiprocessorCount, dev) != hipSuccess) { grid = -1; return; }
        if (hipFuncSetAttribute((const void*)fwd, hipFuncAttributeMaxDynamicSharedMemorySize, LDS_BYTES) != hipSuccess) { fprintf(stderr, "kernel_launch: hipFuncSetAttribute failed\n"); grid = -1; return; }
        if (hipOccupancyMaxActiveBlocksPerMultiprocessor(&per_cu, (const void*)fwd, NTHREADS, LDS_BYTES) != hipSuccess || per_cu < 1) fprintf(stderr, "kernel_launch: occupancy query says %d\n", per_cu);
        (void)hipGetLastError();
        grid = cus;
    }
    if (grid < 0) return;
    (void)hipMemsetAsync((char*)d_ws + WS_CTL, 0, CTL_ZERO_BYTES, stream);
    Args a{};
    for (int i = 0; i < 33; ++i) a.in[i] = (const float*)d_in[i];
    a.out = (float*)d_out; a.ws = (unsigned char*)d_ws;
#if MK_ONE_LAUNCH
    a.ph_lo = 0; a.ph_hi = NPHASE; a.use_bar = 1;
    hipLaunchKernelGGL(fwd, dim3(grid), dim3(NTHREADS), LDS_BYTES, stream, a);
#else
    for (int p = 0; p < NPHASE; ++p) { a.ph_lo = p; a.ph_hi = p + 1; a.use_bar = 0;
        hipLaunchKernelGGL(fwd, dim3(grid), dim3(NTHREADS), LDS_BYTES, stream, a); }
#endif
}
```

```cpp
#include <hip/hip_runtime.h>
#include <cstdio>
#include <cstdint>

#define LAS __attribute__((address_space(3)))
#define GAS __attribute__((address_space(1)))
typedef unsigned short bf16_t;
typedef short bf16x8 __attribute__((ext_vector_type(8)));
typedef float f32x4 __attribute__((ext_vector_type(4)));
typedef float f32x2 __attribute__((ext_vector_type(2)));
typedef unsigned u32x4 __attribute__((ext_vector_type(4)));
typedef unsigned u32x2 __attribute__((ext_vector_type(2)));
typedef float f32x16 __attribute__((ext_vector_type(16)));
typedef int i32x4 __attribute__((ext_vector_type(4)));
typedef int i32x8 __attribute__((ext_vector_type(8)));
typedef __bf16 bfv2 __attribute__((ext_vector_type(2)));
#define MFMA32(a, b, c) __builtin_amdgcn_mfma_f32_32x32x16_bf16((a), (b), (c), 0, 0, 0)

constexpr int BATCH = 4, SEQ = 4096, M = BATCH * SEQ, D = 2048;
constexpr int LRU_W = 1024, RW_W = 1024, NHEAD = 16, HS = 64;
constexpr int DLORA = 96, ALORA = 96, GLORA = 256;
constexpr int RW_SHIFT_W = 3 * RW_W + DLORA + ALORA + GLORA;
constexpr int NP = 2 * LRU_W + RW_SHIFT_W;
constexpr int NPP = 5632;
constexpr int NE = 32, TOPK = 4, DE = 2048;
constexpr int NSLOT_MAX = M * TOPK + NE * 256;
constexpr int NTILE_MAX = NSLOT_MAX / 256;
constexpr float LN_EPS = 1e-5f, GN_EPS = 64e-5f;
constexpr float DN_ALPHA = 1.189207115002721f;
constexpr int KD = 2048;

constexpr size_t MiB = 1u << 20;
constexpr size_t WS_CTL = 0, CTL_ZERO_BYTES = 1 * MiB;
constexpr size_t WS_WIN = 2 * MiB;
constexpr size_t WS_WO = WS_WIN + (size_t)NPP * KD * 2;
constexpr size_t WS_W1 = WS_WO + (size_t)D * KD * 2;
constexpr size_t WS_W2 = WS_W1 + (size_t)NE * 2 * DE * KD * 2;
constexpr size_t WS_XN = WS_W2 + (size_t)NE * D * DE * 2;
constexpr size_t WS_P = WS_XN + (size_t)M * D * 2;
constexpr size_t WS_LA = WS_P + (size_t)M * NPP * 2;
constexpr size_t WS_LB = WS_LA + (size_t)M * LRU_W * 4;
constexpr size_t WS_UC = WS_LB + (size_t)M * LRU_W * 4;
constexpr size_t WS_XL = WS_UC + (size_t)M * LRU_W * 2;
constexpr size_t WS_GATES = WS_XL + (size_t)M * 512 * 2;
constexpr size_t WS_LOUT = WS_GATES + (size_t)M * 2048 * 2;
constexpr size_t WS_V16 = WS_LOUT + (size_t)M * 3072 * 2;
constexpr size_t WS_G16 = WS_V16 + (size_t)M * RW_W * 2;
constexpr size_t WS_WG = WS_G16 + (size_t)M * RW_W * 2;
constexpr size_t WS_WL = WS_WG + (size_t)2048 * 256 * 2;
constexpr size_t WS_RY = WS_WL + (size_t)3072 * 256 * 2;
constexpr size_t WS_BON = WS_RY;
constexpr size_t WS_CAT = WS_BON + (size_t)M * NHEAD * 4;
constexpr size_t WS_Z = WS_CAT + (size_t)M * D * 2;
constexpr size_t WS_H1 = WS_Z + (size_t)M * D * 4;
constexpr size_t WS_H1B = WS_H1 + (size_t)M * D * 4;
constexpr size_t WS_TOPE = WS_H1B + (size_t)M * D * 2;
constexpr size_t WS_TOPP = WS_TOPE + (size_t)M * TOPK * 4;
constexpr size_t WS_TOPG = WS_TOPP + (size_t)M * TOPK * 4;
constexpr size_t WS_TOKSLOT = WS_TOPG + (size_t)M * TOPK * 4;
constexpr size_t WS_SLOTTOK = WS_TOKSLOT + (size_t)M * TOPK * 4;
constexpr size_t WS_SLOTG = WS_SLOTTOK + (size_t)NSLOT_MAX * 4;
constexpr size_t WS_ACT = WS_SLOTG + (size_t)NSLOT_MAX * 4;
constexpr size_t WS_OUTS = WS_ACT + (size_t)NSLOT_MAX * DE * 2;
constexpr int NUNIT = BATCH * NHEAD * (SEQ / 64);
constexpr size_t WS_MT = WS_OUTS + (size_t)NSLOT_MAX * D * 2;
constexpr size_t WS_GG = WS_MT + (size_t)NUNIT * 8192;
constexpr size_t WS_XS = WS_GG + (size_t)NUNIT * 8192;
constexpr size_t WS_NN = WS_XS + (size_t)NUNIT * 8192;
constexpr size_t WS_HH = WS_NN + (size_t)NUNIT * 16384;
constexpr size_t WS_CA = WS_HH + (size_t)NUNIT * 16384;
constexpr size_t WS_CH = WS_CA + (size_t)BATCH * 64 * LRU_W * 4;
constexpr size_t WS_CIN = WS_CH + (size_t)BATCH * 64 * LRU_W * 4;
constexpr size_t WS_XG = WS_CIN + (size_t)BATCH * 64 * LRU_W * 4;
constexpr size_t WS_END = WS_XG + (size_t)NSLOT_MAX * D;
constexpr int CW_CNT = 1024;
constexpr int CW_BAR = 4096;

constexpr int MISC_OFF = 159744;
constexpr int LDS_BYTES = 163840;

#define RLX_AGENT __ATOMIC_RELAXED, __HIP_MEMORY_SCOPE_AGENT
__device__ __forceinline__ unsigned f2bf(float f) { unsigned u = __builtin_bit_cast(unsigned, f); return (u + 0x7fffu + ((u >> 16) & 1u)) >> 16; }
__device__ __forceinline__ unsigned pk2(float lo, float hi) { return f2bf(lo) | (f2bf(hi) << 16); }
__device__ __forceinline__ float bf2f(unsigned short b) { return __builtin_bit_cast(float, (unsigned)b << 16); }
__device__ __forceinline__ float bflo(unsigned w) { return __builtin_bit_cast(float, w << 16); }
__device__ __forceinline__ float bfhi(unsigned w) { return __builtin_bit_cast(float, w & 0xffff0000u); }
__device__ __forceinline__ unsigned cvt2(float a, float b) { const f32x2 v = {a, b}; return __builtin_bit_cast(unsigned, __builtin_convertvector(v, bfv2)); }
__device__ __forceinline__ unsigned short cvt1(float a) { return (unsigned short)(cvt2(a, 0.f) & 0xffffu); }
constexpr float F8_SH = 4.f, F8_SW1 = 32.f, F8_SACT = 4.f, F8_SW2 = 64.f;
__device__ __forceinline__ float f8clamp(float x) { return fminf(fmaxf(x, -448.f), 448.f); }
__device__ __forceinline__ unsigned pk4_f8(float a, float b, float c, float d) { int w = 0; w = __builtin_amdgcn_cvt_pk_fp8_f32(f8clamp(a), f8clamp(b), w, false); w = __builtin_amdgcn_cvt_pk_fp8_f32(f8clamp(c), f8clamp(d), w, true); return (unsigned)w; }
__device__ __forceinline__ int lane_now() { int l; asm volatile("v_mbcnt_lo_u32_b32 %0, -1, 0\n\tv_mbcnt_hi_u32_b32 %0, -1, %0" : "=v"(l)); return l; }
__device__ __forceinline__ int crow(int reg, int h) { return (reg & 3) + 8 * (reg >> 2) + 4 * h; }
__device__ __forceinline__ float row_sum16(float v) {
    v += __builtin_bit_cast(float, __builtin_amdgcn_update_dpp(0, __builtin_bit_cast(int, v), 0xB1, 0xf, 0xf, false));
    v += __builtin_bit_cast(float, __builtin_amdgcn_update_dpp(0, __builtin_bit_cast(int, v), 0x4E, 0xf, 0xf, false));
    v += __builtin_bit_cast(float, __builtin_amdgcn_update_dpp(0, __builtin_bit_cast(int, v), 0x141, 0xf, 0xf, false));
    v += __builtin_bit_cast(float, __builtin_amdgcn_update_dpp(0, __builtin_bit_cast(int, v), 0x140, 0xf, 0xf, false));
    return v;
}
__device__ __forceinline__ float rdlane(float v, int l) { return __builtin_bit_cast(float, __builtin_amdgcn_readlane(__builtin_bit_cast(int, v), l)); }
__device__ __forceinline__ float wave_sum(float v) { v = row_sum16(v); return (rdlane(v, 0) + rdlane(v, 16)) + (rdlane(v, 32) + rdlane(v, 48)); }
__device__ __forceinline__ float half_sum(float v, int hh) { v = row_sum16(v); const float lo = rdlane(v, 0) + rdlane(v, 16), hi = rdlane(v, 32) + rdlane(v, 48); return hh ? hi : lo; }
__device__ __forceinline__ float sigmoidf_(float x) { return __builtin_amdgcn_rcpf(1.f + __expf(-x)); }
__device__ __forceinline__ float gelu_tanh(float x) { const float u = 0.7978845608028654f * (x + 0.044715f * x * x * x); return x * __builtin_amdgcn_rcpf(1.f + __expf(-2.f * u)); }
__device__ __forceinline__ float tanh_fast(float x) { const float e = __expf(-2.f * fabsf(x)); const float t = (1.f - e) * __builtin_amdgcn_rcpf(1.f + e); return x < 0.f ? -t : t; }

#define XB_TMO      128
#define XB_XCNT(j)  (256  + 64 * (j))
#define XB_XSUB(j)  (1280 + 64 * (j))
#define XB_XGEN(j)  (2304 + 64 * (j))
#define XB_TOP      3328
#define XB_TOPGEN   3392
#define XCD_BAR_WORDS 3456
#define XB_SPIN_CAP (1u << 18)
__device__ __forceinline__ unsigned xb_ld(unsigned* p)              { return __hip_atomic_load(p, __ATOMIC_RELAXED, __HIP_MEMORY_SCOPE_AGENT); }
__device__ __forceinline__ unsigned xb_add(unsigned* p, unsigned v) { return __hip_atomic_fetch_add(p, v, __ATOMIC_RELAXED, __HIP_MEMORY_SCOPE_AGENT); }
__device__ __forceinline__ unsigned xb_xcc_id() { return (unsigned)__builtin_amdgcn_s_getreg((3 << 11) | 20) & 0xFu; }
#define XB_SPIN(cond, bar) do { unsigned _sp = 0; while (cond) { __builtin_amdgcn_s_sleep(1); \
    if ((++_sp & 255u) == 0u) { if (xb_ld(&(bar)[XB_TMO])) break; if (_sp > XB_SPIN_CAP) { atomicAdd(&(bar)[XB_TMO], 1u); break; } } } } while (0)
struct XcdBarrier { unsigned* bar; unsigned x; volatile LAS unsigned* st; };
__device__ __forceinline__ XcdBarrier xcd_barrier_post(unsigned* bar, volatile LAS unsigned* st) {
    XcdBarrier b; b.bar = bar; b.x = xb_xcc_id(); b.st = st;
    if (__builtin_amdgcn_readfirstlane(threadIdx.x >> 6) == 0 && lane_now() == 0) (void)xb_add(&bar[XB_XCNT(b.x)], 1u);
    return b;
}
__device__ __forceinline__ void xcd_barrier_complete(unsigned* bar, unsigned x, unsigned& nloc, unsigned& nx) {
    const unsigned G = gridDim.x * gridDim.y * gridDim.z;
    unsigned sum, cnt, mine, sp = 0u;
    for (;;) {
        sum = 0u; cnt = 0u; mine = 0u;
#pragma unroll
        for (unsigned j = 0; j < 16; ++j) { const unsigned c = xb_ld(&bar[XB_XCNT(j)]); sum += c; cnt += (c > 0u) ? 1u : 0u; mine = (j == x) ? c : mine; }
        if (sum == G) break;
        __builtin_amdgcn_s_sleep(1);
        if ((++sp & 255u) == 0u) { if (xb_ld(&bar[XB_TMO])) break; if (sp > XB_SPIN_CAP) { atomicAdd(&bar[XB_TMO], 1u); break; } }
    }
    nloc = mine > 0u ? mine : 1u; nx = cnt > 0u ? cnt : 1u;
}
__device__ __forceinline__ void xcd_barrier(const XcdBarrier& b, int wave_id) {
    asm volatile("s_waitcnt vmcnt(0)" ::: "memory");
    __syncthreads();
    if (wave_id == 0 && lane_now() == 0) {
        unsigned* bar = b.bar;
        __builtin_amdgcn_s_waitcnt(0);
        unsigned nloc = b.st[0], nx = b.st[1];
        if (nloc == 0u) { xcd_barrier_complete(bar, b.x, nloc, nx); b.st[0] = nloc; b.st[1] = nx; }
        const unsigned old = xb_add(&bar[XB_XSUB(b.x)], 1u);
        const unsigned gen = old / nloc;
        if (old + 1u == (gen + 1u) * nloc) {
            __builtin_amdgcn_fence(__ATOMIC_RELEASE, "agent");
            asm volatile("s_waitcnt vmcnt(0)" ::: "memory");
            const unsigned og = xb_add(&bar[XB_TOP], 1u);
            const unsigned tg = og / nx;
            if (og + 1u == (tg + 1u) * nx) xb_add(&bar[XB_TOPGEN], 1u);
            else XB_SPIN(xb_ld(&bar[XB_TOPGEN]) == tg, bar);
            __builtin_amdgcn_fence(__ATOMIC_ACQUIRE, "agent");
            xb_add(&bar[XB_XGEN(b.x)], 1u);
            asm volatile("s_waitcnt vmcnt(0)" ::: "memory");
        } else {
            XB_SPIN(xb_ld(&bar[XB_XGEN(b.x)]) == gen, bar);
            __builtin_amdgcn_fence(__ATOMIC_ACQUIRE, "agent");
            asm volatile("s_waitcnt vmcnt(0)" ::: "memory");
        }
    }
    __syncthreads();
}

namespace pg8 {
constexpr int BM = 256, BK = 64, HALF = 128, HTB = HALF * BK * 2, STAGE_BYTES = 8 * HTB, NXCD = 8, WGM = 8;
__host__ __device__ __forceinline__ int lds_byte(int r, int c) { const int st = (r >> 4) * 2 + (c >> 5), rr = r & 15, cc = c & 31, ob = rr * 64 + cc * 2; return st * 1024 + (ob ^ (((ob >> 9) & 1) << 5)); }
__host__ __device__ __forceinline__ void stage_rc(int b, int& R, int& C) { const int st = b / 1024, sb = b % 1024, swz = sb ^ (((sb >> 9) & 1) << 5); R = (st >> 1) * 16 + swz / 64; C = (st & 1) * 32 + (swz % 64) / 2; }
__host__ __device__ __forceinline__ int perm32(int rho) { const int n = rho >> 4, i = rho & 15; return 8 * (i >> 2) + 4 * n + (i & 3); }
struct Unit { int pm, pn, ak, nt; };
__device__ __forceinline__ unsigned cvt_pk_bf16(float lo, float hi) { unsigned r; asm volatile("v_cvt_pk_bf16_f32 %0, %1, %2" : "=v"(r) : "v"(lo), "v"(hi)); return r; }

struct StaticOrder {
    int nM, nN, nwg, G, c;
    __device__ void init(int M_, int N_, int G_, int c_) { nM = M_ / BM; nN = N_ / BM; nwg = nM * nN; G = G_; c = c_; }
    __device__ bool next(int i, Unit& u) const {
        const long L = (long)i * G + c; if (L >= nwg) return false;
        int wgid = (int)L; { const int q = nwg / NXCD, r = nwg % NXCD, xcd = wgid % NXCD, off = wgid / NXCD; wgid = (xcd < r ? xcd * (q + 1) : r * (q + 1) + (xcd - r) * q) + off; }
        const int nig = WGM * nN, gid = wgid / nig, fm = gid * WGM, gsz = (nM - fm) < WGM ? (nM - fm) : WGM;
        u.pm = fm + ((wgid % nig) % gsz); u.pn = (wgid % nig) / gsz; u.ak = 0; u.nt = KD / BK; return true;
    }
};
struct MoeOrder {
    const LAS int* tile_e; int R, NCT, G, c, nt;
    __device__ bool next(int i, Unit& u) const {
        int rt, ct;
        if (G == 256) { const int x = c & 7, j = c >> 3;
            if (NCT == 16) { rt = 16 * i + (x >> 1) * 4 + (j >> 3); ct = (x & 1) * 8 + (j & 7); }
            else           { rt = 32 * i + 4 * x + (j >> 3); ct = j & 7; } }
        else { const long L = (long)i * G + c; rt = (int)(L / NCT); ct = (int)(L % NCT); }
        if (rt >= R) return false;
        u.pm = rt; u.pn = tile_e[rt] * NCT + ct; u.ak = 0; u.nt = nt; return true;
    }
};
template <int MODE> struct SmallOrder {
    int G, c;
    __device__ bool next(int i, Unit& u) const {
        constexpr int NCT = MODE == 0 ? 8 : 12;
        const int L = i * G + c; if (L >= (M / BM) * NCT) return false;
        u.pm = L / NCT; u.pn = L % NCT;
        if (MODE == 0) { u.ak = 256 * (u.pn & 3); u.nt = 4; }
        else { u.ak = u.pn < 4 ? 0 : (u.pn < 8 ? 128 : 256); u.nt = u.pn < 8 ? 2 : 4; }
        return true;
    }
};
struct DenseRows { static constexpr bool DENSE = true; __device__ __forceinline__ unsigned row(int pm, int r) const { return (unsigned)(pm * BM + r); } };
struct GatherRows { static constexpr bool DENSE = false; const int* idx; __device__ __forceinline__ unsigned row(int pm, int r) const { return (unsigned)idx[pm * BM + r]; } };

struct EpiBf16 {
    static constexpr bool PERM = true;
    bf16_t* O; int ldc;
    __device__ __forceinline__ void operator()(const f32x4 (&acc)[2][2][4][2], const Unit& u, int wr, int wc, int fr, int fq) const {
        const int row0 = u.pm * BM + wr * 64 + fr, col0 = u.pn * BM + wc * 32 + 8 * fq;
#pragma unroll
        for (int ai = 0; ai < 2; ++ai)
#pragma unroll
            for (int m = 0; m < 4; ++m) { bf16_t* rowp = O + (size_t)(row0 + ai * HALF + m * 16) * ldc + col0;
#pragma unroll
                for (int bj = 0; bj < 2; ++bj) { const f32x4 v0 = acc[ai][bj][m][0], v1 = acc[ai][bj][m][1];
                    u32x4 w; w.x = cvt_pk_bf16(v0[0], v0[1]); w.y = cvt_pk_bf16(v0[2], v0[3]); w.z = cvt_pk_bf16(v1[0], v1[1]); w.w = cvt_pk_bf16(v1[2], v1[3]);
                    *(u32x4*)(rowp + bj * HALF) = w; } }
    }
};
struct EpiResF32 {
    static constexpr bool PERM = false;
    float* Z; const bf16_t* R; float alpha;
    __device__ __forceinline__ void operator()(const f32x4 (&acc)[2][2][4][2], const Unit& u, int wr, int wc, int fr, int fq) const {
        const int row0 = u.pm * BM + wr * 64 + fr, col0 = u.pn * BM + wc * 32 + 4 * fq;
#pragma unroll
        for (int ai = 0; ai < 2; ++ai)
#pragma unroll
            for (int m = 0; m < 4; ++m) { const size_t off = (size_t)(row0 + ai * HALF + m * 16) * D + col0;
#pragma unroll
                for (int bj = 0; bj < 2; ++bj)
#pragma unroll
                    for (int n = 0; n < 2; ++n) { const u32x2 rb = *(const u32x2*)(R + off + bj * HALF + n * 16);
                        f32x4 o = acc[ai][bj][m][n]; o[0] += alpha * bflo(rb.x); o[1] += alpha * bfhi(rb.x); o[2] += alpha * bflo(rb.y); o[3] += alpha * bfhi(rb.y);
                        *(f32x4*)(Z + off + bj * HALF + n * 16) = o; } }
    }
};
struct EpiSwiglu {
    static constexpr bool PERM = true;
    unsigned char* O; const float* b1;
    __device__ __forceinline__ void operator()(const f32x4 (&acc)[2][2][4][2], const Unit& u, int wr, int wc, int fr, int fq) const {
        const int e = u.pn >> 4, ct = u.pn & 15;
        const int row0 = u.pm * BM + wr * 64 + fr, cin = wc * 32 + 8 * fq, col0 = ct * HALF + cin;
        const float* bg = b1 + (size_t)e * 2 * DE + col0; const float* bu = bg + DE;
        const f32x4 bg0 = *(const f32x4*)bg, bg1 = *(const f32x4*)(bg + 4), bu0 = *(const f32x4*)bu, bu1 = *(const f32x4*)(bu + 4);
        constexpr float inv = 1.f / (F8_SH * F8_SW1);
#pragma unroll
        for (int ai = 0; ai < 2; ++ai)
#pragma unroll
            for (int m = 0; m < 4; ++m) { unsigned char* rowp = O + (size_t)(row0 + ai * HALF + m * 16) * DE + col0;
                float o[8];
#pragma unroll
                for (int n = 0; n < 2; ++n) { const f32x4 g4 = acc[ai][0][m][n] * inv + (n ? bg1 : bg0), u4 = acc[ai][1][m][n] * inv + (n ? bu1 : bu0);
#pragma unroll
                    for (int j = 0; j < 4; ++j) { const float g = fminf(g4[j], 7.f), up = fminf(fmaxf(u4[j], -7.f), 7.f);
                        o[n * 4 + j] = F8_SACT * g * (up + 1.f) * __builtin_amdgcn_rcpf(1.f + __expf(-1.702f * g)); } }
                *(u32x2*)rowp = (u32x2){pk4_f8(o[0], o[1], o[2], o[3]), pk4_f8(o[4], o[5], o[6], o[7])}; }
    }
};
struct EpiMoeOut {
    static constexpr bool PERM = true;
    bf16_t* O; const float* b2; const float* sg;
    __device__ __forceinline__ void operator()(const f32x4 (&acc)[2][2][4][2], const Unit& u, int wr, int wc, int fr, int fq) const {
        const int e = u.pn >> 3, ct = u.pn & 7;
        const int row0 = u.pm * BM + wr * 64 + fr, col0 = ct * BM + wc * 32 + 8 * fq;
        f32x4 bv[2][2];
#pragma unroll
        for (int bj = 0; bj < 2; ++bj)
#pragma unroll
            for (int n = 0; n < 2; ++n) bv[bj][n] = *(const f32x4*)(b2 + (size_t)e * D + col0 + bj * HALF + 4 * n);
#pragma unroll
        for (int ai = 0; ai < 2; ++ai)
#pragma unroll
            for (int m = 0; m < 4; ++m) { const int row = row0 + ai * HALF + m * 16; const float gt = sg[row]; bf16_t* rowp = O + (size_t)row * D + col0;
#pragma unroll
                for (int bj = 0; bj < 2; ++bj) { const f32x4 v0 = (acc[ai][bj][m][0] * (1.f / (F8_SACT * F8_SW2)) + bv[bj][0]) * gt, v1 = (acc[ai][bj][m][1] * (1.f / (F8_SACT * F8_SW2)) + bv[bj][1]) * gt;
                    u32x4 w; w.x = cvt_pk_bf16(v0[0], v0[1]); w.y = cvt_pk_bf16(v0[2], v0[3]); w.z = cvt_pk_bf16(v1[0], v1[1]); w.w = cvt_pk_bf16(v1[2], v1[3]);
                    *(u32x4*)(rowp + bj * HALF) = w; } }
    }
};

template <class Epi, class Sched, class ARows, bool ALIGN_EPI, int LDA = KD, int LDB = KD, bool F8 = false>
__device__ __forceinline__ void gemm_phase(LAS unsigned char* lds, const bf16_t* A, const bf16_t* Bt, const Sched& S, const Epi& E, const ARows& AR, const int wid) {
    const int lane = lane_now(), tid = wid * 64 + lane, wr = wid >> 2, wc = wid & 3, fr = lane & 15, fq = lane >> 4;
    int sR[2], sC[2]; unsigned voffB[2];
#pragma unroll
    for (int i = 0; i < 2; ++i) { stage_rc(tid * 16 + i * 8192, sR[i], sC[i]); const int Rb = Epi::PERM ? ((sR[i] & ~31) + perm32(sR[i] & 31)) : sR[i];
        voffB[i] = (unsigned)(Rb * LDB + sC[i]) * 2u; }
    constexpr size_t kstep = (size_t)(BK * 2);
    constexpr size_t hstep = (size_t)HALF * LDB * 2;
    constexpr size_t tstep = 2 * hstep;
    const unsigned ldsw = (unsigned)wid * 1024u;
    int aoffs[2], boffs[2];
    if constexpr (F8) { aoffs[0] = lds_byte(wr * 64 + fr, fq * 16); aoffs[1] = aoffs[0] + 16; boffs[0] = 4 * HTB + lds_byte(wc * 32 + fr, fq * 16); boffs[1] = boffs[0] + 16; }
    else { aoffs[0] = lds_byte(wr * 64 + fr, fq * 8); aoffs[1] = aoffs[0] + 1024; boffs[0] = 4 * HTB + lds_byte(wc * 32 + fr, fq * 8); boffs[1] = boffs[0] + 1024; }
#define PG8_SA(b, h) (((b) * 2 + (h)) * HTB)
#define PG8_SB(b, h) ((4 + (b) * 2 + (h)) * HTB)
#define PG8_SBR(b, h) (((b) * 2 + (h)) * HTB)
#define PG8_STAGE(bufoff, gbase, voff) do { const char* gb_ = (const char*)(gbase); _Pragma("unroll") for (int _i = 0; _i < 2; ++_i) { unsigned keep_; \
        asm volatile("s_mov_b32 %0, m0\n\ts_mov_b32 m0, %3\n\ts_nop 0\n\tglobal_load_lds_dwordx4 %1, %2\n\ts_mov_b32 m0, %0" : "=&s"(keep_) : "v"((voff)[_i]), "s"(gb_), "s"((unsigned)((bufoff) + ldsw + _i * 8192)) : "memory"); } } while (0)
#define PG8_LDA(dst, b, h) do { _Pragma("unroll") for (int m = 0; m < 4; ++m) { if constexpr (F8) { const i32x4 lo_ = *(const LAS i32x4*)(lds + PG8_SA(b, h) + aoffs[0] + m * 2048), hi_ = *(const LAS i32x4*)(lds + PG8_SA(b, h) + aoffs[1] + m * 2048); \
            dst##8[m] = __builtin_shufflevector(lo_, hi_, 0, 1, 2, 3, 4, 5, 6, 7); } else { _Pragma("unroll") for (int k = 0; k < 2; ++k) dst[m][k] = *(const LAS bf16x8*)(lds + PG8_SA(b, h) + aoffs[k] + m * 2048); } } } while (0)
#define PG8_LDB(dst, b, h) do { _Pragma("unroll") for (int n = 0; n < 2; ++n) { if constexpr (F8) { const i32x4 lo_ = *(const LAS i32x4*)(lds + PG8_SBR(b, h) + boffs[0] + n * 2048), hi_ = *(const LAS i32x4*)(lds + PG8_SBR(b, h) + boffs[1] + n * 2048); \
            dst##8[n] = __builtin_shufflevector(lo_, hi_, 0, 1, 2, 3, 4, 5, 6, 7); } else { _Pragma("unroll") for (int k = 0; k < 2; ++k) dst[n][k] = *(const LAS bf16x8*)(lds + PG8_SBR(b, h) + boffs[k] + n * 2048); } } } while (0)
#define PG8_MMA(ai, bj, At, Bt_) do { __builtin_amdgcn_s_setprio(1); _Pragma("unroll") for (int m = 0; m < 4; ++m) _Pragma("unroll") for (int n = 0; n < 2; ++n) { \
        if constexpr (F8) { acc[ai][bj][m][n] = __builtin_amdgcn_mfma_scale_f32_16x16x128_f8f6f4(Bt_##8[n], At##8[m], acc[ai][bj][m][n], 0, 0, 0, 0x7f7f7f7f, 0, 0x7f7f7f7f); } \
        else { _Pragma("unroll") for (int k = 0; k < 2; ++k) acc[ai][bj][m][n] = __builtin_amdgcn_mfma_f32_16x16x32_bf16(Bt_[n][k], At[m][k], acc[ai][bj][m][n], 0, 0, 0); } } __builtin_amdgcn_s_setprio(0); } while (0)
#define PG8_WAIT_V(n) asm volatile("s_waitcnt vmcnt(" #n ")" ::: "memory")
#define PG8_WAIT_L(n) asm volatile("s_waitcnt lgkmcnt(" #n ")" ::: "memory")
#define PG8_BAR __builtin_amdgcn_s_barrier()
#define PG8_SCHED __builtin_amdgcn_sched_barrier(0)
#define PG8_AOFF(dst, u) do { const int tq_ = wid * 64 + lane_now(); _Pragma("unroll") for (int _i = 0; _i < 2; ++_i) { int R_, C_; stage_rc(tq_ * 16 + _i * 8192, R_, C_); \
        _Pragma("unroll") for (int _h = 0; _h < 2; ++_h) { \
        if constexpr (ARows::DENSE) dst[_h][_i] = (unsigned)(R_ * LDA + C_) * 2u; \
        else dst[_h][_i] = (AR.row((u).pm, _h * HALF + R_) * (unsigned)LDA + (unsigned)((u).ak + C_)) * 2u; } } } while (0)
#define PG8_ABASE(u) (ARows::DENSE ? (const char*)A + ((size_t)(u).pm * BM * LDA + (u).ak) * 2 : (const char*)A)
    constexpr size_t ahstep = ARows::DENSE ? (size_t)HALF * LDA * 2 : 0;
    Unit cur, nxt; int ui = 0;
    if (!S.next(0, cur)) return;
    f32x4 acc[2][2][4][2];
#pragma unroll
    for (int a = 0; a < 2; ++a)
#pragma unroll
        for (int b = 0; b < 2; ++b)
#pragma unroll
            for (int m = 0; m < 4; ++m)
#pragma unroll
                for (int n = 0; n < 2; ++n) acc[a][b][m][n] = (f32x4){0.f, 0.f, 0.f, 0.f};
    bf16x8 At[4][2], B0[2][2], B1[2][2]; i32x8 At8[4], B08[2], B18[2];
    unsigned ao[2][2], an[2][2];
    PG8_AOFF(ao, cur);
    const char* cA = PG8_ABASE(cur);
    const char* cB = (const char*)Bt + (size_t)cur.pn * tstep;
    PG8_STAGE(PG8_SB(0, 0), cB, voffB); PG8_STAGE(PG8_SB(0, 1), cB + hstep, voffB); PG8_STAGE(PG8_SA(0, 0), cA, ao[0]); PG8_STAGE(PG8_SA(0, 1), cA + ahstep, ao[1]);
    if (wr == 1) PG8_BAR;
    PG8_WAIT_V(2); PG8_BAR;
    PG8_STAGE(PG8_SB(1, 0), cB + kstep, voffB); PG8_STAGE(PG8_SA(1, 0), cA + kstep, ao[0]); PG8_STAGE(PG8_SB(1, 1), cB + hstep + kstep, voffB);
    PG8_WAIT_V(6); PG8_BAR;
    for (;;) {
        const bool has_next = S.next(ui + 1, nxt);
        if (has_next && !ARows::DENSE) { PG8_AOFF(an, nxt); } else {
#pragma unroll
            for (int h = 0; h < 2; ++h)
#pragma unroll
                for (int i = 0; i < 2; ++i) an[h][i] = ao[h][i]; }
        const char* nB = has_next ? (const char*)Bt + (size_t)nxt.pn * tstep : cB;
        const char* nA = has_next ? PG8_ABASE(nxt) : cA;
        const int nt = cur.nt;
#pragma unroll 1
        for (int t = 0; t < nt; t += 2) {
            const bool last = (t == nt - 2);
            const char* a1 = cA + (size_t)(t + 1) * kstep;
            const char* a2 = last ? nA : cA + (size_t)(t + 2) * kstep; const char* b2 = last ? nB : cB + (size_t)(t + 2) * kstep;
            const char* a3 = a2 + kstep; const char* b3 = b2 + kstep;
            unsigned o2[2][2];
#pragma unroll
            for (int h = 0; h < 2; ++h)
#pragma unroll
                for (int i = 0; i < 2; ++i) o2[h][i] = (!ARows::DENSE && last) ? an[h][i] : ao[h][i];
            PG8_LDB(B0, 0, 0); PG8_LDB(B1, 0, 1); PG8_SCHED; PG8_LDA(At, 0, 0); PG8_STAGE(PG8_SA(1, 1), a1 + ahstep, ao[1]);
            PG8_WAIT_V(8); PG8_WAIT_L(0); PG8_BAR; PG8_MMA(0, 0, At, B0); PG8_MMA(0, 1, At, B1); PG8_BAR; PG8_SCHED;
            PG8_LDA(At, 0, 1); PG8_STAGE(PG8_SB(0, 0), b2, voffB); PG8_STAGE(PG8_SB(0, 1), b2 + hstep, voffB); PG8_STAGE(PG8_SA(0, 0), a2, o2[0]);
            PG8_WAIT_V(8); PG8_WAIT_L(0); PG8_BAR; PG8_MMA(1, 0, At, B0); PG8_MMA(1, 1, At, B1); PG8_BAR; PG8_SCHED;
            PG8_LDB(B0, 1, 0); PG8_LDB(B1, 1, 1); PG8_SCHED; PG8_LDA(At, 1, 0); PG8_STAGE(PG8_SA(0, 1), a2 + ahstep, o2[1]);
            PG8_WAIT_V(8); PG8_WAIT_L(0); PG8_BAR; PG8_MMA(0, 0, At, B0); PG8_MMA(0, 1, At, B1); PG8_BAR; PG8_SCHED;
            PG8_LDA(At, 1, 1); PG8_STAGE(PG8_SB(1, 0), b3, voffB); PG8_STAGE(PG8_SB(1, 1), b3 + hstep, voffB); PG8_STAGE(PG8_SA(1, 0), a3, o2[0]);
            PG8_WAIT_V(8); PG8_WAIT_L(0); PG8_BAR; PG8_MMA(1, 0, At, B0); PG8_MMA(1, 1, At, B1); PG8_BAR; PG8_SCHED;
        }
        if constexpr (ALIGN_EPI) { if (wr == 0) PG8_BAR; }
        asm volatile("" : "+s"(cur.pm), "+s"(cur.pn));
        { const int tz = lane_now();
          E(acc, cur, wr, wc, tz & 15, (tz & 63) >> 4); }
        if (!has_next) break;
#pragma unroll
        for (int a = 0; a < 2; ++a)
#pragma unroll
            for (int b = 0; b < 2; ++b)
#pragma unroll
                for (int m = 0; m < 4; ++m)
#pragma unroll
                    for (int n = 0; n < 2; ++n) acc[a][b][m][n] = (f32x4){0.f, 0.f, 0.f, 0.f};
        cur = nxt; cB = nB; cA = nA; ++ui;
#pragma unroll
        for (int h = 0; h < 2; ++h)
#pragma unroll
            for (int i = 0; i < 2; ++i) ao[h][i] = an[h][i];
        if constexpr (ALIGN_EPI) { if (wr == 1) PG8_BAR; }
    }
    PG8_WAIT_V(0);
    if constexpr (!ALIGN_EPI) { if (wr == 0) PG8_BAR; }
    PG8_BAR;
#undef PG8_SA
#undef PG8_SB
#undef PG8_SBR
#undef PG8_STAGE
#undef PG8_LDA
#undef PG8_LDB
#undef PG8_MMA
#undef PG8_WAIT_V
#undef PG8_WAIT_L
#undef PG8_BAR
#undef PG8_SCHED
#undef PG8_AOFF
}
struct DenseRowsH { __device__ __forceinline__ unsigned row(int pm, int r) const { return (unsigned)(pm * 128 + r); } };
struct GatherRowsH { const int* idx; __device__ __forceinline__ unsigned row(int pm, int r) const { return (unsigned)idx[pm * 128 + r]; } };
struct EpiSwigluH {
    unsigned char* O; const float* b1;
    __device__ __forceinline__ void operator()(const f32x4 (&acc)[2][4][2], const Unit& u, int wr, int wc, int fr, int fq) const {
        const int e = u.pn >> 4, ct = u.pn & 15;
        const int row0 = u.pm * 128 + wr * 64 + fr, col0 = ct * HALF + wc * 32 + 8 * fq;
        const float* bg = b1 + (size_t)e * 2 * DE + col0; const float* bu = bg + DE;
        const f32x4 bg0 = *(const f32x4*)bg, bg1 = *(const f32x4*)(bg + 4), bu0 = *(const f32x4*)bu, bu1 = *(const f32x4*)(bu + 4);
        constexpr float inv = 1.f / (F8_SH * F8_SW1);
#pragma unroll
        for (int m = 0; m < 4; ++m) { unsigned char* rowp = O + (size_t)(row0 + m * 16) * DE + col0;
            float o[8];
#pragma unroll
            for (int n = 0; n < 2; ++n) { const f32x4 g4 = acc[0][m][n] * inv + (n ? bg1 : bg0), u4 = acc[1][m][n] * inv + (n ? bu1 : bu0);
#pragma unroll
                for (int j = 0; j < 4; ++j) { const float g = fminf(g4[j], 7.f), up = fminf(fmaxf(u4[j], -7.f), 7.f);
                    o[n * 4 + j] = F8_SACT * g * (up + 1.f) * __builtin_amdgcn_rcpf(1.f + __expf(-1.702f * g)); } }
            *(u32x2*)rowp = (u32x2){pk4_f8(o[0], o[1], o[2], o[3]), pk4_f8(o[4], o[5], o[6], o[7])}; }
    }
};
struct EpiMoeOutH {
    bf16_t* O; const float* b2; const float* sg;
    __device__ __forceinline__ void operator()(const f32x4 (&acc)[2][4][2], const Unit& u, int wr, int wc, int fr, int fq) const {
        const int e = u.pn >> 3, ct = u.pn & 7;
        const int row0 = u.pm * 128 + wr * 64 + fr, col0 = ct * BM + wc * 32 + 8 * fq;
        constexpr float inv = 1.f / (F8_SACT * F8_SW2);
#pragma unroll
        for (int m = 0; m < 4; ++m) { const int row = row0 + m * 16; const float gt = sg[row]; bf16_t* rowp = O + (size_t)row * D + col0;
#pragma unroll
            for (int bj = 0; bj < 2; ++bj) { const f32x4 b0 = *(const f32x4*)(b2 + (size_t)e * D + col0 + bj * HALF), b1_ = *(const f32x4*)(b2 + (size_t)e * D + col0 + bj * HALF + 4);
                const f32x4 v0 = (acc[bj][m][0] * inv + b0) * gt, v1 = (acc[bj][m][1] * inv + b1_) * gt;
                *(u32x4*)(rowp + bj * HALF) = (u32x4){cvt2(v0[0], v0[1]), cvt2(v0[2], v0[3]), cvt2(v1[0], v1[1]), cvt2(v1[2], v1[3])}; } }
    }
};
__host__ __device__ __forceinline__ int f8_g(int R) { return ((R >> 1) & 1) + 4 * ((R >> 3) & 1); }
__host__ __device__ __forceinline__ int f8_lds_byte(int R, int c) { return R * 128 + (((c + f8_g(R)) & 7) << 4); }
__host__ __device__ __forceinline__ void f8_stage_rc(int pos, int& R, int& Cb) { const int P = pos >> 4; R = P >> 3; Cb = (((P & 7) - f8_g(R)) & 7) << 4; }
template <class Epi, class Sched, class ARows>
__device__ __forceinline__ void gemm_f8h(LAS unsigned char* lds, const unsigned char* A, const unsigned char* Bt, const Sched& S, const Epi& E, const ARows& AR, const int wid) {
    constexpr int NT = KD / 128, STG = 3 * HTB;
    const int wr = wid >> 2, wc = wid & 3;
    const unsigned ldsw = (unsigned)wid * 1024u;
    Unit cur, nxt;
    if (!S.next(0, cur)) return;
#define F8_STAGE(dstoff, gbase, voff) do { const char* gb_ = (const char*)(gbase); _Pragma("unroll") for (int _i = 0; _i < 2; ++_i) { unsigned keep_; \
        asm volatile("s_mov_b32 %0, m0\n\ts_mov_b32 m0, %3\n\ts_nop 0\n\tglobal_load_lds_dwordx4 %1, %2\n\ts_mov_b32 m0, %0" : "=&s"(keep_) : "v"((voff)[_i]), "s"(gb_), "s"((unsigned)((dstoff) + ldsw + _i * 8192)) : "memory"); } } while (0)
#define F8_AOFF(dst, u) do { const int tq_ = wid * 64 + lane_now(); _Pragma("unroll") for (int _i = 0; _i < 2; ++_i) { int R_, C_; f8_stage_rc(tq_ * 16 + _i * 8192, R_, C_); dst[_i] = AR.row((u).pm, R_) * (unsigned)KD + (unsigned)C_; } } while (0)
#define F8_STAGE_TILE(so_, kt_, aoffv, bptr) do { F8_STAGE((so_), (const char*)A + (size_t)(kt_) * 128, aoffv); F8_STAGE((so_) + HTB, (bptr) + (size_t)(kt_) * 128, vb); F8_STAGE((so_) + 2 * HTB, (bptr) + (size_t)128 * KD + (size_t)(kt_) * 128, vb); } while (0)
#define F8_LDFRAG(a8, b8, so_) do { _Pragma("unroll") for (int m = 0; m < 4; ++m) { const i32x4 lo = *(const LAS i32x4*)(lds + (so_) + aoff0 + m * 2048), hi = *(const LAS i32x4*)(lds + (so_) + aoff1 + m * 2048); a8[m] = __builtin_shufflevector(lo, hi, 0, 1, 2, 3, 4, 5, 6, 7); } \
        _Pragma("unroll") for (int b = 0; b < 2; ++b) _Pragma("unroll") for (int n = 0; n < 2; ++n) { const i32x4 lo = *(const LAS i32x4*)(lds + (so_) + (1 + b) * HTB + boff0 + n * 2048), hi = *(const LAS i32x4*)(lds + (so_) + (1 + b) * HTB + boff1 + n * 2048); b8[b][n] = __builtin_shufflevector(lo, hi, 0, 1, 2, 3, 4, 5, 6, 7); } } while (0)
#define F8_MMA(a8, b8) do { __builtin_amdgcn_s_setprio(1); _Pragma("unroll") for (int b = 0; b < 2; ++b) _Pragma("unroll") for (int m = 0; m < 4; ++m) _Pragma("unroll") for (int n = 0; n < 2; ++n) \
        acc[b][m][n] = __builtin_amdgcn_mfma_scale_f32_16x16x128_f8f6f4(b8[b][n], a8[m], acc[b][m][n], 0, 0, 0, 0x7f7f7f7f, 0, 0x7f7f7f7f); __builtin_amdgcn_s_setprio(0); } while (0)
    unsigned ao[2], an[2], vb[2];
    { const int tq = wid * 64 + lane_now();
#pragma unroll
        for (int i = 0; i < 2; ++i) { int R, C; f8_stage_rc(tq * 16 + i * 8192, R, C); const int Rb = (R & ~31) + perm32(R & 31); vb[i] = (unsigned)(Rb * KD + C); } }
    F8_AOFF(ao, cur);
    int aoff0, aoff1, boff0, boff1; { const int ln = lane_now(), fr = ln & 15, fq = ln >> 4; aoff0 = f8_lds_byte(wr * 64 + fr, 2 * fq); aoff1 = f8_lds_byte(wr * 64 + fr, 2 * fq + 1); boff0 = f8_lds_byte(wc * 32 + fr, 2 * fq); boff1 = f8_lds_byte(wc * 32 + fr, 2 * fq + 1); }
    const char* cB = (const char*)Bt + (size_t)cur.pn * 256 * KD;
    f32x4 acc[2][4][2];
#pragma unroll
    for (int b = 0; b < 2; ++b)
#pragma unroll
        for (int m = 0; m < 4; ++m)
#pragma unroll
            for (int n = 0; n < 2; ++n) acc[b][m][n] = (f32x4){0.f, 0.f, 0.f, 0.f};
    F8_STAGE_TILE(0, 0, ao, cB); F8_STAGE_TILE(STG, 1, ao, cB);
    int so = 0;
    for (int ui = 0;; ++ui) {
        const bool has_next = S.next(ui + 1, nxt);
        const char* nB = cB;
        if (has_next) { F8_AOFF(an, nxt); nB = (const char*)Bt + (size_t)nxt.pn * 256 * KD; } else { an[0] = ao[0]; an[1] = ao[1]; }
#pragma unroll 1
        for (int kt = 0; kt < NT; ++kt) {
            const int so2 = (so == 0) ? 2 * STG : so - STG;
            if (kt + 1 < NT || has_next) asm volatile("s_waitcnt vmcnt(6)" ::: "memory"); else asm volatile("s_waitcnt vmcnt(0)" ::: "memory");
            __builtin_amdgcn_s_barrier(); asm volatile("" ::: "memory");
            if (kt + 2 < NT) F8_STAGE_TILE(so2, kt + 2, ao, cB); else if (has_next) F8_STAGE_TILE(so2, kt + 2 - NT, an, nB);
            i32x8 fa[4], fb[2][2];
            F8_LDFRAG(fa, fb, so);
            F8_MMA(fa, fb);
            so = (so == 2 * STG) ? 0 : so + STG;
        }
        { const int ln = lane_now(); E(acc, cur, wr, wc, ln & 15, ln >> 4); }
        if (!has_next) break;
#pragma unroll
        for (int b = 0; b < 2; ++b)
#pragma unroll
            for (int m = 0; m < 4; ++m)
#pragma unroll
                for (int n = 0; n < 2; ++n) acc[b][m][n] = (f32x4){0.f, 0.f, 0.f, 0.f};
        cur = nxt; cB = nB; ao[0] = an[0]; ao[1] = an[1];
    }
#undef F8_STAGE
#undef F8_AOFF
#undef F8_STAGE_TILE
#undef F8_LDFRAG
#undef F8_MMA
}
}

constexpr int NWAVES = 8, NTHREADS = 512;
constexpr int NPHASE = 13;
struct Args {
    const float* in[33]; float* out; unsigned char* ws; int ph_lo, ph_hi, use_bar, pad;
};
enum { I_X = 0, I_LNG, I_LNB, I_WIN, I_CONVW, I_CONVB, I_WRG, I_BRG, I_WIG, I_BIG, I_LAMBDA, I_MU, I_W0, I_DECUP, I_A0, I_AAAUP, I_GATEUP,
       I_KK, I_KA, I_RK, I_GNG, I_GNB, I_WOUT, I_LN1G, I_LN1B, I_WROUTER, I_BROUTER, I_WE1, I_BE1, I_WE2, I_BE2, I_LN2G, I_LN2B };

__device__ __forceinline__ void transpose_item(const float* W, int N, bf16_t* WT, int k0, int n0, int dst_row0, LAS float* scr, int lane) {
#pragma unroll 8
    for (int i = 0; i < 32; ++i) { const int kk = 2 * i + (lane >> 5); scr[kk * 33 + (lane & 31)] = W[(size_t)(k0 + kk) * N + n0 + (lane & 31)]; }
    asm volatile("s_waitcnt lgkmcnt(0)" ::: "memory");
    const int c = lane & 7;
#pragma unroll
    for (int j = 0; j < 4; ++j) { const int n = (lane >> 3) + 8 * j; const LAS float* s = scr + (8 * c) * 33 + n;
        u32x4 o; o.x = pk2(s[0 * 33], s[1 * 33]); o.y = pk2(s[2 * 33], s[3 * 33]); o.z = pk2(s[4 * 33], s[5 * 33]); o.w = pk2(s[6 * 33], s[7 * 33]);
        *(u32x4*)(WT + (size_t)(dst_row0 + n) * KD + k0 + 8 * c) = o; }
    asm volatile("s_waitcnt lgkmcnt(0)" ::: "memory");
}

__device__ __forceinline__ void transpose_item_f8(const float* W, int N, unsigned char* WT, int k0, int n0, int dst_row0, float scale, LAS float* scr, int lane) {
#pragma unroll 8
    for (int i = 0; i < 64; ++i) { const int kk = 2 * i + (lane >> 5); scr[kk * 33 + (lane & 31)] = W[(size_t)(k0 + kk) * N + n0 + (lane & 31)]; }
    asm volatile("s_waitcnt lgkmcnt(0)" ::: "memory");
    const int c = lane & 7;
#pragma unroll
    for (int j = 0; j < 4; ++j) { const int n = (lane >> 3) + 8 * j; const LAS float* s = scr + (16 * c) * 33 + n;
        u32x4 o;
        o.x = pk4_f8(s[0 * 33] * scale, s[1 * 33] * scale, s[2 * 33] * scale, s[3 * 33] * scale); o.y = pk4_f8(s[4 * 33] * scale, s[5 * 33] * scale, s[6 * 33] * scale, s[7 * 33] * scale);
        o.z = pk4_f8(s[8 * 33] * scale, s[9 * 33] * scale, s[10 * 33] * scale, s[11 * 33] * scale); o.w = pk4_f8(s[12 * 33] * scale, s[13 * 33] * scale, s[14 * 33] * scale, s[15 * 33] * scale);
        *(u32x4*)(WT + (size_t)(dst_row0 + n) * KD + k0 + 16 * c) = o; }
    asm volatile("s_waitcnt lgkmcnt(0)" ::: "memory");
}

__device__ __forceinline__ void moe_tables(volatile LAS int* tb, unsigned* ctl, int wave_id) {
    if (wave_id == 0 && lane_now() == 0) {
        int off = 0;
        for (int e = 0; e < NE; ++e) { const int c = (int)__hip_atomic_load(ctl + CW_CNT + 64 * e, RLX_AGENT); const int nt = (c + 255) >> 8;
            tb[1 + e] = off; for (int r = 0; r < nt; ++r) tb[64 + off + r] = e; off += nt; }
        tb[1 + NE] = off; tb[0] = off;
    }
    __syncthreads();
}

__global__ void __launch_bounds__(NTHREADS, 2) fwd(Args args) {
    extern __shared__ __attribute__((aligned(16))) unsigned char lds_raw[];
    LAS unsigned char* lds = (LAS unsigned char*)lds_raw;
    volatile LAS unsigned* MISC = (volatile LAS unsigned*)(lds + MISC_OFF);
    const int wave = __builtin_amdgcn_readfirstlane(threadIdx.x >> 6);
#define LANE_TID() const int lane = lane_now(), tid = wave * 64 + lane, gt = bid * NTHREADS + tid; (void)tid; (void)gt
    const int G = gridDim.x, bid = blockIdx.x;
    unsigned char* ws = args.ws;
    unsigned* ctl = (unsigned*)(ws + WS_CTL);
    if (wave == 0) MISC[lane_now()] = 0u;
    __syncthreads();
    XcdBarrier bar; bar.bar = ctl + CW_BAR; bar.x = 0; bar.st = nullptr;
    if (args.use_bar) bar = xcd_barrier_post(ctl + CW_BAR, MISC);
    const int lo = args.ph_lo, hi = args.ph_hi;
#ifndef DUP_MASK
#define DUP_MASK 0
#endif
#define REP(k) for (int rep_ = 0; rep_ <= ((DUP_MASK >> (k)) & 1); ++rep_)
#define IN(k) (lo <= (k) && (k) < hi)
#ifndef PROBE_PHASE
#define PROBE_PHASE -1
#endif
    unsigned long long tprobe0 = 0ull, tprobe1 = 0ull;
#define SEAM(k) do { if (IN(k) && IN((k) + 1)) xcd_barrier(bar, wave); if (PROBE_PHASE >= 0) { if ((k) + 1 == PROBE_PHASE) tprobe0 = __builtin_amdgcn_s_memrealtime(); if ((k) == PROBE_PHASE) tprobe1 = __builtin_amdgcn_s_memrealtime(); } } while (0)
    if (PROBE_PHASE == 0) tprobe0 = __builtin_amdgcn_s_memrealtime();
    const int gw = bid * NWAVES + wave, NGW = G * NWAVES;
    const int NGT = G * NTHREADS;

    bf16_t* WinT = (bf16_t*)(ws + WS_WIN); bf16_t* WoT = (bf16_t*)(ws + WS_WO); unsigned char* W1F = ws + WS_W1; unsigned char* W2F = ws + WS_W2;
    bf16_t* XN = (bf16_t*)(ws + WS_XN); bf16_t* P = (bf16_t*)(ws + WS_P);
    float* LA = (float*)(ws + WS_LA); float* LB = (float*)(ws + WS_LB);
    float* BON = (float*)(ws + WS_BON);
    bf16_t* CAT = (bf16_t*)(ws + WS_CAT); float* Z = (float*)(ws + WS_Z); float* H1 = (float*)(ws + WS_H1); unsigned char* H1F = ws + WS_H1B;
    int* TOPE = (int*)(ws + WS_TOPE); int* TOPP = (int*)(ws + WS_TOPP); float* TOPG = (float*)(ws + WS_TOPG); int* TOKSLOT = (int*)(ws + WS_TOKSLOT);
    int* SLOTTOK = (int*)(ws + WS_SLOTTOK); float* SLOTG = (float*)(ws + WS_SLOTG);
    unsigned char* ACT = ws + WS_ACT; bf16_t* OUTS = (bf16_t*)(ws + WS_OUTS);

    if (IN(0)) REP(0) {
        LANE_TID();
        LAS float* scr = (LAS float*)(lds + wave * 17408);
        constexpr int I_IN = (KD / 64) * (NP / 32), I_OUT = (KD / 64) * (D / 32), I_E1 = (KD / 128) * (2 * DE / 32), I_E2 = (DE / 128) * (D / 32);
        constexpr int NITEMS = I_IN + I_OUT + NE * I_E1 + NE * I_E2;
        for (int it = gw; it < NITEMS; it += NGW) {
            int r = it;
            if (r < I_IN) { const int nb = NP / 32, kb = r / nb, n0 = (r % nb) * 32; transpose_item(args.in[I_WIN], NP, WinT, kb * 64, n0, n0, scr, lane); continue; } r -= I_IN;
            if (r < I_OUT) { const int nb = D / 32, kb = r / nb, n0 = (r % nb) * 32; transpose_item(args.in[I_WOUT], D, WoT, kb * 64, n0, n0, scr, lane); continue; } r -= I_OUT;
            if (r < NE * I_E1) { const int e = r / I_E1, q = r % I_E1, nb = 2 * DE / 32, kb = q / nb, n0 = (q % nb) * 32;
                const int isup = n0 >= DE ? 1 : 0, nn = n0 - isup * DE, drow = 256 * (nn >> 7) + 128 * isup + (nn & 127);
                transpose_item_f8(args.in[I_WE1] + (size_t)e * KD * 2 * DE, 2 * DE, W1F + (size_t)e * 2 * DE * KD, kb * 128, n0, drow, F8_SW1, scr, lane); continue; } r -= NE * I_E1;
            { const int e = r / I_E2, q = r % I_E2, nb = D / 32, kb = q / nb, n0 = (q % nb) * 32;
                transpose_item_f8(args.in[I_WE2] + (size_t)e * DE * D, D, W2F + (size_t)e * D * DE, kb * 128, n0, n0, F8_SW2, scr, lane); }
        }
        { bf16_t* WG = (bf16_t*)(ws + WS_WG); bf16_t* WL = (bf16_t*)(ws + WS_WL);
            for (int i = gt; i < 2048 * 256; i += NGT) { const int row = i >> 8, kl = i & 255, g_ = row >> 10, nb = (row >> 6) & 15, k = row & 63, blk = kl >> 6, j = kl & 63;
                const float v = ((nb & 3) == blk) ? args.in[g_ ? I_WIG : I_WRG][(size_t)(nb * 64 + j) * 64 + k] : 0.f; WG[i] = cvt1(v); }
            for (int i = gt; i < 3072 * 256; i += NGT) { const int row = i >> 8, kl = i & 255, sel = row >> 10, c = row & 1023;
                float v = 0.f; if (sel == 0) { if (kl < DLORA) v = args.in[I_DECUP][(size_t)kl * RW_W + c]; } else if (sel == 1) { if (kl < ALORA) v = args.in[I_AAAUP][(size_t)kl * RW_W + c]; } else v = args.in[I_GATEUP][(size_t)kl * RW_W + c];
                WL[i] = cvt1(v); } }
        for (int i = gt; i < (NPP - NP) * KD / 8; i += NGT) ((u32x4*)(WinT + (size_t)NP * KD))[i] = (u32x4){0u, 0u, 0u, 0u};
        const float* lg = args.in[I_LNG]; const float* lb = args.in[I_LNB];
        for (int m = gw; m < M; m += NGW) {
            const f32x4* xr = (const f32x4*)(args.in[I_X] + (size_t)m * D) + lane;
            f32x4 v[8]; float s = 0.f;
#pragma unroll
            for (int j = 0; j < 8; ++j) { v[j] = xr[64 * j]; s += (v[j][0] + v[j][1]) + (v[j][2] + v[j][3]); }
            const float mean = wave_sum(s) * (1.f / D); float s2 = 0.f;
#pragma unroll
            for (int j = 0; j < 8; ++j) { v[j] = v[j] - mean; s2 += (v[j][0] * v[j][0] + v[j][1] * v[j][1]) + (v[j][2] * v[j][2] + v[j][3] * v[j][3]); }
            const float rstd = 1.f / sqrtf(wave_sum(s2) * (1.f / D) + LN_EPS);
            u32x2* o8 = (u32x2*)(XN + (size_t)m * D) + lane;
#pragma unroll
            for (int j = 0; j < 8; ++j) { const f32x4 g4 = ((const f32x4*)lg)[64 * j + lane], b4 = ((const f32x4*)lb)[64 * j + lane]; const f32x4 y = v[j] * rstd * g4 + b4;
                u32x2 w; w.x = pk2(y[0], y[1]); w.y = pk2(y[2], y[3]); o8[64 * j] = w; }
        }
    }
    SEAM(0);

    if (IN(1)) REP(1) {
        LANE_TID();
        pg8::StaticOrder S; S.init(M, NPP, G, bid);
        pg8::EpiBf16 E{P, NPP};
        pg8::gemm_phase<pg8::EpiBf16, pg8::StaticOrder, pg8::DenseRows, true>(lds, XN, WinT, S, E, pg8::DenseRows{}, wave);
    }
    SEAM(1);

    if (IN(2)) REP(2) {
        LANE_TID();
        bf16_t* UC = (bf16_t*)(ws + WS_UC); bf16_t* XL = (bf16_t*)(ws + WS_XL);
        const float* conv_w = args.in[I_CONVW]; const float* conv_b = args.in[I_CONVB]; const float* mu = args.in[I_MU];
        for (int idx = gt; idx < M * (LRU_W / 8); idx += NGT) { const int m = idx >> 7, c = (idx & 127) * 8, tin = m & (SEQ - 1);
            float o[8];
#pragma unroll
            for (int e = 0; e < 8; ++e) o[e] = conv_b[c + e];
#pragma unroll
            for (int j = 0; j < 4; ++j) { if (tin - 3 + j >= 0) { const u32x4 pv = *(const u32x4*)(P + (size_t)(m - 3 + j) * NPP + c);
                const f32x4 w0 = *(const f32x4*)(conv_w + j * LRU_W + c), w1 = *(const f32x4*)(conv_w + j * LRU_W + c + 4);
                o[0] += w0[0] * bflo(pv.x); o[1] += w0[1] * bfhi(pv.x); o[2] += w0[2] * bflo(pv.y); o[3] += w0[3] * bfhi(pv.y);
                o[4] += w1[0] * bflo(pv.z); o[5] += w1[1] * bfhi(pv.z); o[6] += w1[2] * bflo(pv.w); o[7] += w1[3] * bfhi(pv.w); } }
            *(u32x4*)(UC + (size_t)m * LRU_W + c) = (u32x4){cvt2(o[0], o[1]), cvt2(o[2], o[3]), cvt2(o[4], o[5]), cvt2(o[6], o[7])}; }
        for (int idx = gt; idx < M * 64; idx += NGT) { const int m = idx >> 6, q = idx & 63, tin = m & (SEQ - 1);
            u32x4 res = {0u, 0u, 0u, 0u};
            const int kind = q < 12 ? 0 : (q < 16 ? 3 : (q < 28 ? 1 : (q < 32 ? 3 : 2)));
            if (kind != 3) { const int col = (kind == 0) ? 3 * RW_W + 8 * q : (kind == 1 ? 3 * RW_W + DLORA + 8 * (q - 16) : 3 * RW_W + DLORA + ALORA + 8 * (q - 32));
                const bf16_t* pp = P + (size_t)m * NPP + 2 * LRU_W + col; const u32x4 pc = *(const u32x4*)pp; u32x4 pq = {0u, 0u, 0u, 0u}; if (tin > 0) pq = *(const u32x4*)(pp - NPP);
                const f32x4 m0 = *(const f32x4*)(mu + col), m1 = *(const f32x4*)(mu + col + 4);
                float s[8]; const unsigned pcw[4] = {pc.x, pc.y, pc.z, pc.w}, pqw[4] = {pq.x, pq.y, pq.z, pq.w};
#pragma unroll
                for (int e = 0; e < 4; ++e) { const float c0 = bflo(pcw[e]), c1 = bfhi(pcw[e]), p0 = bflo(pqw[e]), p1 = bfhi(pqw[e]);
                    const float mu0 = (e < 2) ? m0[2 * e] : m1[2 * e - 4], mu1 = (e < 2) ? m0[2 * e + 1] : m1[2 * e - 3];
                    s[2 * e] = c0 + (p0 - c0) * mu0; s[2 * e + 1] = c1 + (p1 - c1) * mu1; }
#pragma unroll
                for (int e = 0; e < 8; ++e) s[e] = (kind == 0) ? tanh_fast(s[e]) : (kind == 1 ? s[e] : sigmoidf_(s[e]));
                res = (u32x4){cvt2(s[0], s[1]), cvt2(s[2], s[3]), cvt2(s[4], s[5]), cvt2(s[6], s[7])}; }
            *(u32x4*)(XL + (size_t)m * 512 + 8 * q) = res; }
    }
    SEAM(2);

    if (IN(3)) {
        LANE_TID();
        const bf16_t* UC = (const bf16_t*)(ws + WS_UC); const bf16_t* XL = (const bf16_t*)(ws + WS_XL);
        { pg8::SmallOrder<0> S{G, bid}; pg8::EpiBf16 E{(bf16_t*)(ws + WS_GATES), 2048};
          pg8::gemm_phase<pg8::EpiBf16, pg8::SmallOrder<0>, pg8::DenseRows, true, LRU_W, 256>(lds, UC, (const bf16_t*)(ws + WS_WG), S, E, pg8::DenseRows{}, wave); }
        { pg8::SmallOrder<1> S{G, bid}; pg8::EpiBf16 E{(bf16_t*)(ws + WS_LOUT), 3072};
          pg8::gemm_phase<pg8::EpiBf16, pg8::SmallOrder<1>, pg8::DenseRows, true, 512, 256>(lds, XL, (const bf16_t*)(ws + WS_WL), S, E, pg8::DenseRows{}, wave); }
    }
    SEAM(3);

    if (IN(4)) {
        LANE_TID();
        constexpr int RS = 144;
        constexpr int L_AT = 0, L_BT = 9216, L_KT = 18432, L_RT = 27648, L_VT = 36864, L_BH = 46080, L_KH = 55296, L_AAB = 64512, L_AAK = 80896, L_ARB = 90112, L_ARK = 99328,
                      L_PT = 108544, L_QT = 117760, L_WC = 126976, L_SEG = 127232, L_A16 = 129280, L_TB = 138496, L_U = L_BT, L_MST = L_AT, L_GST = L_BT;
        bf16_t* MT = (bf16_t*)(ws + WS_MT); bf16_t* GG = (bf16_t*)(ws + WS_GG); float* NN = (float*)(ws + WS_NN); float* HH = (float*)(ws + WS_HH);
        const bf16_t* LOUT = (const bf16_t*)(ws + WS_LOUT); bf16_t* V16 = (bf16_t*)(ws + WS_V16); bf16_t* G16 = (bf16_t*)(ws + WS_G16); const float* mu_ = args.in[I_MU];
        const int r = lane & 31, hh = lane >> 5;
        unsigned short xr[9], xk[9], xv[9], xd[8], xa[8], xg[8];
#define E_LOAD(u_) do { const int cch_ = (u_) & 63, head_ = ((u_) >> 6) & 15, b_ = (u_) >> 10; const size_t tokb_ = (size_t)b_ * SEQ + cch_ * 64 + 8 * wave; const int c_ = head_ * HS + lane; \
            const bf16_t* pp_ = P + tokb_ * NPP + 2 * LRU_W + c_; const bool hp_ = ((cch_ * 64 + 8 * wave) & (SEQ - 1)) != 0; \
            xr[0] = hp_ ? pp_[-NPP] : (unsigned short)0; xk[0] = hp_ ? pp_[-NPP + RW_W] : (unsigned short)0; xv[0] = hp_ ? pp_[-NPP + 2 * RW_W] : (unsigned short)0; \
            _Pragma("unroll") for (int j = 0; j < 8; ++j) { const bf16_t* pj = pp_ + (size_t)j * NPP; xr[j + 1] = pj[0]; xk[j + 1] = pj[RW_W]; xv[j + 1] = pj[2 * RW_W]; \
                const bf16_t* lj = LOUT + (tokb_ + j) * 3072 + c_; xd[j] = lj[0]; xa[j] = lj[1024]; xg[j] = lj[2048]; } } while (0)
        if (bid < NUNIT) E_LOAD(bid);
        REP(4) for (int u = bid; u < NUNIT; u += G) {
            const int cch = u & 63, head = (u >> 6) & 15, b = u >> 10; const size_t tok0 = (size_t)b * SEQ + cch * 64;
            { const int ch = lane, tg = wave, c = head * HS + ch; const size_t tokb = tok0 + 8 * tg;
                float lw[8], rr_[8], kk_[8], vv_[8], kn_[8], aa_[8];
                { const float mur = mu_[c], muk = mu_[RW_W + c], muv = mu_[2 * RW_W + c];
                    const float w0c = args.in[I_W0][c], a0c = args.in[I_A0][c], kkc = args.in[I_KK][c], kac = args.in[I_KA][c], rkc = args.in[I_RK][c];
                    float bonv[8];
#pragma unroll
                    for (int j = 0; j < 8; ++j) { const float cr = bf2f(xr[j + 1]), ck = bf2f(xk[j + 1]), cv = bf2f(xv[j + 1]), pr = bf2f(xr[j]), pk_ = bf2f(xk[j]), pvv = bf2f(xv[j]);
                        const float r = cr + (pr - cr) * mur, k = ck + (pk_ - ck) * muk, v = cv + (pvv - cv) * muv;
                        const float lgw = -0.6065306597126334f * sigmoidf_(w0c + bf2f(xd[j]));
                        const float a = sigmoidf_(a0c + bf2f(xa[j]));
                        float kk = k * kkc; kk = kk * __builtin_amdgcn_rsqf(fmaxf(wave_sum(kk * kk), 1e-24f));
                        const float km = k * (1.f + (a - 1.f) * kac);
                        bonv[j] = wave_sum(r * km * rkc);
                        lw[j] = lgw; rr_[j] = r; kk_[j] = km; vv_[j] = v; kn_[j] = kk; aa_[j] = a; }
#pragma unroll
                    for (int j = 0; j < 8; ++j) { V16[(tokb + j) * RW_W + c] = cvt1(vv_[j]); G16[(tokb + j) * RW_W + c] = xg[j]; }
                    if (lane < 8) { float bsel = bonv[0];
#pragma unroll
                        for (int j = 1; j < 8; ++j) bsel = (lane == j) ? bonv[j] : bsel;
                        BON[(tokb + lane) * NHEAD + head] = bsel; }
                    if (u + G < NUNIT) E_LOAD(u + G); }
                float seg = 0.f;
#pragma unroll
                for (int j = 0; j < 8; ++j) seg += lw[j];
                ((LAS float*)(lds + L_SEG))[tg * 64 + ch] = seg;
                __syncthreads();
                float pre = 0.f, tot = 0.f;
#pragma unroll
                for (int g = 0; g < 8; ++g) { const float sg_ = ((LAS float*)(lds + L_SEG))[g * 64 + ch]; tot += sg_; if (g < tg) pre += sg_; }
                if (tg == 0) ((LAS float*)(lds + L_WC))[ch] = __expf(tot);
                float L = pre; unsigned pv[4], pb[4], pk[4]; float tv[8], tb_[8], tk[8];
                const float eTot = __expf(tot); float eLex = __expf(pre);
#pragma unroll
                for (int j = 0; j < 8; ++j) { L += lw[j];
                    const float eL = __expf(L), eNL = __builtin_amdgcn_rcpf(eL), eEnd = eTot * eNL; const float beta = kn_[j] * aa_[j];
                    const int t = 8 * tg + j;
                    *(LAS unsigned short*)(lds + L_AT + t * RS + ch * 2) = cvt1(kn_[j] * eLex);
                    *(LAS unsigned short*)(lds + L_BT + t * RS + ch * 2) = cvt1(beta * eNL);
                    *(LAS unsigned short*)(lds + L_KT + t * RS + ch * 2) = cvt1(kk_[j] * eNL);
                    *(LAS unsigned short*)(lds + L_RT + t * RS + ch * 2) = cvt1(rr_[j] * eL);
                    tv[j] = vv_[j]; tb_[j] = -beta * eEnd; tk[j] = kk_[j] * eEnd; eLex = eL; }
#pragma unroll
                for (int j = 0; j < 4; ++j) { pv[j] = cvt2(tv[2 * j], tv[2 * j + 1]); pb[j] = cvt2(tb_[2 * j], tb_[2 * j + 1]); pk[j] = cvt2(tk[2 * j], tk[2 * j + 1]); }
                *(LAS u32x4*)(lds + L_VT + ch * RS + tg * 16) = (u32x4){pv[0], pv[1], pv[2], pv[3]};
                *(LAS u32x4*)(lds + L_BH + ch * RS + tg * 16) = (u32x4){pb[0], pb[1], pb[2], pb[3]};
                *(LAS u32x4*)(lds + L_KH + ch * RS + tg * 16) = (u32x4){pk[0], pk[1], pk[2], pk[3]};
            }
            __syncthreads();
            { const int id = wave >> 1, i = wave & 1; const int X = (id < 2) ? L_AT : L_RT, Y = (id & 1) ? L_KT : L_BT;
                f32x16 acc[2];
#pragma unroll
                for (int q = 0; q < 2; ++q)
#pragma unroll
                    for (int e = 0; e < 16; ++e) acc[q][e] = 0.f;
#pragma unroll
                for (int s = 0; s < 4; ++s) { const bf16x8 a = *(const LAS bf16x8*)(lds + X + (32 * i + r) * RS + (16 * s + 8 * hh) * 2);
#pragma unroll
                    for (int q = 0; q < 2; ++q) { const bf16x8 bb = *(const LAS bf16x8*)(lds + Y + (32 * q + r) * RS + (16 * s + 8 * hh) * 2); acc[q] = MFMA32(a, bb, acc[q]); } }
#pragma unroll
                for (int q = 0; q < 2; ++q)
#pragma unroll
                    for (int e = 0; e < 16; ++e) { const int t = 32 * i + crow(e, hh), sc = 32 * q + r; const bool keep = (id < 2) ? (sc < t) : (sc <= t);
                        float val = keep ? acc[q][e] : 0.f; if (id == 2) val = -val;
                        if (id == 0) { ((LAS float*)(lds + L_AAB))[t * 64 + sc] = val; *(LAS unsigned short*)(lds + L_A16 + t * RS + sc * 2) = cvt1(-val); }
                        else *(LAS unsigned short*)(lds + L_AAK + (id - 1) * 9216 + t * RS + sc * 2) = cvt1(val); }
            }
            __syncthreads();
            if (wave < 4) { const int i = wave >> 1, q = wave & 1; f32x16 acc;
#pragma unroll
                for (int e = 0; e < 16; ++e) acc[e] = 0.f;
#pragma unroll
                for (int s = 0; s < 4; ++s) { const bf16x8 a = *(const LAS bf16x8*)(lds + L_AAK + (32 * i + r) * RS + (16 * s + 8 * hh) * 2);
                    const bf16x8 bb = *(const LAS bf16x8*)(lds + L_VT + (32 * q + r) * RS + (16 * s + 8 * hh) * 2); acc = MFMA32(a, bb, acc); }
#pragma unroll
                for (int e = 0; e < 16; ++e) ((LAS float*)(lds + L_U))[(32 * i + crow(e, hh)) * 64 + 32 * q + r] = acc[e];
            }
            if (wave == 4) { const int b2 = lane >> 4, j = lane & 15; float x[16];
                const LAS float* AB = (const LAS float*)(lds + L_AAB) + (16 * b2) * 64 + 16 * b2;
#pragma unroll
                for (int t = 0; t < 16; ++t) { float s_ = (t == j) ? 1.f : 0.f;
#pragma unroll
                    for (int s4 = 0; s4 < (t + 3) / 4; ++s4) { const f32x4 A4 = *(const LAS f32x4*)(AB + t * 64 + 4 * s4);
#pragma unroll
                        for (int e = 0; e < 4; ++e) if (4 * s4 + e < t) s_ -= A4[e] * x[4 * s4 + e]; }
                    x[t] = s_; }
#pragma unroll
                for (int t = 0; t < 16; ++t) *(LAS unsigned short*)(lds + L_TB + ((b2 * 16 + t) * 16 + j) * 2) = cvt1(x[t]);
            }
            __syncthreads();
            { const int c16 = lane & 15, quad = lane >> 4, isQ = wave >> 2, colb = 16 * (wave & 3) + c16;
                f32x4 Xr[4];
#pragma unroll
                for (int b2 = 0; b2 < 4; ++b2) Xr[b2] = (f32x4){0.f, 0.f, 0.f, 0.f};
#pragma unroll
                for (int b2 = 0; b2 < 4; ++b2) {
                    f32x4 y;
#pragma unroll
                    for (int g = 0; g < 4; ++g) { const int row = 16 * b2 + 4 * quad + g;
                        y[g] = isQ ? ((const LAS float*)(lds + L_U))[row * 64 + colb] : bf2f(*(const LAS unsigned short*)(lds + L_AT + row * RS + colb * 2)); }
#pragma unroll
                    for (int ks = 0; ks < 2; ++ks) if (2 * ks < b2) {
                        const u32x2 alo = *(const LAS u32x2*)(lds + L_A16 + (16 * b2 + c16) * RS + (32 * ks + 4 * quad) * 2);
                        u32x2 ahi = {0u, 0u}; if (2 * ks + 1 < b2) ahi = *(const LAS u32x2*)(lds + L_A16 + (16 * b2 + c16) * RS + (32 * ks + 16 + 4 * quad) * 2);
                        const u32x4 af = {alo.x, alo.y, ahi.x, ahi.y};
                        const u32x4 bf = {cvt2(Xr[2 * ks][0], Xr[2 * ks][1]), cvt2(Xr[2 * ks][2], Xr[2 * ks][3]), cvt2(Xr[2 * ks + 1][0], Xr[2 * ks + 1][1]), cvt2(Xr[2 * ks + 1][2], Xr[2 * ks + 1][3])};
                        y = __builtin_amdgcn_mfma_f32_16x16x32_bf16(__builtin_bit_cast(bf16x8, af), __builtin_bit_cast(bf16x8, bf), y, 0, 0, 0); }
                    const u32x2 tlo = *(const LAS u32x2*)(lds + L_TB + ((b2 * 16 + c16) * 16 + 4 * quad) * 2);
                    const u32x4 tf = {tlo.x, tlo.y, 0u, 0u};
                    const u32x4 yf = {cvt2(y[0], y[1]), cvt2(y[2], y[3]), 0u, 0u};
                    Xr[b2] = __builtin_amdgcn_mfma_f32_16x16x32_bf16(__builtin_bit_cast(bf16x8, tf), __builtin_bit_cast(bf16x8, yf), (f32x4){0.f, 0.f, 0.f, 0.f}, 0, 0, 0);
                    *(LAS u32x2*)(lds + (isQ ? L_QT : L_PT) + colb * RS + (16 * b2 + 4 * quad) * 2) = (u32x2){cvt2(Xr[b2][0], Xr[b2][1]), cvt2(Xr[b2][2], Xr[b2][3])};
                }
            }
            __syncthreads();
            { const int mtx = wave >> 1, i = wave & 1;
                const int X1 = (mtx == 0) ? L_BH : (mtx == 1) ? L_KH : (mtx == 2) ? L_ARB : L_ARK;
                const int Y1 = (mtx == 0 || mtx == 2) ? L_PT : L_VT;
                f32x16 acc[2];
#pragma unroll
                for (int q = 0; q < 2; ++q)
#pragma unroll
                    for (int e = 0; e < 16; ++e) acc[q][e] = 0.f;
#pragma unroll
                for (int s = 0; s < 4; ++s) { const bf16x8 a = *(const LAS bf16x8*)(lds + X1 + (32 * i + r) * RS + (16 * s + 8 * hh) * 2);
#pragma unroll
                    for (int q = 0; q < 2; ++q) { const bf16x8 bb = *(const LAS bf16x8*)(lds + Y1 + (32 * q + r) * RS + (16 * s + 8 * hh) * 2); acc[q] = MFMA32(a, bb, acc[q]); } }
                if (mtx & 1) { const int X2 = (mtx == 1) ? L_BH : L_ARB;
#pragma unroll
                    for (int s = 0; s < 4; ++s) { const bf16x8 a = *(const LAS bf16x8*)(lds + X2 + (32 * i + r) * RS + (16 * s + 8 * hh) * 2);
#pragma unroll
                        for (int q = 0; q < 2; ++q) { const bf16x8 bb = *(const LAS bf16x8*)(lds + L_QT + (32 * q + r) * RS + (16 * s + 8 * hh) * 2); acc[q] = MFMA32(a, bb, acc[q]); } } }
                if (mtx == 0) { const float wc = ((const LAS float*)(lds + L_WC))[32 * i + r];
#pragma unroll
                    for (int q = 0; q < 2; ++q)
#pragma unroll
                        for (int e = 0; e < 16; ++e) if (q == i && crow(e, hh) == r) acc[q][e] += wc; }
                if (mtx == 2) {
#pragma unroll
                    for (int q = 0; q < 2; ++q)
#pragma unroll
                        for (int e = 0; e < 16; ++e) acc[q][e] += bf2f(*(const LAS unsigned short*)(lds + L_RT + (32 * i + crow(e, hh)) * RS + (32 * q + r) * 2)); }
                if (mtx & 1) { float* dstg = ((mtx == 1) ? NN : HH) + (size_t)u * 4096;
#pragma unroll
                    for (int q = 0; q < 2; ++q)
#pragma unroll
                        for (int e = 0; e < 16; ++e) dstg[((i * 2 + q) * 16 + e) * 64 + lane] = acc[q][e];
                } else { const int dl = (mtx == 0) ? L_MST : L_GST;
#pragma unroll
                    for (int q = 0; q < 2; ++q)
#pragma unroll
                        for (int e = 0; e < 16; ++e) *(LAS unsigned short*)(lds + dl + (32 * i + crow(e, hh)) * RS + (32 * q + r) * 2) = cvt1(acc[q][e]); }
            }
            __syncthreads();
            { const int f = tid >> 6, i = f >> 2, q = (f >> 1) & 1, s = f & 1, r2 = lane & 31, h2 = lane >> 5; const int off = (32 * i + r2) * RS + (32 * q + 16 * s + 4 * h2) * 2;
                const u32x2 m0 = *(const LAS u32x2*)(lds + L_MST + off), m1 = *(const LAS u32x2*)(lds + L_MST + off + 16);
                const u32x2 g0 = *(const LAS u32x2*)(lds + L_GST + off), g1 = *(const LAS u32x2*)(lds + L_GST + off + 16);
                *(u32x4*)(MT + (size_t)u * 4096 + tid * 8) = (u32x4){m0.x, m0.y, m1.x, m1.y};
                *(u32x4*)(GG + (size_t)u * 4096 + tid * 8) = (u32x4){g0.x, g0.y, g1.x, g1.y}; }
            __syncthreads();
        }
        { float* CA = (float*)(ws + WS_CA); float* CH = (float*)(ws + WS_CH); const bf16_t* UC = (const bf16_t*)(ws + WS_UC); const bf16_t* GATES = (const bf16_t*)(ws + WS_GATES);
            for (int bc = bid; bc < BATCH * 64; bc += G) { const size_t tok0 = (size_t)(bc >> 6) * SEQ + (bc & 63) * 64;
                float h[2] = {0.f, 0.f}, A[2] = {1.f, 1.f}, br[2], bi[2], sp[2];
#pragma unroll
                for (int cc = 0; cc < 2; ++cc) { const int c = tid + 512 * cc; br[cc] = args.in[I_BRG][c]; bi[cc] = args.in[I_BIG][c]; const float lam = args.in[I_LAMBDA][c];
                    sp[cc] = lam > 15.f ? __expf(-lam) : log1pf(__expf(-lam)); }
                unsigned short gr[2][8], gi[2][8], uc[2][8];
#define LRU_LOAD(t_) do { _Pragma("unroll") for (int cc = 0; cc < 2; ++cc) _Pragma("unroll") for (int j = 0; j < 8; ++j) { const size_t tk = tok0 + (t_) + j; const int c = tid + 512 * cc; \
                    gr[cc][j] = GATES[tk * 2048 + c]; gi[cc][j] = GATES[tk * 2048 + LRU_W + c]; uc[cc][j] = UC[tk * LRU_W + c]; } } while (0)
                LRU_LOAD(0);
#pragma unroll 1
                for (int t = 0; t < 64; t += 8) {
                    float hv[2][8], av[2][8];
#pragma unroll
                    for (int cc = 0; cc < 2; ++cc)
#pragma unroll
                        for (int j = 0; j < 8; ++j) { const float rg = sigmoidf_(bf2f(gr[cc][j]) + br[cc]), ig = sigmoidf_(bf2f(gi[cc][j]) + bi[cc]);
                            const float a = __expf(-8.f * rg * sp[cc]), bb = sqrtf(fmaxf(1.f - a * a, 0.f)) * (ig * bf2f(uc[cc][j]));
                            h[cc] = a * h[cc] + bb; A[cc] *= a; hv[cc][j] = h[cc]; av[cc][j] = A[cc]; }
                    if (t + 8 < 64) LRU_LOAD(t + 8);
#pragma unroll
                    for (int cc = 0; cc < 2; ++cc)
#pragma unroll
                        for (int j = 0; j < 8; ++j) { const int c = tid + 512 * cc; LB[(tok0 + t + j) * LRU_W + c] = hv[cc][j]; LA[(tok0 + t + j) * LRU_W + c] = av[cc][j]; }
                }
#undef LRU_LOAD
#pragma unroll
                for (int cc = 0; cc < 2; ++cc) { const int c = tid + 512 * cc; CA[(size_t)bc * LRU_W + c] = A[cc]; CH[(size_t)bc * LRU_W + c] = h[cc]; } } }
    }
    SEAM(4);

    if (IN(5)) REP(5) {
        LANE_TID();
        if (bid < BATCH * NHEAD) {
            const bf16_t* MT = (const bf16_t*)(ws + WS_MT); const float* NN = (const float*)(ws + WS_NN); bf16_t* XS = (bf16_t*)(ws + WS_XS);
            constexpr int SLOT = 24576, NCH = SEQ / 64;
            const int u0 = bid * NCH;
            if (wave >= 2) {
                const int lw = wave - 2;
#define R2_ISSUE(c_) do { const int _u = u0 + (c_); const int _sl = ((c_) & 3) * SLOT; _Pragma("unroll") for (int _rd = 0; _rd < 4; ++_rd) { const int _k0 = _rd * 384 + lw * 64; \
                    const char* _src = (_k0 < 512) ? (const char*)MT + (size_t)_u * 8192 + (size_t)(_k0 + lane) * 16 : (const char*)NN + (size_t)_u * 16384 + (size_t)(_k0 - 512 + lane) * 16; \
                    __builtin_amdgcn_global_load_lds((const unsigned*)_src, (LAS unsigned*)(lds + _sl + _k0 * 16), 16, 0, 0); } } while (0)
                R2_ISSUE(0); R2_ISSUE(1); R2_ISSUE(2);
                for (int c = 0; c < NCH; ++c) {
                    if (c < NCH - 2) asm volatile("s_waitcnt vmcnt(8)" ::: "memory"); else if (c == NCH - 2) asm volatile("s_waitcnt vmcnt(4)" ::: "memory"); else asm volatile("s_waitcnt vmcnt(0)" ::: "memory");
                    __builtin_amdgcn_s_barrier();
                    asm volatile("" ::: "memory");
                    if (c + 3 < NCH) R2_ISSUE(c + 3);
                }
#undef R2_ISSUE
            } else {
                const int vh = wave;
                f32x16 X[2];
#pragma unroll
                for (int q = 0; q < 2; ++q)
#pragma unroll
                    for (int e = 0; e < 16; ++e) X[q][e] = 0.f;
                for (int c = 0; c < NCH; ++c) {
                    bf16x8 xb[2][2];
#pragma unroll
                    for (int q = 0; q < 2; ++q)
#pragma unroll
                        for (int s = 0; s < 2; ++s) { const u32x4 p = {cvt2(X[q][8 * s], X[q][8 * s + 1]), cvt2(X[q][8 * s + 2], X[q][8 * s + 3]), cvt2(X[q][8 * s + 4], X[q][8 * s + 5]), cvt2(X[q][8 * s + 6], X[q][8 * s + 7])};
                            xb[q][s] = __builtin_bit_cast(bf16x8, p);
                            *(u32x4*)(XS + (size_t)(u0 + c) * 4096 + (((vh * 2 + q) * 2 + s) * 64 + lane) * 8) = p; }
                    asm volatile("" ::: "memory");
                    __builtin_amdgcn_s_barrier();
                    asm volatile("" ::: "memory");
                    const LAS unsigned char* sl = lds + (c & 3) * SLOT;
#pragma unroll
                    for (int i = 0; i < 2; ++i) { f32x16 nx;
#pragma unroll
                        for (int e = 0; e < 16; ++e) nx[e] = ((const LAS float*)(sl + 8192))[((i * 2 + vh) * 16 + e) * 64 + lane];
#pragma unroll
                        for (int q = 0; q < 2; ++q)
#pragma unroll
                            for (int s = 0; s < 2; ++s) { const bf16x8 a = *(const LAS bf16x8*)(sl + ((i * 2 + q) * 2 + s) * 1024 + lane * 16); nx = MFMA32(a, xb[q][s], nx); }
                        X[i] = nx; }
                    asm volatile("s_waitcnt lgkmcnt(0)" ::: "memory");
                }
            }
        } else if (bid < BATCH * NHEAD + 8) {
            const float* CA = (const float*)(ws + WS_CA); const float* CH = (const float*)(ws + WS_CH); float* CIN = (float*)(ws + WS_CIN);
            const int i = (bid - BATCH * NHEAD) * NTHREADS + tid, b = i >> 10, c = i & 1023; float s = 0.f;
            for (int ch = 0; ch < 64; ch += 8) { float a[8], hh_[8];
#pragma unroll
                for (int j = 0; j < 8; ++j) { a[j] = CA[(size_t)(b * 64 + ch + j) * LRU_W + c]; hh_[j] = CH[(size_t)(b * 64 + ch + j) * LRU_W + c]; }
#pragma unroll
                for (int j = 0; j < 8; ++j) { CIN[(size_t)(b * 64 + ch + j) * LRU_W + c] = s; s = a[j] * s + hh_[j]; } }
        }
    }
    SEAM(5);

    if (IN(6)) REP(6) {
        LANE_TID();
        { const float* CIN = (const float*)(ws + WS_CIN);
            for (int idx = gt; idx < M * (LRU_W / 8); idx += NGT) { const int m = idx >> 7, c = (idx & 127) * 8; const size_t o = (size_t)m * LRU_W + c;
                const u32x4 gq = *(const u32x4*)(P + (size_t)m * NPP + LRU_W + c);
                const f32x4 h0 = *(const f32x4*)(LB + o), h1 = *(const f32x4*)(LB + o + 4), a0 = *(const f32x4*)(LA + o), a1 = *(const f32x4*)(LA + o + 4);
                const f32x4 c0 = *(const f32x4*)(CIN + (size_t)(m >> 6) * LRU_W + c), c1 = *(const f32x4*)(CIN + (size_t)(m >> 6) * LRU_W + c + 4);
                const unsigned gw_[4] = {gq.x, gq.y, gq.z, gq.w}; float o8[8];
#pragma unroll
                for (int e = 0; e < 4; ++e) { const float hA = (e < 2 ? h0[2 * e] : h1[2 * e - 4]) + (e < 2 ? a0[2 * e] : a1[2 * e - 4]) * (e < 2 ? c0[2 * e] : c1[2 * e - 4]);
                    const float hB = (e < 2 ? h0[2 * e + 1] : h1[2 * e - 3]) + (e < 2 ? a0[2 * e + 1] : a1[2 * e - 3]) * (e < 2 ? c0[2 * e + 1] : c1[2 * e - 3]);
                    o8[2 * e] = hA * gelu_tanh(bflo(gw_[e])); o8[2 * e + 1] = hB * gelu_tanh(bfhi(gw_[e])); }
                *(u32x4*)(CAT + (size_t)m * D + c) = (u32x4){cvt2(o8[0], o8[1]), cvt2(o8[2], o8[3]), cvt2(o8[4], o8[5]), cvt2(o8[6], o8[7])}; } }
        const bf16_t* GG = (const bf16_t*)(ws + WS_GG); const bf16_t* XS = (const bf16_t*)(ws + WS_XS); const float* HH = (const float*)(ws + WS_HH);
        const bf16_t* V16 = (const bf16_t*)(ws + WS_V16); const bf16_t* G16 = (const bf16_t*)(ws + WS_G16);
        const float* gng = args.in[I_GNG]; const float* gnb = args.in[I_GNB];
        const int r = lane & 31, hh = lane >> 5;
        constexpr int YS = 68;
        LAS float* yt = (LAS float*)(lds + wave * (64 * YS * 4));
        for (int u = gw; u < NUNIT; u += NGW) {
            const int cch = u & 63, head = (u >> 6) & 15, b = u >> 10; const size_t tok0 = (size_t)b * SEQ + cch * 64;
            f32x16 acc[2][2];
#pragma unroll
            for (int i = 0; i < 2; ++i)
#pragma unroll
                for (int vh = 0; vh < 2; ++vh)
#pragma unroll
                    for (int e = 0; e < 16; ++e) acc[i][vh][e] = HH[(size_t)u * 4096 + ((i * 2 + vh) * 16 + e) * 64 + lane];
#pragma unroll
            for (int q = 0; q < 2; ++q)
#pragma unroll
                for (int s = 0; s < 2; ++s) { bf16x8 xb[2], ga[2];
#pragma unroll
                    for (int vh = 0; vh < 2; ++vh) xb[vh] = *(const bf16x8*)(XS + (size_t)u * 4096 + (((vh * 2 + q) * 2 + s) * 64 + lane) * 8);
#pragma unroll
                    for (int i = 0; i < 2; ++i) ga[i] = *(const bf16x8*)(GG + (size_t)u * 4096 + (((i * 2 + q) * 2 + s) * 64 + lane) * 8);
#pragma unroll
                    for (int i = 0; i < 2; ++i)
#pragma unroll
                        for (int vh = 0; vh < 2; ++vh) acc[i][vh] = MFMA32(ga[i], xb[vh], acc[i][vh]); }
#pragma unroll
            for (int i = 0; i < 2; ++i)
#pragma unroll
                for (int e = 0; e < 16; ++e) {
                    const float s1 = half_sum(acc[i][0][e] + acc[i][1][e], hh);
                    const float mean = s1 * (1.f / 64.f);
                    const float d0 = acc[i][0][e] - mean, d1 = acc[i][1][e] - mean; const float s2 = half_sum(d0 * d0 + d1 * d1, hh);
                    const float rstd = __builtin_amdgcn_rsqf(s2 * (1.f / 64.f) + GN_EPS);
                    const int t = 32 * i + crow(e, hh);
                    yt[t * YS + r] = d0 * rstd; yt[t * YS + 32 + r] = d1 * rstd; }
            asm volatile("s_waitcnt lgkmcnt(0)" ::: "memory");
            { const int tq = lane >> 3, c8 = (lane & 7) * 8, ch = head * HS + c8;
                const f32x4 g0 = *(const f32x4*)(gng + ch), g1 = *(const f32x4*)(gng + ch + 4), b0 = *(const f32x4*)(gnb + ch), b1 = *(const f32x4*)(gnb + ch + 4);
#pragma unroll 2
                for (int k = 0; k < 8; ++k) { const int t = tq + 8 * k; const size_t tok = tok0 + t; const size_t o = tok * RW_W + ch;
                    const f32x4 y0 = *(const LAS f32x4*)(yt + t * YS + c8), y1 = *(const LAS f32x4*)(yt + t * YS + c8 + 4);
                    const u32x4 vq = *(const u32x4*)(V16 + o), gq = *(const u32x4*)(G16 + o); const float bon = BON[tok * NHEAD + head];
                    const unsigned vw[4] = {vq.x, vq.y, vq.z, vq.w}, gw4[4] = {gq.x, gq.y, gq.z, gq.w}; float o8[8];
#pragma unroll
                    for (int e = 0; e < 4; ++e) { const float ya = (e < 2 ? y0[2 * e] : y1[2 * e - 4]), yb = (e < 2 ? y0[2 * e + 1] : y1[2 * e - 3]);
                        const float ga_ = (e < 2 ? g0[2 * e] : g1[2 * e - 4]), gb_ = (e < 2 ? g0[2 * e + 1] : g1[2 * e - 3]), ba_ = (e < 2 ? b0[2 * e] : b1[2 * e - 4]), bb_ = (e < 2 ? b0[2 * e + 1] : b1[2 * e - 3]);
                        o8[2 * e] = (ya * ga_ + ba_ + bon * bflo(vw[e])) * bflo(gw4[e]); o8[2 * e + 1] = (yb * gb_ + bb_ + bon * bfhi(vw[e])) * bfhi(gw4[e]); }
                    *(u32x4*)(CAT + tok * D + LRU_W + ch) = (u32x4){cvt2(o8[0], o8[1]), cvt2(o8[2], o8[3]), cvt2(o8[4], o8[5]), cvt2(o8[6], o8[7])}; } }
            asm volatile("s_waitcnt lgkmcnt(0)" ::: "memory");
        }
    }
    SEAM(6);

    if (IN(7)) REP(7) {
        LANE_TID();
        pg8::StaticOrder S; S.init(M, D, G, bid);
        pg8::EpiResF32 E{Z, XN, DN_ALPHA};
        pg8::gemm_phase<pg8::EpiResF32, pg8::StaticOrder, pg8::DenseRows, true>(lds, CAT, WoT, S, E, pg8::DenseRows{}, wave);
    }
    SEAM(7);

    if (IN(8)) {
        LANE_TID();
        LAS float* hT = (LAS float*)lds;
        LAS float* part = (LAS float*)lds;
        LAS float* lgt = (LAS float*)(lds + 65536);
        const float* g1 = args.in[I_LN1G]; const float* b1 = args.in[I_LN1B]; const float* wr_ = args.in[I_WROUTER]; const float* br_ = args.in[I_BROUTER];
        for (int tile = bid; tile < M / 16; tile += G) {
            const int t0 = tile * 16;
            __syncthreads();
#pragma unroll 1
            for (int rr = 0; rr < 2; ++rr) { const int tb = wave * 2 + rr, m = t0 + tb;
                const f32x4* zr = (const f32x4*)(Z + (size_t)m * D) + lane;
                f32x4 v[8]; float s = 0.f;
#pragma unroll
                for (int j = 0; j < 8; ++j) { v[j] = zr[64 * j]; s += (v[j][0] + v[j][1]) + (v[j][2] + v[j][3]); }
                const float mean = wave_sum(s) * (1.f / D); float s2 = 0.f;
#pragma unroll
                for (int j = 0; j < 8; ++j) { v[j] = v[j] - mean; s2 += (v[j][0] * v[j][0] + v[j][1] * v[j][1]) + (v[j][2] * v[j][2] + v[j][3] * v[j][3]); }
                const float rstd = 1.f / sqrtf(wave_sum(s2) * (1.f / D) + LN_EPS);
                f32x4* ho = (f32x4*)(H1 + (size_t)m * D) + lane; unsigned* hb = (unsigned*)(H1F + (size_t)m * D) + lane;
#pragma unroll
                for (int j = 0; j < 8; ++j) { const f32x4 g4 = ((const f32x4*)g1)[64 * j + lane], b4 = ((const f32x4*)b1)[64 * j + lane]; const f32x4 y = v[j] * rstd * g4 + b4;
                    ho[64 * j] = y; hb[64 * j] = pk4_f8(y[0] * F8_SH, y[1] * F8_SH, y[2] * F8_SH, y[3] * F8_SH);
#pragma unroll
                    for (int q = 0; q < 4; ++q) hT[(256 * j + 4 * lane + q) * 16 + tb] = y[q]; } }
            __syncthreads();
            float ac[16];
#pragma unroll
            for (int tb = 0; tb < 16; ++tb) ac[tb] = 0.f;
            { const int e = tid & 31, sl = tid >> 5;
                for (int i = sl * 128; i < sl * 128 + 128; ++i) { const float w = wr_[(size_t)i * NE + e]; const LAS f32x4* hp = (const LAS f32x4*)(hT + i * 16);
#pragma unroll
                    for (int q = 0; q < 4; ++q) { const f32x4 h4 = hp[q];
#pragma unroll
                        for (int k = 0; k < 4; ++k) ac[q * 4 + k] += w * h4[k]; } }
                __syncthreads();
#pragma unroll
                for (int tb = 0; tb < 16; ++tb) part[(sl * 16 + tb) * 32 + e] = ac[tb]; }
            __syncthreads();
            { const int tb = tid >> 5, e = tid & 31; float sacc = br_[e];
#pragma unroll
                for (int sl = 0; sl < 16; ++sl) sacc += part[(sl * 16 + tb) * 32 + e];
                lgt[tb * 32 + e] = sacc; }
            __syncthreads();
            if (tid < 16) { const int m = t0 + tid; float bv[4]; int bi[4]; unsigned used = 0u;
#pragma unroll 1
                for (int k = 0; k < 4; ++k) { float best = -3.0e38f; int be = 0;
                    for (int e = 0; e < NE; ++e) { const float x = lgt[tid * 32 + e]; if (!((used >> e) & 1u) && x > best) { best = x; be = e; } }
                    used |= 1u << be; bv[k] = best; bi[k] = be; }
                float ex[4], den = 0.f;
#pragma unroll
                for (int k = 0; k < 4; ++k) { ex[k] = __expf(bv[k] - bv[0]); den += ex[k]; }
#pragma unroll 1
                for (int k = 0; k < 4; ++k) { const int pos = (int)__hip_atomic_fetch_add(ctl + CW_CNT + 64 * bi[k], 1u, RLX_AGENT);
                    TOPE[m * 4 + k] = bi[k]; TOPP[m * 4 + k] = pos; TOPG[m * 4 + k] = ex[k] / den; } }
        }
    }
    SEAM(8);

    if (IN(9)) REP(9) {
        LANE_TID();
        volatile LAS int* tb = (volatile LAS int*)(MISC + 16);
        moe_tables(tb, ctl, wave);
        for (int i = gt; i < M * TOPK; i += NGT) { const int e = TOPE[i], slot = tb[1 + e] * 256 + TOPP[i];
            SLOTTOK[slot] = i >> 2; SLOTG[slot] = TOPG[i]; TOKSLOT[i] = slot; }
        { unsigned char* XG = ws + WS_XG;
            for (int i = bid * NWAVES + wave; i < M * TOPK; i += NGW) { const int e = TOPE[i], slot = tb[1 + e] * 256 + TOPP[i];
                const u32x4* s_ = (const u32x4*)(H1F + (size_t)(i >> 2) * D) + lane; u32x4* d_ = (u32x4*)(XG + (size_t)slot * D) + lane;
                const u32x4 v0 = s_[0], v1 = s_[64]; d_[0] = v0; d_[64] = v1; } }
        if (bid < NE) { const int e = bid, c = (int)__hip_atomic_load(ctl + CW_CNT + 64 * e, RLX_AGENT), s0 = tb[1 + e] * 256 + c, s1 = tb[2 + e] * 256;
            for (int s = s0 + tid; s < s1; s += NTHREADS) { SLOTTOK[s] = 0; SLOTG[s] = 0.f; } }
    }
    SEAM(9);

    if (IN(10)) REP(10) {
        LANE_TID();
        volatile LAS int* tb = (volatile LAS int*)(MISC + 16);
        moe_tables(tb, ctl, wave);
        pg8::MoeOrder S{(const LAS int*)(tb + 64), tb[0], 16, G, bid, KD / 128};
        pg8::EpiSwiglu E{ACT, args.in[I_BE1]};
        pg8::gemm_phase<pg8::EpiSwiglu, pg8::MoeOrder, pg8::DenseRows, true, KD / 2, KD / 2, true>(lds, (const bf16_t*)(ws + WS_XG), (const bf16_t*)W1F, S, E, pg8::DenseRows{}, wave);
    }
    SEAM(10);

    if (IN(11)) REP(11) {
        LANE_TID();
        volatile LAS int* tb = (volatile LAS int*)(MISC + 16);
        moe_tables(tb, ctl, wave);
        pg8::MoeOrder S{(const LAS int*)(tb + 64), tb[0], 8, G, bid, KD / 128};
        pg8::EpiMoeOut E{OUTS, args.in[I_BE2], SLOTG};
        pg8::gemm_phase<pg8::EpiMoeOut, pg8::MoeOrder, pg8::DenseRows, true, KD / 2, KD / 2, true>(lds, (const bf16_t*)ACT, (const bf16_t*)W2F, S, E, pg8::DenseRows{}, wave);
    }
    SEAM(11);

    if (IN(12)) REP(12) {
        LANE_TID();
        const float* g2 = args.in[I_LN2G]; const float* b2 = args.in[I_LN2B];
        for (int m = gw; m < M; m += NGW) {
            const f32x4* hr = (const f32x4*)(H1 + (size_t)m * D) + lane;
            const int s0 = TOKSLOT[m * 4], s1 = TOKSLOT[m * 4 + 1], s2_ = TOKSLOT[m * 4 + 2], s3 = TOKSLOT[m * 4 + 3];
            const u32x2* o0 = (const u32x2*)(OUTS + (size_t)s0 * D) + lane; const u32x2* o1 = (const u32x2*)(OUTS + (size_t)s1 * D) + lane;
            const u32x2* o2 = (const u32x2*)(OUTS + (size_t)s2_ * D) + lane; const u32x2* o3 = (const u32x2*)(OUTS + (size_t)s3 * D) + lane;
            f32x4 v[8]; float s = 0.f;
#pragma unroll
            for (int j = 0; j < 8; ++j) { const f32x4 h4 = hr[64 * j]; const u32x2 a = o0[64 * j], b = o1[64 * j], c = o2[64 * j], d = o3[64 * j];
                f32x4 mo; mo[0] = (bflo(a.x) + bflo(b.x)) + (bflo(c.x) + bflo(d.x)); mo[1] = (bfhi(a.x) + bfhi(b.x)) + (bfhi(c.x) + bfhi(d.x));
                mo[2] = (bflo(a.y) + bflo(b.y)) + (bflo(c.y) + bflo(d.y)); mo[3] = (bfhi(a.y) + bfhi(b.y)) + (bfhi(c.y) + bfhi(d.y));
                v[j] = h4 * DN_ALPHA + mo; s += (v[j][0] + v[j][1]) + (v[j][2] + v[j][3]); }
            const float mean = wave_sum(s) * (1.f / D); float q2 = 0.f;
#pragma unroll
            for (int j = 0; j < 8; ++j) { v[j] = v[j] - mean; q2 += (v[j][0] * v[j][0] + v[j][1] * v[j][1]) + (v[j][2] * v[j][2] + v[j][3] * v[j][3]); }
            const float rstd = 1.f / sqrtf(wave_sum(q2) * (1.f / D) + LN_EPS);
            f32x4* orow = (f32x4*)(args.out + (size_t)m * D) + lane;
#pragma unroll
            for (int j = 0; j < 8; ++j) { const f32x4 g4 = ((const f32x4*)g2)[64 * j + lane], b4 = ((const f32x4*)b2)[64 * j + lane]; orow[64 * j] = v[j] * rstd * g4 + b4; }
        }
    }
    if (PROBE_PHASE >= 0) { if (PROBE_PHASE == NPHASE - 1) tprobe1 = __builtin_amdgcn_s_memrealtime();
        asm volatile("s_waitcnt vmcnt(0)" ::: "memory"); __syncthreads();
        if (bid == 0 && wave == 0 && lane_now() == 0) args.out[0] += 1.0f + (float)(tprobe1 - tprobe0) * 1e-4f; }
#undef IN
#undef SEAM
}

#ifndef MK_ONE_LAUNCH
#define MK_ONE_LAUNCH 1
#endif
extern "C" void kernel_launch(void* const* d_in, const int* in_sizes, int n_in, void* d_out, int out_size, void* d_ws, size_t ws_size, hipStream_t stream) {
    static int grid = 0;
    if (grid == 0) {
        if (n_in != 33 || out_size != M * D || ws_size < WS_END) { fprintf(stderr, "kernel_launch: unexpected sizes n_in %d out %d ws %zu (need %zu)\n", n_in, out_size, ws_size, (size_t)WS_END); grid = -1; return; }
        int dev = 0, cus = 0, per_cu = 0;
        if (hipGetDevice(&dev) != hipSuccess || hipDeviceGetAttribute(&cus, hipDeviceAttributeMultiprocessorCount, dev) != hipSuccess) { grid = -1; return; }
        if (hipFuncSetAttribute((const void*)fwd, hipFuncAttributeMaxDynamicSharedMemorySize, LDS_BYTES) != hipSuccess) { fprintf(stderr, "kernel_launch: hipFuncSetAttribute failed\n"); grid = -1; return; }
        if (hipOccupancyMaxActiveBlocksPerMultiprocessor(&per_cu, (const void*)fwd, NTHREADS, LDS_BYTES) != hipSuccess || per_cu < 1) fprintf(stderr, "kernel_launch: occupancy query says %d\n", per_cu);
        (void)hipGetLastError();
        grid = cus;
    }
    if (grid < 0) return;
    (void)hipMemsetAsync((char*)d_ws + WS_CTL, 0, CTL_ZERO_BYTES, stream);
    Args a{};
    for (int i = 0; i < 33; ++i) a.in[i] = (const float*)d_in[i];
    a.out = (float*)d_out; a.ws = (unsigned char*)d_ws;
#if MK_ONE_LAUNCH
    a.ph_lo = 0; a.ph_hi = NPHASE; a.use_bar = 1;
    hipLaunchKernelGGL(fwd, dim3(grid), dim3(NTHREADS), LDS_BYTES, stream, a);
#else
    for (int p = 0; p < NPHASE; ++p) { a.ph_lo = p; a.ph_hi = p + 1; a.use_bar = 0;
        hipLaunchKernelGGL(fwd, dim3(grid), dim3(NTHREADS), LDS_BYTES, stream, a); }
#endif
}
```

```cpp
#include <hip/hip_runtime.h>
#include <cstdio>
#include <cstdint>

#define LAS __attribute__((address_space(3)))
#define GAS __attribute__((address_space(1)))
typedef unsigned short bf16_t;
typedef short bf16x8 __attribute__((ext_vector_type(8)));
typedef float f32x4 __attribute__((ext_vector_type(4)));
typedef float f32x2 __attribute__((ext_vector_type(2)));
typedef unsigned u32x4 __attribute__((ext_vector_type(4)));
typedef unsigned u32x2 __attribute__((ext_vector_type(2)));
typedef float f32x16 __attribute__((ext_vector_type(16)));
typedef int i32x4 __attribute__((ext_vector_type(4)));
typedef int i32x8 __attribute__((ext_vector_type(8)));
typedef __bf16 bfv2 __attribute__((ext_vector_type(2)));
#define MFMA32(a, b, c) __builtin_amdgcn_mfma_f32_32x32x16_bf16((a), (b), (c), 0, 0, 0)

constexpr int BATCH = 4, SEQ = 4096, M = BATCH * SEQ, D = 2048;
constexpr int LRU_W = 1024, RW_W = 1024, NHEAD = 16, HS = 64;
constexpr int DLORA = 96, ALORA = 96, GLORA = 256;
constexpr int RW_SHIFT_W = 3 * RW_W + DLORA + ALORA + GLORA;
constexpr int NP = 2 * LRU_W + RW_SHIFT_W;
constexpr int NPP = 5632;
constexpr int NE = 32, TOPK = 4, DE = 2048;
constexpr int NSLOT_MAX = M * TOPK + NE * 256;
constexpr int NTILE_MAX = NSLOT_MAX / 256;
constexpr float LN_EPS = 1e-5f, GN_EPS = 64e-5f;
constexpr float DN_ALPHA = 1.189207115002721f;
constexpr int KD = 2048;

constexpr size_t MiB = 1u << 20;
constexpr size_t WS_CTL = 0, CTL_ZERO_BYTES = 1 * MiB;
constexpr size_t WS_WIN = 2 * MiB;
constexpr size_t WS_WO = WS_WIN + (size_t)NPP * KD * 2;
constexpr size_t WS_W1 = WS_WO + (size_t)D * KD * 2;
constexpr size_t WS_W2 = WS_W1 + (size_t)NE * 2 * DE * KD * 2;
constexpr size_t WS_XN = WS_W2 + (size_t)NE * D * DE * 2;
constexpr size_t WS_P = WS_XN + (size_t)M * D * 2;
constexpr size_t WS_LA = WS_P + (size_t)M * NPP * 2;
constexpr size_t WS_LB = WS_LA + (size_t)M * LRU_W * 4;
constexpr size_t WS_UC = WS_LB + (size_t)M * LRU_W * 4;
constexpr size_t WS_XL = WS_UC + (size_t)M * LRU_W * 2;
constexpr size_t WS_GATES = WS_XL + (size_t)M * 512 * 2;
constexpr size_t WS_LOUT = WS_GATES + (size_t)M * 2048 * 2;
constexpr size_t WS_V16 = WS_LOUT + (size_t)M * 3072 * 2;
constexpr size_t WS_G16 = WS_V16 + (size_t)M * RW_W * 2;
constexpr size_t WS_WG = WS_G16 + (size_t)M * RW_W * 2;
constexpr size_t WS_WL = WS_WG + (size_t)2048 * 256 * 2;
constexpr size_t WS_RY = WS_WL + (size_t)3072 * 256 * 2;
constexpr size_t WS_BON = WS_RY;
constexpr size_t WS_CAT = WS_BON + (size_t)M * NHEAD * 4;
constexpr size_t WS_Z = WS_CAT + (size_t)M * D * 2;
constexpr size_t WS_H1 = WS_Z + (size_t)M * D * 4;
constexpr size_t WS_H1B = WS_H1 + (size_t)M * D * 4;
constexpr size_t WS_TOPE = WS_H1B + (size_t)M * D * 2;
constexpr size_t WS_TOPP = WS_TOPE + (size_t)M * TOPK * 4;
constexpr size_t WS_TOPG = WS_TOPP + (size_t)M * TOPK * 4;
constexpr size_t WS_TOKSLOT = WS_TOPG + (size_t)M * TOPK * 4;
constexpr size_t WS_SLOTTOK = WS_TOKSLOT + (size_t)M * TOPK * 4;
constexpr size_t WS_SLOTG = WS_SLOTTOK + (size_t)NSLOT_MAX * 4;
constexpr size_t WS_ACT = WS_SLOTG + (size_t)NSLOT_MAX * 4;
constexpr size_t WS_OUTS = WS_ACT + (size_t)NSLOT_MAX * DE * 2;
constexpr int NUNIT = BATCH * NHEAD * (SEQ / 64);
constexpr size_t WS_MT = WS_OUTS + (size_t)NSLOT_MAX * D * 2;
constexpr size_t WS_GG = WS_MT + (size_t)NUNIT * 8192;
constexpr size_t WS_XS = WS_GG + (size_t)NUNIT * 8192;
constexpr size_t WS_NN = WS_XS + (size_t)NUNIT * 8192;
constexpr size_t WS_HH = WS_NN + (size_t)NUNIT * 16384;
constexpr size_t WS_CA = WS_HH + (size_t)NUNIT * 16384;
constexpr size_t WS_CH = WS_CA + (size_t)BATCH * 64 * LRU_W * 4;
constexpr size_t WS_CIN = WS_CH + (size_t)BATCH * 64 * LRU_W * 4;
constexpr size_t WS_XG = WS_CIN + (size_t)BATCH * 64 * LRU_W * 4;
constexpr size_t WS_WRT = WS_XG + (size_t)NSLOT_MAX * D;
constexpr size_t WS_END = WS_WRT + (size_t)2 * NE * D * 2;
constexpr int CW_CNT = 1024;
constexpr int CW_BAR = 4096;

constexpr int MISC_OFF = 159744;
constexpr int LDS_BYTES = 163840;

#define RLX_AGENT __ATOMIC_RELAXED, __HIP_MEMORY_SCOPE_AGENT
__device__ __forceinline__ unsigned f2bf(float f) { unsigned u = __builtin_bit_cast(unsigned, f); return (u + 0x7fffu + ((u >> 16) & 1u)) >> 16; }
__device__ __forceinline__ unsigned pk2(float lo, float hi) { return f2bf(lo) | (f2bf(hi) << 16); }
__device__ __forceinline__ float bf2f(unsigned short b) { return __builtin_bit_cast(float, (unsigned)b << 16); }
__device__ __forceinline__ float bflo(unsigned w) { return __builtin_bit_cast(float, w << 16); }
__device__ __forceinline__ float bfhi(unsigned w) { return __builtin_bit_cast(float, w & 0xffff0000u); }
__device__ __forceinline__ unsigned cvt2(float a, float b) { const f32x2 v = {a, b}; return __builtin_bit_cast(unsigned, __builtin_convertvector(v, bfv2)); }
__device__ __forceinline__ unsigned short cvt1(float a) { return (unsigned short)(cvt2(a, 0.f) & 0xffffu); }
constexpr float F8_SH = 4.f, F8_SW1 = 32.f, F8_SACT = 4.f, F8_SW2 = 64.f;
__device__ __forceinline__ float f8clamp(float x) { return fminf(fmaxf(x, -448.f), 448.f); }
__device__ __forceinline__ unsigned pk4_f8(float a, float b, float c, float d) { int w = 0; w = __builtin_amdgcn_cvt_pk_fp8_f32(f8clamp(a), f8clamp(b), w, false); w = __builtin_amdgcn_cvt_pk_fp8_f32(f8clamp(c), f8clamp(d), w, true); return (unsigned)w; }
__device__ __forceinline__ int lane_now() { int l; asm volatile("v_mbcnt_lo_u32_b32 %0, -1, 0\n\tv_mbcnt_hi_u32_b32 %0, -1, %0" : "=v"(l)); return l; }
__device__ __forceinline__ int crow(int reg, int h) { return (reg & 3) + 8 * (reg >> 2) + 4 * h; }
__device__ __forceinline__ float row_sum16(float v) {
    v += __builtin_bit_cast(float, __builtin_amdgcn_update_dpp(0, __builtin_bit_cast(int, v), 0xB1, 0xf, 0xf, false));
    v += __builtin_bit_cast(float, __builtin_amdgcn_update_dpp(0, __builtin_bit_cast(int, v), 0x4E, 0xf, 0xf, false));
    v += __builtin_bit_cast(float, __builtin_amdgcn_update_dpp(0, __builtin_bit_cast(int, v), 0x141, 0xf, 0xf, false));
    v += __builtin_bit_cast(float, __builtin_amdgcn_update_dpp(0, __builtin_bit_cast(int, v), 0x140, 0xf, 0xf, false));
    return v;
}
__device__ __forceinline__ float rdlane(float v, int l) { return __builtin_bit_cast(float, __builtin_amdgcn_readlane(__builtin_bit_cast(int, v), l)); }
__device__ __forceinline__ float wave_sum(float v) { v = row_sum16(v); return (rdlane(v, 0) + rdlane(v, 16)) + (rdlane(v, 32) + rdlane(v, 48)); }
__device__ __forceinline__ float half_sum(float v, int hh) { v = row_sum16(v); const float lo = rdlane(v, 0) + rdlane(v, 16), hi = rdlane(v, 32) + rdlane(v, 48); return hh ? hi : lo; }
__device__ __forceinline__ float sigmoidf_(float x) { return __builtin_amdgcn_rcpf(1.f + __expf(-x)); }
__device__ __forceinline__ float gelu_tanh(float x) { const float u = 0.7978845608028654f * (x + 0.044715f * x * x * x); return x * __builtin_amdgcn_rcpf(1.f + __expf(-2.f * u)); }
__device__ __forceinline__ float tanh_fast(float x) { const float e = __expf(-2.f * fabsf(x)); const float t = (1.f - e) * __builtin_amdgcn_rcpf(1.f + e); return x < 0.f ? -t : t; }

#define XB_TMO      128
#define XB_XCNT(j)  (256  + 64 * (j))
#define XB_XSUB(j)  (1280 + 64 * (j))
#define XB_XGEN(j)  (2304 + 64 * (j))
#define XB_TOP      3328
#define XB_TOPGEN   3392
#define XCD_BAR_WORDS 3456
#define XB_SPIN_CAP (1u << 18)
__device__ __forceinline__ unsigned xb_ld(unsigned* p)              { return __hip_atomic_load(p, __ATOMIC_RELAXED, __HIP_MEMORY_SCOPE_AGENT); }
__device__ __forceinline__ unsigned xb_add(unsigned* p, unsigned v) { return __hip_atomic_fetch_add(p, v, __ATOMIC_RELAXED, __HIP_MEMORY_SCOPE_AGENT); }
__device__ __forceinline__ unsigned xb_xcc_id() { return (unsigned)__builtin_amdgcn_s_getreg((3 << 11) | 20) & 0xFu; }
#define XB_SPIN(cond, bar) do { unsigned _sp = 0; while (cond) { __builtin_amdgcn_s_sleep(1); \
    if ((++_sp & 255u) == 0u) { if (xb_ld(&(bar)[XB_TMO])) break; if (_sp > XB_SPIN_CAP) { atomicAdd(&(bar)[XB_TMO], 1u); break; } } } } while (0)
struct XcdBarrier { unsigned* bar; unsigned x; volatile LAS unsigned* st; };
__device__ __forceinline__ XcdBarrier xcd_barrier_post(unsigned* bar, volatile LAS unsigned* st) {
    XcdBarrier b; b.bar = bar; b.x = xb_xcc_id(); b.st = st;
    if (__builtin_amdgcn_readfirstlane(threadIdx.x >> 6) == 0 && lane_now() == 0) (void)xb_add(&bar[XB_XCNT(b.x)], 1u);
    return b;
}
__device__ __forceinline__ void xcd_barrier_complete(unsigned* bar, unsigned x, unsigned& nloc, unsigned& nx) {
    const unsigned G = gridDim.x * gridDim.y * gridDim.z;
    unsigned sum, cnt, mine, sp = 0u;
    for (;;) {
        sum = 0u; cnt = 0u; mine = 0u;
#pragma unroll
        for (unsigned j = 0; j < 16; ++j) { const unsigned c = xb_ld(&bar[XB_XCNT(j)]); sum += c; cnt += (c > 0u) ? 1u : 0u; mine = (j == x) ? c : mine; }
        if (sum == G) break;
        __builtin_amdgcn_s_sleep(1);
        if ((++sp & 255u) == 0u) { if (xb_ld(&bar[XB_TMO])) break; if (sp > XB_SPIN_CAP) { atomicAdd(&bar[XB_TMO], 1u); break; } }
    }
    nloc = mine > 0u ? mine : 1u; nx = cnt > 0u ? cnt : 1u;
}
__device__ __forceinline__ void xcd_barrier(const XcdBarrier& b, int wave_id) {
    asm volatile("s_waitcnt vmcnt(0)" ::: "memory");
    __syncthreads();
    if (wave_id == 0 && lane_now() == 0) {
        unsigned* bar = b.bar;
        __builtin_amdgcn_s_waitcnt(0);
        unsigned nloc = b.st[0], nx = b.st[1];
        if (nloc == 0u) { xcd_barrier_complete(bar, b.x, nloc, nx); b.st[0] = nloc; b.st[1] = nx; }
        const unsigned old = xb_add(&bar[XB_XSUB(b.x)], 1u);
        const unsigned gen = old / nloc;
        if (old + 1u == (gen + 1u) * nloc) {
            __builtin_amdgcn_fence(__ATOMIC_RELEASE, "agent");
            asm volatile("s_waitcnt vmcnt(0)" ::: "memory");
            const unsigned og = xb_add(&bar[XB_TOP], 1u);
            const unsigned tg = og / nx;
            if (og + 1u == (tg + 1u) * nx) xb_add(&bar[XB_TOPGEN], 1u);
            else XB_SPIN(xb_ld(&bar[XB_TOPGEN]) == tg, bar);
            __builtin_amdgcn_fence(__ATOMIC_ACQUIRE, "agent");
            xb_add(&bar[XB_XGEN(b.x)], 1u);
            asm volatile("s_waitcnt vmcnt(0)" ::: "memory");
        } else {
            XB_SPIN(xb_ld(&bar[XB_XGEN(b.x)]) == gen, bar);
            __builtin_amdgcn_fence(__ATOMIC_ACQUIRE, "agent");
            asm volatile("s_waitcnt vmcnt(0)" ::: "memory");
        }
    }
    __syncthreads();
}

namespace pg8 {
constexpr int BM = 256, BK = 64, HALF = 128, HTB = HALF * BK * 2, STAGE_BYTES = 8 * HTB, NXCD = 8, WGM = 8;
__host__ __device__ __forceinline__ int lds_byte(int r, int c) { const int st = (r >> 4) * 2 + (c >> 5), rr = r & 15, cc = c & 31, ob = rr * 64 + cc * 2; return st * 1024 + (ob ^ (((ob >> 9) & 1) << 5)); }
__host__ __device__ __forceinline__ void stage_rc(int b, int& R, int& C) { const int st = b / 1024, sb = b % 1024, swz = sb ^ (((sb >> 9) & 1) << 5); R = (st >> 1) * 16 + swz / 64; C = (st & 1) * 32 + (swz % 64) / 2; }
__host__ __device__ __forceinline__ int perm32(int rho) { const int n = rho >> 4, i = rho & 15; return 8 * (i >> 2) + 4 * n + (i & 3); }
struct Unit { int pm, pn, ak, nt; };
__device__ __forceinline__ unsigned cvt_pk_bf16(float lo, float hi) { unsigned r; asm volatile("v_cvt_pk_bf16_f32 %0, %1, %2" : "=v"(r) : "v"(lo), "v"(hi)); return r; }

struct StaticOrder {
    int nM, nN, nwg, G, c;
    __device__ void init(int M_, int N_, int G_, int c_) { nM = M_ / BM; nN = N_ / BM; nwg = nM * nN; G = G_; c = c_; }
    __device__ bool next(int i, Unit& u) const {
        const long L = (long)i * G + c; if (L >= nwg) return false;
        int wgid = (int)L; { const int q = nwg / NXCD, r = nwg % NXCD, xcd = wgid % NXCD, off = wgid / NXCD; wgid = (xcd < r ? xcd * (q + 1) : r * (q + 1) + (xcd - r) * q) + off; }
        const int nig = WGM * nN, gid = wgid / nig, fm = gid * WGM, gsz = (nM - fm) < WGM ? (nM - fm) : WGM;
        u.pm = fm + ((wgid % nig) % gsz); u.pn = (wgid % nig) / gsz; u.ak = 0; u.nt = KD / BK; return true;
    }
};
struct MoeOrder {
    const LAS int* tile_e; int R, NCT, G, c, nt;
    __device__ bool next(int i, Unit& u) const {
        int rt, ct;
        if (G == 256) { const int x = c & 7, j = c >> 3;
            if (NCT == 16) { rt = 16 * i + (x >> 1) * 4 + (j >> 3); ct = (x & 1) * 8 + (j & 7); }
            else           { rt = 32 * i + 4 * x + (j >> 3); ct = j & 7; } }
        else { const long L = (long)i * G + c; rt = (int)(L / NCT); ct = (int)(L % NCT); }
        if (rt >= R) return false;
        u.pm = rt; u.pn = tile_e[rt] * NCT + ct; u.ak = 0; u.nt = nt; return true;
    }
};
template <int MODE> struct SmallOrder {
    int G, c;
    __device__ bool next(int i, Unit& u) const {
        constexpr int NCT = MODE == 0 ? 8 : 12;
        const int L = i * G + c; if (L >= (M / BM) * NCT) return false;
        u.pm = L / NCT; u.pn = L % NCT;
        if (MODE == 0) { u.ak = 256 * (u.pn & 3); u.nt = 4; }
        else { u.ak = u.pn < 4 ? 0 : (u.pn < 8 ? 128 : 256); u.nt = u.pn < 8 ? 2 : 4; }
        return true;
    }
};
struct DenseRows { static constexpr bool DENSE = true; __device__ __forceinline__ unsigned row(int pm, int r) const { return (unsigned)(pm * BM + r); } };
struct GatherRows { static constexpr bool DENSE = false; const int* idx; __device__ __forceinline__ unsigned row(int pm, int r) const { return (unsigned)idx[pm * BM + r]; } };

struct EpiBf16 {
    static constexpr bool PERM = true;
    bf16_t* O; int ldc;
    __device__ __forceinline__ void operator()(const f32x4 (&acc)[2][2][4][2], const Unit& u, int wr, int wc, int fr, int fq) const {
        const int row0 = u.pm * BM + wr * 64 + fr, col0 = u.pn * BM + wc * 32 + 8 * fq;
#pragma unroll
        for (int ai = 0; ai < 2; ++ai)
#pragma unroll
            for (int m = 0; m < 4; ++m) { bf16_t* rowp = O + (size_t)(row0 + ai * HALF + m * 16) * ldc + col0;
#pragma unroll
                for (int bj = 0; bj < 2; ++bj) { const f32x4 v0 = acc[ai][bj][m][0], v1 = acc[ai][bj][m][1];
                    u32x4 w; w.x = cvt_pk_bf16(v0[0], v0[1]); w.y = cvt_pk_bf16(v0[2], v0[3]); w.z = cvt_pk_bf16(v1[0], v1[1]); w.w = cvt_pk_bf16(v1[2], v1[3]);
                    *(u32x4*)(rowp + bj * HALF) = w; } }
    }
};
struct EpiResF32 {
    static constexpr bool PERM = false;
    float* Z; const bf16_t* R; float alpha;
    __device__ __forceinline__ void operator()(const f32x4 (&acc)[2][2][4][2], const Unit& u, int wr, int wc, int fr, int fq) const {
        const int row0 = u.pm * BM + wr * 64 + fr, col0 = u.pn * BM + wc * 32 + 4 * fq;
#pragma unroll
        for (int ai = 0; ai < 2; ++ai)
#pragma unroll
            for (int m = 0; m < 4; ++m) { const size_t off = (size_t)(row0 + ai * HALF + m * 16) * D + col0;
#pragma unroll
                for (int bj = 0; bj < 2; ++bj)
#pragma unroll
                    for (int n = 0; n < 2; ++n) { const u32x2 rb = *(const u32x2*)(R + off + bj * HALF + n * 16);
                        f32x4 o = acc[ai][bj][m][n]; o[0] += alpha * bflo(rb.x); o[1] += alpha * bfhi(rb.x); o[2] += alpha * bflo(rb.y); o[3] += alpha * bfhi(rb.y);
                        *(f32x4*)(Z + off + bj * HALF + n * 16) = o; } }
    }
};
struct EpiSwiglu {
    static constexpr bool PERM = true;
    unsigned char* O; const float* b1;
    __device__ __forceinline__ void operator()(const f32x4 (&acc)[2][2][4][2], const Unit& u, int wr, int wc, int fr, int fq) const {
        const int e = u.pn >> 4, ct = u.pn & 15;
        const int row0 = u.pm * BM + wr * 64 + fr, cin = wc * 32 + 8 * fq, col0 = ct * HALF + cin;
        const float* bg = b1 + (size_t)e * 2 * DE + col0; const float* bu = bg + DE;
        const f32x4 bg0 = *(const f32x4*)bg, bg1 = *(const f32x4*)(bg + 4), bu0 = *(const f32x4*)bu, bu1 = *(const f32x4*)(bu + 4);
        constexpr float inv = 1.f / (F8_SH * F8_SW1);
#pragma unroll
        for (int ai = 0; ai < 2; ++ai)
#pragma unroll
            for (int m = 0; m < 4; ++m) { unsigned char* rowp = O + (size_t)(row0 + ai * HALF + m * 16) * DE + col0;
                float o[8];
#pragma unroll
                for (int n = 0; n < 2; ++n) { const f32x4 g4 = acc[ai][0][m][n] * inv + (n ? bg1 : bg0), u4 = acc[ai][1][m][n] * inv + (n ? bu1 : bu0);
#pragma unroll
                    for (int j = 0; j < 4; ++j) { const float g = fminf(g4[j], 7.f), up = fminf(fmaxf(u4[j], -7.f), 7.f);
                        o[n * 4 + j] = F8_SACT * g * (up + 1.f) * __builtin_amdgcn_rcpf(1.f + __expf(-1.702f * g)); } }
                *(u32x2*)rowp = (u32x2){pk4_f8(o[0], o[1], o[2], o[3]), pk4_f8(o[4], o[5], o[6], o[7])}; }
    }
};
struct EpiMoeOut {
    static constexpr bool PERM = true;
    bf16_t* O; const float* b2; const float* sg;
    __device__ __forceinline__ void operator()(const f32x4 (&acc)[2][2][4][2], const Unit& u, int wr, int wc, int fr, int fq) const {
        const int e = u.pn >> 3, ct = u.pn & 7;
        const int row0 = u.pm * BM + wr * 64 + fr, col0 = ct * BM + wc * 32 + 8 * fq;
        f32x4 bv[2][2];
#pragma unroll
        for (int bj = 0; bj < 2; ++bj)
#pragma unroll
            for (int n = 0; n < 2; ++n) bv[bj][n] = *(const f32x4*)(b2 + (size_t)e * D + col0 + bj * HALF + 4 * n);
#pragma unroll
        for (int ai = 0; ai < 2; ++ai)
#pragma unroll
            for (int m = 0; m < 4; ++m) { const int row = row0 + ai * HALF + m * 16; const float gt = sg[row]; bf16_t* rowp = O + (size_t)row * D + col0;
#pragma unroll
                for (int bj = 0; bj < 2; ++bj) { const f32x4 v0 = (acc[ai][bj][m][0] * (1.f / (F8_SACT * F8_SW2)) + bv[bj][0]) * gt, v1 = (acc[ai][bj][m][1] * (1.f / (F8_SACT * F8_SW2)) + bv[bj][1]) * gt;
                    u32x4 w; w.x = cvt_pk_bf16(v0[0], v0[1]); w.y = cvt_pk_bf16(v0[2], v0[3]); w.z = cvt_pk_bf16(v1[0], v1[1]); w.w = cvt_pk_bf16(v1[2], v1[3]);
                    *(u32x4*)(rowp + bj * HALF) = w; } }
    }
};

template <class Epi, class Sched, class ARows, bool ALIGN_EPI, int LDA = KD, int LDB = KD, bool F8 = false>
__device__ __forceinline__ void gemm_phase(LAS unsigned char* lds, const bf16_t* A, const bf16_t* Bt, const Sched& S, const Epi& E, const ARows& AR, const int wid) {
    const int lane = lane_now(), tid = wid * 64 + lane, wr = wid >> 2, wc = wid & 3, fr = lane & 15, fq = lane >> 4;
    int sR[2], sC[2]; unsigned voffB[2];
#pragma unroll
    for (int i = 0; i < 2; ++i) { stage_rc(tid * 16 + i * 8192, sR[i], sC[i]); const int Rb = Epi::PERM ? ((sR[i] & ~31) + perm32(sR[i] & 31)) : sR[i];
        voffB[i] = (unsigned)(Rb * LDB + sC[i]) * 2u; }
    constexpr size_t kstep = (size_t)(BK * 2);
    constexpr size_t hstep = (size_t)HALF * LDB * 2;
    constexpr size_t tstep = 2 * hstep;
    const unsigned ldsw = (unsigned)wid * 1024u;
    int aoffs[2], boffs[2];
    if constexpr (F8) { aoffs[0] = lds_byte(wr * 64 + fr, fq * 16); aoffs[1] = aoffs[0] + 16; boffs[0] = 4 * HTB + lds_byte(wc * 32 + fr, fq * 16); boffs[1] = boffs[0] + 16; }
    else { aoffs[0] = lds_byte(wr * 64 + fr, fq * 8); aoffs[1] = aoffs[0] + 1024; boffs[0] = 4 * HTB + lds_byte(wc * 32 + fr, fq * 8); boffs[1] = boffs[0] + 1024; }
#define PG8_SA(b, h) (((b) * 2 + (h)) * HTB)
#define PG8_SB(b, h) ((4 + (b) * 2 + (h)) * HTB)
#define PG8_SBR(b, h) (((b) * 2 + (h)) * HTB)
#define PG8_STAGE(bufoff, gbase, voff) do { const char* gb_ = (const char*)(gbase); _Pragma("unroll") for (int _i = 0; _i < 2; ++_i) { unsigned keep_; \
        asm volatile("s_mov_b32 %0, m0\n\ts_mov_b32 m0, %3\n\ts_nop 0\n\tglobal_load_lds_dwordx4 %1, %2\n\ts_mov_b32 m0, %0" : "=&s"(keep_) : "v"((voff)[_i]), "s"(gb_), "s"((unsigned)((bufoff) + ldsw + _i * 8192)) : "memory"); } } while (0)
#define PG8_LDA(dst, b, h) do { _Pragma("unroll") for (int m = 0; m < 4; ++m) { if constexpr (F8) { const i32x4 lo_ = *(const LAS i32x4*)(lds + PG8_SA(b, h) + aoffs[0] + m * 2048), hi_ = *(const LAS i32x4*)(lds + PG8_SA(b, h) + aoffs[1] + m * 2048); \
            dst##8[m] = __builtin_shufflevector(lo_, hi_, 0, 1, 2, 3, 4, 5, 6, 7); } else { _Pragma("unroll") for (int k = 0; k < 2; ++k) dst[m][k] = *(const LAS bf16x8*)(lds + PG8_SA(b, h) + aoffs[k] + m * 2048); } } } while (0)
#define PG8_LDB(dst, b, h) do { _Pragma("unroll") for (int n = 0; n < 2; ++n) { if constexpr (F8) { const i32x4 lo_ = *(const LAS i32x4*)(lds + PG8_SBR(b, h) + boffs[0] + n * 2048), hi_ = *(const LAS i32x4*)(lds + PG8_SBR(b, h) + boffs[1] + n * 2048); \
            dst##8[n] = __builtin_shufflevector(lo_, hi_, 0, 1, 2, 3, 4, 5, 6, 7); } else { _Pragma("unroll") for (int k = 0; k < 2; ++k) dst[n][k] = *(const LAS bf16x8*)(lds + PG8_SBR(b, h) + boffs[k] + n * 2048); } } } while (0)
#define PG8_MMA(ai, bj, At, Bt_) do { __builtin_amdgcn_s_setprio(1); _Pragma("unroll") for (int m = 0; m < 4; ++m) _Pragma("unroll") for (int n = 0; n < 2; ++n) { \
        if constexpr (F8) { acc[ai][bj][m][n] = __builtin_amdgcn_mfma_scale_f32_16x16x128_f8f6f4(Bt_##8[n], At##8[m], acc[ai][bj][m][n], 0, 0, 0, 0x7f7f7f7f, 0, 0x7f7f7f7f); } \
        else { _Pragma("unroll") for (int k = 0; k < 2; ++k) acc[ai][bj][m][n] = __builtin_amdgcn_mfma_f32_16x16x32_bf16(Bt_[n][k], At[m][k], acc[ai][bj][m][n], 0, 0, 0); } } __builtin_amdgcn_s_setprio(0); } while (0)
#define PG8_WAIT_V(n) asm volatile("s_waitcnt vmcnt(" #n ")" ::: "memory")
#define PG8_WAIT_L(n) asm volatile("s_waitcnt lgkmcnt(" #n ")" ::: "memory")
#define PG8_BAR __builtin_amdgcn_s_barrier()
#define PG8_SCHED __builtin_amdgcn_sched_barrier(0)
#define PG8_AOFF(dst, u) do { const int tq_ = wid * 64 + lane_now(); _Pragma("unroll") for (int _i = 0; _i < 2; ++_i) { int R_, C_; stage_rc(tq_ * 16 + _i * 8192, R_, C_); \
        _Pragma("unroll") for (int _h = 0; _h < 2; ++_h) { \
        if constexpr (ARows::DENSE) dst[_h][_i] = (unsigned)(R_ * LDA + C_) * 2u; \
        else dst[_h][_i] = (AR.row((u).pm, _h * HALF + R_) * (unsigned)LDA + (unsigned)((u).ak + C_)) * 2u; } } } while (0)
#define PG8_ABASE(u) (ARows::DENSE ? (const char*)A + ((size_t)(u).pm * BM * LDA + (u).ak) * 2 : (const char*)A)
    constexpr size_t ahstep = ARows::DENSE ? (size_t)HALF * LDA * 2 : 0;
    Unit cur, nxt; int ui = 0;
    if (!S.next(0, cur)) return;
    f32x4 acc[2][2][4][2];
#pragma unroll
    for (int a = 0; a < 2; ++a)
#pragma unroll
        for (int b = 0; b < 2; ++b)
#pragma unroll
            for (int m = 0; m < 4; ++m)
#pragma unroll
                for (int n = 0; n < 2; ++n) acc[a][b][m][n] = (f32x4){0.f, 0.f, 0.f, 0.f};
    bf16x8 At[4][2], B0[2][2], B1[2][2]; i32x8 At8[4], B08[2], B18[2];
    unsigned ao[2][2], an[2][2];
    PG8_AOFF(ao, cur);
    const char* cA = PG8_ABASE(cur);
    const char* cB = (const char*)Bt + (size_t)cur.pn * tstep;
    PG8_STAGE(PG8_SB(0, 0), cB, voffB); PG8_STAGE(PG8_SB(0, 1), cB + hstep, voffB); PG8_STAGE(PG8_SA(0, 0), cA, ao[0]); PG8_STAGE(PG8_SA(0, 1), cA + ahstep, ao[1]);
    if (wr == 1) PG8_BAR;
    PG8_WAIT_V(2); PG8_BAR;
    PG8_STAGE(PG8_SB(1, 0), cB + kstep, voffB); PG8_STAGE(PG8_SA(1, 0), cA + kstep, ao[0]); PG8_STAGE(PG8_SB(1, 1), cB + hstep + kstep, voffB);
    PG8_WAIT_V(6); PG8_BAR;
    for (;;) {
        const bool has_next = S.next(ui + 1, nxt);
        if (has_next && !ARows::DENSE) { PG8_AOFF(an, nxt); } else {
#pragma unroll
            for (int h = 0; h < 2; ++h)
#pragma unroll
                for (int i = 0; i < 2; ++i) an[h][i] = ao[h][i]; }
        const char* nB = has_next ? (const char*)Bt + (size_t)nxt.pn * tstep : cB;
        const char* nA = has_next ? PG8_ABASE(nxt) : cA;
        const int nt = cur.nt;
#pragma unroll 1
        for (int t = 0; t < nt; t += 2) {
            const bool last = (t == nt - 2);
            const char* a1 = cA + (size_t)(t + 1) * kstep;
            const char* a2 = last ? nA : cA + (size_t)(t + 2) * kstep; const char* b2 = last ? nB : cB + (size_t)(t + 2) * kstep;
            const char* a3 = a2 + kstep; const char* b3 = b2 + kstep;
            unsigned o2[2][2];
#pragma unroll
            for (int h = 0; h < 2; ++h)
#pragma unroll
                for (int i = 0; i < 2; ++i) o2[h][i] = (!ARows::DENSE && last) ? an[h][i] : ao[h][i];
            PG8_LDB(B0, 0, 0); PG8_LDB(B1, 0, 1); PG8_SCHED; PG8_LDA(At, 0, 0); PG8_STAGE(PG8_SA(1, 1), a1 + ahstep, ao[1]);
            PG8_WAIT_V(8); PG8_WAIT_L(0); PG8_BAR; PG8_MMA(0, 0, At, B0); PG8_MMA(0, 1, At, B1); PG8_BAR; PG8_SCHED;
            PG8_LDA(At, 0, 1); PG8_STAGE(PG8_SB(0, 0), b2, voffB); PG8_STAGE(PG8_SB(0, 1), b2 + hstep, voffB); PG8_STAGE(PG8_SA(0, 0), a2, o2[0]);
            PG8_WAIT_V(8); PG8_WAIT_L(0); PG8_BAR; PG8_MMA(1, 0, At, B0); PG8_MMA(1, 1, At, B1); PG8_BAR; PG8_SCHED;
            PG8_LDB(B0, 1, 0); PG8_LDB(B1, 1, 1); PG8_SCHED; PG8_LDA(At, 1, 0); PG8_STAGE(PG8_SA(0, 1), a2 + ahstep, o2[1]);
            PG8_WAIT_V(8); PG8_WAIT_L(0); PG8_BAR; PG8_MMA(0, 0, At, B0); PG8_MMA(0, 1, At, B1); PG8_BAR; PG8_SCHED;
            PG8_LDA(At, 1, 1); PG8_STAGE(PG8_SB(1, 0), b3, voffB); PG8_STAGE(PG8_SB(1, 1), b3 + hstep, voffB); PG8_STAGE(PG8_SA(1, 0), a3, o2[0]);
            PG8_WAIT_V(8); PG8_WAIT_L(0); PG8_BAR; PG8_MMA(1, 0, At, B0); PG8_MMA(1, 1, At, B1); PG8_BAR; PG8_SCHED;
        }
        if constexpr (ALIGN_EPI) { if (wr == 0) PG8_BAR; }
        asm volatile("" : "+s"(cur.pm), "+s"(cur.pn));
        { const int tz = lane_now();
          E(acc, cur, wr, wc, tz & 15, (tz & 63) >> 4); }
        if (!has_next) break;
#pragma unroll
        for (int a = 0; a < 2; ++a)
#pragma unroll
            for (int b = 0; b < 2; ++b)
#pragma unroll
                for (int m = 0; m < 4; ++m)
#pragma unroll
                    for (int n = 0; n < 2; ++n) acc[a][b][m][n] = (f32x4){0.f, 0.f, 0.f, 0.f};
        cur = nxt; cB = nB; cA = nA; ++ui;
#pragma unroll
        for (int h = 0; h < 2; ++h)
#pragma unroll
            for (int i = 0; i < 2; ++i) ao[h][i] = an[h][i];
        if constexpr (ALIGN_EPI) { if (wr == 1) PG8_BAR; }
    }
    PG8_WAIT_V(0);
    if constexpr (!ALIGN_EPI) { if (wr == 0) PG8_BAR; }
    PG8_BAR;
#undef PG8_SA
#undef PG8_SB
#undef PG8_SBR
#undef PG8_STAGE
#undef PG8_LDA
#undef PG8_LDB
#undef PG8_MMA
#undef PG8_WAIT_V
#undef PG8_WAIT_L
#undef PG8_BAR
#undef PG8_SCHED
#undef PG8_AOFF
}
struct DenseRowsH { __device__ __forceinline__ unsigned row(int pm, int r) const { return (unsigned)(pm * 128 + r); } };
struct GatherRowsH { const int* idx; __device__ __forceinline__ unsigned row(int pm, int r) const { return (unsigned)idx[pm * 128 + r]; } };
struct EpiSwigluH {
    unsigned char* O; const float* b1;
    __device__ __forceinline__ void operator()(const f32x4 (&acc)[2][4][2], const Unit& u, int wr, int wc, int fr, int fq) const {
        const int e = u.pn >> 4, ct = u.pn & 15;
        const int row0 = u.pm * 128 + wr * 64 + fr, col0 = ct * HALF + wc * 32 + 8 * fq;
        const float* bg = b1 + (size_t)e * 2 * DE + col0; const float* bu = bg + DE;
        const f32x4 bg0 = *(const f32x4*)bg, bg1 = *(const f32x4*)(bg + 4), bu0 = *(const f32x4*)bu, bu1 = *(const f32x4*)(bu + 4);
        constexpr float inv = 1.f / (F8_SH * F8_SW1);
#pragma unroll
        for (int m = 0; m < 4; ++m) { unsigned char* rowp = O + (size_t)(row0 + m * 16) * DE + col0;
            float o[8];
#pragma unroll
            for (int n = 0; n < 2; ++n) { const f32x4 g4 = acc[0][m][n] * inv + (n ? bg1 : bg0), u4 = acc[1][m][n] * inv + (n ? bu1 : bu0);
#pragma unroll
                for (int j = 0; j < 4; ++j) { const float g = fminf(g4[j], 7.f), up = fminf(fmaxf(u4[j], -7.f), 7.f);
                    o[n * 4 + j] = F8_SACT * g * (up + 1.f) * __builtin_amdgcn_rcpf(1.f + __expf(-1.702f * g)); } }
            *(u32x2*)rowp = (u32x2){pk4_f8(o[0], o[1], o[2], o[3]), pk4_f8(o[4], o[5], o[6], o[7])}; }
    }
};
struct EpiMoeOutH {
    bf16_t* O; const float* b2; const float* sg;
    __device__ __forceinline__ void operator()(const f32x4 (&acc)[2][4][2], const Unit& u, int wr, int wc, int fr, int fq) const {
        const int e = u.pn >> 3, ct = u.pn & 7;
        const int row0 = u.pm * 128 + wr * 64 + fr, col0 = ct * BM + wc * 32 + 8 * fq;
        constexpr float inv = 1.f / (F8_SACT * F8_SW2);
#pragma unroll
        for (int m = 0; m < 4; ++m) { const int row = row0 + m * 16; const float gt = sg[row]; bf16_t* rowp = O + (size_t)row * D + col0;
#pragma unroll
            for (int bj = 0; bj < 2; ++bj) { const f32x4 b0 = *(const f32x4*)(b2 + (size_t)e * D + col0 + bj * HALF), b1_ = *(const f32x4*)(b2 + (size_t)e * D + col0 + bj * HALF + 4);
                const f32x4 v0 = (acc[bj][m][0] * inv + b0) * gt, v1 = (acc[bj][m][1] * inv + b1_) * gt;
                *(u32x4*)(rowp + bj * HALF) = (u32x4){cvt2(v0[0], v0[1]), cvt2(v0[2], v0[3]), cvt2(v1[0], v1[1]), cvt2(v1[2], v1[3])}; } }
    }
};
__host__ __device__ __forceinline__ int f8_g(int R) { return ((R >> 1) & 1) + 4 * ((R >> 3) & 1); }
__host__ __device__ __forceinline__ int f8_lds_byte(int R, int c) { return R * 128 + (((c + f8_g(R)) & 7) << 4); }
__host__ __device__ __forceinline__ void f8_stage_rc(int pos, int& R, int& Cb) { const int P = pos >> 4; R = P >> 3; Cb = (((P & 7) - f8_g(R)) & 7) << 4; }
template <class Epi, class Sched, class ARows>
__device__ __forceinline__ void gemm_f8h(LAS unsigned char* lds, const unsigned char* A, const unsigned char* Bt, const Sched& S, const Epi& E, const ARows& AR, const int wid) {
    constexpr int NT = KD / 128, STG = 3 * HTB;
    const int wr = wid >> 2, wc = wid & 3;
    const unsigned ldsw = (unsigned)wid * 1024u;
    Unit cur, nxt;
    if (!S.next(0, cur)) return;
#define F8_STAGE(dstoff, gbase, voff) do { const char* gb_ = (const char*)(gbase); _Pragma("unroll") for (int _i = 0; _i < 2; ++_i) { unsigned keep_; \
        asm volatile("s_mov_b32 %0, m0\n\ts_mov_b32 m0, %3\n\ts_nop 0\n\tglobal_load_lds_dwordx4 %1, %2\n\ts_mov_b32 m0, %0" : "=&s"(keep_) : "v"((voff)[_i]), "s"(gb_), "s"((unsigned)((dstoff) + ldsw + _i * 8192)) : "memory"); } } while (0)
#define F8_AOFF(dst, u) do { const int tq_ = wid * 64 + lane_now(); _Pragma("unroll") for (int _i = 0; _i < 2; ++_i) { int R_, C_; f8_stage_rc(tq_ * 16 + _i * 8192, R_, C_); dst[_i] = AR.row((u).pm, R_) * (unsigned)KD + (unsigned)C_; } } while (0)
#define F8_STAGE_TILE(so_, kt_, aoffv, bptr) do { F8_STAGE((so_), (const char*)A + (size_t)(kt_) * 128, aoffv); F8_STAGE((so_) + HTB, (bptr) + (size_t)(kt_) * 128, vb); F8_STAGE((so_) + 2 * HTB, (bptr) + (size_t)128 * KD + (size_t)(kt_) * 128, vb); } while (0)
#define F8_LDFRAG(a8, b8, so_) do { _Pragma("unroll") for (int m = 0; m < 4; ++m) { const i32x4 lo = *(const LAS i32x4*)(lds + (so_) + aoff0 + m * 2048), hi = *(const LAS i32x4*)(lds + (so_) + aoff1 + m * 2048); a8[m] = __builtin_shufflevector(lo, hi, 0, 1, 2, 3, 4, 5, 6, 7); } \
        _Pragma("unroll") for (int b = 0; b < 2; ++b) _Pragma("unroll") for (int n = 0; n < 2; ++n) { const i32x4 lo = *(const LAS i32x4*)(lds + (so_) + (1 + b) * HTB + boff0 + n * 2048), hi = *(const LAS i32x4*)(lds + (so_) + (1 + b) * HTB + boff1 + n * 2048); b8[b][n] = __builtin_shufflevector(lo, hi, 0, 1, 2, 3, 4, 5, 6, 7); } } while (0)
#define F8_MMA(a8, b8) do { __builtin_amdgcn_s_setprio(1); _Pragma("unroll") for (int b = 0; b < 2; ++b) _Pragma("unroll") for (int m = 0; m < 4; ++m) _Pragma("unroll") for (int n = 0; n < 2; ++n) \
        acc[b][m][n] = __builtin_amdgcn_mfma_scale_f32_16x16x128_f8f6f4(b8[b][n], a8[m], acc[b][m][n], 0, 0, 0, 0x7f7f7f7f, 0, 0x7f7f7f7f); __builtin_amdgcn_s_setprio(0); } while (0)
    unsigned ao[2], an[2], vb[2];
    { const int tq = wid * 64 + lane_now();
#pragma unroll
        for (int i = 0; i < 2; ++i) { int R, C; f8_stage_rc(tq * 16 + i * 8192, R, C); const int Rb = (R & ~31) + perm32(R & 31); vb[i] = (unsigned)(Rb * KD + C); } }
    F8_AOFF(ao, cur);
    int aoff0, aoff1, boff0, boff1; { const int ln = lane_now(), fr = ln & 15, fq = ln >> 4; aoff0 = f8_lds_byte(wr * 64 + fr, 2 * fq); aoff1 = f8_lds_byte(wr * 64 + fr, 2 * fq + 1); boff0 = f8_lds_byte(wc * 32 + fr, 2 * fq); boff1 = f8_lds_byte(wc * 32 + fr, 2 * fq + 1); }
    const char* cB = (const char*)Bt + (size_t)cur.pn * 256 * KD;
    f32x4 acc[2][4][2];
#pragma unroll
    for (int b = 0; b < 2; ++b)
#pragma unroll
        for (int m = 0; m < 4; ++m)
#pragma unroll
            for (int n = 0; n < 2; ++n) acc[b][m][n] = (f32x4){0.f, 0.f, 0.f, 0.f};
    F8_STAGE_TILE(0, 0, ao, cB); F8_STAGE_TILE(STG, 1, ao, cB);
    int so = 0;
    for (int ui = 0;; ++ui) {
        const bool has_next = S.next(ui + 1, nxt);
        const char* nB = cB;
        if (has_next) { F8_AOFF(an, nxt); nB = (const char*)Bt + (size_t)nxt.pn * 256 * KD; } else { an[0] = ao[0]; an[1] = ao[1]; }
#pragma unroll 1
        for (int kt = 0; kt < NT; ++kt) {
            const int so2 = (so == 0) ? 2 * STG : so - STG;
            if (kt + 1 < NT || has_next) asm volatile("s_waitcnt vmcnt(6)" ::: "memory"); else asm volatile("s_waitcnt vmcnt(0)" ::: "memory");
            __builtin_amdgcn_s_barrier(); asm volatile("" ::: "memory");
            if (kt + 2 < NT) F8_STAGE_TILE(so2, kt + 2, ao, cB); else if (has_next) F8_STAGE_TILE(so2, kt + 2 - NT, an, nB);
            i32x8 fa[4], fb[2][2];
            F8_LDFRAG(fa, fb, so);
            F8_MMA(fa, fb);
            so = (so == 2 * STG) ? 0 : so + STG;
        }
        { const int ln = lane_now(); E(acc, cur, wr, wc, ln & 15, ln >> 4); }
        if (!has_next) break;
#pragma unroll
        for (int b = 0; b < 2; ++b)
#pragma unroll
            for (int m = 0; m < 4; ++m)
#pragma unroll
                for (int n = 0; n < 2; ++n) acc[b][m][n] = (f32x4){0.f, 0.f, 0.f, 0.f};
        cur = nxt; cB = nB; ao[0] = an[0]; ao[1] = an[1];
    }
#undef F8_STAGE
#undef F8_AOFF
#undef F8_STAGE_TILE
#undef F8_LDFRAG
#undef F8_MMA
}
}

constexpr int NWAVES = 8, NTHREADS = 512;
constexpr int NPHASE = 13;
struct Args {
    const float* in[33]; float* out; unsigned char* ws; int ph_lo, ph_hi, use_bar, pad;
};
enum { I_X = 0, I_LNG, I_LNB, I_WIN, I_CONVW, I_CONVB, I_WRG, I_BRG, I_WIG, I_BIG, I_LAMBDA, I_MU, I_W0, I_DECUP, I_A0, I_AAAUP, I_GATEUP,
       I_KK, I_KA, I_RK, I_GNG, I_GNB, I_WOUT, I_LN1G, I_LN1B, I_WROUTER, I_BROUTER, I_WE1, I_BE1, I_WE2, I_BE2, I_LN2G, I_LN2B };

__device__ __forceinline__ void transpose_item(const float* W, int N, bf16_t* WT, int k0, int n0, int dst_row0, LAS float* scr, int lane) {
#pragma unroll 8
    for (int i = 0; i < 32; ++i) { const int kk = 2 * i + (lane >> 5); scr[kk * 33 + (lane & 31)] = W[(size_t)(k0 + kk) * N + n0 + (lane & 31)]; }
    asm volatile("s_waitcnt lgkmcnt(0)" ::: "memory");
    const int c = lane & 7;
#pragma unroll
    for (int j = 0; j < 4; ++j) { const int n = (lane >> 3) + 8 * j; const LAS float* s = scr + (8 * c) * 33 + n;
        u32x4 o; o.x = pk2(s[0 * 33], s[1 * 33]); o.y = pk2(s[2 * 33], s[3 * 33]); o.z = pk2(s[4 * 33], s[5 * 33]); o.w = pk2(s[6 * 33], s[7 * 33]);
        *(u32x4*)(WT + (size_t)(dst_row0 + n) * KD + k0 + 8 * c) = o; }
    asm volatile("s_waitcnt lgkmcnt(0)" ::: "memory");
}

__device__ __forceinline__ void transpose_item_f8(const float* W, int N, unsigned char* WT, int k0, int n0, int dst_row0, float scale, LAS float* scr, int lane) {
#pragma unroll 8
    for (int i = 0; i < 64; ++i) { const int kk = 2 * i + (lane >> 5); scr[kk * 33 + (lane & 31)] = W[(size_t)(k0 + kk) * N + n0 + (lane & 31)]; }
    asm volatile("s_waitcnt lgkmcnt(0)" ::: "memory");
    const int c = lane & 7;
#pragma unroll
    for (int j = 0; j < 4; ++j) { const int n = (lane >> 3) + 8 * j; const LAS float* s = scr + (16 * c) * 33 + n;
        u32x4 o;
        o.x = pk4_f8(s[0 * 33] * scale, s[1 * 33] * scale, s[2 * 33] * scale, s[3 * 33] * scale); o.y = pk4_f8(s[4 * 33] * scale, s[5 * 33] * scale, s[6 * 33] * scale, s[7 * 33] * scale);
        o.z = pk4_f8(s[8 * 33] * scale, s[9 * 33] * scale, s[10 * 33] * scale, s[11 * 33] * scale); o.w = pk4_f8(s[12 * 33] * scale, s[13 * 33] * scale, s[14 * 33] * scale, s[15 * 33] * scale);
        *(u32x4*)(WT + (size_t)(dst_row0 + n) * KD + k0 + 16 * c) = o; }
    asm volatile("s_waitcnt lgkmcnt(0)" ::: "memory");
}

__device__ __forceinline__ void moe_tables(volatile LAS int* tb, unsigned* ctl, int wave_id) {
    if (wave_id == 0 && lane_now() == 0) {
        int off = 0;
        for (int e = 0; e < NE; ++e) { const int c = (int)__hip_atomic_load(ctl + CW_CNT + 64 * e, RLX_AGENT); const int nt = (c + 255) >> 8;
            tb[1 + e] = off; for (int r = 0; r < nt; ++r) tb[64 + off + r] = e; off += nt; }
        tb[1 + NE] = off; tb[0] = off;
    }
    __syncthreads();
}

__global__ void __launch_bounds__(NTHREADS, 2) fwd(Args args) {
    extern __shared__ __attribute__((aligned(16))) unsigned char lds_raw[];
    LAS unsigned char* lds = (LAS unsigned char*)lds_raw;
    volatile LAS unsigned* MISC = (volatile LAS unsigned*)(lds + MISC_OFF);
    const int wave = __builtin_amdgcn_readfirstlane(threadIdx.x >> 6);
#define LANE_TID() const int lane = lane_now(), tid = wave * 64 + lane, gt = bid * NTHREADS + tid; (void)tid; (void)gt
    const int G = gridDim.x, bid = blockIdx.x;
    unsigned char* ws = args.ws;
    unsigned* ctl = (unsigned*)(ws + WS_CTL);
    if (wave == 0) MISC[lane_now()] = 0u;
    __syncthreads();
    XcdBarrier bar; bar.bar = ctl + CW_BAR; bar.x = 0; bar.st = nullptr;
    if (args.use_bar) bar = xcd_barrier_post(ctl + CW_BAR, MISC);
    const int lo = args.ph_lo, hi = args.ph_hi;
#ifndef DUP_MASK
#define DUP_MASK 0
#endif
#define REP(k) for (int rep_ = 0; rep_ <= ((DUP_MASK >> (k)) & 1); ++rep_)
#define IN(k) (lo <= (k) && (k) < hi)
#ifndef PROBE_PHASE
#define PROBE_PHASE -1
#endif
    unsigned long long tprobe0 = 0ull, tprobe1 = 0ull;
#define SEAM(k) do { if (IN(k) && IN((k) + 1)) xcd_barrier(bar, wave); if (PROBE_PHASE >= 0) { if ((k) + 1 == PROBE_PHASE) tprobe0 = __builtin_amdgcn_s_memrealtime(); if ((k) == PROBE_PHASE) tprobe1 = __builtin_amdgcn_s_memrealtime(); } } while (0)
    if (PROBE_PHASE == 0) tprobe0 = __builtin_amdgcn_s_memrealtime();
    const int gw = bid * NWAVES + wave, NGW = G * NWAVES;
    const int NGT = G * NTHREADS;

    bf16_t* WinT = (bf16_t*)(ws + WS_WIN); bf16_t* WoT = (bf16_t*)(ws + WS_WO); unsigned char* W1F = ws + WS_W1; unsigned char* W2F = ws + WS_W2;
    bf16_t* XN = (bf16_t*)(ws + WS_XN); bf16_t* P = (bf16_t*)(ws + WS_P);
    float* LA = (float*)(ws + WS_LA); float* LB = (float*)(ws + WS_LB);
    float* BON = (float*)(ws + WS_BON);
    bf16_t* CAT = (bf16_t*)(ws + WS_CAT); float* Z = (float*)(ws + WS_Z); float* H1 = (float*)(ws + WS_H1); unsigned char* H1F = ws + WS_H1B;
    int* TOPE = (int*)(ws + WS_TOPE); int* TOPP = (int*)(ws + WS_TOPP); float* TOPG = (float*)(ws + WS_TOPG); int* TOKSLOT = (int*)(ws + WS_TOKSLOT);
    int* SLOTTOK = (int*)(ws + WS_SLOTTOK); float* SLOTG = (float*)(ws + WS_SLOTG);
    unsigned char* ACT = ws + WS_ACT; bf16_t* OUTS = (bf16_t*)(ws + WS_OUTS);

    constexpr int CV_I_IN = (KD / 64) * (NP / 32), CV_I_OUT = (KD / 64) * (D / 32), CV_I_E1 = (KD / 128) * (2 * DE / 32), CV_I_E2 = (DE / 128) * (D / 32);
    constexpr int CV_NITEMS = CV_I_IN + CV_I_OUT + NE * CV_I_E1 + NE * CV_I_E2;
#ifndef CV_SHADOW
#define CV_SHADOW 9200
#endif
#ifndef CV_SHADOW1
#define CV_SHADOW1 5120
#endif
#define CONVERT_ITEM(it_) do { int r = (it_); LAS float* scr = (LAS float*)(lds + wave * 17408); \
        if (r < CV_I_IN) { const int nb = NP / 32, kb = r / nb, n0 = (r % nb) * 32; transpose_item(args.in[I_WIN], NP, WinT, kb * 64, n0, n0, scr, lane); break; } r -= CV_I_IN; \
        if (r < CV_I_OUT) { const int nb = D / 32, kb = r / nb, n0 = (r % nb) * 32; transpose_item(args.in[I_WOUT], D, WoT, kb * 64, n0, n0, scr, lane); break; } r -= CV_I_OUT; \
        if (r < NE * CV_I_E1) { const int e = r / CV_I_E1, q = r % CV_I_E1, nb = 2 * DE / 32, kb = q / nb, n0 = (q % nb) * 32; \
            const int isup = n0 >= DE ? 1 : 0, nn = n0 - isup * DE, drow = 256 * (nn >> 7) + 128 * isup + (nn & 127); \
            transpose_item_f8(args.in[I_WE1] + (size_t)e * KD * 2 * DE, 2 * DE, W1F + (size_t)e * 2 * DE * KD, kb * 128, n0, drow, F8_SW1, scr, lane); break; } r -= NE * CV_I_E1; \
        { const int e = r / CV_I_E2, q = r % CV_I_E2, nb = D / 32, kb = q / nb, n0 = (q % nb) * 32; \
            transpose_item_f8(args.in[I_WE2] + (size_t)e * DE * D, D, W2F + (size_t)e * D * DE, kb * 128, n0, n0, F8_SW2, scr, lane); } } while (0)

    if (IN(0)) REP(0) {
        LANE_TID();
        for (int it = gw; it < CV_NITEMS - CV_SHADOW - CV_SHADOW1; it += NGW) CONVERT_ITEM(it);
        { bf16_t* WG = (bf16_t*)(ws + WS_WG); bf16_t* WL = (bf16_t*)(ws + WS_WL);
            for (int i = gt; i < 2048 * 256; i += NGT) { const int row = i >> 8, kl = i & 255, g_ = row >> 10, nb = (row >> 6) & 15, k = row & 63, blk = kl >> 6, j = kl & 63;
                const float v = ((nb & 3) == blk) ? args.in[g_ ? I_WIG : I_WRG][(size_t)(nb * 64 + j) * 64 + k] : 0.f; WG[i] = cvt1(v); }
            for (int i = gt; i < 3072 * 256; i += NGT) { const int row = i >> 8, kl = i & 255, sel = row >> 10, c = row & 1023;
                float v = 0.f; if (sel == 0) { if (kl < DLORA) v = args.in[I_DECUP][(size_t)kl * RW_W + c]; } else if (sel == 1) { if (kl < ALORA) v = args.in[I_AAAUP][(size_t)kl * RW_W + c]; } else v = args.in[I_GATEUP][(size_t)kl * RW_W + c];
                WL[i] = cvt1(v); } }
        { bf16_t* WRH = (bf16_t*)(ws + WS_WRT); bf16_t* WRL = WRH + NE * D;
            for (int i = gt; i < NE * D; i += NGT) { const int e = i >> 11, k = i & 2047; const float w = args.in[I_WROUTER][(size_t)k * NE + e]; const unsigned short h = cvt1(w); WRH[i] = h; WRL[i] = cvt1(w - bf2f(h)); } }
        for (int i = gt; i < (NPP - NP) * KD / 8; i += NGT) ((u32x4*)(WinT + (size_t)NP * KD))[i] = (u32x4){0u, 0u, 0u, 0u};
        const float* lg = args.in[I_LNG]; const float* lb = args.in[I_LNB];
        for (int m = gw; m < M; m += NGW) {
            const f32x4* xr = (const f32x4*)(args.in[I_X] + (size_t)m * D) + lane;
            f32x4 v[8]; float s = 0.f;
#pragma unroll
            for (int j = 0; j < 8; ++j) { v[j] = xr[64 * j]; s += (v[j][0] + v[j][1]) + (v[j][2] + v[j][3]); }
            const float mean = wave_sum(s) * (1.f / D); float s2 = 0.f;
#pragma unroll
            for (int j = 0; j < 8; ++j) { v[j] = v[j] - mean; s2 += (v[j][0] * v[j][0] + v[j][1] * v[j][1]) + (v[j][2] * v[j][2] + v[j][3] * v[j][3]); }
            const float rstd = 1.f / sqrtf(wave_sum(s2) * (1.f / D) + LN_EPS);
            u32x2* o8 = (u32x2*)(XN + (size_t)m * D) + lane;
#pragma unroll
            for (int j = 0; j < 8; ++j) { const f32x4 g4 = ((const f32x4*)lg)[64 * j + lane], b4 = ((const f32x4*)lb)[64 * j + lane]; const f32x4 y = v[j] * rstd * g4 + b4;
                u32x2 w; w.x = pk2(y[0], y[1]); w.y = pk2(y[2], y[3]); o8[64 * j] = w; }
        }
    }
    SEAM(0);

    if (IN(1)) REP(1) {
        LANE_TID();
        pg8::StaticOrder S; S.init(M, NPP, G, bid);
        pg8::EpiBf16 E{P, NPP};
        pg8::gemm_phase<pg8::EpiBf16, pg8::StaticOrder, pg8::DenseRows, true>(lds, XN, WinT, S, E, pg8::DenseRows{}, wave);
        if (G == 256 && bid >= 128) {
            __syncthreads();
            for (int it = CV_NITEMS - CV_SHADOW - CV_SHADOW1 + (bid - 128) * NWAVES + wave; it < CV_NITEMS - CV_SHADOW; it += 128 * NWAVES) CONVERT_ITEM(it); }
        else if (G != 256) { for (int it = CV_NITEMS - CV_SHADOW - CV_SHADOW1 + gw; it < CV_NITEMS - CV_SHADOW; it += NGW) CONVERT_ITEM(it); }
    }
    SEAM(1);

    if (IN(2)) REP(2) {
        LANE_TID();
        bf16_t* UC = (bf16_t*)(ws + WS_UC); bf16_t* XL = (bf16_t*)(ws + WS_XL);
        const float* conv_w = args.in[I_CONVW]; const float* conv_b = args.in[I_CONVB]; const float* mu = args.in[I_MU];
        for (int idx = gt; idx < (M / 16) * (LRU_W / 8); idx += NGT) { const int m0 = (idx >> 7) * 16, c = (idx & 127) * 8, tin0 = m0 & (SEQ - 1);
            f32x4 wlo[4], whi[4];
#pragma unroll
            for (int j = 0; j < 4; ++j) { wlo[j] = *(const f32x4*)(conv_w + j * LRU_W + c); whi[j] = *(const f32x4*)(conv_w + j * LRU_W + c + 4); }
            const f32x4 cb0 = *(const f32x4*)(conv_b + c), cb1 = *(const f32x4*)(conv_b + c + 4);
            u32x4 row[19];
#pragma unroll
            for (int j = 0; j < 19; ++j) { row[j] = (u32x4){0u, 0u, 0u, 0u}; if (tin0 - 3 + j >= 0) row[j] = *(const u32x4*)(P + (size_t)(m0 - 3 + j) * NPP + c); }
#pragma unroll
            for (int t = 0; t < 16; ++t) { f32x4 o0 = cb0, o1 = cb1;
#pragma unroll
                for (int j = 0; j < 4; ++j) { const u32x4 pv = row[t + j];
                    o0[0] += wlo[j][0] * bflo(pv.x); o0[1] += wlo[j][1] * bfhi(pv.x); o0[2] += wlo[j][2] * bflo(pv.y); o0[3] += wlo[j][3] * bfhi(pv.y);
                    o1[0] += whi[j][0] * bflo(pv.z); o1[1] += whi[j][1] * bfhi(pv.z); o1[2] += whi[j][2] * bflo(pv.w); o1[3] += whi[j][3] * bfhi(pv.w); }
                *(u32x4*)(UC + (size_t)(m0 + t) * LRU_W + c) = (u32x4){cvt2(o0[0], o0[1]), cvt2(o0[2], o0[3]), cvt2(o1[0], o1[1]), cvt2(o1[2], o1[3])}; } }
        for (int idx = gt; idx < M * 64; idx += NGT) { const int m = idx >> 6, q = idx & 63, tin = m & (SEQ - 1);
            u32x4 res = {0u, 0u, 0u, 0u};
            const int kind = q < 12 ? 0 : (q < 16 ? 3 : (q < 28 ? 1 : (q < 32 ? 3 : 2)));
            if (kind != 3) { const int col = (kind == 0) ? 3 * RW_W + 8 * q : (kind == 1 ? 3 * RW_W + DLORA + 8 * (q - 16) : 3 * RW_W + DLORA + ALORA + 8 * (q - 32));
                const bf16_t* pp = P + (size_t)m * NPP + 2 * LRU_W + col; const u32x4 pc = *(const u32x4*)pp; u32x4 pq = {0u, 0u, 0u, 0u}; if (tin > 0) pq = *(const u32x4*)(pp - NPP);
                const f32x4 m0 = *(const f32x4*)(mu + col), m1 = *(const f32x4*)(mu + col + 4);
                float s[8]; const unsigned pcw[4] = {pc.x, pc.y, pc.z, pc.w}, pqw[4] = {pq.x, pq.y, pq.z, pq.w};
#pragma unroll
                for (int e = 0; e < 4; ++e) { const float c0 = bflo(pcw[e]), c1 = bfhi(pcw[e]), p0 = bflo(pqw[e]), p1 = bfhi(pqw[e]);
                    const float mu0 = (e < 2) ? m0[2 * e] : m1[2 * e - 4], mu1 = (e < 2) ? m0[2 * e + 1] : m1[2 * e - 3];
                    s[2 * e] = c0 + (p0 - c0) * mu0; s[2 * e + 1] = c1 + (p1 - c1) * mu1; }
#pragma unroll
                for (int e = 0; e < 8; ++e) s[e] = (kind == 0) ? tanh_fast(s[e]) : (kind == 1 ? s[e] : sigmoidf_(s[e]));
                res = (u32x4){cvt2(s[0], s[1]), cvt2(s[2], s[3]), cvt2(s[4], s[5]), cvt2(s[6], s[7])}; }
            *(u32x4*)(XL + (size_t)m * 512 + 8 * q) = res; }
    }
    SEAM(2);

    if (IN(3)) {
        LANE_TID();
        const bf16_t* UC = (const bf16_t*)(ws + WS_UC); const bf16_t* XL = (const bf16_t*)(ws + WS_XL);
        { pg8::SmallOrder<0> S{G, bid}; pg8::EpiBf16 E{(bf16_t*)(ws + WS_GATES), 2048};
          pg8::gemm_phase<pg8::EpiBf16, pg8::SmallOrder<0>, pg8::DenseRows, true, LRU_W, 256>(lds, UC, (const bf16_t*)(ws + WS_WG), S, E, pg8::DenseRows{}, wave); }
        { pg8::SmallOrder<1> S{G, bid}; pg8::EpiBf16 E{(bf16_t*)(ws + WS_LOUT), 3072};
          pg8::gemm_phase<pg8::EpiBf16, pg8::SmallOrder<1>, pg8::DenseRows, true, 512, 256>(lds, XL, (const bf16_t*)(ws + WS_WL), S, E, pg8::DenseRows{}, wave); }
    }
    SEAM(3);

    if (IN(4)) {
        LANE_TID();
        constexpr int RS = 144;
        constexpr int L_AT = 0, L_BT = 9216, L_KT = 18432, L_RT = 27648, L_VT = 36864, L_BH = 46080, L_KH = 55296, L_AAB = 64512, L_AAK = 80896, L_ARB = 90112, L_ARK = 99328,
                      L_PT = 108544, L_QT = 117760, L_WC = 126976, L_SEG = 127232, L_A16 = 129280, L_TB = 138496, L_U = L_BT, L_MST = L_AT, L_GST = L_BT;
        bf16_t* MT = (bf16_t*)(ws + WS_MT); bf16_t* GG = (bf16_t*)(ws + WS_GG); float* NN = (float*)(ws + WS_NN); float* HH = (float*)(ws + WS_HH);
        const bf16_t* LOUT = (const bf16_t*)(ws + WS_LOUT); bf16_t* V16 = (bf16_t*)(ws + WS_V16); bf16_t* G16 = (bf16_t*)(ws + WS_G16); const float* mu_ = args.in[I_MU];
        const int r = lane & 31, hh = lane >> 5;
        unsigned short xr[9], xk[9], xv[9], xd[8], xa[8], xg[8];
#define E_LOAD(u_) do { const int cch_ = (u_) & 63, head_ = ((u_) >> 6) & 15, b_ = (u_) >> 10; const size_t tokb_ = (size_t)b_ * SEQ + cch_ * 64 + 8 * wave; const int c_ = head_ * HS + lane; \
            const bf16_t* pp_ = P + tokb_ * NPP + 2 * LRU_W + c_; const bool hp_ = ((cch_ * 64 + 8 * wave) & (SEQ - 1)) != 0; \
            xr[0] = hp_ ? pp_[-NPP] : (unsigned short)0; xk[0] = hp_ ? pp_[-NPP + RW_W] : (unsigned short)0; xv[0] = hp_ ? pp_[-NPP + 2 * RW_W] : (unsigned short)0; \
            _Pragma("unroll") for (int j = 0; j < 8; ++j) { const bf16_t* pj = pp_ + (size_t)j * NPP; xr[j + 1] = pj[0]; xk[j + 1] = pj[RW_W]; xv[j + 1] = pj[2 * RW_W]; \
                const bf16_t* lj = LOUT + (tokb_ + j) * 3072 + c_; xd[j] = lj[0]; xa[j] = lj[1024]; xg[j] = lj[2048]; } } while (0)
        if (bid < NUNIT) E_LOAD(bid);
        REP(4) for (int u = bid; u < NUNIT; u += G) {
            const int cch = u & 63, head = (u >> 6) & 15, b = u >> 10; const size_t tok0 = (size_t)b * SEQ + cch * 64;
            { const int ch = lane, tg = wave, c = head * HS + ch; const size_t tokb = tok0 + 8 * tg;
                float lw[8], rr_[8], kk_[8], vv_[8], kn_[8], aa_[8];
                { const float mur = mu_[c], muk = mu_[RW_W + c], muv = mu_[2 * RW_W + c];
                    const float w0c = args.in[I_W0][c], a0c = args.in[I_A0][c], kkc = args.in[I_KK][c], kac = args.in[I_KA][c], rkc = args.in[I_RK][c];
                    float bonv[8];
#pragma unroll
                    for (int j = 0; j < 8; ++j) { const float cr = bf2f(xr[j + 1]), ck = bf2f(xk[j + 1]), cv = bf2f(xv[j + 1]), pr = bf2f(xr[j]), pk_ = bf2f(xk[j]), pvv = bf2f(xv[j]);
                        const float r = cr + (pr - cr) * mur, k = ck + (pk_ - ck) * muk, v = cv + (pvv - cv) * muv;
                        const float lgw = -0.6065306597126334f * sigmoidf_(w0c + bf2f(xd[j]));
                        const float a = sigmoidf_(a0c + bf2f(xa[j]));
                        float kk = k * kkc; kk = kk * __builtin_amdgcn_rsqf(fmaxf(wave_sum(kk * kk), 1e-24f));
                        const float km = k * (1.f + (a - 1.f) * kac);
                        bonv[j] = wave_sum(r * km * rkc);
                        lw[j] = lgw; rr_[j] = r; kk_[j] = km; vv_[j] = v; kn_[j] = kk; aa_[j] = a; }
#pragma unroll
                    for (int j = 0; j < 8; ++j) { V16[(tokb + j) * RW_W + c] = cvt1(vv_[j]); G16[(tokb + j) * RW_W + c] = xg[j]; }
                    if (lane < 8) { float bsel = bonv[0];
#pragma unroll
                        for (int j = 1; j < 8; ++j) bsel = (lane == j) ? bonv[j] : bsel;
                        BON[(tokb + lane) * NHEAD + head] = bsel; }
                    if (u + G < NUNIT) E_LOAD(u + G); }
                float seg = 0.f;
#pragma unroll
                for (int j = 0; j < 8; ++j) seg += lw[j];
                ((LAS float*)(lds + L_SEG))[tg * 64 + ch] = seg;
                __syncthreads();
                float pre = 0.f, tot = 0.f;
#pragma unroll
                for (int g = 0; g < 8; ++g) { const float sg_ = ((LAS float*)(lds + L_SEG))[g * 64 + ch]; tot += sg_; if (g < tg) pre += sg_; }
                if (tg == 0) ((LAS float*)(lds + L_WC))[ch] = __expf(tot);
                float L = pre; unsigned pv[4], pb[4], pk[4]; float tv[8], tb_[8], tk[8];
                const float eTot = __expf(tot); float eLex = __expf(pre);
#pragma unroll
                for (int j = 0; j < 8; ++j) { L += lw[j];
                    const float eL = __expf(L), eNL = __builtin_amdgcn_rcpf(eL), eEnd = eTot * eNL; const float beta = kn_[j] * aa_[j];
                    const int t = 8 * tg + j;
                    *(LAS unsigned short*)(lds + L_AT + t * RS + ch * 2) = cvt1(kn_[j] * eLex);
                    *(LAS unsigned short*)(lds + L_BT + t * RS + ch * 2) = cvt1(beta * eNL);
                    *(LAS unsigned short*)(lds + L_KT + t * RS + ch * 2) = cvt1(kk_[j] * eNL);
                    *(LAS unsigned short*)(lds + L_RT + t * RS + ch * 2) = cvt1(rr_[j] * eL);
                    tv[j] = vv_[j]; tb_[j] = -beta * eEnd; tk[j] = kk_[j] * eEnd; eLex = eL; }
#pragma unroll
                for (int j = 0; j < 4; ++j) { pv[j] = cvt2(tv[2 * j], tv[2 * j + 1]); pb[j] = cvt2(tb_[2 * j], tb_[2 * j + 1]); pk[j] = cvt2(tk[2 * j], tk[2 * j + 1]); }
                *(LAS u32x4*)(lds + L_VT + ch * RS + tg * 16) = (u32x4){pv[0], pv[1], pv[2], pv[3]};
                *(LAS u32x4*)(lds + L_BH + ch * RS + tg * 16) = (u32x4){pb[0], pb[1], pb[2], pb[3]};
                *(LAS u32x4*)(lds + L_KH + ch * RS + tg * 16) = (u32x4){pk[0], pk[1], pk[2], pk[3]};
            }
            __syncthreads();
            { const int id = wave >> 1, i = wave & 1; const int X = (id < 2) ? L_AT : L_RT, Y = (id & 1) ? L_KT : L_BT;
                f32x16 acc[2];
#pragma unroll
                for (int q = 0; q < 2; ++q)
#pragma unroll
                    for (int e = 0; e < 16; ++e) acc[q][e] = 0.f;
#pragma unroll
                for (int s = 0; s < 4; ++s) { const bf16x8 a = *(const LAS bf16x8*)(lds + X + (32 * i + r) * RS + (16 * s + 8 * hh) * 2);
#pragma unroll
                    for (int q = 0; q < 2; ++q) { const bf16x8 bb = *(const LAS bf16x8*)(lds + Y + (32 * q + r) * RS + (16 * s + 8 * hh) * 2); acc[q] = MFMA32(a, bb, acc[q]); } }
#pragma unroll
                for (int q = 0; q < 2; ++q)
#pragma unroll
                    for (int e = 0; e < 16; ++e) { const int t = 32 * i + crow(e, hh), sc = 32 * q + r; const bool keep = (id < 2) ? (sc < t) : (sc <= t);
                        float val = keep ? acc[q][e] : 0.f; if (id == 2) val = -val;
                        if (id == 0) { ((LAS float*)(lds + L_AAB))[t * 64 + sc] = val; *(LAS unsigned short*)(lds + L_A16 + t * RS + sc * 2) = cvt1(-val); }
                        else *(LAS unsigned short*)(lds + L_AAK + (id - 1) * 9216 + t * RS + sc * 2) = cvt1(val); }
            }
            __syncthreads();
            if (wave < 4) { const int i = wave >> 1, q = wave & 1; f32x16 acc;
#pragma unroll
                for (int e = 0; e < 16; ++e) acc[e] = 0.f;
#pragma unroll
                for (int s = 0; s < 4; ++s) { const bf16x8 a = *(const LAS bf16x8*)(lds + L_AAK + (32 * i + r) * RS + (16 * s + 8 * hh) * 2);
                    const bf16x8 bb = *(const LAS bf16x8*)(lds + L_VT + (32 * q + r) * RS + (16 * s + 8 * hh) * 2); acc = MFMA32(a, bb, acc); }
#pragma unroll
                for (int e = 0; e < 16; ++e) ((LAS float*)(lds + L_U))[(32 * i + crow(e, hh)) * 64 + 32 * q + r] = acc[e];
            }
            if (wave == 4) { const int b2 = lane >> 4, j = lane & 15; float x[16];
                const LAS float* AB = (const LAS float*)(lds + L_AAB) + (16 * b2) * 64 + 16 * b2;
#pragma unroll
                for (int t = 0; t < 16; ++t) { float s_ = (t == j) ? 1.f : 0.f;
#pragma unroll
                    for (int s4 = 0; s4 < (t + 3) / 4; ++s4) { const f32x4 A4 = *(const LAS f32x4*)(AB + t * 64 + 4 * s4);
#pragma unroll
                        for (int e = 0; e < 4; ++e) if (4 * s4 + e < t) s_ -= A4[e] * x[4 * s4 + e]; }
                    x[t] = s_; }
#pragma unroll
                for (int t = 0; t < 16; ++t) *(LAS unsigned short*)(lds + L_TB + ((b2 * 16 + t) * 16 + j) * 2) = cvt1(x[t]);
            }
            __syncthreads();
            { const int c16 = lane & 15, quad = lane >> 4, isQ = wave >> 2, colb = 16 * (wave & 3) + c16;
                f32x4 Xr[4];
#pragma unroll
                for (int b2 = 0; b2 < 4; ++b2) Xr[b2] = (f32x4){0.f, 0.f, 0.f, 0.f};
#pragma unroll
                for (int b2 = 0; b2 < 4; ++b2) {
                    f32x4 y;
#pragma unroll
                    for (int g = 0; g < 4; ++g) { const int row = 16 * b2 + 4 * quad + g;
                        y[g] = isQ ? ((const LAS float*)(lds + L_U))[row * 64 + colb] : bf2f(*(const LAS unsigned short*)(lds + L_AT + row * RS + colb * 2)); }
#pragma unroll
                    for (int ks = 0; ks < 2; ++ks) if (2 * ks < b2) {
                        const u32x2 alo = *(const LAS u32x2*)(lds + L_A16 + (16 * b2 + c16) * RS + (32 * ks + 4 * quad) * 2);
                        u32x2 ahi = {0u, 0u}; if (2 * ks + 1 < b2) ahi = *(const LAS u32x2*)(lds + L_A16 + (16 * b2 + c16) * RS + (32 * ks + 16 + 4 * quad) * 2);
                        const u32x4 af = {alo.x, alo.y, ahi.x, ahi.y};
                        const u32x4 bf = {cvt2(Xr[2 * ks][0], Xr[2 * ks][1]), cvt2(Xr[2 * ks][2], Xr[2 * ks][3]), cvt2(Xr[2 * ks + 1][0], Xr[2 * ks + 1][1]), cvt2(Xr[2 * ks + 1][2], Xr[2 * ks + 1][3])};
                        y = __builtin_amdgcn_mfma_f32_16x16x32_bf16(__builtin_bit_cast(bf16x8, af), __builtin_bit_cast(bf16x8, bf), y, 0, 0, 0); }
                    const u32x2 tlo = *(const LAS u32x2*)(lds + L_TB + ((b2 * 16 + c16) * 16 + 4 * quad) * 2);
                    const u32x4 tf = {tlo.x, tlo.y, 0u, 0u};
                    const u32x4 yf = {cvt2(y[0], y[1]), cvt2(y[2], y[3]), 0u, 0u};
                    Xr[b2] = __builtin_amdgcn_mfma_f32_16x16x32_bf16(__builtin_bit_cast(bf16x8, tf), __builtin_bit_cast(bf16x8, yf), (f32x4){0.f, 0.f, 0.f, 0.f}, 0, 0, 0);
                    *(LAS u32x2*)(lds + (isQ ? L_QT : L_PT) + colb * RS + (16 * b2 + 4 * quad) * 2) = (u32x2){cvt2(Xr[b2][0], Xr[b2][1]), cvt2(Xr[b2][2], Xr[b2][3])};
                }
            }
            __syncthreads();
            { const int mtx = wave >> 1, i = wave & 1;
                const int X1 = (mtx == 0) ? L_BH : (mtx == 1) ? L_KH : (mtx == 2) ? L_ARB : L_ARK;
                const int Y1 = (mtx == 0 || mtx == 2) ? L_PT : L_VT;
                f32x16 acc[2];
#pragma unroll
                for (int q = 0; q < 2; ++q)
#pragma unroll
                    for (int e = 0; e < 16; ++e) acc[q][e] = 0.f;
#pragma unroll
                for (int s = 0; s < 4; ++s) { const bf16x8 a = *(const LAS bf16x8*)(lds + X1 + (32 * i + r) * RS + (16 * s + 8 * hh) * 2);
#pragma unroll
                    for (int q = 0; q < 2; ++q) { const bf16x8 bb = *(const LAS bf16x8*)(lds + Y1 + (32 * q + r) * RS + (16 * s + 8 * hh) * 2); acc[q] = MFMA32(a, bb, acc[q]); } }
                if (mtx & 1) { const int X2 = (mtx == 1) ? L_BH : L_ARB;
#pragma unroll
                    for (int s = 0; s < 4; ++s) { const bf16x8 a = *(const LAS bf16x8*)(lds + X2 + (32 * i + r) * RS + (16 * s + 8 * hh) * 2);
#pragma unroll
                        for (int q = 0; q < 2; ++q) { const bf16x8 bb = *(const LAS bf16x8*)(lds + L_QT + (32 * q + r) * RS + (16 * s + 8 * hh) * 2); acc[q] = MFMA32(a, bb, acc[q]); } } }
                if (mtx == 0) { const float wc = ((const LAS float*)(lds + L_WC))[32 * i + r];
#pragma unroll
                    for (int q = 0; q < 2; ++q)
#pragma unroll
                        for (int e = 0; e < 16; ++e) if (q == i && crow(e, hh) == r) acc[q][e] += wc; }
                if (mtx == 2) {
#pragma unroll
                    for (int q = 0; q < 2; ++q)
#pragma unroll
                        for (int e = 0; e < 16; ++e) acc[q][e] += bf2f(*(const LAS unsigned short*)(lds + L_RT + (32 * i + crow(e, hh)) * RS + (32 * q + r) * 2)); }
                if (mtx & 1) { unsigned* dstg = (unsigned*)((mtx == 1) ? NN : HH) + (size_t)u * 2048;
#pragma unroll
                    for (int q = 0; q < 2; ++q)
#pragma unroll
                        for (int e = 0; e < 16; e += 2) dstg[((i * 2 + q) * 8 + (e >> 1)) * 64 + lane] = cvt2(acc[q][e], acc[q][e + 1]);
                } else { const int dl = (mtx == 0) ? L_MST : L_GST;
#pragma unroll
                    for (int q = 0; q < 2; ++q)
#pragma unroll
                        for (int e = 0; e < 16; ++e) *(LAS unsigned short*)(lds + dl + (32 * i + crow(e, hh)) * RS + (32 * q + r) * 2) = cvt1(acc[q][e]); }
            }
            __syncthreads();
            { const int f = tid >> 6, i = f >> 2, q = (f >> 1) & 1, s = f & 1, r2 = lane & 31, h2 = lane >> 5; const int off = (32 * i + r2) * RS + (32 * q + 16 * s + 4 * h2) * 2;
                const u32x2 m0 = *(const LAS u32x2*)(lds + L_MST + off), m1 = *(const LAS u32x2*)(lds + L_MST + off + 16);
                const u32x2 g0 = *(const LAS u32x2*)(lds + L_GST + off), g1 = *(const LAS u32x2*)(lds + L_GST + off + 16);
                *(u32x4*)(MT + (size_t)u * 4096 + tid * 8) = (u32x4){m0.x, m0.y, m1.x, m1.y};
                *(u32x4*)(GG + (size_t)u * 4096 + tid * 8) = (u32x4){g0.x, g0.y, g1.x, g1.y}; }
            __syncthreads();
        }
        { float* CA = (float*)(ws + WS_CA); float* CH = (float*)(ws + WS_CH); const bf16_t* UC = (const bf16_t*)(ws + WS_UC); const bf16_t* GATES = (const bf16_t*)(ws + WS_GATES);
            for (int bc = bid; bc < BATCH * 64; bc += G) { const size_t tok0 = (size_t)(bc >> 6) * SEQ + (bc & 63) * 64;
                float h[2] = {0.f, 0.f}, A[2] = {1.f, 1.f}, br[2], bi[2], sp[2];
#pragma unroll
                for (int cc = 0; cc < 2; ++cc) { const int c = tid + 512 * cc; br[cc] = args.in[I_BRG][c]; bi[cc] = args.in[I_BIG][c]; const float lam = args.in[I_LAMBDA][c];
                    sp[cc] = lam > 15.f ? __expf(-lam) : log1pf(__expf(-lam)); }
                unsigned short gr[2][8], gi[2][8], uc[2][8];
#define LRU_LOAD(t_) do { _Pragma("unroll") for (int cc = 0; cc < 2; ++cc) _Pragma("unroll") for (int j = 0; j < 8; ++j) { const size_t tk = tok0 + (t_) + j; const int c = tid + 512 * cc; \
                    gr[cc][j] = GATES[tk * 2048 + c]; gi[cc][j] = GATES[tk * 2048 + LRU_W + c]; uc[cc][j] = UC[tk * LRU_W + c]; } } while (0)
                LRU_LOAD(0);
#pragma unroll 1
                for (int t = 0; t < 64; t += 8) {
                    float hv[2][8], av[2][8];
#pragma unroll
                    for (int cc = 0; cc < 2; ++cc)
#pragma unroll
                        for (int j = 0; j < 8; ++j) { const float rg = sigmoidf_(bf2f(gr[cc][j]) + br[cc]), ig = sigmoidf_(bf2f(gi[cc][j]) + bi[cc]);
                            const float a = __expf(-8.f * rg * sp[cc]), bb = sqrtf(fmaxf(1.f - a * a, 0.f)) * (ig * bf2f(uc[cc][j]));
                            h[cc] = a * h[cc] + bb; A[cc] *= a; hv[cc][j] = h[cc]; av[cc][j] = A[cc]; }
                    if (t + 8 < 64) LRU_LOAD(t + 8);
#pragma unroll
                    for (int cc = 0; cc < 2; ++cc)
#pragma unroll
                        for (int j = 0; j < 8; ++j) { const int c = tid + 512 * cc; ((bf16_t*)LB)[(tok0 + t + j) * LRU_W + c] = cvt1(hv[cc][j]); ((bf16_t*)LA)[(tok0 + t + j) * LRU_W + c] = cvt1(av[cc][j]); }
                }
#undef LRU_LOAD
#pragma unroll
                for (int cc = 0; cc < 2; ++cc) { const int c = tid + 512 * cc; CA[(size_t)bc * LRU_W + c] = A[cc]; CH[(size_t)bc * LRU_W + c] = h[cc]; } } }
    }
    SEAM(4);

    if (IN(5)) REP(5) {
        LANE_TID();
        if (bid < BATCH * NHEAD) {
            const bf16_t* MT = (const bf16_t*)(ws + WS_MT); const float* NN = (const float*)(ws + WS_NN); bf16_t* XS = (bf16_t*)(ws + WS_XS);
            constexpr int SLOT = 16384, NCH = SEQ / 64;
            const int u0 = bid * NCH;
            if (wave >= 2) {
                const int lw = wave - 2;
#define R2_ISSUE(c_) do { if (lw < 4) { const int _u = u0 + (c_); const int _sl = ((c_) & 3) * SLOT; _Pragma("unroll") for (int _rd = 0; _rd < 4; ++_rd) { const int _k0 = _rd * 256 + lw * 64; \
                    const char* _src = (_k0 < 512) ? (const char*)MT + (size_t)_u * 8192 + (size_t)(_k0 + lane) * 16 : (const char*)NN + (size_t)_u * 8192 + (size_t)(_k0 - 512 + lane) * 16; \
                    __builtin_amdgcn_global_load_lds((const unsigned*)_src, (LAS unsigned*)(lds + _sl + _k0 * 16), 16, 0, 0); } } } while (0)
                R2_ISSUE(0); R2_ISSUE(1); R2_ISSUE(2);
                for (int c = 0; c < NCH; ++c) {
                    if (c < NCH - 2) asm volatile("s_waitcnt vmcnt(8)" ::: "memory"); else if (c == NCH - 2) asm volatile("s_waitcnt vmcnt(4)" ::: "memory"); else asm volatile("s_waitcnt vmcnt(0)" ::: "memory");
                    __builtin_amdgcn_s_barrier();
                    asm volatile("" ::: "memory");
                    if (c + 3 < NCH) R2_ISSUE(c + 3);
                }
#undef R2_ISSUE
            } else {
                const int vh = wave;
                f32x16 X[2];
#pragma unroll
                for (int q = 0; q < 2; ++q)
#pragma unroll
                    for (int e = 0; e < 16; ++e) X[q][e] = 0.f;
                for (int c = 0; c < NCH; ++c) {
                    bf16x8 xb[2][2];
#pragma unroll
                    for (int q = 0; q < 2; ++q)
#pragma unroll
                        for (int s = 0; s < 2; ++s) { const u32x4 p = {cvt2(X[q][8 * s], X[q][8 * s + 1]), cvt2(X[q][8 * s + 2], X[q][8 * s + 3]), cvt2(X[q][8 * s + 4], X[q][8 * s + 5]), cvt2(X[q][8 * s + 6], X[q][8 * s + 7])};
                            xb[q][s] = __builtin_bit_cast(bf16x8, p);
                            *(u32x4*)(XS + (size_t)(u0 + c) * 4096 + (((vh * 2 + q) * 2 + s) * 64 + lane) * 8) = p; }
                    asm volatile("" ::: "memory");
                    __builtin_amdgcn_s_barrier();
                    asm volatile("" ::: "memory");
                    const LAS unsigned char* sl = lds + (c & 3) * SLOT;
#pragma unroll
                    for (int i = 0; i < 2; ++i) { f32x16 nx;
#pragma unroll
                        for (int e = 0; e < 16; e += 2) { const unsigned w_ = ((const LAS unsigned*)(sl + 8192))[((i * 2 + vh) * 8 + (e >> 1)) * 64 + lane]; nx[e] = bflo(w_); nx[e + 1] = bfhi(w_); }
#pragma unroll
                        for (int q = 0; q < 2; ++q)
#pragma unroll
                            for (int s = 0; s < 2; ++s) { const bf16x8 a = *(const LAS bf16x8*)(sl + ((i * 2 + q) * 2 + s) * 1024 + lane * 16); nx = MFMA32(a, xb[q][s], nx); }
                        X[i] = nx; }
                    asm volatile("s_waitcnt lgkmcnt(0)" ::: "memory");
                }
            }
        } else if (bid >= BATCH * NHEAD + 8) {
            const int nb_ = G - (BATCH * NHEAD + 8);
            for (int it = CV_NITEMS - CV_SHADOW + (bid - (BATCH * NHEAD + 8)) * NWAVES + wave; it < CV_NITEMS; it += nb_ * NWAVES) CONVERT_ITEM(it);
        } else {
            const float* CA = (const float*)(ws + WS_CA); const float* CH = (const float*)(ws + WS_CH); float* CIN = (float*)(ws + WS_CIN);
            const int i = (bid - BATCH * NHEAD) * NTHREADS + tid, b = i >> 10, c = i & 1023; float s = 0.f;
            for (int ch = 0; ch < 64; ch += 8) { float a[8], hh_[8];
#pragma unroll
                for (int j = 0; j < 8; ++j) { a[j] = CA[(size_t)(b * 64 + ch + j) * LRU_W + c]; hh_[j] = CH[(size_t)(b * 64 + ch + j) * LRU_W + c]; }
#pragma unroll
                for (int j = 0; j < 8; ++j) { CIN[(size_t)(b * 64 + ch + j) * LRU_W + c] = s; s = a[j] * s + hh_[j]; } }
        }
    }
    SEAM(5);

    if (IN(6)) REP(6) {
        LANE_TID();
        { const float* CIN = (const float*)(ws + WS_CIN);
            for (int idx = gt; idx < M * (LRU_W / 8); idx += NGT) { const int m = idx >> 7, c = (idx & 127) * 8; const size_t o = (size_t)m * LRU_W + c;
                const u32x4 gq = *(const u32x4*)(P + (size_t)m * NPP + LRU_W + c);
                const u32x4 hq = *(const u32x4*)((const bf16_t*)LB + o), aq = *(const u32x4*)((const bf16_t*)LA + o);
                const f32x4 h0 = {bflo(hq.x), bfhi(hq.x), bflo(hq.y), bfhi(hq.y)}, h1 = {bflo(hq.z), bfhi(hq.z), bflo(hq.w), bfhi(hq.w)}, a0 = {bflo(aq.x), bfhi(aq.x), bflo(aq.y), bfhi(aq.y)}, a1 = {bflo(aq.z), bfhi(aq.z), bflo(aq.w), bfhi(aq.w)};
                const f32x4 c0 = *(const f32x4*)(CIN + (size_t)(m >> 6) * LRU_W + c), c1 = *(const f32x4*)(CIN + (size_t)(m >> 6) * LRU_W + c + 4);
                const unsigned gw_[4] = {gq.x, gq.y, gq.z, gq.w}; float o8[8];
#pragma unroll
                for (int e = 0; e < 4; ++e) { const float hA = (e < 2 ? h0[2 * e] : h1[2 * e - 4]) + (e < 2 ? a0[2 * e] : a1[2 * e - 4]) * (e < 2 ? c0[2 * e] : c1[2 * e - 4]);
                    const float hB = (e < 2 ? h0[2 * e + 1] : h1[2 * e - 3]) + (e < 2 ? a0[2 * e + 1] : a1[2 * e - 3]) * (e < 2 ? c0[2 * e + 1] : c1[2 * e - 3]);
                    o8[2 * e] = hA * gelu_tanh(bflo(gw_[e])); o8[2 * e + 1] = hB * gelu_tanh(bfhi(gw_[e])); }
                *(u32x4*)(CAT + (size_t)m * D + c) = (u32x4){cvt2(o8[0], o8[1]), cvt2(o8[2], o8[3]), cvt2(o8[4], o8[5]), cvt2(o8[6], o8[7])}; } }
        const bf16_t* GG = (const bf16_t*)(ws + WS_GG); const bf16_t* XS = (const bf16_t*)(ws + WS_XS); const float* HH = (const float*)(ws + WS_HH);
        const bf16_t* V16 = (const bf16_t*)(ws + WS_V16); const bf16_t* G16 = (const bf16_t*)(ws + WS_G16);
        const float* gng = args.in[I_GNG]; const float* gnb = args.in[I_GNB];
        const int r = lane & 31, hh = lane >> 5;
        constexpr int YS = 68;
        LAS float* yt = (LAS float*)(lds + wave * (64 * YS * 4));
        for (int u = gw; u < NUNIT; u += NGW) {
            const int cch = u & 63, head = (u >> 6) & 15, b = u >> 10; const size_t tok0 = (size_t)b * SEQ + cch * 64;
            f32x16 acc[2][2];
#pragma unroll
            for (int i = 0; i < 2; ++i)
#pragma unroll
                for (int vh = 0; vh < 2; ++vh)
#pragma unroll
                    for (int e = 0; e < 16; e += 2) { const unsigned w_ = ((const unsigned*)HH)[(size_t)u * 2048 + ((i * 2 + vh) * 8 + (e >> 1)) * 64 + lane]; acc[i][vh][e] = bflo(w_); acc[i][vh][e + 1] = bfhi(w_); }
#pragma unroll
            for (int q = 0; q < 2; ++q)
#pragma unroll
                for (int s = 0; s < 2; ++s) { bf16x8 xb[2], ga[2];
#pragma unroll
                    for (int vh = 0; vh < 2; ++vh) xb[vh] = *(const bf16x8*)(XS + (size_t)u * 4096 + (((vh * 2 + q) * 2 + s) * 64 + lane) * 8);
#pragma unroll
                    for (int i = 0; i < 2; ++i) ga[i] = *(const bf16x8*)(GG + (size_t)u * 4096 + (((i * 2 + q) * 2 + s) * 64 + lane) * 8);
#pragma unroll
                    for (int i = 0; i < 2; ++i)
#pragma unroll
                        for (int vh = 0; vh < 2; ++vh) acc[i][vh] = MFMA32(ga[i], xb[vh], acc[i][vh]); }
#pragma unroll
            for (int i = 0; i < 2; ++i)
#pragma unroll
                for (int e = 0; e < 16; ++e) {
                    const float s1 = half_sum(acc[i][0][e] + acc[i][1][e], hh);
                    const float mean = s1 * (1.f / 64.f);
                    const float d0 = acc[i][0][e] - mean, d1 = acc[i][1][e] - mean; const float s2 = half_sum(d0 * d0 + d1 * d1, hh);
                    const float rstd = __builtin_amdgcn_rsqf(s2 * (1.f / 64.f) + GN_EPS);
                    const int t = 32 * i + crow(e, hh);
                    yt[t * YS + r] = d0 * rstd; yt[t * YS + 32 + r] = d1 * rstd; }
            asm volatile("s_waitcnt lgkmcnt(0)" ::: "memory");
            { const int tq = lane >> 3, c8 = (lane & 7) * 8, ch = head * HS + c8;
                const f32x4 g0 = *(const f32x4*)(gng + ch), g1 = *(const f32x4*)(gng + ch + 4), b0 = *(const f32x4*)(gnb + ch), b1 = *(const f32x4*)(gnb + ch + 4);
#pragma unroll 2
                for (int k = 0; k < 8; ++k) { const int t = tq + 8 * k; const size_t tok = tok0 + t; const size_t o = tok * RW_W + ch;
                    const f32x4 y0 = *(const LAS f32x4*)(yt + t * YS + c8), y1 = *(const LAS f32x4*)(yt + t * YS + c8 + 4);
                    const u32x4 vq = *(const u32x4*)(V16 + o), gq = *(const u32x4*)(G16 + o); const float bon = BON[tok * NHEAD + head];
                    const unsigned vw[4] = {vq.x, vq.y, vq.z, vq.w}, gw4[4] = {gq.x, gq.y, gq.z, gq.w}; float o8[8];
#pragma unroll
                    for (int e = 0; e < 4; ++e) { const float ya = (e < 2 ? y0[2 * e] : y1[2 * e - 4]), yb = (e < 2 ? y0[2 * e + 1] : y1[2 * e - 3]);
                        const float ga_ = (e < 2 ? g0[2 * e] : g1[2 * e - 4]), gb_ = (e < 2 ? g0[2 * e + 1] : g1[2 * e - 3]), ba_ = (e < 2 ? b0[2 * e] : b1[2 * e - 4]), bb_ = (e < 2 ? b0[2 * e + 1] : b1[2 * e - 3]);
                        o8[2 * e] = (ya * ga_ + ba_ + bon * bflo(vw[e])) * bflo(gw4[e]); o8[2 * e + 1] = (yb * gb_ + bb_ + bon * bfhi(vw[e])) * bfhi(gw4[e]); }
                    *(u32x4*)(CAT + tok * D + LRU_W + ch) = (u32x4){cvt2(o8[0], o8[1]), cvt2(o8[2], o8[3]), cvt2(o8[4], o8[5]), cvt2(o8[6], o8[7])}; } }
            asm volatile("s_waitcnt lgkmcnt(0)" ::: "memory");
        }
    }
    SEAM(6);

    if (IN(7)) REP(7) {
        LANE_TID();
        pg8::StaticOrder S; S.init(M, D, G, bid);
        pg8::EpiResF32 E{Z, XN, DN_ALPHA};
        pg8::gemm_phase<pg8::EpiResF32, pg8::StaticOrder, pg8::DenseRows, true>(lds, CAT, WoT, S, E, pg8::DenseRows{}, wave);
    }
    SEAM(7);

    if (IN(8)) {
        LANE_TID();
        constexpr int RSH = 4112;
        constexpr int L_LO = 16 * RSH, L_PART = 2 * 16 * RSH, L_LGT = L_PART + 16384;
        const float* g1 = args.in[I_LN1G]; const float* b1 = args.in[I_LN1B]; const float* br_ = args.in[I_BROUTER];
        const bf16_t* WRH = (const bf16_t*)(ws + WS_WRT); const bf16_t* WRL = WRH + NE * D;
        for (int tile = bid; tile < M / 16; tile += G) {
            const int t0 = tile * 16;
            __syncthreads();
#pragma unroll 1
            for (int rr = 0; rr < 2; ++rr) { const int tb = wave * 2 + rr, m = t0 + tb;
                const f32x4* zr = (const f32x4*)(Z + (size_t)m * D) + lane;
                f32x4 v[8]; float s = 0.f;
#pragma unroll
                for (int j = 0; j < 8; ++j) { v[j] = zr[64 * j]; s += (v[j][0] + v[j][1]) + (v[j][2] + v[j][3]); }
                const float mean = wave_sum(s) * (1.f / D); float s2 = 0.f;
#pragma unroll
                for (int j = 0; j < 8; ++j) { v[j] = v[j] - mean; s2 += (v[j][0] * v[j][0] + v[j][1] * v[j][1]) + (v[j][2] * v[j][2] + v[j][3] * v[j][3]); }
                const float rstd = __builtin_amdgcn_rsqf(wave_sum(s2) * (1.f / D) + LN_EPS);
                u32x2* ho = (u32x2*)((bf16_t*)H1 + (size_t)m * D) + lane; unsigned* hb = (unsigned*)(H1F + (size_t)m * D) + lane;
#pragma unroll
                for (int j = 0; j < 8; ++j) { const f32x4 g4 = ((const f32x4*)g1)[64 * j + lane], b4 = ((const f32x4*)b1)[64 * j + lane]; const f32x4 y = v[j] * rstd * g4 + b4;
                    const u32x2 hi = {cvt2(y[0], y[1]), cvt2(y[2], y[3])};
                    const u32x2 lo = {cvt2(y[0] - bflo(hi.x), y[1] - bfhi(hi.x)), cvt2(y[2] - bflo(hi.y), y[3] - bfhi(hi.y))};
                    ho[64 * j] = hi; hb[64 * j] = pk4_f8(y[0] * F8_SH, y[1] * F8_SH, y[2] * F8_SH, y[3] * F8_SH);
                    *(LAS u32x2*)(lds + tb * RSH + 512 * j + 8 * lane) = hi; *(LAS u32x2*)(lds + L_LO + tb * RSH + 512 * j + 8 * lane) = lo; } }
            __syncthreads();
            { const int c16 = lane & 15, q4 = lane >> 4; f32x4 acc[2] = {{0.f, 0.f, 0.f, 0.f}, {0.f, 0.f, 0.f, 0.f}};
#pragma unroll 2
                for (int kk = 0; kk < 8; ++kk) { const int k0 = 32 * (8 * wave + kk) + 8 * q4;
                    const bf16x8 hh = *(const LAS bf16x8*)(lds + c16 * RSH + k0 * 2), hl = *(const LAS bf16x8*)(lds + L_LO + c16 * RSH + k0 * 2);
#pragma unroll
                    for (int hf = 0; hf < 2; ++hf) { const bf16x8 wh = *(const bf16x8*)(WRH + (size_t)(hf * 16 + c16) * D + k0), wl = *(const bf16x8*)(WRL + (size_t)(hf * 16 + c16) * D + k0);
                        acc[hf] = __builtin_amdgcn_mfma_f32_16x16x32_bf16(wh, hh, acc[hf], 0, 0, 0);
                        acc[hf] = __builtin_amdgcn_mfma_f32_16x16x32_bf16(wl, hh, acc[hf], 0, 0, 0);
                        acc[hf] = __builtin_amdgcn_mfma_f32_16x16x32_bf16(wh, hl, acc[hf], 0, 0, 0); } }
#pragma unroll
                for (int hf = 0; hf < 2; ++hf)
#pragma unroll
                    for (int g = 0; g < 4; ++g) ((LAS float*)(lds + L_PART))[((wave * 2 + hf) * 4 + g) * 64 + lane] = acc[hf][g]; }
            __syncthreads();
            { const int tk = tid & 15, e = tid >> 4, hf = e >> 4, el = e & 15; float sacc = br_[e];
#pragma unroll
                for (int w = 0; w < 8; ++w) sacc += ((const LAS float*)(lds + L_PART))[((w * 2 + hf) * 4 + (el & 3)) * 64 + tk + 16 * (el >> 2)];
                ((LAS float*)(lds + L_LGT))[tk * 32 + e] = sacc; }
            __syncthreads();
            if (tid < 16) { const int m = t0 + tid; float bv[4]; int bi[4]; unsigned used = 0u; const LAS float* lgt = (const LAS float*)(lds + L_LGT);
#pragma unroll 1
                for (int k = 0; k < 4; ++k) { float best = -3.0e38f; int be = 0;
                    for (int e = 0; e < NE; ++e) { const float x = lgt[tid * 32 + e]; if (!((used >> e) & 1u) && x > best) { best = x; be = e; } }
                    used |= 1u << be; bv[k] = best; bi[k] = be; }
                float ex[4], den = 0.f;
#pragma unroll
                for (int k = 0; k < 4; ++k) { ex[k] = __expf(bv[k] - bv[0]); den += ex[k]; }
#pragma unroll 1
                for (int k = 0; k < 4; ++k) { const int pos = (int)__hip_atomic_fetch_add(ctl + CW_CNT + 64 * bi[k], 1u, RLX_AGENT);
                    TOPE[m * 4 + k] = bi[k]; TOPP[m * 4 + k] = pos; TOPG[m * 4 + k] = ex[k] / den; } }
        }
    }
    SEAM(8);

    if (IN(9)) REP(9) {
        LANE_TID();
        volatile LAS int* tb = (volatile LAS int*)(MISC + 16);
        moe_tables(tb, ctl, wave);
        for (int i = gt; i < M * TOPK; i += NGT) { const int e = TOPE[i], slot = tb[1 + e] * 256 + TOPP[i];
            SLOTTOK[slot] = i >> 2; SLOTG[slot] = TOPG[i]; TOKSLOT[i] = slot; }
        { unsigned char* XG = ws + WS_XG;
            for (int i = bid * NWAVES + wave; i < M * TOPK; i += NGW) { const int e = TOPE[i], slot = tb[1 + e] * 256 + TOPP[i];
                const u32x4* s_ = (const u32x4*)(H1F + (size_t)(i >> 2) * D) + lane; u32x4* d_ = (u32x4*)(XG + (size_t)slot * D) + lane;
                const u32x4 v0 = s_[0], v1 = s_[64]; d_[0] = v0; d_[64] = v1; } }
        if (bid < NE) { const int e = bid, c = (int)__hip_atomic_load(ctl + CW_CNT + 64 * e, RLX_AGENT), s0 = tb[1 + e] * 256 + c, s1 = tb[2 + e] * 256;
            for (int s = s0 + tid; s < s1; s += NTHREADS) { SLOTTOK[s] = 0; SLOTG[s] = 0.f; } }
    }
    SEAM(9);

    if (IN(10)) REP(10) {
        LANE_TID();
        volatile LAS int* tb = (volatile LAS int*)(MISC + 16);
        moe_tables(tb, ctl, wave);
        pg8::MoeOrder S{(const LAS int*)(tb + 64), tb[0], 16, G, bid, KD / 128};
        pg8::EpiSwiglu E{ACT, args.in[I_BE1]};
        pg8::gemm_phase<pg8::EpiSwiglu, pg8::MoeOrder, pg8::DenseRows, true, KD / 2, KD / 2, true>(lds, (const bf16_t*)(ws + WS_XG), (const bf16_t*)W1F, S, E, pg8::DenseRows{}, wave);
    }
    SEAM(10);

    if (IN(11)) REP(11) {
        LANE_TID();
        volatile LAS int* tb = (volatile LAS int*)(MISC + 16);
        moe_tables(tb, ctl, wave);
        pg8::MoeOrder S{(const LAS int*)(tb + 64), tb[0], 8, G, bid, KD / 128};
        pg8::EpiMoeOut E{OUTS, args.in[I_BE2], SLOTG};
        pg8::gemm_phase<pg8::EpiMoeOut, pg8::MoeOrder, pg8::DenseRows, true, KD / 2, KD / 2, true>(lds, (const bf16_t*)ACT, (const bf16_t*)W2F, S, E, pg8::DenseRows{}, wave);
    }
    SEAM(11);

    if (IN(12)) REP(12) {
        LANE_TID();
        const float* g2 = args.in[I_LN2G]; const float* b2 = args.in[I_LN2B];
        for (int m = gw; m < M; m += NGW) {
            const u32x2* hr = (const u32x2*)((const bf16_t*)H1 + (size_t)m * D) + lane;
            const int s0 = TOKSLOT[m * 4], s1 = TOKSLOT[m * 4 + 1], s2_ = TOKSLOT[m * 4 + 2], s3 = TOKSLOT[m * 4 + 3];
            const u32x2* o0 = (const u32x2*)(OUTS + (size_t)s0 * D) + lane; const u32x2* o1 = (const u32x2*)(OUTS + (size_t)s1 * D) + lane;
            const u32x2* o2 = (const u32x2*)(OUTS + (size_t)s2_ * D) + lane; const u32x2* o3 = (const u32x2*)(OUTS + (size_t)s3 * D) + lane;
            f32x4 v[8]; float s = 0.f;
#pragma unroll
            for (int j = 0; j < 8; ++j) { const u32x2 hq = hr[64 * j]; const f32x4 h4 = {bflo(hq.x), bfhi(hq.x), bflo(hq.y), bfhi(hq.y)}; const u32x2 a = o0[64 * j], b = o1[64 * j], c = o2[64 * j], d = o3[64 * j];
                f32x4 mo; mo[0] = (bflo(a.x) + bflo(b.x)) + (bflo(c.x) + bflo(d.x)); mo[1] = (bfhi(a.x) + bfhi(b.x)) + (bfhi(c.x) + bfhi(d.x));
                mo[2] = (bflo(a.y) + bflo(b.y)) + (bflo(c.y) + bflo(d.y)); mo[3] = (bfhi(a.y) + bfhi(b.y)) + (bfhi(c.y) + bfhi(d.y));
                v[j] = h4 * DN_ALPHA + mo; s += (v[j][0] + v[j][1]) + (v[j][2] + v[j][3]); }
            const float mean = wave_sum(s) * (1.f / D); float q2 = 0.f;
#pragma unroll
            for (int j = 0; j < 8; ++j) { v[j] = v[j] - mean; q2 += (v[j][0] * v[j][0] + v[j][1] * v[j][1]) + (v[j][2] * v[j][2] + v[j][3] * v[j][3]); }
            const float rstd = 1.f / sqrtf(wave_sum(q2) * (1.f / D) + LN_EPS);
            f32x4* orow = (f32x4*)(args.out + (size_t)m * D) + lane;
#pragma unroll
            for (int j = 0; j < 8; ++j) { const f32x4 g4 = ((const f32x4*)g2)[64 * j + lane], b4 = ((const f32x4*)b2)[64 * j + lane]; orow[64 * j] = v[j] * rstd * g4 + b4; }
        }
    }
    if (PROBE_PHASE >= 0) { if (PROBE_PHASE == NPHASE - 1) tprobe1 = __builtin_amdgcn_s_memrealtime();
        asm volatile("s_waitcnt vmcnt(0)" ::: "memory"); __syncthreads();
        if (bid == 0 && wave == 0 && lane_now() == 0) args.out[0] += 1.0f + (float)(tprobe1 - tprobe0) * 1e-4f; }
#undef IN
#undef SEAM
}

#ifndef MK_ONE_LAUNCH
#define MK_ONE_LAUNCH 1
#endif
extern "C" void kernel_launch(void* const* d_in, const int* in_sizes, int n_in, void* d_out, int out_size, void* d_ws, size_t ws_size, hipStream_t stream) {
    static int grid = 0;
    if (grid == 0) {
        if (n_in != 33 || out_size != M * D || ws_size < WS_END) { fprintf(stderr, "kernel_launch: unexpected sizes n_in %d out %d ws %zu (need %zu)\n", n_in, out_size, ws_size, (size_t)WS_END); grid = -1; return; }
        int dev = 0, cus = 0, per_cu = 0;
        if (hipGetDevice(&dev) != hipSuccess || hipDeviceGetAttribute(&cus, hipDeviceAttributeMultiprocessorCount, dev) != hipSuccess) { grid = -1; return; }
        if (hipFuncSetAttribute((const void*)fwd, hipFuncAttributeMaxDynamicSharedMemorySize, LDS_BYTES) != hipSuccess) { fprintf(stderr, "kernel_launch: hipFuncSetAttribute failed\n"); grid = -1; return; }
        if (hipOccupancyMaxActiveBlocksPerMultiprocessor(&per_cu, (const void*)fwd, NTHREADS, LDS_BYTES) != hipSuccess || per_cu < 1) fprintf(stderr, "kernel_launch: occupancy query says %d\n", per_cu);
        (void)hipGetLastError();
        grid = cus;
    }
    if (grid < 0) return;
    (void)hipMemsetAsync((char*)d_ws + WS_CTL, 0, CTL_ZERO_BYTES, stream);
    Args a{};
    for (int i = 0; i < 33; ++i) a.in[i] = (const float*)d_in[i];
    a.out = (float*)d_out; a.ws = (unsigned char*)d_ws;
#if MK_ONE_LAUNCH
    a.ph_lo = 0; a.ph_hi = NPHASE; a.use_bar = 1;
    hipLaunchKernelGGL(fwd, dim3(grid), dim3(NTHREADS), LDS_BYTES, stream, a);
#else
    for (int p = 0; p < NPHASE; ++p) { a.ph_lo = p; a.ph_hi = p + 1; a.use_bar = 0;
        hipLaunchKernelGGL(fwd, dim3(grid), dim3(NTHREADS), LDS_BYTES, stream, a); }
#endif
}
```

```cpp
#include <hip/hip_runtime.h>
#include <cstdio>
#include <cstdint>

#define LAS __attribute__((address_space(3)))
#define GAS __attribute__((address_space(1)))
typedef unsigned short bf16_t;
typedef short bf16x8 __attribute__((ext_vector_type(8)));
typedef float f32x4 __attribute__((ext_vector_type(4)));
typedef float f32x2 __attribute__((ext_vector_type(2)));
typedef unsigned u32x4 __attribute__((ext_vector_type(4)));
typedef unsigned u32x2 __attribute__((ext_vector_type(2)));
typedef float f32x16 __attribute__((ext_vector_type(16)));
typedef int i32x4 __attribute__((ext_vector_type(4)));
typedef int i32x8 __attribute__((ext_vector_type(8)));
typedef __bf16 bfv2 __attribute__((ext_vector_type(2)));
#define MFMA32(a, b, c) __builtin_amdgcn_mfma_f32_32x32x16_bf16((a), (b), (c), 0, 0, 0)

constexpr int BATCH = 4, SEQ = 4096, M = BATCH * SEQ, D = 2048;
constexpr int LRU_W = 1024, RW_W = 1024, NHEAD = 16, HS = 64;
constexpr int DLORA = 96, ALORA = 96, GLORA = 256;
constexpr int RW_SHIFT_W = 3 * RW_W + DLORA + ALORA + GLORA;
constexpr int NP = 2 * LRU_W + RW_SHIFT_W;
constexpr int NPP = 5632;
constexpr int NE = 32, TOPK = 4, DE = 2048;
constexpr int NSLOT_MAX = M * TOPK + NE * 256;
constexpr int NTILE_MAX = NSLOT_MAX / 256;
constexpr float LN_EPS = 1e-5f, GN_EPS = 64e-5f;
constexpr float DN_ALPHA = 1.189207115002721f;
constexpr int KD = 2048;

constexpr size_t MiB = 1u << 20;
constexpr size_t WS_CTL = 0, CTL_ZERO_BYTES = 1 * MiB;
constexpr size_t WS_WIN = 2 * MiB;
constexpr size_t WS_WO = WS_WIN + (size_t)NPP * KD * 2;
constexpr size_t WS_W1 = WS_WO + (size_t)D * KD * 2;
constexpr size_t WS_W2 = WS_W1 + (size_t)NE * 2 * DE * KD * 2;
constexpr size_t WS_XN = WS_W2 + (size_t)NE * D * DE * 2;
constexpr size_t WS_P = WS_XN + (size_t)M * D * 2;
constexpr size_t WS_LA = WS_P + (size_t)M * NPP * 2;
constexpr size_t WS_LB = WS_LA + (size_t)M * LRU_W * 4;
constexpr size_t WS_UC = WS_LB + (size_t)M * LRU_W * 4;
constexpr size_t WS_XL = WS_UC + (size_t)M * LRU_W * 2;
constexpr size_t WS_GATES = WS_XL + (size_t)M * 512 * 2;
constexpr size_t WS_LOUT = WS_GATES + (size_t)M * 2048 * 2;
constexpr size_t WS_V16 = WS_LOUT + (size_t)M * 3072 * 2;
constexpr size_t WS_G16 = WS_V16 + (size_t)M * RW_W * 2;
constexpr size_t WS_WG = WS_G16 + (size_t)M * RW_W * 2;
constexpr size_t WS_WL = WS_WG + (size_t)2048 * 256 * 2;
constexpr size_t WS_RY = WS_WL + (size_t)3072 * 256 * 2;
constexpr size_t WS_BON = WS_RY;
constexpr size_t WS_CAT = WS_BON + (size_t)M * NHEAD * 4;
constexpr size_t WS_Z = WS_CAT + (size_t)M * D * 2;
constexpr size_t WS_H1 = WS_Z + (size_t)M * D * 4;
constexpr size_t WS_H1B = WS_H1 + (size_t)M * D * 4;
constexpr size_t WS_TOPE = WS_H1B + (size_t)M * D * 2;
constexpr size_t WS_TOPP = WS_TOPE + (size_t)M * TOPK * 4;
constexpr size_t WS_TOPG = WS_TOPP + (size_t)M * TOPK * 4;
constexpr size_t WS_TOKSLOT = WS_TOPG + (size_t)M * TOPK * 4;
constexpr size_t WS_SLOTTOK = WS_TOKSLOT + (size_t)M * TOPK * 4;
constexpr size_t WS_SLOTG = WS_SLOTTOK + (size_t)NSLOT_MAX * 4;
constexpr size_t WS_ACT = WS_SLOTG + (size_t)NSLOT_MAX * 4;
constexpr size_t WS_OUTS = WS_ACT + (size_t)NSLOT_MAX * DE * 2;
constexpr int NUNIT = BATCH * NHEAD * (SEQ / 64);
constexpr size_t WS_MT = WS_OUTS + (size_t)NSLOT_MAX * D * 2;
constexpr size_t WS_GG = WS_MT + (size_t)NUNIT * 8192;
constexpr size_t WS_XS = WS_GG + (size_t)NUNIT * 8192;
constexpr size_t WS_NN = WS_XS + (size_t)NUNIT * 8192;
constexpr size_t WS_HH = WS_NN + (size_t)NUNIT * 16384;
constexpr size_t WS_CA = WS_HH + (size_t)NUNIT * 16384;
constexpr size_t WS_CH = WS_CA + (size_t)BATCH * 64 * LRU_W * 4;
constexpr size_t WS_CIN = WS_CH + (size_t)BATCH * 64 * LRU_W * 4;
constexpr size_t WS_XG = WS_CIN + (size_t)BATCH * 64 * LRU_W * 4;
constexpr size_t WS_WRT = WS_XG + (size_t)NSLOT_MAX * D;
constexpr size_t WS_END = WS_WRT + (size_t)2 * NE * D * 2;
constexpr int CW_CNT = 1024;
constexpr int CW_BAR = 4096;

constexpr int MISC_OFF = 159744;
constexpr int LDS_BYTES = 163840;

#define RLX_AGENT __ATOMIC_RELAXED, __HIP_MEMORY_SCOPE_AGENT
__device__ __forceinline__ unsigned f2bf(float f) { unsigned u = __builtin_bit_cast(unsigned, f); return (u + 0x7fffu + ((u >> 16) & 1u)) >> 16; }
__device__ __forceinline__ unsigned pk2(float lo, float hi) { return f2bf(lo) | (f2bf(hi) << 16); }
__device__ __forceinline__ float bf2f(unsigned short b) { return __builtin_bit_cast(float, (unsigned)b << 16); }
__device__ __forceinline__ float bflo(unsigned w) { return __builtin_bit_cast(float, w << 16); }
__device__ __forceinline__ float bfhi(unsigned w) { return __builtin_bit_cast(float, w & 0xffff0000u); }
__device__ __forceinline__ unsigned cvt2(float a, float b) { const f32x2 v = {a, b}; return __builtin_bit_cast(unsigned, __builtin_convertvector(v, bfv2)); }
__device__ __forceinline__ unsigned short cvt1(float a) { return (unsigned short)(cvt2(a, 0.f) & 0xffffu); }
constexpr float F8_SH = 4.f, F8_SW1 = 32.f, F8_SACT = 4.f, F8_SW2 = 64.f;
__device__ __forceinline__ float f8clamp(float x) { return fminf(fmaxf(x, -448.f), 448.f); }
__device__ __forceinline__ unsigned pk4_f8(float a, float b, float c, float d) { int w = 0; w = __builtin_amdgcn_cvt_pk_fp8_f32(f8clamp(a), f8clamp(b), w, false); w = __builtin_amdgcn_cvt_pk_fp8_f32(f8clamp(c), f8clamp(d), w, true); return (unsigned)w; }
__device__ __forceinline__ int lane_now() { int l; asm volatile("v_mbcnt_lo_u32_b32 %0, -1, 0\n\tv_mbcnt_hi_u32_b32 %0, -1, %0" : "=v"(l)); return l; }
__device__ __forceinline__ int crow(int reg, int h) { return (reg & 3) + 8 * (reg >> 2) + 4 * h; }
__device__ __forceinline__ float row_sum16(float v) {
    v += __builtin_bit_cast(float, __builtin_amdgcn_update_dpp(0, __builtin_bit_cast(int, v), 0xB1, 0xf, 0xf, false));
    v += __builtin_bit_cast(float, __builtin_amdgcn_update_dpp(0, __builtin_bit_cast(int, v), 0x4E, 0xf, 0xf, false));
    v += __builtin_bit_cast(float, __builtin_amdgcn_update_dpp(0, __builtin_bit_cast(int, v), 0x141, 0xf, 0xf, false));
    v += __builtin_bit_cast(float, __builtin_amdgcn_update_dpp(0, __builtin_bit_cast(int, v), 0x140, 0xf, 0xf, false));
    return v;
}
__device__ __forceinline__ float rdlane(float v, int l) { return __builtin_bit_cast(float, __builtin_amdgcn_readlane(__builtin_bit_cast(int, v), l)); }
__device__ __forceinline__ float wave_sum(float v) { v = row_sum16(v); return (rdlane(v, 0) + rdlane(v, 16)) + (rdlane(v, 32) + rdlane(v, 48)); }
__device__ __forceinline__ float half_sum(float v, int hh) { v = row_sum16(v); const float lo = rdlane(v, 0) + rdlane(v, 16), hi = rdlane(v, 32) + rdlane(v, 48); return hh ? hi : lo; }
__device__ __forceinline__ float sigmoidf_(float x) { return __builtin_amdgcn_rcpf(1.f + __expf(-x)); }
__device__ __forceinline__ float gelu_tanh(float x) { const float u = 0.7978845608028654f * (x + 0.044715f * x * x * x); return x * __builtin_amdgcn_rcpf(1.f + __expf(-2.f * u)); }
__device__ __forceinline__ float tanh_fast(float x) { const float e = __expf(-2.f * fabsf(x)); const float t = (1.f - e) * __builtin_amdgcn_rcpf(1.f + e); return x < 0.f ? -t : t; }

#define XB_TMO      128
#define XB_XCNT(j)  (256  + 64 * (j))
#define XB_XSUB(j)  (1280 + 64 * (j))
#define XB_XGEN(j)  (2304 + 64 * (j))
#define XB_TOP      3328
#define XB_TOPGEN   3392
#define XCD_BAR_WORDS 3456
#define XB_SPIN_CAP (1u << 18)
__device__ __forceinline__ unsigned xb_ld(unsigned* p)              { return __hip_atomic_load(p, __ATOMIC_RELAXED, __HIP_MEMORY_SCOPE_AGENT); }
__device__ __forceinline__ unsigned xb_add(unsigned* p, unsigned v) { return __hip_atomic_fetch_add(p, v, __ATOMIC_RELAXED, __HIP_MEMORY_SCOPE_AGENT); }
__device__ __forceinline__ unsigned xb_xcc_id() { return (unsigned)__builtin_amdgcn_s_getreg((3 << 11) | 20) & 0xFu; }
#define XB_SPIN(cond, bar) do { unsigned _sp = 0; while (cond) { __builtin_amdgcn_s_sleep(1); \
    if ((++_sp & 255u) == 0u) { if (xb_ld(&(bar)[XB_TMO])) break; if (_sp > XB_SPIN_CAP) { atomicAdd(&(bar)[XB_TMO], 1u); break; } } } } while (0)
struct XcdBarrier { unsigned* bar; unsigned x; volatile LAS unsigned* st; };
__device__ __forceinline__ XcdBarrier xcd_barrier_post(unsigned* bar, volatile LAS unsigned* st) {
    XcdBarrier b; b.bar = bar; b.x = xb_xcc_id(); b.st = st;
    if (__builtin_amdgcn_readfirstlane(threadIdx.x >> 6) == 0 && lane_now() == 0) (void)xb_add(&bar[XB_XCNT(b.x)], 1u);
    return b;
}
__device__ __forceinline__ void xcd_barrier_complete(unsigned* bar, unsigned x, unsigned& nloc, unsigned& nx) {
    const unsigned G = gridDim.x * gridDim.y * gridDim.z;
    unsigned sum, cnt, mine, sp = 0u;
    for (;;) {
        sum = 0u; cnt = 0u; mine = 0u;
#pragma unroll
        for (unsigned j = 0; j < 16; ++j) { const unsigned c = xb_ld(&bar[XB_XCNT(j)]); sum += c; cnt += (c > 0u) ? 1u : 0u; mine = (j == x) ? c : mine; }
        if (sum == G) break;
        __builtin_amdgcn_s_sleep(1);
        if ((++sp & 255u) == 0u) { if (xb_ld(&bar[XB_TMO])) break; if (sp > XB_SPIN_CAP) { atomicAdd(&bar[XB_TMO], 1u); break; } }
    }
    nloc = mine > 0u ? mine : 1u; nx = cnt > 0u ? cnt : 1u;
}
__device__ __forceinline__ void xcd_barrier(const XcdBarrier& b, int wave_id) {
    asm volatile("s_waitcnt vmcnt(0)" ::: "memory");
    __syncthreads();
    if (wave_id == 0 && lane_now() == 0) {
        unsigned* bar = b.bar;
        __builtin_amdgcn_s_waitcnt(0);
        unsigned nloc = b.st[0], nx = b.st[1];
        if (nloc == 0u) { xcd_barrier_complete(bar, b.x, nloc, nx); b.st[0] = nloc; b.st[1] = nx; }
        const unsigned old = xb_add(&bar[XB_XSUB(b.x)], 1u);
        const unsigned gen = old / nloc;
        if (old + 1u == (gen + 1u) * nloc) {
            __builtin_amdgcn_fence(__ATOMIC_RELEASE, "agent");
            asm volatile("s_waitcnt vmcnt(0)" ::: "memory");
            const unsigned og = xb_add(&bar[XB_TOP], 1u);
            const unsigned tg = og / nx;
            if (og + 1u == (tg + 1u) * nx) xb_add(&bar[XB_TOPGEN], 1u);
            else XB_SPIN(xb_ld(&bar[XB_TOPGEN]) == tg, bar);
            __builtin_amdgcn_fence(__ATOMIC_ACQUIRE, "agent");
            xb_add(&bar[XB_XGEN(b.x)], 1u);
            asm volatile("s_waitcnt vmcnt(0)" ::: "memory");
        } else {
            XB_SPIN(xb_ld(&bar[XB_XGEN(b.x)]) == gen, bar);
            __builtin_amdgcn_fence(__ATOMIC_ACQUIRE, "agent");
            asm volatile("s_waitcnt vmcnt(0)" ::: "memory");
        }
    }
    __syncthreads();
}

namespace pg8 {
constexpr int BM = 256, BK = 64, HALF = 128, HTB = HALF * BK * 2, STAGE_BYTES = 8 * HTB, NXCD = 8, WGM = 8;
__host__ __device__ __forceinline__ int lds_byte(int r, int c) { const int st = (r >> 4) * 2 + (c >> 5), rr = r & 15, cc = c & 31, ob = rr * 64 + cc * 2; return st * 1024 + (ob ^ (((ob >> 9) & 1) << 5)); }
__host__ __device__ __forceinline__ void stage_rc(int b, int& R, int& C) { const int st = b / 1024, sb = b % 1024, swz = sb ^ (((sb >> 9) & 1) << 5); R = (st >> 1) * 16 + swz / 64; C = (st & 1) * 32 + (swz % 64) / 2; }
__host__ __device__ __forceinline__ int perm32(int rho) { const int n = rho >> 4, i = rho & 15; return 8 * (i >> 2) + 4 * n + (i & 3); }
__host__ __device__ __forceinline__ int f8_g(int R) { return ((R >> 1) & 1) + 4 * ((R >> 3) & 1); }
__host__ __device__ __forceinline__ int f8_lds_byte(int R, int c) { return R * 128 + (((c + f8_g(R)) & 7) << 4); }
__host__ __device__ __forceinline__ void f8_stage_rc(int pos, int& R, int& Cb) { const int P = pos >> 4; R = P >> 3; Cb = (((P & 7) - f8_g(R)) & 7) << 4; }
struct Unit { int pm, pn, ak, nt; };
__device__ __forceinline__ unsigned cvt_pk_bf16(float lo, float hi) { unsigned r; asm volatile("v_cvt_pk_bf16_f32 %0, %1, %2" : "=v"(r) : "v"(lo), "v"(hi)); return r; }

struct StaticOrder {
    int nM, nN, nwg, G, c;
    __device__ void init(int M_, int N_, int G_, int c_) { nM = M_ / BM; nN = N_ / BM; nwg = nM * nN; G = G_; c = c_; }
    __device__ bool next(int i, Unit& u) const {
        const long L = (long)i * G + c; if (L >= nwg) return false;
        int wgid = (int)L; { const int q = nwg / NXCD, r = nwg % NXCD, xcd = wgid % NXCD, off = wgid / NXCD; wgid = (xcd < r ? xcd * (q + 1) : r * (q + 1) + (xcd - r) * q) + off; }
        const int nig = WGM * nN, gid = wgid / nig, fm = gid * WGM, gsz = (nM - fm) < WGM ? (nM - fm) : WGM;
        u.pm = fm + ((wgid % nig) % gsz); u.pn = (wgid % nig) / gsz; u.ak = 0; u.nt = KD / BK; return true;
    }
};
struct MoeOrder {
    const LAS int* tile_e; int R, NCT, G, c, nt;
    __device__ bool next(int i, Unit& u) const {
        int rt, ct;
        if (G == 256) { const int x = c & 7, j = c >> 3;
            if (NCT == 16) { rt = 16 * i + (x >> 1) * 4 + (j >> 3); ct = (x & 1) * 8 + (j & 7); }
            else           { rt = 32 * i + 4 * x + (j >> 3); ct = j & 7; } }
        else { const long L = (long)i * G + c; rt = (int)(L / NCT); ct = (int)(L % NCT); }
        if (rt >= R) return false;
        u.pm = rt; u.pn = tile_e[rt] * NCT + ct; u.ak = 0; u.nt = nt; return true;
    }
};
template <int MODE> struct SmallOrder {
    int G, c;
    __device__ bool next(int i, Unit& u) const {
        constexpr int NCT = MODE == 0 ? 8 : 12;
        const int L = i * G + c; if (L >= (M / BM) * NCT) return false;
        u.pm = L / NCT; u.pn = L % NCT;
        if (MODE == 0) { u.ak = 256 * (u.pn & 3); u.nt = 4; }
        else { u.ak = u.pn < 4 ? 0 : (u.pn < 8 ? 128 : 256); u.nt = u.pn < 8 ? 2 : 4; }
        return true;
    }
};
struct DenseRows { static constexpr bool DENSE = true; __device__ __forceinline__ unsigned row(int pm, int r) const { return (unsigned)(pm * BM + r); } };
struct GatherRows { static constexpr bool DENSE = false; const int* idx; __device__ __forceinline__ unsigned row(int pm, int r) const { return (unsigned)idx[pm * BM + r]; } };

struct EpiBf16 {
    static constexpr bool PERM = true;
    bf16_t* O; int ldc;
    __device__ __forceinline__ void operator()(const f32x4 (&acc)[2][2][4][2], const Unit& u, int wr, int wc, int fr, int fq) const {
        const int row0 = u.pm * BM + wr * 64 + fr, col0 = u.pn * BM + wc * 32 + 8 * fq;
#pragma unroll
        for (int ai = 0; ai < 2; ++ai)
#pragma unroll
            for (int m = 0; m < 4; ++m) { bf16_t* rowp = O + (size_t)(row0 + ai * HALF + m * 16) * ldc + col0;
#pragma unroll
                for (int bj = 0; bj < 2; ++bj) { const f32x4 v0 = acc[ai][bj][m][0], v1 = acc[ai][bj][m][1];
                    u32x4 w; w.x = cvt_pk_bf16(v0[0], v0[1]); w.y = cvt_pk_bf16(v0[2], v0[3]); w.z = cvt_pk_bf16(v1[0], v1[1]); w.w = cvt_pk_bf16(v1[2], v1[3]);
                    *(u32x4*)(rowp + bj * HALF) = w; } }
    }
};
struct EpiResF32 {
    static constexpr bool PERM = false;
    float* Z; const bf16_t* R; float alpha;
    __device__ __forceinline__ void operator()(const f32x4 (&acc)[2][2][4][2], const Unit& u, int wr, int wc, int fr, int fq) const {
        const int row0 = u.pm * BM + wr * 64 + fr, col0 = u.pn * BM + wc * 32 + 4 * fq;
#pragma unroll
        for (int ai = 0; ai < 2; ++ai)
#pragma unroll
            for (int m = 0; m < 4; ++m) { const size_t off = (size_t)(row0 + ai * HALF + m * 16) * D + col0;
#pragma unroll
                for (int bj = 0; bj < 2; ++bj)
#pragma unroll
                    for (int n = 0; n < 2; ++n) { const u32x2 rb = *(const u32x2*)(R + off + bj * HALF + n * 16);
                        f32x4 o = acc[ai][bj][m][n]; o[0] += alpha * bflo(rb.x); o[1] += alpha * bfhi(rb.x); o[2] += alpha * bflo(rb.y); o[3] += alpha * bfhi(rb.y);
                        *(f32x4*)(Z + off + bj * HALF + n * 16) = o; } }
    }
};
struct EpiSwiglu {
    static constexpr bool PERM = true;
    unsigned char* O; const float* b1;
    __device__ __forceinline__ void operator()(const f32x4 (&acc)[2][2][4][2], const Unit& u, int wr, int wc, int fr, int fq) const {
        const int e = u.pn >> 4, ct = u.pn & 15;
        const int row0 = u.pm * BM + wr * 64 + fr, cin = wc * 32 + 8 * fq, col0 = ct * HALF + cin;
        const float* bg = b1 + (size_t)e * 2 * DE + col0; const float* bu = bg + DE;
        const f32x4 bg0 = *(const f32x4*)bg, bg1 = *(const f32x4*)(bg + 4), bu0 = *(const f32x4*)bu, bu1 = *(const f32x4*)(bu + 4);
        constexpr float inv = 1.f / (F8_SH * F8_SW1);
#pragma unroll
        for (int ai = 0; ai < 2; ++ai)
#pragma unroll
            for (int m = 0; m < 4; ++m) { unsigned char* rowp = O + (size_t)(row0 + ai * HALF + m * 16) * DE + col0;
                float o[8];
#pragma unroll
                for (int n = 0; n < 2; ++n) { const f32x4 g4 = acc[ai][0][m][n] * inv + (n ? bg1 : bg0), u4 = acc[ai][1][m][n] * inv + (n ? bu1 : bu0);
#pragma unroll
                    for (int j = 0; j < 4; ++j) { const float g = fminf(g4[j], 7.f), up = fminf(fmaxf(u4[j], -7.f), 7.f);
                        o[n * 4 + j] = F8_SACT * g * (up + 1.f) * __builtin_amdgcn_rcpf(1.f + __expf(-1.702f * g)); } }
                *(u32x2*)rowp = (u32x2){pk4_f8(o[0], o[1], o[2], o[3]), pk4_f8(o[4], o[5], o[6], o[7])}; }
    }
};
struct EpiMoeOut {
    static constexpr bool PERM = true;
    bf16_t* O; const float* b2; const float* sg;
    __device__ __forceinline__ void operator()(const f32x4 (&acc)[2][2][4][2], const Unit& u, int wr, int wc, int fr, int fq) const {
        const int e = u.pn >> 3, ct = u.pn & 7;
        const int row0 = u.pm * BM + wr * 64 + fr, col0 = ct * BM + wc * 32 + 8 * fq;
        f32x4 bv[2][2];
#pragma unroll
        for (int bj = 0; bj < 2; ++bj)
#pragma unroll
            for (int n = 0; n < 2; ++n) bv[bj][n] = *(const f32x4*)(b2 + (size_t)e * D + col0 + bj * HALF + 4 * n);
#pragma unroll
        for (int ai = 0; ai < 2; ++ai)
#pragma unroll
            for (int m = 0; m < 4; ++m) { const int row = row0 + ai * HALF + m * 16; const float gt = sg[row]; bf16_t* rowp = O + (size_t)row * D + col0;
#pragma unroll
                for (int bj = 0; bj < 2; ++bj) { const f32x4 v0 = (acc[ai][bj][m][0] * (1.f / (F8_SACT * F8_SW2)) + bv[bj][0]) * gt, v1 = (acc[ai][bj][m][1] * (1.f / (F8_SACT * F8_SW2)) + bv[bj][1]) * gt;
                    u32x4 w; w.x = cvt_pk_bf16(v0[0], v0[1]); w.y = cvt_pk_bf16(v0[2], v0[3]); w.z = cvt_pk_bf16(v1[0], v1[1]); w.w = cvt_pk_bf16(v1[2], v1[3]);
                    *(u32x4*)(rowp + bj * HALF) = w; } }
    }
};

template <class Epi, class Sched, class ARows, bool ALIGN_EPI, int LDA = KD, int LDB = KD, bool F8 = false>
__device__ __forceinline__ void gemm_phase(LAS unsigned char* lds, const bf16_t* A, const bf16_t* Bt, const Sched& S, const Epi& E, const ARows& AR, const int wid) {
    const int lane = lane_now(), tid = wid * 64 + lane, wr = wid >> 2, wc = wid & 3, fr = lane & 15, fq = lane >> 4;
    int sR[2], sC[2]; unsigned voffB[2];
#pragma unroll
    for (int i = 0; i < 2; ++i) { if constexpr (F8) { int cb_; f8_stage_rc(tid * 16 + i * 8192, sR[i], cb_); sC[i] = cb_ >> 1; } else stage_rc(tid * 16 + i * 8192, sR[i], sC[i]); const int Rb = Epi::PERM ? ((sR[i] & ~31) + perm32(sR[i] & 31)) : sR[i];
        voffB[i] = (unsigned)(Rb * LDB + sC[i]) * 2u; }
    constexpr size_t kstep = (size_t)(BK * 2);
    constexpr size_t hstep = (size_t)HALF * LDB * 2;
    constexpr size_t tstep = 2 * hstep;
    const unsigned ldsw = (unsigned)wid * 1024u;
    int aoffs[2], boffs[2];
    if constexpr (F8) { aoffs[0] = f8_lds_byte(wr * 64 + fr, 2 * fq); aoffs[1] = f8_lds_byte(wr * 64 + fr, 2 * fq + 1); boffs[0] = 4 * HTB + f8_lds_byte(wc * 32 + fr, 2 * fq); boffs[1] = 4 * HTB + f8_lds_byte(wc * 32 + fr, 2 * fq + 1); }
    else { aoffs[0] = lds_byte(wr * 64 + fr, fq * 8); aoffs[1] = aoffs[0] + 1024; boffs[0] = 4 * HTB + lds_byte(wc * 32 + fr, fq * 8); boffs[1] = boffs[0] + 1024; }
#define PG8_SA(b, h) (((b) * 2 + (h)) * HTB)
#define PG8_SB(b, h) ((4 + (b) * 2 + (h)) * HTB)
#define PG8_SBR(b, h) (((b) * 2 + (h)) * HTB)
#define PG8_STAGE(bufoff, gbase, voff) do { const char* gb_ = (const char*)(gbase); _Pragma("unroll") for (int _i = 0; _i < 2; ++_i) { unsigned keep_; \
        asm volatile("s_mov_b32 %0, m0\n\ts_mov_b32 m0, %3\n\ts_nop 0\n\tglobal_load_lds_dwordx4 %1, %2\n\ts_mov_b32 m0, %0" : "=&s"(keep_) : "v"((voff)[_i]), "s"(gb_), "s"((unsigned)((bufoff) + ldsw + _i * 8192)) : "memory"); } } while (0)
#define PG8_LDA(dst, b, h) do { _Pragma("unroll") for (int m = 0; m < 4; ++m) { if constexpr (F8) { const i32x4 lo_ = *(const LAS i32x4*)(lds + PG8_SA(b, h) + aoffs[0] + m * 2048), hi_ = *(const LAS i32x4*)(lds + PG8_SA(b, h) + aoffs[1] + m * 2048); \
            dst##8[m] = __builtin_shufflevector(lo_, hi_, 0, 1, 2, 3, 4, 5, 6, 7); } else { _Pragma("unroll") for (int k = 0; k < 2; ++k) dst[m][k] = *(const LAS bf16x8*)(lds + PG8_SA(b, h) + aoffs[k] + m * 2048); } } } while (0)
#define PG8_LDB(dst, b, h) do { _Pragma("unroll") for (int n = 0; n < 2; ++n) { if constexpr (F8) { const i32x4 lo_ = *(const LAS i32x4*)(lds + PG8_SBR(b, h) + boffs[0] + n * 2048), hi_ = *(const LAS i32x4*)(lds + PG8_SBR(b, h) + boffs[1] + n * 2048); \
            dst##8[n] = __builtin_shufflevector(lo_, hi_, 0, 1, 2, 3, 4, 5, 6, 7); } else { _Pragma("unroll") for (int k = 0; k < 2; ++k) dst[n][k] = *(const LAS bf16x8*)(lds + PG8_SBR(b, h) + boffs[k] + n * 2048); } } } while (0)
#define PG8_MMA(ai, bj, At, Bt_) do { __builtin_amdgcn_s_setprio(1); _Pragma("unroll") for (int m = 0; m < 4; ++m) _Pragma("unroll") for (int n = 0; n < 2; ++n) { \
        if constexpr (F8) { acc[ai][bj][m][n] = __builtin_amdgcn_mfma_scale_f32_16x16x128_f8f6f4(Bt_##8[n], At##8[m], acc[ai][bj][m][n], 0, 0, 0, 0x7f7f7f7f, 0, 0x7f7f7f7f); } \
        else { _Pragma("unroll") for (int k = 0; k < 2; ++k) acc[ai][bj][m][n] = __builtin_amdgcn_mfma_f32_16x16x32_bf16(Bt_[n][k], At[m][k], acc[ai][bj][m][n], 0, 0, 0); } } __builtin_amdgcn_s_setprio(0); } while (0)
#define PG8_WAIT_V(n) asm volatile("s_waitcnt vmcnt(" #n ")" ::: "memory")
#define PG8_WAIT_L(n) asm volatile("s_waitcnt lgkmcnt(" #n ")" ::: "memory")
#define PG8_BAR __builtin_amdgcn_s_barrier()
#define PG8_SCHED __builtin_amdgcn_sched_barrier(0)
#define PG8_AOFF(dst, u) do { const int tq_ = wid * 64 + lane_now(); _Pragma("unroll") for (int _i = 0; _i < 2; ++_i) { int R_, C_; if constexpr (F8) { int cb_; f8_stage_rc(tq_ * 16 + _i * 8192, R_, cb_); C_ = cb_ >> 1; } else stage_rc(tq_ * 16 + _i * 8192, R_, C_); \
        _Pragma("unroll") for (int _h = 0; _h < 2; ++_h) { \
        if constexpr (ARows::DENSE) dst[_h][_i] = (unsigned)(R_ * LDA + C_) * 2u; \
        else dst[_h][_i] = (AR.row((u).pm, _h * HALF + R_) * (unsigned)LDA + (unsigned)((u).ak + C_)) * 2u; } } } while (0)
#define PG8_ABASE(u) (ARows::DENSE ? (const char*)A + ((size_t)(u).pm * BM * LDA + (u).ak) * 2 : (const char*)A)
    constexpr size_t ahstep = ARows::DENSE ? (size_t)HALF * LDA * 2 : 0;
    Unit cur, nxt; int ui = 0;
    if (!S.next(0, cur)) return;
    f32x4 acc[2][2][4][2];
#pragma unroll
    for (int a = 0; a < 2; ++a)
#pragma unroll
        for (int b = 0; b < 2; ++b)
#pragma unroll
            for (int m = 0; m < 4; ++m)
#pragma unroll
                for (int n = 0; n < 2; ++n) acc[a][b][m][n] = (f32x4){0.f, 0.f, 0.f, 0.f};
    bf16x8 At[4][2], B0[2][2], B1[2][2]; i32x8 At8[4], B08[2], B18[2];
    unsigned ao[2][2], an[2][2];
    PG8_AOFF(ao, cur);
    const char* cA = PG8_ABASE(cur);
    const char* cB = (const char*)Bt + (size_t)cur.pn * tstep;
    PG8_STAGE(PG8_SB(0, 0), cB, voffB); PG8_STAGE(PG8_SB(0, 1), cB + hstep, voffB); PG8_STAGE(PG8_SA(0, 0), cA, ao[0]); PG8_STAGE(PG8_SA(0, 1), cA + ahstep, ao[1]);
    if (wr == 1) PG8_BAR;
    PG8_WAIT_V(2); PG8_BAR;
    PG8_STAGE(PG8_SB(1, 0), cB + kstep, voffB); PG8_STAGE(PG8_SA(1, 0), cA + kstep, ao[0]); PG8_STAGE(PG8_SB(1, 1), cB + hstep + kstep, voffB);
    PG8_WAIT_V(6); PG8_BAR;
    for (;;) {
        const bool has_next = S.next(ui + 1, nxt);
        if (has_next && !ARows::DENSE) { PG8_AOFF(an, nxt); } else {
#pragma unroll
            for (int h = 0; h < 2; ++h)
#pragma unroll
                for (int i = 0; i < 2; ++i) an[h][i] = ao[h][i]; }
        const char* nB = has_next ? (const char*)Bt + (size_t)nxt.pn * tstep : cB;
        const char* nA = has_next ? PG8_ABASE(nxt) : cA;
        const int nt = cur.nt;
#pragma unroll 1
        for (int t = 0; t < nt; t += 2) {
            const bool last = (t == nt - 2);
            const char* a1 = cA + (size_t)(t + 1) * kstep;
            const char* a2 = last ? nA : cA + (size_t)(t + 2) * kstep; const char* b2 = last ? nB : cB + (size_t)(t + 2) * kstep;
            const char* a3 = a2 + kstep; const char* b3 = b2 + kstep;
            unsigned o2[2][2];
#pragma unroll
            for (int h = 0; h < 2; ++h)
#pragma unroll
                for (int i = 0; i < 2; ++i) o2[h][i] = (!ARows::DENSE && last) ? an[h][i] : ao[h][i];
            PG8_LDB(B0, 0, 0); PG8_LDB(B1, 0, 1); PG8_SCHED; PG8_LDA(At, 0, 0); PG8_STAGE(PG8_SA(1, 1), a1 + ahstep, ao[1]);
            PG8_WAIT_V(8); PG8_WAIT_L(0); PG8_BAR; PG8_MMA(0, 0, At, B0); PG8_MMA(0, 1, At, B1); PG8_BAR; PG8_SCHED;
            PG8_LDA(At, 0, 1); PG8_STAGE(PG8_SB(0, 0), b2, voffB); PG8_STAGE(PG8_SB(0, 1), b2 + hstep, voffB); PG8_STAGE(PG8_SA(0, 0), a2, o2[0]);
            PG8_WAIT_V(8); PG8_WAIT_L(0); PG8_BAR; PG8_MMA(1, 0, At, B0); PG8_MMA(1, 1, At, B1); PG8_BAR; PG8_SCHED;
            PG8_LDB(B0, 1, 0); PG8_LDB(B1, 1, 1); PG8_SCHED; PG8_LDA(At, 1, 0); PG8_STAGE(PG8_SA(0, 1), a2 + ahstep, o2[1]);
            PG8_WAIT_V(8); PG8_WAIT_L(0); PG8_BAR; PG8_MMA(0, 0, At, B0); PG8_MMA(0, 1, At, B1); PG8_BAR; PG8_SCHED;
            PG8_LDA(At, 1, 1); PG8_STAGE(PG8_SB(1, 0), b3, voffB); PG8_STAGE(PG8_SB(1, 1), b3 + hstep, voffB); PG8_STAGE(PG8_SA(1, 0), a3, o2[0]);
            PG8_WAIT_V(8); PG8_WAIT_L(0); PG8_BAR; PG8_MMA(1, 0, At, B0); PG8_MMA(1, 1, At, B1); PG8_BAR; PG8_SCHED;
        }
        if constexpr (ALIGN_EPI) { if (wr == 0) PG8_BAR; }
        asm volatile("" : "+s"(cur.pm), "+s"(cur.pn));
        { const int tz = lane_now();
          E(acc, cur, wr, wc, tz & 15, (tz & 63) >> 4); }
        if (!has_next) break;
#pragma unroll
        for (int a = 0; a < 2; ++a)
#pragma unroll
            for (int b = 0; b < 2; ++b)
#pragma unroll
                for (int m = 0; m < 4; ++m)
#pragma unroll
                    for (int n = 0; n < 2; ++n) acc[a][b][m][n] = (f32x4){0.f, 0.f, 0.f, 0.f};
        cur = nxt; cB = nB; cA = nA; ++ui;
#pragma unroll
        for (int h = 0; h < 2; ++h)
#pragma unroll
            for (int i = 0; i < 2; ++i) ao[h][i] = an[h][i];
        if constexpr (ALIGN_EPI) { if (wr == 1) PG8_BAR; }
    }
    PG8_WAIT_V(0);
    if constexpr (!ALIGN_EPI) { if (wr == 0) PG8_BAR; }
    PG8_BAR;
#undef PG8_SA
#undef PG8_SB
#undef PG8_SBR
#undef PG8_STAGE
#undef PG8_LDA
#undef PG8_LDB
#undef PG8_MMA
#undef PG8_WAIT_V
#undef PG8_WAIT_L
#undef PG8_BAR
#undef PG8_SCHED
#undef PG8_AOFF
}
struct DenseRowsH { __device__ __forceinline__ unsigned row(int pm, int r) const { return (unsigned)(pm * 128 + r); } };
struct GatherRowsH { const int* idx; __device__ __forceinline__ unsigned row(int pm, int r) const { return (unsigned)idx[pm * 128 + r]; } };
struct EpiSwigluH {
    unsigned char* O; const float* b1;
    __device__ __forceinline__ void operator()(const f32x4 (&acc)[2][4][2], const Unit& u, int wr, int wc, int fr, int fq) const {
        const int e = u.pn >> 4, ct = u.pn & 15;
        const int row0 = u.pm * 128 + wr * 64 + fr, col0 = ct * HALF + wc * 32 + 8 * fq;
        const float* bg = b1 + (size_t)e * 2 * DE + col0; const float* bu = bg + DE;
        const f32x4 bg0 = *(const f32x4*)bg, bg1 = *(const f32x4*)(bg + 4), bu0 = *(const f32x4*)bu, bu1 = *(const f32x4*)(bu + 4);
        constexpr float inv = 1.f / (F8_SH * F8_SW1);
#pragma unroll
        for (int m = 0; m < 4; ++m) { unsigned char* rowp = O + (size_t)(row0 + m * 16) * DE + col0;
            float o[8];
#pragma unroll
            for (int n = 0; n < 2; ++n) { const f32x4 g4 = acc[0][m][n] * inv + (n ? bg1 : bg0), u4 = acc[1][m][n] * inv + (n ? bu1 : bu0);
#pragma unroll
                for (int j = 0; j < 4; ++j) { const float g = fminf(g4[j], 7.f), up = fminf(fmaxf(u4[j], -7.f), 7.f);
                    o[n * 4 + j] = F8_SACT * g * (up + 1.f) * __builtin_amdgcn_rcpf(1.f + __expf(-1.702f * g)); } }
            *(u32x2*)rowp = (u32x2){pk4_f8(o[0], o[1], o[2], o[3]), pk4_f8(o[4], o[5], o[6], o[7])}; }
    }
};
struct EpiMoeOutH {
    bf16_t* O; const float* b2; const float* sg;
    __device__ __forceinline__ void operator()(const f32x4 (&acc)[2][4][2], const Unit& u, int wr, int wc, int fr, int fq) const {
        const int e = u.pn >> 3, ct = u.pn & 7;
        const int row0 = u.pm * 128 + wr * 64 + fr, col0 = ct * BM + wc * 32 + 8 * fq;
        constexpr float inv = 1.f / (F8_SACT * F8_SW2);
#pragma unroll
        for (int m = 0; m < 4; ++m) { const int row = row0 + m * 16; const float gt = sg[row]; bf16_t* rowp = O + (size_t)row * D + col0;
#pragma unroll
            for (int bj = 0; bj < 2; ++bj) { const f32x4 b0 = *(const f32x4*)(b2 + (size_t)e * D + col0 + bj * HALF), b1_ = *(const f32x4*)(b2 + (size_t)e * D + col0 + bj * HALF + 4);
                const f32x4 v0 = (acc[bj][m][0] * inv + b0) * gt, v1 = (acc[bj][m][1] * inv + b1_) * gt;
                *(u32x4*)(rowp + bj * HALF) = (u32x4){cvt2(v0[0], v0[1]), cvt2(v0[2], v0[3]), cvt2(v1[0], v1[1]), cvt2(v1[2], v1[3])}; } }
    }
};
template <class Epi, class Sched, class ARows>
__device__ __forceinline__ void gemm_f8h(LAS unsigned char* lds, const unsigned char* A, const unsigned char* Bt, const Sched& S, const Epi& E, const ARows& AR, const int wid) {
    constexpr int NT = KD / 128, STG = 3 * HTB;
    const int wr = wid >> 2, wc = wid & 3;
    const unsigned ldsw = (unsigned)wid * 1024u;
    Unit cur, nxt;
    if (!S.next(0, cur)) return;
#define F8_STAGE(dstoff, gbase, voff) do { const char* gb_ = (const char*)(gbase); _Pragma("unroll") for (int _i = 0; _i < 2; ++_i) { unsigned keep_; \
        asm volatile("s_mov_b32 %0, m0\n\ts_mov_b32 m0, %3\n\ts_nop 0\n\tglobal_load_lds_dwordx4 %1, %2\n\ts_mov_b32 m0, %0" : "=&s"(keep_) : "v"((voff)[_i]), "s"(gb_), "s"((unsigned)((dstoff) + ldsw + _i * 8192)) : "memory"); } } while (0)
#define F8_AOFF(dst, u) do { const int tq_ = wid * 64 + lane_now(); _Pragma("unroll") for (int _i = 0; _i < 2; ++_i) { int R_, C_; f8_stage_rc(tq_ * 16 + _i * 8192, R_, C_); dst[_i] = AR.row((u).pm, R_) * (unsigned)KD + (unsigned)C_; } } while (0)
#define F8_STAGE_TILE(so_, kt_, aoffv, bptr) do { F8_STAGE((so_), (const char*)A + (size_t)(kt_) * 128, aoffv); F8_STAGE((so_) + HTB, (bptr) + (size_t)(kt_) * 128, vb); F8_STAGE((so_) + 2 * HTB, (bptr) + (size_t)128 * KD + (size_t)(kt_) * 128, vb); } while (0)
#define F8_LDFRAG(a8, b8, so_) do { _Pragma("unroll") for (int m = 0; m < 4; ++m) { const i32x4 lo = *(const LAS i32x4*)(lds + (so_) + aoff0 + m * 2048), hi = *(const LAS i32x4*)(lds + (so_) + aoff1 + m * 2048); a8[m] = __builtin_shufflevector(lo, hi, 0, 1, 2, 3, 4, 5, 6, 7); } \
        _Pragma("unroll") for (int b = 0; b < 2; ++b) _Pragma("unroll") for (int n = 0; n < 2; ++n) { const i32x4 lo = *(const LAS i32x4*)(lds + (so_) + (1 + b) * HTB + boff0 + n * 2048), hi = *(const LAS i32x4*)(lds + (so_) + (1 + b) * HTB + boff1 + n * 2048); b8[b][n] = __builtin_shufflevector(lo, hi, 0, 1, 2, 3, 4, 5, 6, 7); } } while (0)
#define F8_MMA(a8, b8) do { __builtin_amdgcn_s_setprio(1); _Pragma("unroll") for (int b = 0; b < 2; ++b) _Pragma("unroll") for (int m = 0; m < 4; ++m) _Pragma("unroll") for (int n = 0; n < 2; ++n) \
        acc[b][m][n] = __builtin_amdgcn_mfma_scale_f32_16x16x128_f8f6f4(b8[b][n], a8[m], acc[b][m][n], 0, 0, 0, 0x7f7f7f7f, 0, 0x7f7f7f7f); __builtin_amdgcn_s_setprio(0); } while (0)
    unsigned ao[2], an[2], vb[2];
    { const int tq = wid * 64 + lane_now();
#pragma unroll
        for (int i = 0; i < 2; ++i) { int R, C; f8_stage_rc(tq * 16 + i * 8192, R, C); const int Rb = (R & ~31) + perm32(R & 31); vb[i] = (unsigned)(Rb * KD + C); } }
    F8_AOFF(ao, cur);
    int aoff0, aoff1, boff0, boff1; { const int ln = lane_now(), fr = ln & 15, fq = ln >> 4; aoff0 = f8_lds_byte(wr * 64 + fr, 2 * fq); aoff1 = f8_lds_byte(wr * 64 + fr, 2 * fq + 1); boff0 = f8_lds_byte(wc * 32 + fr, 2 * fq); boff1 = f8_lds_byte(wc * 32 + fr, 2 * fq + 1); }
    const char* cB = (const char*)Bt + (size_t)cur.pn * 256 * KD;
    f32x4 acc[2][4][2];
#pragma unroll
    for (int b = 0; b < 2; ++b)
#pragma unroll
        for (int m = 0; m < 4; ++m)
#pragma unroll
            for (int n = 0; n < 2; ++n) acc[b][m][n] = (f32x4){0.f, 0.f, 0.f, 0.f};
    F8_STAGE_TILE(0, 0, ao, cB); F8_STAGE_TILE(STG, 1, ao, cB);
    int so = 0;
    for (int ui = 0;; ++ui) {
        const bool has_next = S.next(ui + 1, nxt);
        const char* nB = cB;
        if (has_next) { F8_AOFF(an, nxt); nB = (const char*)Bt + (size_t)nxt.pn * 256 * KD; } else { an[0] = ao[0]; an[1] = ao[1]; }
#pragma unroll 1
        for (int kt = 0; kt < NT; ++kt) {
            const int so2 = (so == 0) ? 2 * STG : so - STG;
            if (kt + 1 < NT || has_next) asm volatile("s_waitcnt vmcnt(6)" ::: "memory"); else asm volatile("s_waitcnt vmcnt(0)" ::: "memory");
            __builtin_amdgcn_s_barrier(); asm volatile("" ::: "memory");
            if (kt + 2 < NT) F8_STAGE_TILE(so2, kt + 2, ao, cB); else if (has_next) F8_STAGE_TILE(so2, kt + 2 - NT, an, nB);
            i32x8 fa[4], fb[2][2];
            F8_LDFRAG(fa, fb, so);
            F8_MMA(fa, fb);
            so = (so == 2 * STG) ? 0 : so + STG;
        }
        { const int ln = lane_now(); E(acc, cur, wr, wc, ln & 15, ln >> 4); }
        if (!has_next) break;
#pragma unroll
        for (int b = 0; b < 2; ++b)
#pragma unroll
            for (int m = 0; m < 4; ++m)
#pragma unroll
                for (int n = 0; n < 2; ++n) acc[b][m][n] = (f32x4){0.f, 0.f, 0.f, 0.f};
        cur = nxt; cB = nB; ao[0] = an[0]; ao[1] = an[1];
    }
#undef F8_STAGE
#undef F8_AOFF
#undef F8_STAGE_TILE
#undef F8_LDFRAG
#undef F8_MMA
}
}

constexpr int NWAVES = 8, NTHREADS = 512;
constexpr int NPHASE = 13;
struct Args {
    const float* in[33]; float* out; unsigned char* ws; int ph_lo, ph_hi, use_bar, pad;
};
enum { I_X = 0, I_LNG, I_LNB, I_WIN, I_CONVW, I_CONVB, I_WRG, I_BRG, I_WIG, I_BIG, I_LAMBDA, I_MU, I_W0, I_DECUP, I_A0, I_AAAUP, I_GATEUP,
       I_KK, I_KA, I_RK, I_GNG, I_GNB, I_WOUT, I_LN1G, I_LN1B, I_WROUTER, I_BROUTER, I_WE1, I_BE1, I_WE2, I_BE2, I_LN2G, I_LN2B };

__device__ __forceinline__ void transpose_item(const float* W, int N, bf16_t* WT, int k0, int n0, int dst_row0, LAS float* scr, int lane) {
#pragma unroll 8
    for (int i = 0; i < 32; ++i) { const int kk = 2 * i + (lane >> 5); scr[kk * 33 + (lane & 31)] = W[(size_t)(k0 + kk) * N + n0 + (lane & 31)]; }
    asm volatile("s_waitcnt lgkmcnt(0)" ::: "memory");
    const int c = lane & 7;
#pragma unroll
    for (int j = 0; j < 4; ++j) { const int n = (lane >> 3) + 8 * j; const LAS float* s = scr + (8 * c) * 33 + n;
        u32x4 o; o.x = pk2(s[0 * 33], s[1 * 33]); o.y = pk2(s[2 * 33], s[3 * 33]); o.z = pk2(s[4 * 33], s[5 * 33]); o.w = pk2(s[6 * 33], s[7 * 33]);
        *(u32x4*)(WT + (size_t)(dst_row0 + n) * KD + k0 + 8 * c) = o; }
    asm volatile("s_waitcnt lgkmcnt(0)" ::: "memory");
}

__device__ __forceinline__ void transpose_item_f8(const float* W, int N, unsigned char* WT, int k0, int n0, int dst_row0, float scale, LAS float* scr, int lane) {
#pragma unroll 8
    for (int i = 0; i < 64; ++i) { const int kk = 2 * i + (lane >> 5); scr[kk * 33 + (lane & 31)] = W[(size_t)(k0 + kk) * N + n0 + (lane & 31)]; }
    asm volatile("s_waitcnt lgkmcnt(0)" ::: "memory");
    const int c = lane & 7;
#pragma unroll
    for (int j = 0; j < 4; ++j) { const int n = (lane >> 3) + 8 * j; const LAS float* s = scr + (16 * c) * 33 + n;
        u32x4 o;
        o.x = pk4_f8(s[0 * 33] * scale, s[1 * 33] * scale, s[2 * 33] * scale, s[3 * 33] * scale); o.y = pk4_f8(s[4 * 33] * scale, s[5 * 33] * scale, s[6 * 33] * scale, s[7 * 33] * scale);
        o.z = pk4_f8(s[8 * 33] * scale, s[9 * 33] * scale, s[10 * 33] * scale, s[11 * 33] * scale); o.w = pk4_f8(s[12 * 33] * scale, s[13 * 33] * scale, s[14 * 33] * scale, s[15 * 33] * scale);
        *(u32x4*)(WT + (size_t)(dst_row0 + n) * KD + k0 + 16 * c) = o; }
    asm volatile("s_waitcnt lgkmcnt(0)" ::: "memory");
}

__device__ __forceinline__ void moe_tables(volatile LAS int* tb, unsigned* ctl, int wave_id) {
    if (wave_id == 0 && lane_now() == 0) {
        int off = 0;
        for (int e = 0; e < NE; ++e) { const int c = (int)__hip_atomic_load(ctl + CW_CNT + 64 * e, RLX_AGENT); const int nt = (c + 255) >> 8;
            tb[1 + e] = off; for (int r = 0; r < nt; ++r) tb[64 + off + r] = e; off += nt; }
        tb[1 + NE] = off; tb[0] = off;
    }
    __syncthreads();
}

__global__ void __launch_bounds__(NTHREADS, 2) fwd(Args args) {
    extern __shared__ __attribute__((aligned(16))) unsigned char lds_raw[];
    LAS unsigned char* lds = (LAS unsigned char*)lds_raw;
    volatile LAS unsigned* MISC = (volatile LAS unsigned*)(lds + MISC_OFF);
    const int wave = __builtin_amdgcn_readfirstlane(threadIdx.x >> 6);
#define LANE_TID() const int lane = lane_now(), tid = wave * 64 + lane, gt = bid * NTHREADS + tid; (void)tid; (void)gt
    const int G = gridDim.x, bid = blockIdx.x;
    unsigned char* ws = args.ws;
    unsigned* ctl = (unsigned*)(ws + WS_CTL);
    if (wave == 0) MISC[lane_now()] = 0u;
    __syncthreads();
    XcdBarrier bar; bar.bar = ctl + CW_BAR; bar.x = 0; bar.st = nullptr;
    if (args.use_bar) bar = xcd_barrier_post(ctl + CW_BAR, MISC);
    const int lo = args.ph_lo, hi = args.ph_hi;
#ifndef DUP_MASK
#define DUP_MASK 0
#endif
#define REP(k) for (int rep_ = 0; rep_ <= ((DUP_MASK >> (k)) & 1); ++rep_)
#define IN(k) (lo <= (k) && (k) < hi)
#ifndef PROBE_PHASE
#define PROBE_PHASE -1
#endif
    unsigned long long tprobe0 = 0ull, tprobe1 = 0ull;
#define SEAM(k) do { if (IN(k) && IN((k) + 1)) xcd_barrier(bar, wave); if (PROBE_PHASE >= 0) { if ((k) + 1 == PROBE_PHASE) tprobe0 = __builtin_amdgcn_s_memrealtime(); if ((k) == PROBE_PHASE) tprobe1 = __builtin_amdgcn_s_memrealtime(); } } while (0)
    if (PROBE_PHASE == 0) tprobe0 = __builtin_amdgcn_s_memrealtime();
    const int gw = bid * NWAVES + wave, NGW = G * NWAVES;
    const int NGT = G * NTHREADS;

    bf16_t* WinT = (bf16_t*)(ws + WS_WIN); bf16_t* WoT = (bf16_t*)(ws + WS_WO); unsigned char* W1F = ws + WS_W1; unsigned char* W2F = ws + WS_W2;
    bf16_t* XN = (bf16_t*)(ws + WS_XN); bf16_t* P = (bf16_t*)(ws + WS_P);
    float* LA = (float*)(ws + WS_LA); float* LB = (float*)(ws + WS_LB);
    float* BON = (float*)(ws + WS_BON);
    bf16_t* CAT = (bf16_t*)(ws + WS_CAT); float* Z = (float*)(ws + WS_Z); float* H1 = (float*)(ws + WS_H1); unsigned char* H1F = ws + WS_H1B;
    int* TOPE = (int*)(ws + WS_TOPE); int* TOPP = (int*)(ws + WS_TOPP); float* TOPG = (float*)(ws + WS_TOPG); int* TOKSLOT = (int*)(ws + WS_TOKSLOT);
    int* SLOTTOK = (int*)(ws + WS_SLOTTOK); float* SLOTG = (float*)(ws + WS_SLOTG);
    unsigned char* ACT = ws + WS_ACT; bf16_t* OUTS = (bf16_t*)(ws + WS_OUTS);

    constexpr int CV_I_IN = (KD / 64) * (NP / 32), CV_I_OUT = (KD / 64) * (D / 32), CV_I_E1 = (KD / 128) * (2 * DE / 32), CV_I_E2 = (DE / 128) * (D / 32);
    constexpr int CV_NITEMS = CV_I_IN + CV_I_OUT + NE * CV_I_E1 + NE * CV_I_E2;
#ifndef CV_SHADOW
#define CV_SHADOW 9200
#endif
#ifndef CV_SHADOW1
#define CV_SHADOW1 5120
#endif
#define CONVERT_ITEM(it_) do { int r = (it_); LAS float* scr = (LAS float*)(lds + wave * 17408); \
        if (r < CV_I_IN) { const int nb = NP / 32, kb = r / nb, n0 = (r % nb) * 32; transpose_item(args.in[I_WIN], NP, WinT, kb * 64, n0, n0, scr, lane); break; } r -= CV_I_IN; \
        if (r < CV_I_OUT) { const int nb = D / 32, kb = r / nb, n0 = (r % nb) * 32; transpose_item(args.in[I_WOUT], D, WoT, kb * 64, n0, n0, scr, lane); break; } r -= CV_I_OUT; \
        if (r < NE * CV_I_E1) { const int e = r / CV_I_E1, q = r % CV_I_E1, nb = 2 * DE / 32, kb = q / nb, n0 = (q % nb) * 32; \
            const int isup = n0 >= DE ? 1 : 0, nn = n0 - isup * DE, drow = 256 * (nn >> 7) + 128 * isup + (nn & 127); \
            transpose_item_f8(args.in[I_WE1] + (size_t)e * KD * 2 * DE, 2 * DE, W1F + (size_t)e * 2 * DE * KD, kb * 128, n0, drow, F8_SW1, scr, lane); break; } r -= NE * CV_I_E1; \
        { const int e = r / CV_I_E2, q = r % CV_I_E2, nb = D / 32, kb = q / nb, n0 = (q % nb) * 32; \
            transpose_item_f8(args.in[I_WE2] + (size_t)e * DE * D, D, W2F + (size_t)e * D * DE, kb * 128, n0, n0, F8_SW2, scr, lane); } } while (0)

    if (IN(0)) REP(0) {
        LANE_TID();
        for (int it = gw; it < CV_NITEMS - CV_SHADOW - CV_SHADOW1; it += NGW) CONVERT_ITEM(it);
        { bf16_t* WG = (bf16_t*)(ws + WS_WG); bf16_t* WL = (bf16_t*)(ws + WS_WL);
            for (int i = gt; i < 2048 * 256; i += NGT) { const int row = i >> 8, kl = i & 255, g_ = row >> 10, nb = (row >> 6) & 15, k = row & 63, blk = kl >> 6, j = kl & 63;
                const float v = ((nb & 3) == blk) ? args.in[g_ ? I_WIG : I_WRG][(size_t)(nb * 64 + j) * 64 + k] : 0.f; WG[i] = cvt1(v); }
            for (int i = gt; i < 3072 * 256; i += NGT) { const int row = i >> 8, kl = i & 255, sel = row >> 10, c = row & 1023;
                float v = 0.f; if (sel == 0) { if (kl < DLORA) v = args.in[I_DECUP][(size_t)kl * RW_W + c]; } else if (sel == 1) { if (kl < ALORA) v = args.in[I_AAAUP][(size_t)kl * RW_W + c]; } else v = args.in[I_GATEUP][(size_t)kl * RW_W + c];
                WL[i] = cvt1(v); } }
        { bf16_t* WRH = (bf16_t*)(ws + WS_WRT); bf16_t* WRL = WRH + NE * D;
            for (int i = gt; i < NE * D; i += NGT) { const int e = i >> 11, k = i & 2047; const float w = args.in[I_WROUTER][(size_t)k * NE + e]; const unsigned short h = cvt1(w); WRH[i] = h; WRL[i] = cvt1(w - bf2f(h)); } }
        for (int i = gt; i < (NPP - NP) * KD / 8; i += NGT) ((u32x4*)(WinT + (size_t)NP * KD))[i] = (u32x4){0u, 0u, 0u, 0u};
        const float* lg = args.in[I_LNG]; const float* lb = args.in[I_LNB];
        for (int m = gw; m < M; m += NGW) {
            const f32x4* xr = (const f32x4*)(args.in[I_X] + (size_t)m * D) + lane;
            f32x4 v[8]; float s = 0.f;
#pragma unroll
            for (int j = 0; j < 8; ++j) { v[j] = xr[64 * j]; s += (v[j][0] + v[j][1]) + (v[j][2] + v[j][3]); }
            const float mean = wave_sum(s) * (1.f / D); float s2 = 0.f;
#pragma unroll
            for (int j = 0; j < 8; ++j) { v[j] = v[j] - mean; s2 += (v[j][0] * v[j][0] + v[j][1] * v[j][1]) + (v[j][2] * v[j][2] + v[j][3] * v[j][3]); }
            const float rstd = 1.f / sqrtf(wave_sum(s2) * (1.f / D) + LN_EPS);
            u32x2* o8 = (u32x2*)(XN + (size_t)m * D) + lane;
#pragma unroll
            for (int j = 0; j < 8; ++j) { const f32x4 g4 = ((const f32x4*)lg)[64 * j + lane], b4 = ((const f32x4*)lb)[64 * j + lane]; const f32x4 y = v[j] * rstd * g4 + b4;
                u32x2 w; w.x = pk2(y[0], y[1]); w.y = pk2(y[2], y[3]); o8[64 * j] = w; }
        }
    }
    SEAM(0);

    if (IN(1)) REP(1) {
        LANE_TID();
        pg8::StaticOrder S; S.init(M, NPP, G, bid);
        pg8::EpiBf16 E{P, NPP};
        pg8::gemm_phase<pg8::EpiBf16, pg8::StaticOrder, pg8::DenseRows, true>(lds, XN, WinT, S, E, pg8::DenseRows{}, wave);
        if (G == 256 && bid >= 128) {
            __syncthreads();
            for (int it = CV_NITEMS - CV_SHADOW - CV_SHADOW1 + (bid - 128) * NWAVES + wave; it < CV_NITEMS - CV_SHADOW; it += 128 * NWAVES) CONVERT_ITEM(it); }
        else if (G != 256) { for (int it = CV_NITEMS - CV_SHADOW - CV_SHADOW1 + gw; it < CV_NITEMS - CV_SHADOW; it += NGW) CONVERT_ITEM(it); }
    }
    SEAM(1);

    if (IN(2)) REP(2) {
        LANE_TID();
        bf16_t* UC = (bf16_t*)(ws + WS_UC); bf16_t* XL = (bf16_t*)(ws + WS_XL);
        const float* conv_w = args.in[I_CONVW]; const float* conv_b = args.in[I_CONVB]; const float* mu = args.in[I_MU];
        for (int idx = gt; idx < (M / 16) * (LRU_W / 8); idx += NGT) { const int m0 = (idx >> 7) * 16, c = (idx & 127) * 8, tin0 = m0 & (SEQ - 1);
            f32x4 wlo[4], whi[4];
#pragma unroll
            for (int j = 0; j < 4; ++j) { wlo[j] = *(const f32x4*)(conv_w + j * LRU_W + c); whi[j] = *(const f32x4*)(conv_w + j * LRU_W + c + 4); }
            const f32x4 cb0 = *(const f32x4*)(conv_b + c), cb1 = *(const f32x4*)(conv_b + c + 4);
            u32x4 row[19];
#pragma unroll
            for (int j = 0; j < 19; ++j) { row[j] = (u32x4){0u, 0u, 0u, 0u}; if (tin0 - 3 + j >= 0) row[j] = *(const u32x4*)(P + (size_t)(m0 - 3 + j) * NPP + c); }
#pragma unroll
            for (int t = 0; t < 16; ++t) { f32x4 o0 = cb0, o1 = cb1;
#pragma unroll
                for (int j = 0; j < 4; ++j) { const u32x4 pv = row[t + j];
                    o0[0] += wlo[j][0] * bflo(pv.x); o0[1] += wlo[j][1] * bfhi(pv.x); o0[2] += wlo[j][2] * bflo(pv.y); o0[3] += wlo[j][3] * bfhi(pv.y);
                    o1[0] += whi[j][0] * bflo(pv.z); o1[1] += whi[j][1] * bfhi(pv.z); o1[2] += whi[j][2] * bflo(pv.w); o1[3] += whi[j][3] * bfhi(pv.w); }
                *(u32x4*)(UC + (size_t)(m0 + t) * LRU_W + c) = (u32x4){cvt2(o0[0], o0[1]), cvt2(o0[2], o0[3]), cvt2(o1[0], o1[1]), cvt2(o1[2], o1[3])}; } }
        for (int idx = gt; idx < M * 64; idx += NGT) { const int m = idx >> 6, q = idx & 63, tin = m & (SEQ - 1);
            u32x4 res = {0u, 0u, 0u, 0u};
            const int kind = q < 12 ? 0 : (q < 16 ? 3 : (q < 28 ? 1 : (q < 32 ? 3 : 2)));
            if (kind != 3) { const int col = (kind == 0) ? 3 * RW_W + 8 * q : (kind == 1 ? 3 * RW_W + DLORA + 8 * (q - 16) : 3 * RW_W + DLORA + ALORA + 8 * (q - 32));
                const bf16_t* pp = P + (size_t)m * NPP + 2 * LRU_W + col; const u32x4 pc = *(const u32x4*)pp; u32x4 pq = {0u, 0u, 0u, 0u}; if (tin > 0) pq = *(const u32x4*)(pp - NPP);
                const f32x4 m0 = *(const f32x4*)(mu + col), m1 = *(const f32x4*)(mu + col + 4);
                float s[8]; const unsigned pcw[4] = {pc.x, pc.y, pc.z, pc.w}, pqw[4] = {pq.x, pq.y, pq.z, pq.w};
#pragma unroll
                for (int e = 0; e < 4; ++e) { const float c0 = bflo(pcw[e]), c1 = bfhi(pcw[e]), p0 = bflo(pqw[e]), p1 = bfhi(pqw[e]);
                    const float mu0 = (e < 2) ? m0[2 * e] : m1[2 * e - 4], mu1 = (e < 2) ? m0[2 * e + 1] : m1[2 * e - 3];
                    s[2 * e] = c0 + (p0 - c0) * mu0; s[2 * e + 1] = c1 + (p1 - c1) * mu1; }
#pragma unroll
                for (int e = 0; e < 8; ++e) s[e] = (kind == 0) ? tanh_fast(s[e]) : (kind == 1 ? s[e] : sigmoidf_(s[e]));
                res = (u32x4){cvt2(s[0], s[1]), cvt2(s[2], s[3]), cvt2(s[4], s[5]), cvt2(s[6], s[7])}; }
            *(u32x4*)(XL + (size_t)m * 512 + 8 * q) = res; }
    }
    SEAM(2);

    if (IN(3)) {
        LANE_TID();
        const bf16_t* UC = (const bf16_t*)(ws + WS_UC); const bf16_t* XL = (const bf16_t*)(ws + WS_XL);
        { pg8::SmallOrder<0> S{G, bid}; pg8::EpiBf16 E{(bf16_t*)(ws + WS_GATES), 2048};
          pg8::gemm_phase<pg8::EpiBf16, pg8::SmallOrder<0>, pg8::DenseRows, true, LRU_W, 256>(lds, UC, (const bf16_t*)(ws + WS_WG), S, E, pg8::DenseRows{}, wave); }
        { pg8::SmallOrder<1> S{G, bid}; pg8::EpiBf16 E{(bf16_t*)(ws + WS_LOUT), 3072};
          pg8::gemm_phase<pg8::EpiBf16, pg8::SmallOrder<1>, pg8::DenseRows, true, 512, 256>(lds, XL, (const bf16_t*)(ws + WS_WL), S, E, pg8::DenseRows{}, wave); }
    }
    SEAM(3);

    if (IN(4)) {
        LANE_TID();
        constexpr int RS = 144;
        constexpr int L_AT = 0, L_BT = 9216, L_KT = 18432, L_RT = 27648, L_VT = 36864, L_BH = 46080, L_KH = 55296, L_AAB = 64512, L_AAK = 80896, L_ARB = 90112, L_ARK = 99328,
                      L_PT = 108544, L_QT = 117760, L_WC = 126976, L_A16 = 129280, L_TB = 138496, L_SEG = 140544, L_U = L_BT, L_MST = L_AT, L_GST = L_BT;
        bf16_t* MT = (bf16_t*)(ws + WS_MT); bf16_t* GG = (bf16_t*)(ws + WS_GG); float* NN = (float*)(ws + WS_NN); float* HH = (float*)(ws + WS_HH);
        const bf16_t* LOUT = (const bf16_t*)(ws + WS_LOUT); bf16_t* V16 = (bf16_t*)(ws + WS_V16); bf16_t* G16 = (bf16_t*)(ws + WS_G16); const float* mu_ = args.in[I_MU];
        const int r = lane & 31, hh = lane >> 5;
        unsigned xr[5], xk[5], xv[5], xd[4], xa[4], xg[4];
#define E_LOAD(u_) do { const int cch_ = (u_) & 63, head_ = ((u_) >> 6) & 15, b_ = (u_) >> 10; const int sg_ = 2 * wave + (lane >> 5); const size_t tokb_ = (size_t)b_ * SEQ + cch_ * 64 + 4 * sg_; const int c_ = head_ * HS + 2 * (lane & 31); \
            const bf16_t* pp_ = P + tokb_ * NPP + 2 * LRU_W + c_; const bool hp_ = ((cch_ * 64 + 4 * sg_) & (SEQ - 1)) != 0; \
            xr[0] = hp_ ? *(const unsigned*)(pp_ - NPP) : 0u; xk[0] = hp_ ? *(const unsigned*)(pp_ - NPP + RW_W) : 0u; xv[0] = hp_ ? *(const unsigned*)(pp_ - NPP + 2 * RW_W) : 0u; \
            _Pragma("unroll") for (int j = 0; j < 4; ++j) { const bf16_t* pj = pp_ + (size_t)j * NPP; xr[j + 1] = *(const unsigned*)pj; xk[j + 1] = *(const unsigned*)(pj + RW_W); xv[j + 1] = *(const unsigned*)(pj + 2 * RW_W); \
                const bf16_t* lj = LOUT + (tokb_ + j) * 3072 + c_; xd[j] = *(const unsigned*)lj; xa[j] = *(const unsigned*)(lj + 1024); xg[j] = *(const unsigned*)(lj + 2048); } } while (0)
        if (bid < NUNIT) E_LOAD(bid);
        REP(4) for (int u = bid; u < NUNIT; u += G) {
            const int cch = u & 63, head = (u >> 6) & 15, b = u >> 10; const size_t tok0 = (size_t)b * SEQ + cch * 64;
            { const int cp = lane & 31, hq = lane >> 5, sg = 2 * wave + hq, ch = 2 * cp, c = head * HS + ch; const size_t tokb = tok0 + 4 * sg;
                float lw[4][2], rr_[4][2], kk_[4][2], vv_[4][2], kn_[4][2], aa_[4][2];
                { const f32x2 mur = *(const f32x2*)(mu_ + c), muk = *(const f32x2*)(mu_ + RW_W + c), muv = *(const f32x2*)(mu_ + 2 * RW_W + c);
                    const f32x2 w0c = *(const f32x2*)(args.in[I_W0] + c), a0c = *(const f32x2*)(args.in[I_A0] + c), kkc = *(const f32x2*)(args.in[I_KK] + c), kac = *(const f32x2*)(args.in[I_KA] + c), rkc = *(const f32x2*)(args.in[I_RK] + c);
                    float bonv[4];
#pragma unroll
                    for (int j = 0; j < 4; ++j) { float s_kk = 0.f, s_bo = 0.f;
#pragma unroll
                        for (int x = 0; x < 2; ++x) { const float cr = x ? bfhi(xr[j + 1]) : bflo(xr[j + 1]), ck = x ? bfhi(xk[j + 1]) : bflo(xk[j + 1]), cv = x ? bfhi(xv[j + 1]) : bflo(xv[j + 1]);
                            const float pr = x ? bfhi(xr[j]) : bflo(xr[j]), pk_ = x ? bfhi(xk[j]) : bflo(xk[j]), pvv = x ? bfhi(xv[j]) : bflo(xv[j]);
                            const float r = cr + (pr - cr) * mur[x], k = ck + (pk_ - ck) * muk[x], v = cv + (pvv - cv) * muv[x];
                            const float lgw = -0.6065306597126334f * sigmoidf_(w0c[x] + (x ? bfhi(xd[j]) : bflo(xd[j])));
                            const float a = sigmoidf_(a0c[x] + (x ? bfhi(xa[j]) : bflo(xa[j])));
                            const float kk = k * kkc[x]; const float km = k * (1.f + (a - 1.f) * kac[x]);
                            s_kk += kk * kk; s_bo += r * km * rkc[x];
                            lw[j][x] = lgw; rr_[j][x] = r; kk_[j][x] = km; vv_[j][x] = v; kn_[j][x] = kk; aa_[j][x] = a; }
                        const float inv = __builtin_amdgcn_rsqf(fmaxf(half_sum(s_kk, hq), 1e-24f)); kn_[j][0] *= inv; kn_[j][1] *= inv;
                        bonv[j] = half_sum(s_bo, hq); }
#pragma unroll
                    for (int j = 0; j < 4; ++j) { *(unsigned*)(V16 + (tokb + j) * RW_W + c) = cvt2(vv_[j][0], vv_[j][1]); *(unsigned*)(G16 + (tokb + j) * RW_W + c) = xg[j]; }
                    if (cp < 4) { float bsel = bonv[0];
#pragma unroll
                        for (int j = 1; j < 4; ++j) bsel = (cp == j) ? bonv[j] : bsel;
                        BON[(tokb + cp) * NHEAD + head] = bsel; }
                    if (u + G < NUNIT) E_LOAD(u + G); }
                f32x2 seg = {0.f, 0.f};
#pragma unroll
                for (int j = 0; j < 4; ++j) { seg[0] += lw[j][0]; seg[1] += lw[j][1]; }
                *(LAS f32x2*)(lds + L_SEG + (sg * 64 + ch) * 4) = seg;
                __syncthreads();
                f32x2 pre = {0.f, 0.f}, tot = {0.f, 0.f};
#pragma unroll
                for (int g = 0; g < 16; ++g) { const f32x2 sv = *(const LAS f32x2*)(lds + L_SEG + (g * 64 + ch) * 4); tot += sv; if (g < sg) pre += sv; }
                if (sg == 0) *(LAS f32x2*)(lds + L_WC + ch * 4) = (f32x2){__expf(tot[0]), __expf(tot[1])};
                float tv[2][4], tb_[2][4], tk[2][4];
#pragma unroll
                for (int x = 0; x < 2; ++x) { float L = pre[x]; const float eTot = __expf(tot[x]); float eLex = __expf(pre[x]);
#pragma unroll
                    for (int j = 0; j < 4; ++j) { L += lw[j][x];
                        const float eL = __expf(L), eNL = __builtin_amdgcn_rcpf(eL), eEnd = eTot * eNL; const float beta = kn_[j][x] * aa_[j][x];
                        rr_[j][x] = rr_[j][x] * eL; const float at_ = kn_[j][x] * eLex, bt_ = beta * eNL, kt_ = kk_[j][x] * eNL;
                        tv[x][j] = vv_[j][x]; tb_[x][j] = -beta * eEnd; tk[x][j] = kk_[j][x] * eEnd; eLex = eL;
                        kn_[j][x] = at_; aa_[j][x] = bt_; kk_[j][x] = kt_; } }
#pragma unroll
                for (int j = 0; j < 4; ++j) { const int t = 4 * sg + j;
                    *(LAS unsigned*)(lds + L_AT + t * RS + ch * 2) = cvt2(kn_[j][0], kn_[j][1]);
                    *(LAS unsigned*)(lds + L_BT + t * RS + ch * 2) = cvt2(aa_[j][0], aa_[j][1]);
                    *(LAS unsigned*)(lds + L_KT + t * RS + ch * 2) = cvt2(kk_[j][0], kk_[j][1]);
                    *(LAS unsigned*)(lds + L_RT + t * RS + ch * 2) = cvt2(rr_[j][0], rr_[j][1]); }
#pragma unroll
                for (int x = 0; x < 2; ++x) {
                    *(LAS u32x2*)(lds + L_VT + (ch + x) * RS + sg * 8) = (u32x2){cvt2(tv[x][0], tv[x][1]), cvt2(tv[x][2], tv[x][3])};
                    *(LAS u32x2*)(lds + L_BH + (ch + x) * RS + sg * 8) = (u32x2){cvt2(tb_[x][0], tb_[x][1]), cvt2(tb_[x][2], tb_[x][3])};
                    *(LAS u32x2*)(lds + L_KH + (ch + x) * RS + sg * 8) = (u32x2){cvt2(tk[x][0], tk[x][1]), cvt2(tk[x][2], tk[x][3])}; }
            }
            __syncthreads();
            { const int id = wave >> 1, i = wave & 1; const int X = (id < 2) ? L_AT : L_RT, Y = (id & 1) ? L_KT : L_BT;
                f32x16 acc[2];
#pragma unroll
                for (int q = 0; q < 2; ++q)
#pragma unroll
                    for (int e = 0; e < 16; ++e) acc[q][e] = 0.f;
#pragma unroll
                for (int s = 0; s < 4; ++s) { const bf16x8 a = *(const LAS bf16x8*)(lds + X + (32 * i + r) * RS + (16 * s + 8 * hh) * 2);
#pragma unroll
                    for (int q = 0; q < 2; ++q) { const bf16x8 bb = *(const LAS bf16x8*)(lds + Y + (32 * q + r) * RS + (16 * s + 8 * hh) * 2); acc[q] = MFMA32(a, bb, acc[q]); } }
#pragma unroll
                for (int q = 0; q < 2; ++q)
#pragma unroll
                    for (int e = 0; e < 16; ++e) { const int t = 32 * i + crow(e, hh), sc = 32 * q + r; const bool keep = (id < 2) ? (sc < t) : (sc <= t);
                        float val = keep ? acc[q][e] : 0.f; if (id == 2) val = -val;
                        if (id == 0) { ((LAS float*)(lds + L_AAB))[t * 64 + sc] = val; *(LAS unsigned short*)(lds + L_A16 + t * RS + sc * 2) = cvt1(-val); }
                        else *(LAS unsigned short*)(lds + L_AAK + (id - 1) * 9216 + t * RS + sc * 2) = cvt1(val); }
            }
            __syncthreads();
            if (wave < 4) { const int i = wave >> 1, q = wave & 1; f32x16 acc;
#pragma unroll
                for (int e = 0; e < 16; ++e) acc[e] = 0.f;
#pragma unroll
                for (int s = 0; s < 4; ++s) { const bf16x8 a = *(const LAS bf16x8*)(lds + L_AAK + (32 * i + r) * RS + (16 * s + 8 * hh) * 2);
                    const bf16x8 bb = *(const LAS bf16x8*)(lds + L_VT + (32 * q + r) * RS + (16 * s + 8 * hh) * 2); acc = MFMA32(a, bb, acc); }
#pragma unroll
                for (int e = 0; e < 16; ++e) ((LAS float*)(lds + L_U))[(32 * i + crow(e, hh)) * 64 + 32 * q + r] = acc[e];
            }
            if (wave == 4) { const int b2 = lane >> 4, j = lane & 15; float x[16];
                const LAS float* AB = (const LAS float*)(lds + L_AAB) + (16 * b2) * 64 + 16 * b2;
#pragma unroll
                for (int t = 0; t < 16; ++t) x[t] = (t == j) ? 1.f : 0.f;
                { f32x4 Ar[8][2];
#pragma unroll
                    for (int t = 1; t < 8; ++t)
#pragma unroll
                        for (int s4 = 0; s4 < (t + 3) / 4; ++s4) Ar[t][s4] = *(const LAS f32x4*)(AB + t * 64 + 4 * s4);
#pragma unroll
                    for (int s = 0; s < 7; ++s) { const float xs = x[s];
#pragma unroll
                        for (int t = s + 1; t < 8; ++t) x[t] -= Ar[t][s >> 2][s & 3] * xs; } }
                { f32x4 Ar[8][2];
#pragma unroll
                    for (int t = 0; t < 8; ++t)
#pragma unroll
                        for (int s4 = 0; s4 < 2; ++s4) Ar[t][s4] = *(const LAS f32x4*)(AB + (8 + t) * 64 + 4 * s4);
#pragma unroll
                    for (int t = 0; t < 8; ++t) { float a0 = 0.f, a1 = 0.f;
#pragma unroll
                        for (int s = 0; s < 8; s += 2) { a0 += Ar[t][s >> 2][s & 3] * x[s]; a1 += Ar[t][(s + 1) >> 2][(s + 1) & 3] * x[s + 1]; }
                        x[8 + t] -= (a0 + a1); } }
                { f32x4 Ar[8][2];
#pragma unroll
                    for (int t = 1; t < 8; ++t)
#pragma unroll
                        for (int s4 = 0; s4 < (t + 3) / 4; ++s4) Ar[t][s4] = *(const LAS f32x4*)(AB + (8 + t) * 64 + 8 + 4 * s4);
#pragma unroll
                    for (int s = 0; s < 7; ++s) { const float xs = x[8 + s];
#pragma unroll
                        for (int t = s + 1; t < 8; ++t) x[8 + t] -= Ar[t][s >> 2][s & 3] * xs; } }
#pragma unroll
                for (int t = 0; t < 16; ++t) *(LAS unsigned short*)(lds + L_TB + ((b2 * 16 + t) * 16 + j) * 2) = cvt1(x[t]);
            }
            __syncthreads();
            { const int c16 = lane & 15, quad = lane >> 4, isQ = wave >> 2, colb = 16 * (wave & 3) + c16;
                f32x4 Xr[4];
#pragma unroll
                for (int b2 = 0; b2 < 4; ++b2) Xr[b2] = (f32x4){0.f, 0.f, 0.f, 0.f};
#pragma unroll
                for (int b2 = 0; b2 < 4; ++b2) {
                    f32x4 y;
#pragma unroll
                    for (int g = 0; g < 4; ++g) { const int row = 16 * b2 + 4 * quad + g;
                        y[g] = isQ ? ((const LAS float*)(lds + L_U))[row * 64 + colb] : bf2f(*(const LAS unsigned short*)(lds + L_AT + row * RS + colb * 2)); }
#pragma unroll
                    for (int ks = 0; ks < 2; ++ks) if (2 * ks < b2) {
                        const u32x2 alo = *(const LAS u32x2*)(lds + L_A16 + (16 * b2 + c16) * RS + (32 * ks + 4 * quad) * 2);
                        u32x2 ahi = {0u, 0u}; if (2 * ks + 1 < b2) ahi = *(const LAS u32x2*)(lds + L_A16 + (16 * b2 + c16) * RS + (32 * ks + 16 + 4 * quad) * 2);
                        const u32x4 af = {alo.x, alo.y, ahi.x, ahi.y};
                        const u32x4 bf = {cvt2(Xr[2 * ks][0], Xr[2 * ks][1]), cvt2(Xr[2 * ks][2], Xr[2 * ks][3]), cvt2(Xr[2 * ks + 1][0], Xr[2 * ks + 1][1]), cvt2(Xr[2 * ks + 1][2], Xr[2 * ks + 1][3])};
                        y = __builtin_amdgcn_mfma_f32_16x16x32_bf16(__builtin_bit_cast(bf16x8, af), __builtin_bit_cast(bf16x8, bf), y, 0, 0, 0); }
                    const u32x2 tlo = *(const LAS u32x2*)(lds + L_TB + ((b2 * 16 + c16) * 16 + 4 * quad) * 2);
                    const u32x4 tf = {tlo.x, tlo.y, 0u, 0u};
                    const u32x4 yf = {cvt2(y[0], y[1]), cvt2(y[2], y[3]), 0u, 0u};
                    Xr[b2] = __builtin_amdgcn_mfma_f32_16x16x32_bf16(__builtin_bit_cast(bf16x8, tf), __builtin_bit_cast(bf16x8, yf), (f32x4){0.f, 0.f, 0.f, 0.f}, 0, 0, 0);
                    *(LAS u32x2*)(lds + (isQ ? L_QT : L_PT) + colb * RS + (16 * b2 + 4 * quad) * 2) = (u32x2){cvt2(Xr[b2][0], Xr[b2][1]), cvt2(Xr[b2][2], Xr[b2][3])};
                }
            }
            __syncthreads();
            { const int mtx = wave >> 1, i = wave & 1;
                const int X1 = (mtx == 0) ? L_BH : (mtx == 1) ? L_KH : (mtx == 2) ? L_ARB : L_ARK;
                const int Y1 = (mtx == 0 || mtx == 2) ? L_PT : L_VT;
                f32x16 acc[2];
#pragma unroll
                for (int q = 0; q < 2; ++q)
#pragma unroll
                    for (int e = 0; e < 16; ++e) acc[q][e] = 0.f;
#pragma unroll
                for (int s = 0; s < 4; ++s) { const bf16x8 a = *(const LAS bf16x8*)(lds + X1 + (32 * i + r) * RS + (16 * s + 8 * hh) * 2);
#pragma unroll
                    for (int q = 0; q < 2; ++q) { const bf16x8 bb = *(const LAS bf16x8*)(lds + Y1 + (32 * q + r) * RS + (16 * s + 8 * hh) * 2); acc[q] = MFMA32(a, bb, acc[q]); } }
                if (mtx & 1) { const int X2 = (mtx == 1) ? L_BH : L_ARB;
#pragma unroll
                    for (int s = 0; s < 4; ++s) { const bf16x8 a = *(const LAS bf16x8*)(lds + X2 + (32 * i + r) * RS + (16 * s + 8 * hh) * 2);
#pragma unroll
                        for (int q = 0; q < 2; ++q) { const bf16x8 bb = *(const LAS bf16x8*)(lds + L_QT + (32 * q + r) * RS + (16 * s + 8 * hh) * 2); acc[q] = MFMA32(a, bb, acc[q]); } } }
                if (mtx == 0) { const float wc = ((const LAS float*)(lds + L_WC))[32 * i + r];
#pragma unroll
                    for (int q = 0; q < 2; ++q)
#pragma unroll
                        for (int e = 0; e < 16; ++e) if (q == i && crow(e, hh) == r) acc[q][e] += wc; }
                if (mtx == 2) {
#pragma unroll
                    for (int q = 0; q < 2; ++q)
#pragma unroll
                        for (int e = 0; e < 16; ++e) acc[q][e] += bf2f(*(const LAS unsigned short*)(lds + L_RT + (32 * i + crow(e, hh)) * RS + (32 * q + r) * 2)); }
                if (mtx & 1) { unsigned* dstg = (unsigned*)((mtx == 1) ? NN : HH) + (size_t)u * 2048;
#pragma unroll
                    for (int q = 0; q < 2; ++q)
#pragma unroll
                        for (int e = 0; e < 16; e += 2) dstg[((i * 2 + q) * 8 + (e >> 1)) * 64 + lane] = cvt2(acc[q][e], acc[q][e + 1]);
                } else { const int dl = (mtx == 0) ? L_MST : L_GST;
#pragma unroll
                    for (int q = 0; q < 2; ++q)
#pragma unroll
                        for (int e = 0; e < 16; ++e) *(LAS unsigned short*)(lds + dl + (32 * i + crow(e, hh)) * RS + (32 * q + r) * 2) = cvt1(acc[q][e]); }
            }
            __syncthreads();
            { const int f = tid >> 6, i = f >> 2, q = (f >> 1) & 1, s = f & 1, r2 = lane & 31, h2 = lane >> 5; const int off = (32 * i + r2) * RS + (32 * q + 16 * s + 4 * h2) * 2;
                const u32x2 m0 = *(const LAS u32x2*)(lds + L_MST + off), m1 = *(const LAS u32x2*)(lds + L_MST + off + 16);
                const u32x2 g0 = *(const LAS u32x2*)(lds + L_GST + off), g1 = *(const LAS u32x2*)(lds + L_GST + off + 16);
                *(u32x4*)(MT + (size_t)u * 4096 + tid * 8) = (u32x4){m0.x, m0.y, m1.x, m1.y};
                *(u32x4*)(GG + (size_t)u * 4096 + tid * 8) = (u32x4){g0.x, g0.y, g1.x, g1.y}; }
            __syncthreads();
        }
        { float* CA = (float*)(ws + WS_CA); float* CH = (float*)(ws + WS_CH); const unsigned* UC2 = (const unsigned*)(ws + WS_UC); const unsigned* GT2 = (const unsigned*)(ws + WS_GATES);
            unsigned* LB2 = (unsigned*)LB; unsigned* LA2 = (unsigned*)LA;
            for (int bc = bid; bc < BATCH * 64; bc += G) { const size_t tok0 = (size_t)(bc >> 6) * SEQ + (bc & 63) * 64;
                float h[2] = {0.f, 0.f}, A[2] = {1.f, 1.f}, br[2], bi[2], sp[2];
#pragma unroll
                for (int cc = 0; cc < 2; ++cc) { const int c = 2 * tid + cc; br[cc] = args.in[I_BRG][c]; bi[cc] = args.in[I_BIG][c]; const float lam = args.in[I_LAMBDA][c];
                    sp[cc] = lam > 15.f ? __expf(-lam) : log1pf(__expf(-lam)); }
                unsigned gr[8], gi[8], uc[8];
#define LRU_LOAD(t_) do { _Pragma("unroll") for (int j = 0; j < 8; ++j) { const size_t tk = tok0 + (t_) + j; \
                    gr[j] = GT2[tk * 1024 + tid]; gi[j] = GT2[tk * 1024 + 512 + tid]; uc[j] = UC2[tk * 512 + tid]; } } while (0)
                LRU_LOAD(0);
#pragma unroll 1
                for (int t = 0; t < 64; t += 8) {
                    unsigned hv[8], av[8];
#pragma unroll
                    for (int j = 0; j < 8; ++j) { float hh_[2], aa_[2];
#pragma unroll
                        for (int cc = 0; cc < 2; ++cc) { const float gR = cc ? bfhi(gr[j]) : bflo(gr[j]), gI = cc ? bfhi(gi[j]) : bflo(gi[j]), uu = cc ? bfhi(uc[j]) : bflo(uc[j]);
                            const float rg = sigmoidf_(gR + br[cc]), ig = sigmoidf_(gI + bi[cc]);
                            const float a = __expf(-8.f * rg * sp[cc]), bb = sqrtf(fmaxf(1.f - a * a, 0.f)) * (ig * uu);
                            h[cc] = a * h[cc] + bb; A[cc] *= a; hh_[cc] = h[cc]; aa_[cc] = A[cc]; }
                        hv[j] = cvt2(hh_[0], hh_[1]); av[j] = cvt2(aa_[0], aa_[1]); }
                    if (t + 8 < 64) LRU_LOAD(t + 8);
#pragma unroll
                    for (int j = 0; j < 8; ++j) { LB2[(tok0 + t + j) * 512 + tid] = hv[j]; LA2[(tok0 + t + j) * 512 + tid] = av[j]; }
                }
#undef LRU_LOAD
                *(f32x2*)(CA + (size_t)bc * LRU_W + 2 * tid) = (f32x2){A[0], A[1]}; *(f32x2*)(CH + (size_t)bc * LRU_W + 2 * tid) = (f32x2){h[0], h[1]}; } }
    }
    SEAM(4);

    if (IN(5)) REP(5) {
        LANE_TID();
        if (bid < BATCH * NHEAD) {
            const bf16_t* MT = (const bf16_t*)(ws + WS_MT); const float* NN = (const float*)(ws + WS_NN); bf16_t* XS = (bf16_t*)(ws + WS_XS);
            constexpr int SLOT = 16384, NCH = SEQ / 64;
            const int u0 = bid * NCH;
            if (wave >= 2) {
                const int lw = wave - 2;
#define R2_ISSUE(c_) do { if (lw < 4) { const int _u = u0 + (c_); const int _sl = ((c_) & 3) * SLOT; _Pragma("unroll") for (int _rd = 0; _rd < 4; ++_rd) { const int _k0 = _rd * 256 + lw * 64; \
                    const char* _src = (_k0 < 512) ? (const char*)MT + (size_t)_u * 8192 + (size_t)(_k0 + lane) * 16 : (const char*)NN + (size_t)_u * 8192 + (size_t)(_k0 - 512 + lane) * 16; \
                    __builtin_amdgcn_global_load_lds((const unsigned*)_src, (LAS unsigned*)(lds + _sl + _k0 * 16), 16, 0, 0); } } } while (0)
                R2_ISSUE(0); R2_ISSUE(1); R2_ISSUE(2);
                for (int c = 0; c < NCH; ++c) {
                    if (c < NCH - 2) asm volatile("s_waitcnt vmcnt(8)" ::: "memory"); else if (c == NCH - 2) asm volatile("s_waitcnt vmcnt(4)" ::: "memory"); else asm volatile("s_waitcnt vmcnt(0)" ::: "memory");
                    __builtin_amdgcn_s_barrier();
                    asm volatile("" ::: "memory");
                    if (c + 3 < NCH) R2_ISSUE(c + 3);
                }
#undef R2_ISSUE
            } else {
                const int vh = wave;
                f32x16 X[2];
#pragma unroll
                for (int q = 0; q < 2; ++q)
#pragma unroll
                    for (int e = 0; e < 16; ++e) X[q][e] = 0.f;
                for (int c = 0; c < NCH; ++c) {
                    bf16x8 xb[2][2];
#pragma unroll
                    for (int q = 0; q < 2; ++q)
#pragma unroll
                        for (int s = 0; s < 2; ++s) { const u32x4 p = {cvt2(X[q][8 * s], X[q][8 * s + 1]), cvt2(X[q][8 * s + 2], X[q][8 * s + 3]), cvt2(X[q][8 * s + 4], X[q][8 * s + 5]), cvt2(X[q][8 * s + 6], X[q][8 * s + 7])};
                            xb[q][s] = __builtin_bit_cast(bf16x8, p);
                            *(u32x4*)(XS + (size_t)(u0 + c) * 4096 + (((vh * 2 + q) * 2 + s) * 64 + lane) * 8) = p; }
                    asm volatile("" ::: "memory");
                    __builtin_amdgcn_s_barrier();
                    asm volatile("" ::: "memory");
                    const LAS unsigned char* sl = lds + (c & 3) * SLOT;
#pragma unroll
                    for (int i = 0; i < 2; ++i) { f32x16 nx;
#pragma unroll
                        for (int e = 0; e < 16; e += 2) { const unsigned w_ = ((const LAS unsigned*)(sl + 8192))[((i * 2 + vh) * 8 + (e >> 1)) * 64 + lane]; nx[e] = bflo(w_); nx[e + 1] = bfhi(w_); }
#pragma unroll
                        for (int q = 0; q < 2; ++q)
#pragma unroll
                            for (int s = 0; s < 2; ++s) { const bf16x8 a = *(const LAS bf16x8*)(sl + ((i * 2 + q) * 2 + s) * 1024 + lane * 16); nx = MFMA32(a, xb[q][s], nx); }
                        X[i] = nx; }
                    asm volatile("s_waitcnt lgkmcnt(0)" ::: "memory");
                }
            }
        } else if (bid >= BATCH * NHEAD + 8) {
            const int nb_ = G - (BATCH * NHEAD + 8);
            for (int it = CV_NITEMS - CV_SHADOW + (bid - (BATCH * NHEAD + 8)) * NWAVES + wave; it < CV_NITEMS; it += nb_ * NWAVES) CONVERT_ITEM(it);
        } else {
            const float* CA = (const float*)(ws + WS_CA); const float* CH = (const float*)(ws + WS_CH); float* CIN = (float*)(ws + WS_CIN);
            const int i = (bid - BATCH * NHEAD) * NTHREADS + tid, b = i >> 10, c = i & 1023; float s = 0.f;
            for (int ch = 0; ch < 64; ch += 8) { float a[8], hh_[8];
#pragma unroll
                for (int j = 0; j < 8; ++j) { a[j] = CA[(size_t)(b * 64 + ch + j) * LRU_W + c]; hh_[j] = CH[(size_t)(b * 64 + ch + j) * LRU_W + c]; }
#pragma unroll
                for (int j = 0; j < 8; ++j) { CIN[(size_t)(b * 64 + ch + j) * LRU_W + c] = s; s = a[j] * s + hh_[j]; } }
        }
    }
    SEAM(5);

    if (IN(6)) REP(6) {
        LANE_TID();
        { const float* CIN = (const float*)(ws + WS_CIN);
            for (int idx = gt; idx < M * (LRU_W / 8); idx += NGT) { const int m = idx >> 7, c = (idx & 127) * 8; const size_t o = (size_t)m * LRU_W + c;
                const u32x4 gq = *(const u32x4*)(P + (size_t)m * NPP + LRU_W + c);
                const u32x4 hq = *(const u32x4*)((const bf16_t*)LB + o), aq = *(const u32x4*)((const bf16_t*)LA + o);
                const f32x4 h0 = {bflo(hq.x), bfhi(hq.x), bflo(hq.y), bfhi(hq.y)}, h1 = {bflo(hq.z), bfhi(hq.z), bflo(hq.w), bfhi(hq.w)}, a0 = {bflo(aq.x), bfhi(aq.x), bflo(aq.y), bfhi(aq.y)}, a1 = {bflo(aq.z), bfhi(aq.z), bflo(aq.w), bfhi(aq.w)};
                const f32x4 c0 = *(const f32x4*)(CIN + (size_t)(m >> 6) * LRU_W + c), c1 = *(const f32x4*)(CIN + (size_t)(m >> 6) * LRU_W + c + 4);
                const unsigned gw_[4] = {gq.x, gq.y, gq.z, gq.w}; float o8[8];
#pragma unroll
                for (int e = 0; e < 4; ++e) { const float hA = (e < 2 ? h0[2 * e] : h1[2 * e - 4]) + (e < 2 ? a0[2 * e] : a1[2 * e - 4]) * (e < 2 ? c0[2 * e] : c1[2 * e - 4]);
                    const float hB = (e < 2 ? h0[2 * e + 1] : h1[2 * e - 3]) + (e < 2 ? a0[2 * e + 1] : a1[2 * e - 3]) * (e < 2 ? c0[2 * e + 1] : c1[2 * e - 3]);
                    o8[2 * e] = hA * gelu_tanh(bflo(gw_[e])); o8[2 * e + 1] = hB * gelu_tanh(bfhi(gw_[e])); }
                *(u32x4*)(CAT + (size_t)m * D + c) = (u32x4){cvt2(o8[0], o8[1]), cvt2(o8[2], o8[3]), cvt2(o8[4], o8[5]), cvt2(o8[6], o8[7])}; } }
        const bf16_t* GG = (const bf16_t*)(ws + WS_GG); const bf16_t* XS = (const bf16_t*)(ws + WS_XS); const float* HH = (const float*)(ws + WS_HH);
        const bf16_t* V16 = (const bf16_t*)(ws + WS_V16); const bf16_t* G16 = (const bf16_t*)(ws + WS_G16);
        const float* gng = args.in[I_GNG]; const float* gnb = args.in[I_GNB];
        const int r = lane & 31, hh = lane >> 5;
        constexpr int YS = 68;
        LAS float* yt = (LAS float*)(lds + wave * (64 * YS * 4));
        for (int u = gw; u < NUNIT; u += NGW) {
            const int cch = u & 63, head = (u >> 6) & 15, b = u >> 10; const size_t tok0 = (size_t)b * SEQ + cch * 64;
            f32x16 acc[2][2];
#pragma unroll
            for (int i = 0; i < 2; ++i)
#pragma unroll
                for (int vh = 0; vh < 2; ++vh)
#pragma unroll
                    for (int e = 0; e < 16; e += 2) { const unsigned w_ = ((const unsigned*)HH)[(size_t)u * 2048 + ((i * 2 + vh) * 8 + (e >> 1)) * 64 + lane]; acc[i][vh][e] = bflo(w_); acc[i][vh][e + 1] = bfhi(w_); }
#pragma unroll
            for (int q = 0; q < 2; ++q)
#pragma unroll
                for (int s = 0; s < 2; ++s) { bf16x8 xb[2], ga[2];
#pragma unroll
                    for (int vh = 0; vh < 2; ++vh) xb[vh] = *(const bf16x8*)(XS + (size_t)u * 4096 + (((vh * 2 + q) * 2 + s) * 64 + lane) * 8);
#pragma unroll
                    for (int i = 0; i < 2; ++i) ga[i] = *(const bf16x8*)(GG + (size_t)u * 4096 + (((i * 2 + q) * 2 + s) * 64 + lane) * 8);
#pragma unroll
                    for (int i = 0; i < 2; ++i)
#pragma unroll
                        for (int vh = 0; vh < 2; ++vh) acc[i][vh] = MFMA32(ga[i], xb[vh], acc[i][vh]); }
#pragma unroll
            for (int i = 0; i < 2; ++i)
#pragma unroll
                for (int e = 0; e < 16; ++e) {
                    const float s1 = half_sum(acc[i][0][e] + acc[i][1][e], hh);
                    const float mean = s1 * (1.f / 64.f);
                    const float d0 = acc[i][0][e] - mean, d1 = acc[i][1][e] - mean; const float s2 = half_sum(d0 * d0 + d1 * d1, hh);
                    const float rstd = __builtin_amdgcn_rsqf(s2 * (1.f / 64.f) + GN_EPS);
                    const int t = 32 * i + crow(e, hh);
                    yt[t * YS + r] = d0 * rstd; yt[t * YS + 32 + r] = d1 * rstd; }
            asm volatile("s_waitcnt lgkmcnt(0)" ::: "memory");
            { const int tq = lane >> 3, c8 = (lane & 7) * 8, ch = head * HS + c8;
                const f32x4 g0 = *(const f32x4*)(gng + ch), g1 = *(const f32x4*)(gng + ch + 4), b0 = *(const f32x4*)(gnb + ch), b1 = *(const f32x4*)(gnb + ch + 4);
#pragma unroll 2
                for (int k = 0; k < 8; ++k) { const int t = tq + 8 * k; const size_t tok = tok0 + t; const size_t o = tok * RW_W + ch;
                    const f32x4 y0 = *(const LAS f32x4*)(yt + t * YS + c8), y1 = *(const LAS f32x4*)(yt + t * YS + c8 + 4);
                    const u32x4 vq = *(const u32x4*)(V16 + o), gq = *(const u32x4*)(G16 + o); const float bon = BON[tok * NHEAD + head];
                    const unsigned vw[4] = {vq.x, vq.y, vq.z, vq.w}, gw4[4] = {gq.x, gq.y, gq.z, gq.w}; float o8[8];
#pragma unroll
                    for (int e = 0; e < 4; ++e) { const float ya = (e < 2 ? y0[2 * e] : y1[2 * e - 4]), yb = (e < 2 ? y0[2 * e + 1] : y1[2 * e - 3]);
                        const float ga_ = (e < 2 ? g0[2 * e] : g1[2 * e - 4]), gb_ = (e < 2 ? g0[2 * e + 1] : g1[2 * e - 3]), ba_ = (e < 2 ? b0[2 * e] : b1[2 * e - 4]), bb_ = (e < 2 ? b0[2 * e + 1] : b1[2 * e - 3]);
                        o8[2 * e] = (ya * ga_ + ba_ + bon * bflo(vw[e])) * bflo(gw4[e]); o8[2 * e + 1] = (yb * gb_ + bb_ + bon * bfhi(vw[e])) * bfhi(gw4[e]); }
                    *(u32x4*)(CAT + tok * D + LRU_W + ch) = (u32x4){cvt2(o8[0], o8[1]), cvt2(o8[2], o8[3]), cvt2(o8[4], o8[5]), cvt2(o8[6], o8[7])}; } }
            asm volatile("s_waitcnt lgkmcnt(0)" ::: "memory");
        }
    }
    SEAM(6);

    if (IN(7)) REP(7) {
        LANE_TID();
        pg8::StaticOrder S; S.init(M, D, G, bid);
        pg8::EpiResF32 E{Z, XN, DN_ALPHA};
        pg8::gemm_phase<pg8::EpiResF32, pg8::StaticOrder, pg8::DenseRows, true>(lds, CAT, WoT, S, E, pg8::DenseRows{}, wave);
    }
    SEAM(7);

    if (IN(8)) {
        LANE_TID();
        constexpr int RSH = 4112;
        constexpr int L_LO = 16 * RSH, L_PART = 2 * 16 * RSH, L_LGT = L_PART + 16384;
        const float* g1 = args.in[I_LN1G]; const float* b1 = args.in[I_LN1B]; const float* br_ = args.in[I_BROUTER];
        const bf16_t* WRH = (const bf16_t*)(ws + WS_WRT); const bf16_t* WRL = WRH + NE * D;
        for (int tile = bid; tile < M / 16; tile += G) {
            const int t0 = tile * 16;
            __syncthreads();
#pragma unroll 1
            for (int rr = 0; rr < 2; ++rr) { const int tb = wave * 2 + rr, m = t0 + tb;
                const f32x4* zr = (const f32x4*)(Z + (size_t)m * D) + lane;
                f32x4 v[8]; float s = 0.f;
#pragma unroll
                for (int j = 0; j < 8; ++j) { v[j] = zr[64 * j]; s += (v[j][0] + v[j][1]) + (v[j][2] + v[j][3]); }
                const float mean = wave_sum(s) * (1.f / D); float s2 = 0.f;
#pragma unroll
                for (int j = 0; j < 8; ++j) { v[j] = v[j] - mean; s2 += (v[j][0] * v[j][0] + v[j][1] * v[j][1]) + (v[j][2] * v[j][2] + v[j][3] * v[j][3]); }
                const float rstd = __builtin_amdgcn_rsqf(wave_sum(s2) * (1.f / D) + LN_EPS);
                u32x2* ho = (u32x2*)((bf16_t*)H1 + (size_t)m * D) + lane; unsigned* hb = (unsigned*)(H1F + (size_t)m * D) + lane;
#pragma unroll
                for (int j = 0; j < 8; ++j) { const f32x4 g4 = ((const f32x4*)g1)[64 * j + lane], b4 = ((const f32x4*)b1)[64 * j + lane]; const f32x4 y = v[j] * rstd * g4 + b4;
                    const u32x2 hi = {cvt2(y[0], y[1]), cvt2(y[2], y[3])};
                    const u32x2 lo = {cvt2(y[0] - bflo(hi.x), y[1] - bfhi(hi.x)), cvt2(y[2] - bflo(hi.y), y[3] - bfhi(hi.y))};
                    ho[64 * j] = hi; hb[64 * j] = pk4_f8(y[0] * F8_SH, y[1] * F8_SH, y[2] * F8_SH, y[3] * F8_SH);
                    *(LAS u32x2*)(lds + tb * RSH + 512 * j + 8 * lane) = hi; *(LAS u32x2*)(lds + L_LO + tb * RSH + 512 * j + 8 * lane) = lo; } }
            __syncthreads();
            { const int c16 = lane & 15, q4 = lane >> 4; f32x4 acc[2] = {{0.f, 0.f, 0.f, 0.f}, {0.f, 0.f, 0.f, 0.f}};
#pragma unroll 2
                for (int kk = 0; kk < 8; ++kk) { const int k0 = 32 * (8 * wave + kk) + 8 * q4;
                    const bf16x8 hh = *(const LAS bf16x8*)(lds + c16 * RSH + k0 * 2), hl = *(const LAS bf16x8*)(lds + L_LO + c16 * RSH + k0 * 2);
#pragma unroll
                    for (int hf = 0; hf < 2; ++hf) { const bf16x8 wh = *(const bf16x8*)(WRH + (size_t)(hf * 16 + c16) * D + k0), wl = *(const bf16x8*)(WRL + (size_t)(hf * 16 + c16) * D + k0);
                        acc[hf] = __builtin_amdgcn_mfma_f32_16x16x32_bf16(wh, hh, acc[hf], 0, 0, 0);
                        acc[hf] = __builtin_amdgcn_mfma_f32_16x16x32_bf16(wl, hh, acc[hf], 0, 0, 0);
                        acc[hf] = __builtin_amdgcn_mfma_f32_16x16x32_bf16(wh, hl, acc[hf], 0, 0, 0); } }
#pragma unroll
                for (int hf = 0; hf < 2; ++hf)
#pragma unroll
                    for (int g = 0; g < 4; ++g) ((LAS float*)(lds + L_PART))[((wave * 2 + hf) * 4 + g) * 64 + lane] = acc[hf][g]; }
            __syncthreads();
            { const int tk = tid & 15, e = tid >> 4, hf = e >> 4, el = e & 15; float sacc = br_[e];
#pragma unroll
                for (int w = 0; w < 8; ++w) sacc += ((const LAS float*)(lds + L_PART))[((w * 2 + hf) * 4 + (el & 3)) * 64 + tk + 16 * (el >> 2)];
                ((LAS float*)(lds + L_LGT))[tk * 32 + e] = sacc; }
            __syncthreads();
            if (tid < 16) { const int m = t0 + tid; float bv[4]; int bi[4]; unsigned used = 0u; const LAS float* lgt = (const LAS float*)(lds + L_LGT);
#pragma unroll 1
                for (int k = 0; k < 4; ++k) { float best = -3.0e38f; int be = 0;
                    for (int e = 0; e < NE; ++e) { const float x = lgt[tid * 32 + e]; if (!((used >> e) & 1u) && x > best) { best = x; be = e; } }
                    used |= 1u << be; bv[k] = best; bi[k] = be; }
                float ex[4], den = 0.f;
#pragma unroll
                for (int k = 0; k < 4; ++k) { ex[k] = __expf(bv[k] - bv[0]); den += ex[k]; }
#pragma unroll 1
                for (int k = 0; k < 4; ++k) { const int pos = (int)__hip_atomic_fetch_add(ctl + CW_CNT + 64 * bi[k], 1u, RLX_AGENT);
                    TOPE[m * 4 + k] = bi[k]; TOPP[m * 4 + k] = pos; TOPG[m * 4 + k] = ex[k] / den; } }
        }
    }
    SEAM(8);

    if (IN(9)) REP(9) {
        LANE_TID();
        volatile LAS int* tb = (volatile LAS int*)(MISC + 16);
        moe_tables(tb, ctl, wave);
        for (int i = gt; i < M * TOPK; i += NGT) { const int e = TOPE[i], slot = tb[1 + e] * 256 + TOPP[i];
            SLOTTOK[slot] = i >> 2; SLOTG[slot] = TOPG[i]; TOKSLOT[i] = slot; }
        { unsigned char* XG = ws + WS_XG;
            for (int i = bid * NWAVES + wave; i < M * TOPK; i += NGW) { const int e = TOPE[i], slot = tb[1 + e] * 256 + TOPP[i];
                const u32x4* s_ = (const u32x4*)(H1F + (size_t)(i >> 2) * D) + lane; u32x4* d_ = (u32x4*)(XG + (size_t)slot * D) + lane;
                const u32x4 v0 = s_[0], v1 = s_[64]; d_[0] = v0; d_[64] = v1; } }
        if (bid < NE) { const int e = bid, c = (int)__hip_atomic_load(ctl + CW_CNT + 64 * e, RLX_AGENT), s0 = tb[1 + e] * 256 + c, s1 = tb[2 + e] * 256;
            for (int s = s0 + tid; s < s1; s += NTHREADS) { SLOTTOK[s] = 0; SLOTG[s] = 0.f; } }
    }
    SEAM(9);

    if (IN(10)) REP(10) {
        LANE_TID();
        volatile LAS int* tb = (volatile LAS int*)(MISC + 16);
        moe_tables(tb, ctl, wave);
        pg8::MoeOrder S{(const LAS int*)(tb + 64), tb[0], 16, G, bid, KD / 128};
        pg8::EpiSwiglu E{ACT, args.in[I_BE1]};
        pg8::gemm_phase<pg8::EpiSwiglu, pg8::MoeOrder, pg8::DenseRows, true, KD / 2, KD / 2, true>(lds, (const bf16_t*)(ws + WS_XG), (const bf16_t*)W1F, S, E, pg8::DenseRows{}, wave);
    }
    SEAM(10);

    if (IN(11)) REP(11) {
        LANE_TID();
        volatile LAS int* tb = (volatile LAS int*)(MISC + 16);
        moe_tables(tb, ctl, wave);
        pg8::MoeOrder S{(const LAS int*)(tb + 64), tb[0], 8, G, bid, KD / 128};
        pg8::EpiMoeOut E{OUTS, args.in[I_BE2], SLOTG};
        pg8::gemm_phase<pg8::EpiMoeOut, pg8::MoeOrder, pg8::DenseRows, true, KD / 2, KD / 2, true>(lds, (const bf16_t*)ACT, (const bf16_t*)W2F, S, E, pg8::DenseRows{}, wave);
    }
    SEAM(11);

    if (IN(12)) REP(12) {
        LANE_TID();
        const float* g2 = args.in[I_LN2G]; const float* b2 = args.in[I_LN2B];
        for (int m = gw; m < M; m += NGW) {
            const u32x2* hr = (const u32x2*)((const bf16_t*)H1 + (size_t)m * D) + lane;
            const int s0 = TOKSLOT[m * 4], s1 = TOKSLOT[m * 4 + 1], s2_ = TOKSLOT[m * 4 + 2], s3 = TOKSLOT[m * 4 + 3];
            const u32x2* o0 = (const u32x2*)(OUTS + (size_t)s0 * D) + lane; const u32x2* o1 = (const u32x2*)(OUTS + (size_t)s1 * D) + lane;
            const u32x2* o2 = (const u32x2*)(OUTS + (size_t)s2_ * D) + lane; const u32x2* o3 = (const u32x2*)(OUTS + (size_t)s3 * D) + lane;
            f32x4 v[8]; float s = 0.f;
#pragma unroll
            for (int j = 0; j < 8; ++j) { const u32x2 hq = hr[64 * j]; const f32x4 h4 = {bflo(hq.x), bfhi(hq.x), bflo(hq.y), bfhi(hq.y)}; const u32x2 a = o0[64 * j], b = o1[64 * j], c = o2[64 * j], d = o3[64 * j];
                f32x4 mo; mo[0] = (bflo(a.x) + bflo(b.x)) + (bflo(c.x) + bflo(d.x)); mo[1] = (bfhi(a.x) + bfhi(b.x)) + (bfhi(c.x) + bfhi(d.x));
                mo[2] = (bflo(a.y) + bflo(b.y)) + (bflo(c.y) + bflo(d.y)); mo[3] = (bfhi(a.y) + bfhi(b.y)) + (bfhi(c.y) + bfhi(d.y));
                v[j] = h4 * DN_ALPHA + mo; s += (v[j][0] + v[j][1]) + (v[j][2] + v[j][3]); }
            const float mean = wave_sum(s) * (1.f / D); float q2 = 0.f;
#pragma unroll
            for (int j = 0; j < 8; ++j) { v[j] = v[j] - mean; q2 += (v[j][0] * v[j][0] + v[j][1] * v[j][1]) + (v[j][2] * v[j][2] + v[j][3] * v[j][3]); }
            const float rstd = 1.f / sqrtf(wave_sum(q2) * (1.f / D) + LN_EPS);
            f32x4* orow = (f32x4*)(args.out + (size_t)m * D) + lane;
#pragma unroll
            for (int j = 0; j < 8; ++j) { const f32x4 g4 = ((const f32x4*)g2)[64 * j + lane], b4 = ((const f32x4*)b2)[64 * j + lane]; orow[64 * j] = v[j] * rstd * g4 + b4; }
        }
    }
    if (PROBE_PHASE >= 0) { if (PROBE_PHASE == NPHASE - 1) tprobe1 = __builtin_amdgcn_s_memrealtime();
        asm volatile("s_waitcnt vmcnt(0)" ::: "memory"); __syncthreads();
        if (bid == 0 && wave == 0 && lane_now() == 0) args.out[0] += 1.0f + (float)(tprobe1 - tprobe0) * 1e-4f; }
#undef IN
#undef SEAM
}

#ifndef MK_ONE_LAUNCH
#define MK_ONE_LAUNCH 1
#endif
extern "C" void kernel_launch(void* const* d_in, const int* in_sizes, int n_in, void* d_out, int out_size, void* d_ws, size_t ws_size, hipStream_t stream) {
    static int grid = 0;
    if (grid == 0) {
        if (n_in != 33 || out_size != M * D || ws_size < WS_END) { fprintf(stderr, "kernel_launch: unexpected sizes n_in %d out %d ws %zu (need %zu)\n", n_in, out_size, ws_size, (size_t)WS_END); grid = -1; return; }
        int dev = 0, cus = 0, per_cu = 0;
        if (hipGetDevice(&dev) != hipSuccess || hipDeviceGetAttribute(&cus, hipDeviceAttributeMultiprocessorCount, dev) != hipSuccess) { grid = -1; return; }
        if (hipFuncSetAttribute((const void*)fwd, hipFuncAttributeMaxDynamicSharedMemorySize, LDS_BYTES) != hipSuccess) { fprintf(stderr, "kernel_launch: hipFuncSetAttribute failed\n"); grid = -1; return; }
        if (hipOccupancyMaxActiveBlocksPerMultiprocessor(&per_cu, (const void*)fwd, NTHREADS, LDS_BYTES) != hipSuccess || per_cu < 1) fprintf(stderr, "kernel_launch: occupancy query says %d\n", per_cu);
        (void)hipGetLastError();
        grid = cus;
    }
    if (grid < 0) return;
    (void)hipMemsetAsync((char*)d_ws + WS_CTL, 0, CTL_ZERO_BYTES, stream);
    Args a{};
    for (int i = 0; i < 33; ++i) a.in[i] = (const float*)d_in[i];
    a.out = (float*)d_out; a.ws = (unsigned char*)d_ws;
#if MK_ONE_LAUNCH
    a.ph_lo = 0; a.ph_hi = NPHASE; a.use_bar = 1;
    hipLaunchKernelGGL(fwd, dim3(grid), dim3(NTHREADS), LDS_BYTES, stream, a);
#else
    for (int p = 0; p < NPHASE; ++p) { a.ph_lo = p; a.ph_hi = p + 1; a.use_bar = 0;
        hipLaunchKernelGGL(fwd, dim3(grid), dim3(NTHREADS), LDS_BYTES, stream, a); }
#endif
}
```

```cpp
#include <hip/hip_runtime.h>
#include <cstdio>
#include <cstdint>

#define LAS __attribute__((address_space(3)))
#define GAS __attribute__((address_space(1)))
typedef unsigned short bf16_t;
typedef short bf16x8 __attribute__((ext_vector_type(8)));
typedef float f32x4 __attribute__((ext_vector_type(4)));
typedef float f32x2 __attribute__((ext_vector_type(2)));
typedef unsigned u32x4 __attribute__((ext_vector_type(4)));
typedef unsigned u32x2 __attribute__((ext_vector_type(2)));
typedef float f32x16 __attribute__((ext_vector_type(16)));
typedef int i32x4 __attribute__((ext_vector_type(4)));
typedef int i32x8 __attribute__((ext_vector_type(8)));
typedef __bf16 bfv2 __attribute__((ext_vector_type(2)));
#define MFMA32(a, b, c) __builtin_amdgcn_mfma_f32_32x32x16_bf16((a), (b), (c), 0, 0, 0)

constexpr int BATCH = 4, SEQ = 4096, M = BATCH * SEQ, D = 2048;
constexpr int LRU_W = 1024, RW_W = 1024, NHEAD = 16, HS = 64;
constexpr int DLORA = 96, ALORA = 96, GLORA = 256;
constexpr int RW_SHIFT_W = 3 * RW_W + DLORA + ALORA + GLORA;
constexpr int NP = 2 * LRU_W + RW_SHIFT_W;
constexpr int NPP = 5632;
constexpr int NE = 32, TOPK = 4, DE = 2048;
constexpr int NSLOT_MAX = M * TOPK + NE * 256;
constexpr int NTILE_MAX = NSLOT_MAX / 256;
constexpr float LN_EPS = 1e-5f, GN_EPS = 64e-5f;
constexpr float DN_ALPHA = 1.189207115002721f;
constexpr int KD = 2048;

constexpr size_t MiB = 1u << 20;
constexpr size_t WS_CTL = 0, CTL_ZERO_BYTES = 1 * MiB;
constexpr size_t WS_WIN = 2 * MiB;
constexpr size_t WS_WO = WS_WIN + (size_t)NPP * KD * 2;
constexpr size_t WS_W1 = WS_WO + (size_t)D * KD * 2;
constexpr size_t WS_W2 = WS_W1 + (size_t)NE * 2 * DE * KD * 2;
constexpr size_t WS_XN = WS_W2 + (size_t)NE * D * DE * 2;
constexpr size_t WS_P = WS_XN + (size_t)M * D * 2;
constexpr size_t WS_LA = WS_P + (size_t)M * NPP * 2;
constexpr size_t WS_LB = WS_LA + (size_t)M * LRU_W * 4;
constexpr size_t WS_UC = WS_LB + (size_t)M * LRU_W * 4;
constexpr size_t WS_XL = WS_UC + (size_t)M * LRU_W * 2;
constexpr size_t WS_GATES = WS_XL + (size_t)M * 512 * 2;
constexpr size_t WS_LOUT = WS_GATES + (size_t)M * 2048 * 2;
constexpr size_t WS_V16 = WS_LOUT + (size_t)M * 3072 * 2;
constexpr size_t WS_G16 = WS_V16 + (size_t)M * RW_W * 2;
constexpr size_t WS_WG = WS_G16 + (size_t)M * RW_W * 2;
constexpr size_t WS_WL = WS_WG + (size_t)2048 * 256 * 2;
constexpr size_t WS_RY = WS_WL + (size_t)3072 * 256 * 2;
constexpr size_t WS_BON = WS_RY;
constexpr size_t WS_CAT = WS_BON + (size_t)M * NHEAD * 4;
constexpr size_t WS_Z = WS_CAT + (size_t)M * D * 2;
constexpr size_t WS_H1 = WS_Z + (size_t)M * D * 4;
constexpr size_t WS_H1B = WS_H1 + (size_t)M * D * 4;
constexpr size_t WS_TOPE = WS_H1B + (size_t)M * D * 2;
constexpr size_t WS_TOPP = WS_TOPE + (size_t)M * TOPK * 4;
constexpr size_t WS_TOPG = WS_TOPP + (size_t)M * TOPK * 4;
constexpr size_t WS_TOKSLOT = WS_TOPG + (size_t)M * TOPK * 4;
constexpr size_t WS_SLOTTOK = WS_TOKSLOT + (size_t)M * TOPK * 4;
constexpr size_t WS_SLOTG = WS_SLOTTOK + (size_t)NSLOT_MAX * 4;
constexpr size_t WS_ACT = WS_SLOTG + (size_t)NSLOT_MAX * 4;
constexpr size_t WS_OUTS = WS_ACT + (size_t)NSLOT_MAX * DE * 2;
constexpr int NUNIT = BATCH * NHEAD * (SEQ / 64);
constexpr size_t WS_MT = WS_OUTS + (size_t)NSLOT_MAX * D * 2;
constexpr size_t WS_GG = WS_MT + (size_t)NUNIT * 8192;
constexpr size_t WS_XS = WS_GG + (size_t)NUNIT * 8192;
constexpr size_t WS_NN = WS_XS + (size_t)NUNIT * 8192;
constexpr size_t WS_HH = WS_NN + (size_t)NUNIT * 16384;
constexpr size_t WS_CA = WS_HH + (size_t)NUNIT * 16384;
constexpr size_t WS_CH = WS_CA + (size_t)BATCH * 64 * LRU_W * 4;
constexpr size_t WS_CIN = WS_CH + (size_t)BATCH * 64 * LRU_W * 4;
constexpr size_t WS_XG = WS_CIN + (size_t)BATCH * 64 * LRU_W * 4;
constexpr size_t WS_WRT = WS_XG + (size_t)NSLOT_MAX * D;
constexpr size_t WS_END = WS_WRT + (size_t)2 * NE * D * 2;
constexpr int CW_CNT = 1024;
constexpr int CW_BAR = 4096;

constexpr int MISC_OFF = 159744;
constexpr int LDS_BYTES = 163840;

#define RLX_AGENT __ATOMIC_RELAXED, __HIP_MEMORY_SCOPE_AGENT
__device__ __forceinline__ unsigned f2bf(float f) { unsigned u = __builtin_bit_cast(unsigned, f); return (u + 0x7fffu + ((u >> 16) & 1u)) >> 16; }
__device__ __forceinline__ unsigned pk2(float lo, float hi) { return f2bf(lo) | (f2bf(hi) << 16); }
__device__ __forceinline__ float bf2f(unsigned short b) { return __builtin_bit_cast(float, (unsigned)b << 16); }
__device__ __forceinline__ float bflo(unsigned w) { return __builtin_bit_cast(float, w << 16); }
__device__ __forceinline__ float bfhi(unsigned w) { return __builtin_bit_cast(float, w & 0xffff0000u); }
__device__ __forceinline__ unsigned cvt2(float a, float b) { const f32x2 v = {a, b}; return __builtin_bit_cast(unsigned, __builtin_convertvector(v, bfv2)); }
__device__ __forceinline__ unsigned short cvt1(float a) { return (unsigned short)(cvt2(a, 0.f) & 0xffffu); }
constexpr float F8_SH = 4.f, F8_SW1 = 32.f, F8_SACT = 4.f, F8_SW2 = 64.f;
__device__ __forceinline__ float f8clamp(float x) { return fminf(fmaxf(x, -448.f), 448.f); }
__device__ __forceinline__ unsigned pk4_f8(float a, float b, float c, float d) { int w = 0; w = __builtin_amdgcn_cvt_pk_fp8_f32(f8clamp(a), f8clamp(b), w, false); w = __builtin_amdgcn_cvt_pk_fp8_f32(f8clamp(c), f8clamp(d), w, true); return (unsigned)w; }
__device__ __forceinline__ int lane_now() { int l; asm volatile("v_mbcnt_lo_u32_b32 %0, -1, 0\n\tv_mbcnt_hi_u32_b32 %0, -1, %0" : "=v"(l)); return l; }
__device__ __forceinline__ int crow(int reg, int h) { return (reg & 3) + 8 * (reg >> 2) + 4 * h; }
__device__ __forceinline__ float row_sum16(float v) {
    v += __builtin_bit_cast(float, __builtin_amdgcn_update_dpp(0, __builtin_bit_cast(int, v), 0xB1, 0xf, 0xf, false));
    v += __builtin_bit_cast(float, __builtin_amdgcn_update_dpp(0, __builtin_bit_cast(int, v), 0x4E, 0xf, 0xf, false));
    v += __builtin_bit_cast(float, __builtin_amdgcn_update_dpp(0, __builtin_bit_cast(int, v), 0x141, 0xf, 0xf, false));
    v += __builtin_bit_cast(float, __builtin_amdgcn_update_dpp(0, __builtin_bit_cast(int, v), 0x140, 0xf, 0xf, false));
    return v;
}
__device__ __forceinline__ float rdlane(float v, int l) { return __builtin_bit_cast(float, __builtin_amdgcn_readlane(__builtin_bit_cast(int, v), l)); }
__device__ __forceinline__ float wave_sum(float v) { v = row_sum16(v); return (rdlane(v, 0) + rdlane(v, 16)) + (rdlane(v, 32) + rdlane(v, 48)); }
__device__ __forceinline__ float half_sum(float v, int hh) { v = row_sum16(v); const float lo = rdlane(v, 0) + rdlane(v, 16), hi = rdlane(v, 32) + rdlane(v, 48); return hh ? hi : lo; }
__device__ __forceinline__ float sigmoidf_(float x) { return __builtin_amdgcn_rcpf(1.f + __expf(-x)); }
__device__ __forceinline__ float gelu_tanh(float x) { const float u = 0.7978845608028654f * (x + 0.044715f * x * x * x); return x * __builtin_amdgcn_rcpf(1.f + __expf(-2.f * u)); }
__device__ __forceinline__ float tanh_fast(float x) { const float e = __expf(-2.f * fabsf(x)); const float t = (1.f - e) * __builtin_amdgcn_rcpf(1.f + e); return x < 0.f ? -t : t; }

#define XB_TMO      128
#define XB_XCNT(j)  (256  + 64 * (j))
#define XB_XSUB(j)  (1280 + 64 * (j))
#define XB_XGEN(j)  (2304 + 64 * (j))
#define XB_TOP      3328
#define XB_TOPGEN   3392
#define XCD_BAR_WORDS 3456
#define XB_SPIN_CAP (1u << 18)
__device__ __forceinline__ unsigned xb_ld(unsigned* p)              { return __hip_atomic_load(p, __ATOMIC_RELAXED, __HIP_MEMORY_SCOPE_AGENT); }
__device__ __forceinline__ unsigned xb_add(unsigned* p, unsigned v) { return __hip_atomic_fetch_add(p, v, __ATOMIC_RELAXED, __HIP_MEMORY_SCOPE_AGENT); }
__device__ __forceinline__ unsigned xb_xcc_id() { return (unsigned)__builtin_amdgcn_s_getreg((3 << 11) | 20) & 0xFu; }
#define XB_SPIN(cond, bar) do { unsigned _sp = 0; while (cond) { __builtin_amdgcn_s_sleep(1); \
    if ((++_sp & 255u) == 0u) { if (xb_ld(&(bar)[XB_TMO])) break; if (_sp > XB_SPIN_CAP) { atomicAdd(&(bar)[XB_TMO], 1u); break; } } } } while (0)
struct XcdBarrier { unsigned* bar; unsigned x; volatile LAS unsigned* st; };
__device__ __forceinline__ XcdBarrier xcd_barrier_post(unsigned* bar, volatile LAS unsigned* st) {
    XcdBarrier b; b.bar = bar; b.x = xb_xcc_id(); b.st = st;
    if (__builtin_amdgcn_readfirstlane(threadIdx.x >> 6) == 0 && lane_now() == 0) (void)xb_add(&bar[XB_XCNT(b.x)], 1u);
    return b;
}
__device__ __forceinline__ void xcd_barrier_complete(unsigned* bar, unsigned x, unsigned& nloc, unsigned& nx) {
    const unsigned G = gridDim.x * gridDim.y * gridDim.z;
    unsigned sum, cnt, mine, sp = 0u;
    for (;;) {
        sum = 0u; cnt = 0u; mine = 0u;
#pragma unroll
        for (unsigned j = 0; j < 16; ++j) { const unsigned c = xb_ld(&bar[XB_XCNT(j)]); sum += c; cnt += (c > 0u) ? 1u : 0u; mine = (j == x) ? c : mine; }
        if (sum == G) break;
        __builtin_amdgcn_s_sleep(1);
        if ((++sp & 255u) == 0u) { if (xb_ld(&bar[XB_TMO])) break; if (sp > XB_SPIN_CAP) { atomicAdd(&bar[XB_TMO], 1u); break; } }
    }
    nloc = mine > 0u ? mine : 1u; nx = cnt > 0u ? cnt : 1u;
}
__device__ __forceinline__ void xcd_barrier(const XcdBarrier& b, int wave_id) {
    asm volatile("s_waitcnt vmcnt(0)" ::: "memory");
    __syncthreads();
    if (wave_id == 0 && lane_now() == 0) {
        unsigned* bar = b.bar;
        __builtin_amdgcn_s_waitcnt(0);
        unsigned nloc = b.st[0], nx = b.st[1];
        if (nloc == 0u) { xcd_barrier_complete(bar, b.x, nloc, nx); b.st[0] = nloc; b.st[1] = nx; }
        const unsigned old = xb_add(&bar[XB_XSUB(b.x)], 1u);
        const unsigned gen = old / nloc;
        if (old + 1u == (gen + 1u) * nloc) {
            __builtin_amdgcn_fence(__ATOMIC_RELEASE, "agent");
            asm volatile("s_waitcnt vmcnt(0)" ::: "memory");
            const unsigned og = xb_add(&bar[XB_TOP], 1u);
            const unsigned tg = og / nx;
            if (og + 1u == (tg + 1u) * nx) xb_add(&bar[XB_TOPGEN], 1u);
            else XB_SPIN(xb_ld(&bar[XB_TOPGEN]) == tg, bar);
            __builtin_amdgcn_fence(__ATOMIC_ACQUIRE, "agent");
            xb_add(&bar[XB_XGEN(b.x)], 1u);
            asm volatile("s_waitcnt vmcnt(0)" ::: "memory");
        } else {
            XB_SPIN(xb_ld(&bar[XB_XGEN(b.x)]) == gen, bar);
            __builtin_amdgcn_fence(__ATOMIC_ACQUIRE, "agent");
            asm volatile("s_waitcnt vmcnt(0)" ::: "memory");
        }
    }
    __syncthreads();
}

namespace pg8 {
constexpr int BM = 256, BK = 64, HALF = 128, HTB = HALF * BK * 2, STAGE_BYTES = 8 * HTB, NXCD = 8, WGM = 8;
__host__ __device__ __forceinline__ int lds_byte(int r, int c) { const int st = (r >> 4) * 2 + (c >> 5), rr = r & 15, cc = c & 31, ob = rr * 64 + cc * 2; return st * 1024 + (ob ^ (((ob >> 9) & 1) << 5)); }
__host__ __device__ __forceinline__ void stage_rc(int b, int& R, int& C) { const int st = b / 1024, sb = b % 1024, swz = sb ^ (((sb >> 9) & 1) << 5); R = (st >> 1) * 16 + swz / 64; C = (st & 1) * 32 + (swz % 64) / 2; }
__host__ __device__ __forceinline__ int perm32(int rho) { const int n = rho >> 4, i = rho & 15; return 8 * (i >> 2) + 4 * n + (i & 3); }
__host__ __device__ __forceinline__ int f8_g(int R) { return ((R >> 1) & 1) + 4 * ((R >> 3) & 1); }
__host__ __device__ __forceinline__ int f8_lds_byte(int R, int c) { return R * 128 + (((c + f8_g(R)) & 7) << 4); }
__host__ __device__ __forceinline__ void f8_stage_rc(int pos, int& R, int& Cb) { const int P = pos >> 4; R = P >> 3; Cb = (((P & 7) - f8_g(R)) & 7) << 4; }
struct Unit { int pm, pn, ak, nt; };
__device__ __forceinline__ unsigned cvt_pk_bf16(float lo, float hi) { unsigned r; asm volatile("v_cvt_pk_bf16_f32 %0, %1, %2" : "=v"(r) : "v"(lo), "v"(hi)); return r; }

struct StaticOrder {
    int nM, nN, nwg, G, c;
    __device__ void init(int M_, int N_, int G_, int c_) { nM = M_ / BM; nN = N_ / BM; nwg = nM * nN; G = G_; c = c_; }
    __device__ bool next(int i, Unit& u) const {
        const long L = (long)i * G + c; if (L >= nwg) return false;
        int wgid = (int)L; { const int q = nwg / NXCD, r = nwg % NXCD, xcd = wgid % NXCD, off = wgid / NXCD; wgid = (xcd < r ? xcd * (q + 1) : r * (q + 1) + (xcd - r) * q) + off; }
        const int nig = WGM * nN, gid = wgid / nig, fm = gid * WGM, gsz = (nM - fm) < WGM ? (nM - fm) : WGM;
        u.pm = fm + ((wgid % nig) % gsz); u.pn = (wgid % nig) / gsz; u.ak = 0; u.nt = KD / BK; return true;
    }
};
struct MoeOrder {
    const LAS int* tile_e; int R, NCT, G, c, nt;
    __device__ bool next(int i, Unit& u) const {
        int rt, ct;
        if (G == 256) { const int x = c & 7, j = c >> 3;
            if (NCT == 16) { rt = 16 * i + (x >> 1) * 4 + (j >> 3); ct = (x & 1) * 8 + (j & 7); }
            else           { rt = 32 * i + 4 * x + (j >> 3); ct = j & 7; } }
        else { const long L = (long)i * G + c; rt = (int)(L / NCT); ct = (int)(L % NCT); }
        if (rt >= R) return false;
        u.pm = rt; u.pn = tile_e[rt] * NCT + ct; u.ak = 0; u.nt = nt; return true;
    }
};
template <int MODE> struct SmallOrder {
    int G, c;
    __device__ bool next(int i, Unit& u) const {
        constexpr int NCT = MODE == 0 ? 8 : 12;
        const int L = i * G + c; if (L >= (M / BM) * NCT) return false;
        u.pm = L / NCT; u.pn = L % NCT;
        if (MODE == 0) { u.ak = 256 * (u.pn & 3); u.nt = 4; }
        else { u.ak = u.pn < 4 ? 0 : (u.pn < 8 ? 128 : 256); u.nt = u.pn < 8 ? 2 : 4; }
        return true;
    }
};
struct DenseRows { static constexpr bool DENSE = true; __device__ __forceinline__ const int* idxp() const { return nullptr; } __device__ __forceinline__ unsigned row(int pm, int r) const { return (unsigned)(pm * BM + r); } };
struct GatherRows { static constexpr bool DENSE = false; const int* idx; __device__ __forceinline__ const int* idxp() const { return idx; } __device__ __forceinline__ unsigned row(int pm, int r) const { return (unsigned)idx[pm * BM + r]; } };

struct EpiBf16 {
    static constexpr bool PERM = true;
    bf16_t* O; int ldc;
    __device__ __forceinline__ void operator()(const f32x4 (&acc)[2][2][4][2], const Unit& u, int wr, int wc, int fr, int fq) const {
        const int row0 = u.pm * BM + wr * 64 + fr, col0 = u.pn * BM + wc * 32 + 8 * fq;
#pragma unroll
        for (int ai = 0; ai < 2; ++ai)
#pragma unroll
            for (int m = 0; m < 4; ++m) { bf16_t* rowp = O + (size_t)(row0 + ai * HALF + m * 16) * ldc + col0;
#pragma unroll
                for (int bj = 0; bj < 2; ++bj) { const f32x4 v0 = acc[ai][bj][m][0], v1 = acc[ai][bj][m][1];
                    u32x4 w; w.x = cvt_pk_bf16(v0[0], v0[1]); w.y = cvt_pk_bf16(v0[2], v0[3]); w.z = cvt_pk_bf16(v1[0], v1[1]); w.w = cvt_pk_bf16(v1[2], v1[3]);
                    *(u32x4*)(rowp + bj * HALF) = w; } }
    }
};
struct EpiResF32 {
    static constexpr bool PERM = false;
    float* Z; const bf16_t* R; float alpha;
    __device__ __forceinline__ void operator()(const f32x4 (&acc)[2][2][4][2], const Unit& u, int wr, int wc, int fr, int fq) const {
        const int row0 = u.pm * BM + wr * 64 + fr, col0 = u.pn * BM + wc * 32 + 4 * fq;
#pragma unroll
        for (int ai = 0; ai < 2; ++ai)
#pragma unroll
            for (int m = 0; m < 4; ++m) { const size_t off = (size_t)(row0 + ai * HALF + m * 16) * D + col0;
#pragma unroll
                for (int bj = 0; bj < 2; ++bj)
#pragma unroll
                    for (int n = 0; n < 2; ++n) { const u32x2 rb = *(const u32x2*)(R + off + bj * HALF + n * 16);
                        f32x4 o = acc[ai][bj][m][n]; o[0] += alpha * bflo(rb.x); o[1] += alpha * bfhi(rb.x); o[2] += alpha * bflo(rb.y); o[3] += alpha * bfhi(rb.y);
                        *(f32x4*)(Z + off + bj * HALF + n * 16) = o; } }
    }
};
struct EpiSwiglu {
    static constexpr bool PERM = true;
    unsigned char* O; const float* b1;
    __device__ __forceinline__ void operator()(const f32x4 (&acc)[2][2][4][2], const Unit& u, int wr, int wc, int fr, int fq) const {
        const int e = u.pn >> 4, ct = u.pn & 15;
        const int row0 = u.pm * BM + wr * 64 + fr, cin = wc * 32 + 8 * fq, col0 = ct * HALF + cin;
        const float* bg = b1 + (size_t)e * 2 * DE + col0; const float* bu = bg + DE;
        const f32x4 bg0 = *(const f32x4*)bg, bg1 = *(const f32x4*)(bg + 4), bu0 = *(const f32x4*)bu, bu1 = *(const f32x4*)(bu + 4);
        constexpr float inv = 1.f / (F8_SH * F8_SW1);
#pragma unroll
        for (int ai = 0; ai < 2; ++ai)
#pragma unroll
            for (int m = 0; m < 4; ++m) { unsigned char* rowp = O + (size_t)(row0 + ai * HALF + m * 16) * DE + col0;
                float o[8];
#pragma unroll
                for (int n = 0; n < 2; ++n) { const f32x4 g4 = acc[ai][0][m][n] * inv + (n ? bg1 : bg0), u4 = acc[ai][1][m][n] * inv + (n ? bu1 : bu0);
#pragma unroll
                    for (int j = 0; j < 4; ++j) { const float g = fminf(g4[j], 7.f), up = fminf(fmaxf(u4[j], -7.f), 7.f);
                        o[n * 4 + j] = F8_SACT * g * (up + 1.f) * __builtin_amdgcn_rcpf(1.f + __expf(-1.702f * g)); } }
                *(u32x2*)rowp = (u32x2){pk4_f8(o[0], o[1], o[2], o[3]), pk4_f8(o[4], o[5], o[6], o[7])}; }
    }
};
struct EpiMoeOut {
    static constexpr bool PERM = true;
    bf16_t* O; const float* b2; const float* sg;
    __device__ __forceinline__ void operator()(const f32x4 (&acc)[2][2][4][2], const Unit& u, int wr, int wc, int fr, int fq) const {
        const int e = u.pn >> 3, ct = u.pn & 7;
        const int row0 = u.pm * BM + wr * 64 + fr, col0 = ct * BM + wc * 32 + 8 * fq;
        f32x4 bv[2][2];
#pragma unroll
        for (int bj = 0; bj < 2; ++bj)
#pragma unroll
            for (int n = 0; n < 2; ++n) bv[bj][n] = *(const f32x4*)(b2 + (size_t)e * D + col0 + bj * HALF + 4 * n);
#pragma unroll
        for (int ai = 0; ai < 2; ++ai)
#pragma unroll
            for (int m = 0; m < 4; ++m) { const int row = row0 + ai * HALF + m * 16; const float gt = sg[row]; bf16_t* rowp = O + (size_t)row * D + col0;
#pragma unroll
                for (int bj = 0; bj < 2; ++bj) { const f32x4 v0 = (acc[ai][bj][m][0] * (1.f / (F8_SACT * F8_SW2)) + bv[bj][0]) * gt, v1 = (acc[ai][bj][m][1] * (1.f / (F8_SACT * F8_SW2)) + bv[bj][1]) * gt;
                    u32x4 w; w.x = cvt_pk_bf16(v0[0], v0[1]); w.y = cvt_pk_bf16(v0[2], v0[3]); w.z = cvt_pk_bf16(v1[0], v1[1]); w.w = cvt_pk_bf16(v1[2], v1[3]);
                    *(u32x4*)(rowp + bj * HALF) = w; } }
    }
};

template <class Epi, class Sched, class ARows, bool ALIGN_EPI, int LDA = KD, int LDB = KD, bool F8 = false>
__device__ __forceinline__ void gemm_phase(LAS unsigned char* lds, const bf16_t* A, const bf16_t* Bt, const Sched& S, const Epi& E, const ARows& AR, const int wid) {
    const int lane = lane_now(), tid = wid * 64 + lane, wr = wid >> 2, wc = wid & 3, fr = lane & 15, fq = lane >> 4;
    int sR[2], sC[2]; unsigned voffB[2];
#pragma unroll
    for (int i = 0; i < 2; ++i) { if constexpr (F8) { int cb_; f8_stage_rc(tid * 16 + i * 8192, sR[i], cb_); sC[i] = cb_ >> 1; } else stage_rc(tid * 16 + i * 8192, sR[i], sC[i]); const int Rb = Epi::PERM ? ((sR[i] & ~31) + perm32(sR[i] & 31)) : sR[i];
        voffB[i] = (unsigned)(Rb * LDB + sC[i]) * 2u; }
    constexpr size_t kstep = (size_t)(BK * 2);
    constexpr size_t hstep = (size_t)HALF * LDB * 2;
    constexpr size_t tstep = 2 * hstep;
    const unsigned ldsw = (unsigned)wid * 1024u;
    int aoffs[2], boffs[2];
    if constexpr (F8) { aoffs[0] = f8_lds_byte(wr * 64 + fr, 2 * fq); aoffs[1] = f8_lds_byte(wr * 64 + fr, 2 * fq + 1); boffs[0] = 4 * HTB + f8_lds_byte(wc * 32 + fr, 2 * fq); boffs[1] = 4 * HTB + f8_lds_byte(wc * 32 + fr, 2 * fq + 1); }
    else { aoffs[0] = lds_byte(wr * 64 + fr, fq * 8); aoffs[1] = aoffs[0] + 1024; boffs[0] = 4 * HTB + lds_byte(wc * 32 + fr, fq * 8); boffs[1] = boffs[0] + 1024; }
#define PG8_SA(b, h) (((b) * 2 + (h)) * HTB)
#define PG8_SB(b, h) ((4 + (b) * 2 + (h)) * HTB)
#define PG8_SBR(b, h) (((b) * 2 + (h)) * HTB)
#define PG8_STAGE(bufoff, gbase, voff) do { const char* gb_ = (const char*)(gbase); _Pragma("unroll") for (int _i = 0; _i < 2; ++_i) { unsigned keep_; \
        asm volatile("s_mov_b32 %0, m0\n\ts_mov_b32 m0, %3\n\ts_nop 0\n\tglobal_load_lds_dwordx4 %1, %2\n\ts_mov_b32 m0, %0" : "=&s"(keep_) : "v"((voff)[_i]), "s"(gb_), "s"((unsigned)((bufoff) + ldsw + _i * 8192)) : "memory"); } } while (0)
#define PG8_LDA(dst, b, h) do { _Pragma("unroll") for (int m = 0; m < 4; ++m) { if constexpr (F8) { const i32x4 lo_ = *(const LAS i32x4*)(lds + PG8_SA(b, h) + aoffs[0] + m * 2048), hi_ = *(const LAS i32x4*)(lds + PG8_SA(b, h) + aoffs[1] + m * 2048); \
            dst##8[m] = __builtin_shufflevector(lo_, hi_, 0, 1, 2, 3, 4, 5, 6, 7); } else { _Pragma("unroll") for (int k = 0; k < 2; ++k) dst[m][k] = *(const LAS bf16x8*)(lds + PG8_SA(b, h) + aoffs[k] + m * 2048); } } } while (0)
#define PG8_LDB(dst, b, h) do { _Pragma("unroll") for (int n = 0; n < 2; ++n) { if constexpr (F8) { const i32x4 lo_ = *(const LAS i32x4*)(lds + PG8_SBR(b, h) + boffs[0] + n * 2048), hi_ = *(const LAS i32x4*)(lds + PG8_SBR(b, h) + boffs[1] + n * 2048); \
            dst##8[n] = __builtin_shufflevector(lo_, hi_, 0, 1, 2, 3, 4, 5, 6, 7); } else { _Pragma("unroll") for (int k = 0; k < 2; ++k) dst[n][k] = *(const LAS bf16x8*)(lds + PG8_SBR(b, h) + boffs[k] + n * 2048); } } } while (0)
#define PG8_MMA(ai, bj, At, Bt_) do { __builtin_amdgcn_s_setprio(1); _Pragma("unroll") for (int m = 0; m < 4; ++m) _Pragma("unroll") for (int n = 0; n < 2; ++n) { \
        if constexpr (F8) { acc[ai][bj][m][n] = __builtin_amdgcn_mfma_scale_f32_16x16x128_f8f6f4(Bt_##8[n], At##8[m], acc[ai][bj][m][n], 0, 0, 0, 0x7f7f7f7f, 0, 0x7f7f7f7f); } \
        else { _Pragma("unroll") for (int k = 0; k < 2; ++k) acc[ai][bj][m][n] = __builtin_amdgcn_mfma_f32_16x16x32_bf16(Bt_[n][k], At[m][k], acc[ai][bj][m][n], 0, 0, 0); } } __builtin_amdgcn_s_setprio(0); } while (0)
#define PG8_WAIT_V(n) asm volatile("s_waitcnt vmcnt(" #n ")" ::: "memory")
#define PG8_WAIT_L(n) asm volatile("s_waitcnt lgkmcnt(" #n ")" ::: "memory")
#define PG8_BAR __builtin_amdgcn_s_barrier()
#define PG8_SCHED __builtin_amdgcn_sched_barrier(0)
#define PG8_AOFF(dst, u) do { const int tq_ = wid * 64 + lane_now(); _Pragma("unroll") for (int _i = 0; _i < 2; ++_i) { int R_, C_; if constexpr (F8) { int cb_; f8_stage_rc(tq_ * 16 + _i * 8192, R_, cb_); C_ = cb_ >> 1; } else stage_rc(tq_ * 16 + _i * 8192, R_, C_); \
        _Pragma("unroll") for (int _h = 0; _h < 2; ++_h) { \
        if constexpr (ARows::DENSE) dst[_h][_i] = (unsigned)(R_ * LDA + C_) * 2u; \
        else dst[_h][_i] = (AR.row((u).pm, _h * HALF + R_) * (unsigned)LDA + (unsigned)((u).ak + C_)) * 2u; } } } while (0)
#define PG8_ABASE(u) (ARows::DENSE ? (const char*)A + ((size_t)(u).pm * BM * LDA + (u).ak) * 2 : (const char*)A)
    constexpr size_t ahstep = ARows::DENSE ? (size_t)HALF * LDA * 2 : 0;
    Unit cur, nxt; int ui = 0;
    if (!S.next(0, cur)) return;
    f32x4 acc[2][2][4][2];
#pragma unroll
    for (int a = 0; a < 2; ++a)
#pragma unroll
        for (int b = 0; b < 2; ++b)
#pragma unroll
            for (int m = 0; m < 4; ++m)
#pragma unroll
                for (int n = 0; n < 2; ++n) acc[a][b][m][n] = (f32x4){0.f, 0.f, 0.f, 0.f};
    bf16x8 At[4][2], B0[2][2], B1[2][2]; i32x8 At8[4], B08[2], B18[2];
    unsigned ao[2][2];
    if constexpr (ARows::DENSE) { PG8_AOFF(ao, cur); } else { ao[0][0] = ao[0][1] = ao[1][0] = ao[1][1] = 0u; }
    constexpr int TBL = 131072;
#define PG8_STAGE_A(bufoff, base, h_, slot_) do { if constexpr (ARows::DENSE) { PG8_STAGE(bufoff, (base) + ((h_) ? ahstep : (size_t)0), ao[0]); } else { \
        const int tq_ = wid * 64 + lane_now(); unsigned go_[2]; _Pragma("unroll") for (int _i = 0; _i < 2; ++_i) { int R_, C_; if constexpr (F8) { int cb_; f8_stage_rc(tq_ * 16 + _i * 8192, R_, cb_); C_ = cb_ >> 1; } else stage_rc(tq_ * 16 + _i * 8192, R_, C_); \
            const unsigned row_ = *(const LAS unsigned*)(lds + TBL + (slot_) * 1024 + ((h_) * HALF + R_) * 4); go_[_i] = (row_ * (unsigned)LDA + (unsigned)C_) * 2u; } \
        PG8_STAGE(bufoff, base, go_); } } while (0)
#define PG8_TBL_FILL(u, slot_) do { if (wid < 4) { const unsigned vo_ = (unsigned)((u).pm * BM + wid * 64 + lane_now()) * 4u; unsigned keep_; const char* ib_ = (const char*)AR.idxp(); \
        asm volatile("s_mov_b32 %0, m0\n\ts_mov_b32 m0, %3\n\ts_nop 0\n\tglobal_load_lds_dword %1, %2\n\ts_mov_b32 m0, %0" : "=&s"(keep_) : "v"(vo_), "s"(ib_), "s"((unsigned)(TBL + (slot_) * 1024 + wid * 256)) : "memory"); } } while (0)
    const char* cA = PG8_ABASE(cur);
    const char* cB = (const char*)Bt + (size_t)cur.pn * tstep;
    if constexpr (!ARows::DENSE) { PG8_TBL_FILL(cur, 0); PG8_WAIT_V(0); PG8_BAR; }
    PG8_STAGE(PG8_SB(0, 0), cB, voffB); PG8_STAGE(PG8_SB(0, 1), cB + hstep, voffB); PG8_STAGE_A(PG8_SA(0, 0), cA, 0, 0); PG8_STAGE_A(PG8_SA(0, 1), cA, 1, 0);
    if (wr == 1) PG8_BAR;
    PG8_WAIT_V(2); PG8_BAR;
    PG8_STAGE(PG8_SB(1, 0), cB + kstep, voffB); PG8_STAGE_A(PG8_SA(1, 0), cA + kstep, 0, 0); PG8_STAGE(PG8_SB(1, 1), cB + hstep + kstep, voffB);
    PG8_WAIT_V(6); PG8_BAR;
    for (;;) {
        const bool has_next = S.next(ui + 1, nxt);
        const int slc = ui & 1, sln = has_next ? (slc ^ 1) : slc;
        if constexpr (!ARows::DENSE) { if (has_next) PG8_TBL_FILL(nxt, sln); }
        const char* nB = has_next ? (const char*)Bt + (size_t)nxt.pn * tstep : cB;
        const char* nA = has_next ? PG8_ABASE(nxt) : cA;
        const int nt = cur.nt;
#pragma unroll 1
        for (int t = 0; t < nt; t += 2) {
            const bool last = (t == nt - 2);
            const char* a1 = cA + (size_t)(t + 1) * kstep;
            const char* a2 = last ? nA : cA + (size_t)(t + 2) * kstep; const char* b2 = last ? nB : cB + (size_t)(t + 2) * kstep;
            const char* a3 = a2 + kstep; const char* b3 = b2 + kstep;
            const int sl2 = last ? sln : slc;
            PG8_LDB(B0, 0, 0); PG8_LDB(B1, 0, 1); PG8_SCHED; PG8_LDA(At, 0, 0); PG8_STAGE_A(PG8_SA(1, 1), a1, 1, slc);
            PG8_WAIT_V(8); PG8_WAIT_L(0); PG8_BAR; PG8_MMA(0, 0, At, B0); PG8_MMA(0, 1, At, B1); PG8_BAR; PG8_SCHED;
            PG8_LDA(At, 0, 1); PG8_STAGE(PG8_SB(0, 0), b2, voffB); PG8_STAGE(PG8_SB(0, 1), b2 + hstep, voffB); PG8_STAGE_A(PG8_SA(0, 0), a2, 0, sl2);
            PG8_WAIT_V(8); PG8_WAIT_L(0); PG8_BAR; PG8_MMA(1, 0, At, B0); PG8_MMA(1, 1, At, B1); PG8_BAR; PG8_SCHED;
            PG8_LDB(B0, 1, 0); PG8_LDB(B1, 1, 1); PG8_SCHED; PG8_LDA(At, 1, 0); PG8_STAGE_A(PG8_SA(0, 1), a2, 1, sl2);
            PG8_WAIT_V(8); PG8_WAIT_L(0); PG8_BAR; PG8_MMA(0, 0, At, B0); PG8_MMA(0, 1, At, B1); PG8_BAR; PG8_SCHED;
            PG8_LDA(At, 1, 1); PG8_STAGE(PG8_SB(1, 0), b3, voffB); PG8_STAGE(PG8_SB(1, 1), b3 + hstep, voffB); PG8_STAGE_A(PG8_SA(1, 0), a3, 0, sl2);
            PG8_WAIT_V(8); PG8_WAIT_L(0); PG8_BAR; PG8_MMA(1, 0, At, B0); PG8_MMA(1, 1, At, B1); PG8_BAR; PG8_SCHED;
        }
        if constexpr (ALIGN_EPI) { if (wr == 0) PG8_BAR; }
        asm volatile("" : "+s"(cur.pm), "+s"(cur.pn));
        { const int tz = lane_now();
          E(acc, cur, wr, wc, tz & 15, (tz & 63) >> 4); }
        if (!has_next) break;
#pragma unroll
        for (int a = 0; a < 2; ++a)
#pragma unroll
            for (int b = 0; b < 2; ++b)
#pragma unroll
                for (int m = 0; m < 4; ++m)
#pragma unroll
                    for (int n = 0; n < 2; ++n) acc[a][b][m][n] = (f32x4){0.f, 0.f, 0.f, 0.f};
        cur = nxt; cB = nB; cA = nA; ++ui;
        if constexpr (ALIGN_EPI) { if (wr == 1) PG8_BAR; }
    }
    PG8_WAIT_V(0);
    if constexpr (!ALIGN_EPI) { if (wr == 0) PG8_BAR; }
    PG8_BAR;
#undef PG8_SA
#undef PG8_SB
#undef PG8_SBR
#undef PG8_STAGE
#undef PG8_LDA
#undef PG8_LDB
#undef PG8_MMA
#undef PG8_WAIT_V
#undef PG8_WAIT_L
#undef PG8_BAR
#undef PG8_SCHED
#undef PG8_AOFF
#undef PG8_STAGE_A
#undef PG8_TBL_FILL
}
struct DenseRowsH { __device__ __forceinline__ unsigned row(int pm, int r) const { return (unsigned)(pm * 128 + r); } };
struct GatherRowsH { const int* idx; __device__ __forceinline__ unsigned row(int pm, int r) const { return (unsigned)idx[pm * 128 + r]; } };
struct EpiSwigluH {
    unsigned char* O; const float* b1;
    __device__ __forceinline__ void operator()(const f32x4 (&acc)[2][4][2], const Unit& u, int wr, int wc, int fr, int fq) const {
        const int e = u.pn >> 4, ct = u.pn & 15;
        const int row0 = u.pm * 128 + wr * 64 + fr, col0 = ct * HALF + wc * 32 + 8 * fq;
        const float* bg = b1 + (size_t)e * 2 * DE + col0; const float* bu = bg + DE;
        const f32x4 bg0 = *(const f32x4*)bg, bg1 = *(const f32x4*)(bg + 4), bu0 = *(const f32x4*)bu, bu1 = *(const f32x4*)(bu + 4);
        constexpr float inv = 1.f / (F8_SH * F8_SW1);
#pragma unroll
        for (int m = 0; m < 4; ++m) { unsigned char* rowp = O + (size_t)(row0 + m * 16) * DE + col0;
            float o[8];
#pragma unroll
            for (int n = 0; n < 2; ++n) { const f32x4 g4 = acc[0][m][n] * inv + (n ? bg1 : bg0), u4 = acc[1][m][n] * inv + (n ? bu1 : bu0);
#pragma unroll
                for (int j = 0; j < 4; ++j) { const float g = fminf(g4[j], 7.f), up = fminf(fmaxf(u4[j], -7.f), 7.f);
                    o[n * 4 + j] = F8_SACT * g * (up + 1.f) * __builtin_amdgcn_rcpf(1.f + __expf(-1.702f * g)); } }
            *(u32x2*)rowp = (u32x2){pk4_f8(o[0], o[1], o[2], o[3]), pk4_f8(o[4], o[5], o[6], o[7])}; }
    }
};
struct EpiMoeOutH {
    bf16_t* O; const float* b2; const float* sg;
    __device__ __forceinline__ void operator()(const f32x4 (&acc)[2][4][2], const Unit& u, int wr, int wc, int fr, int fq) const {
        const int e = u.pn >> 3, ct = u.pn & 7;
        const int row0 = u.pm * 128 + wr * 64 + fr, col0 = ct * BM + wc * 32 + 8 * fq;
        constexpr float inv = 1.f / (F8_SACT * F8_SW2);
#pragma unroll
        for (int m = 0; m < 4; ++m) { const int row = row0 + m * 16; const float gt = sg[row]; bf16_t* rowp = O + (size_t)row * D + col0;
#pragma unroll
            for (int bj = 0; bj < 2; ++bj) { const f32x4 b0 = *(const f32x4*)(b2 + (size_t)e * D + col0 + bj * HALF), b1_ = *(const f32x4*)(b2 + (size_t)e * D + col0 + bj * HALF + 4);
                const f32x4 v0 = (acc[bj][m][0] * inv + b0) * gt, v1 = (acc[bj][m][1] * inv + b1_) * gt;
                *(u32x4*)(rowp + bj * HALF) = (u32x4){cvt2(v0[0], v0[1]), cvt2(v0[2], v0[3]), cvt2(v1[0], v1[1]), cvt2(v1[2], v1[3])}; } }
    }
};
template <class Epi, class Sched, class ARows>
__device__ __forceinline__ void gemm_f8h(LAS unsigned char* lds, const unsigned char* A, const unsigned char* Bt, const Sched& S, const Epi& E, const ARows& AR, const int wid) {
    constexpr int NT = KD / 128, STG = 3 * HTB;
    const int wr = wid >> 2, wc = wid & 3;
    const unsigned ldsw = (unsigned)wid * 1024u;
    Unit cur, nxt;
    if (!S.next(0, cur)) return;
#define F8_STAGE(dstoff, gbase, voff) do { const char* gb_ = (const char*)(gbase); _Pragma("unroll") for (int _i = 0; _i < 2; ++_i) { unsigned keep_; \
        asm volatile("s_mov_b32 %0, m0\n\ts_mov_b32 m0, %3\n\ts_nop 0\n\tglobal_load_lds_dwordx4 %1, %2\n\ts_mov_b32 m0, %0" : "=&s"(keep_) : "v"((voff)[_i]), "s"(gb_), "s"((unsigned)((dstoff) + ldsw + _i * 8192)) : "memory"); } } while (0)
#define F8_AOFF(dst, u) do { const int tq_ = wid * 64 + lane_now(); _Pragma("unroll") for (int _i = 0; _i < 2; ++_i) { int R_, C_; f8_stage_rc(tq_ * 16 + _i * 8192, R_, C_); dst[_i] = AR.row((u).pm, R_) * (unsigned)KD + (unsigned)C_; } } while (0)
#define F8_STAGE_TILE(so_, kt_, aoffv, bptr) do { F8_STAGE((so_), (const char*)A + (size_t)(kt_) * 128, aoffv); F8_STAGE((so_) + HTB, (bptr) + (size_t)(kt_) * 128, vb); F8_STAGE((so_) + 2 * HTB, (bptr) + (size_t)128 * KD + (size_t)(kt_) * 128, vb); } while (0)
#define F8_LDFRAG(a8, b8, so_) do { _Pragma("unroll") for (int m = 0; m < 4; ++m) { const i32x4 lo = *(const LAS i32x4*)(lds + (so_) + aoff0 + m * 2048), hi = *(const LAS i32x4*)(lds + (so_) + aoff1 + m * 2048); a8[m] = __builtin_shufflevector(lo, hi, 0, 1, 2, 3, 4, 5, 6, 7); } \
        _Pragma("unroll") for (int b = 0; b < 2; ++b) _Pragma("unroll") for (int n = 0; n < 2; ++n) { const i32x4 lo = *(const LAS i32x4*)(lds + (so_) + (1 + b) * HTB + boff0 + n * 2048), hi = *(const LAS i32x4*)(lds + (so_) + (1 + b) * HTB + boff1 + n * 2048); b8[b][n] = __builtin_shufflevector(lo, hi, 0, 1, 2, 3, 4, 5, 6, 7); } } while (0)
#define F8_MMA(a8, b8) do { __builtin_amdgcn_s_setprio(1); _Pragma("unroll") for (int b = 0; b < 2; ++b) _Pragma("unroll") for (int m = 0; m < 4; ++m) _Pragma("unroll") for (int n = 0; n < 2; ++n) \
        acc[b][m][n] = __builtin_amdgcn_mfma_scale_f32_16x16x128_f8f6f4(b8[b][n], a8[m], acc[b][m][n], 0, 0, 0, 0x7f7f7f7f, 0, 0x7f7f7f7f); __builtin_amdgcn_s_setprio(0); } while (0)
    unsigned ao[2], an[2], vb[2];
    { const int tq = wid * 64 + lane_now();
#pragma unroll
        for (int i = 0; i < 2; ++i) { int R, C; f8_stage_rc(tq * 16 + i * 8192, R, C); const int Rb = (R & ~31) + perm32(R & 31); vb[i] = (unsigned)(Rb * KD + C); } }
    F8_AOFF(ao, cur);
    int aoff0, aoff1, boff0, boff1; { const int ln = lane_now(), fr = ln & 15, fq = ln >> 4; aoff0 = f8_lds_byte(wr * 64 + fr, 2 * fq); aoff1 = f8_lds_byte(wr * 64 + fr, 2 * fq + 1); boff0 = f8_lds_byte(wc * 32 + fr, 2 * fq); boff1 = f8_lds_byte(wc * 32 + fr, 2 * fq + 1); }
    const char* cB = (const char*)Bt + (size_t)cur.pn * 256 * KD;
    f32x4 acc[2][4][2];
#pragma unroll
    for (int b = 0; b < 2; ++b)
#pragma unroll
        for (int m = 0; m < 4; ++m)
#pragma unroll
            for (int n = 0; n < 2; ++n) acc[b][m][n] = (f32x4){0.f, 0.f, 0.f, 0.f};
    F8_STAGE_TILE(0, 0, ao, cB); F8_STAGE_TILE(STG, 1, ao, cB);
    int so = 0;
    for (int ui = 0;; ++ui) {
        const bool has_next = S.next(ui + 1, nxt);
        const char* nB = cB;
        if (has_next) { F8_AOFF(an, nxt); nB = (const char*)Bt + (size_t)nxt.pn * 256 * KD; } else { an[0] = ao[0]; an[1] = ao[1]; }
#pragma unroll 1
        for (int kt = 0; kt < NT; ++kt) {
            const int so2 = (so == 0) ? 2 * STG : so - STG;
            if (kt + 1 < NT || has_next) asm volatile("s_waitcnt vmcnt(6)" ::: "memory"); else asm volatile("s_waitcnt vmcnt(0)" ::: "memory");
            __builtin_amdgcn_s_barrier(); asm volatile("" ::: "memory");
            if (kt + 2 < NT) F8_STAGE_TILE(so2, kt + 2, ao, cB); else if (has_next) F8_STAGE_TILE(so2, kt + 2 - NT, an, nB);
            i32x8 fa[4], fb[2][2];
            F8_LDFRAG(fa, fb, so);
            F8_MMA(fa, fb);
            so = (so == 2 * STG) ? 0 : so + STG;
        }
        { const int ln = lane_now(); E(acc, cur, wr, wc, ln & 15, ln >> 4); }
        if (!has_next) break;
#pragma unroll
        for (int b = 0; b < 2; ++b)
#pragma unroll
            for (int m = 0; m < 4; ++m)
#pragma unroll
                for (int n = 0; n < 2; ++n) acc[b][m][n] = (f32x4){0.f, 0.f, 0.f, 0.f};
        cur = nxt; cB = nB; ao[0] = an[0]; ao[1] = an[1];
    }
#undef F8_STAGE
#undef F8_AOFF
#undef F8_STAGE_TILE
#undef F8_LDFRAG
#undef F8_MMA
}
}

constexpr int NWAVES = 8, NTHREADS = 512;
constexpr int NPHASE = 13;
struct Args {
    const float* in[33]; float* out; unsigned char* ws; int ph_lo, ph_hi, use_bar, pad;
};
enum { I_X = 0, I_LNG, I_LNB, I_WIN, I_CONVW, I_CONVB, I_WRG, I_BRG, I_WIG, I_BIG, I_LAMBDA, I_MU, I_W0, I_DECUP, I_A0, I_AAAUP, I_GATEUP,
       I_KK, I_KA, I_RK, I_GNG, I_GNB, I_WOUT, I_LN1G, I_LN1B, I_WROUTER, I_BROUTER, I_WE1, I_BE1, I_WE2, I_BE2, I_LN2G, I_LN2B };

__device__ __forceinline__ void transpose_item(const float* W, int N, bf16_t* WT, int k0, int n0, int dst_row0, LAS float* scr, int lane) {
#pragma unroll 8
    for (int i = 0; i < 32; ++i) { const int kk = 2 * i + (lane >> 5); scr[kk * 33 + (lane & 31)] = W[(size_t)(k0 + kk) * N + n0 + (lane & 31)]; }
    asm volatile("s_waitcnt lgkmcnt(0)" ::: "memory");
    const int c = lane & 7;
#pragma unroll
    for (int j = 0; j < 4; ++j) { const int n = (lane >> 3) + 8 * j; const LAS float* s = scr + (8 * c) * 33 + n;
        u32x4 o; o.x = pk2(s[0 * 33], s[1 * 33]); o.y = pk2(s[2 * 33], s[3 * 33]); o.z = pk2(s[4 * 33], s[5 * 33]); o.w = pk2(s[6 * 33], s[7 * 33]);
        *(u32x4*)(WT + (size_t)(dst_row0 + n) * KD + k0 + 8 * c) = o; }
    asm volatile("s_waitcnt lgkmcnt(0)" ::: "memory");
}

__device__ __forceinline__ void transpose_item_f8(const float* W, int N, unsigned char* WT, int k0, int n0, int dst_row0, float scale, LAS float* scr, int lane) {
#pragma unroll 8
    for (int i = 0; i < 64; ++i) { const int kk = 2 * i + (lane >> 5); scr[kk * 33 + (lane & 31)] = W[(size_t)(k0 + kk) * N + n0 + (lane & 31)]; }
    asm volatile("s_waitcnt lgkmcnt(0)" ::: "memory");
    const int c = lane & 7;
#pragma unroll
    for (int j = 0; j < 4; ++j) { const int n = (lane >> 3) + 8 * j; const LAS float* s = scr + (16 * c) * 33 + n;
        u32x4 o;
        o.x = pk4_f8(s[0 * 33] * scale, s[1 * 33] * scale, s[2 * 33] * scale, s[3 * 33] * scale); o.y = pk4_f8(s[4 * 33] * scale, s[5 * 33] * scale, s[6 * 33] * scale, s[7 * 33] * scale);
        o.z = pk4_f8(s[8 * 33] * scale, s[9 * 33] * scale, s[10 * 33] * scale, s[11 * 33] * scale); o.w = pk4_f8(s[12 * 33] * scale, s[13 * 33] * scale, s[14 * 33] * scale, s[15 * 33] * scale);
        *(u32x4*)(WT + (size_t)(dst_row0 + n) * KD + k0 + 16 * c) = o; }
    asm volatile("s_waitcnt lgkmcnt(0)" ::: "memory");
}

__device__ __forceinline__ void moe_tables(volatile LAS int* tb, unsigned* ctl, int wave_id) {
    if (wave_id == 0 && lane_now() == 0) {
        int off = 0;
        for (int e = 0; e < NE; ++e) { const int c = (int)__hip_atomic_load(ctl + CW_CNT + 64 * e, RLX_AGENT); const int nt = (c + 255) >> 8;
            tb[1 + e] = off; for (int r = 0; r < nt; ++r) tb[64 + off + r] = e; off += nt; }
        tb[1 + NE] = off; tb[0] = off;
    }
    __syncthreads();
}

__global__ void __launch_bounds__(NTHREADS, 2) fwd(Args args) {
    extern __shared__ __attribute__((aligned(16))) unsigned char lds_raw[];
    LAS unsigned char* lds = (LAS unsigned char*)lds_raw;
    volatile LAS unsigned* MISC = (volatile LAS unsigned*)(lds + MISC_OFF);
    const int wave = __builtin_amdgcn_readfirstlane(threadIdx.x >> 6);
#define LANE_TID() const int lane = lane_now(), tid = wave * 64 + lane, gt = bid * NTHREADS + tid; (void)tid; (void)gt
    const int G = gridDim.x, bid = blockIdx.x;
    unsigned char* ws = args.ws;
    unsigned* ctl = (unsigned*)(ws + WS_CTL);
    if (wave == 0) MISC[lane_now()] = 0u;
    __syncthreads();
    XcdBarrier bar; bar.bar = ctl + CW_BAR; bar.x = 0; bar.st = nullptr;
    if (args.use_bar) bar = xcd_barrier_post(ctl + CW_BAR, MISC);
    const int lo = args.ph_lo, hi = args.ph_hi;
#ifndef DUP_MASK
#define DUP_MASK 0
#endif
#define REP(k) for (int rep_ = 0; rep_ <= ((DUP_MASK >> (k)) & 1); ++rep_)
#define IN(k) (lo <= (k) && (k) < hi)
#ifndef PROBE_PHASE
#define PROBE_PHASE -1
#endif
    unsigned long long tprobe0 = 0ull, tprobe1 = 0ull;
#define SEAM(k) do { if (IN(k) && IN((k) + 1)) xcd_barrier(bar, wave); if (PROBE_PHASE >= 0) { if ((k) + 1 == PROBE_PHASE) tprobe0 = __builtin_amdgcn_s_memrealtime(); if ((k) == PROBE_PHASE) tprobe1 = __builtin_amdgcn_s_memrealtime(); } } while (0)
    if (PROBE_PHASE == 0) tprobe0 = __builtin_amdgcn_s_memrealtime();
    const int gw = bid * NWAVES + wave, NGW = G * NWAVES;
    const int NGT = G * NTHREADS;

    bf16_t* WinT = (bf16_t*)(ws + WS_WIN); bf16_t* WoT = (bf16_t*)(ws + WS_WO); unsigned char* W1F = ws + WS_W1; unsigned char* W2F = ws + WS_W2;
    bf16_t* XN = (bf16_t*)(ws + WS_XN); bf16_t* P = (bf16_t*)(ws + WS_P);
    float* LA = (float*)(ws + WS_LA); float* LB = (float*)(ws + WS_LB);
    float* BON = (float*)(ws + WS_BON);
    bf16_t* CAT = (bf16_t*)(ws + WS_CAT); float* Z = (float*)(ws + WS_Z); float* H1 = (float*)(ws + WS_H1); unsigned char* H1F = ws + WS_H1B;
    int* TOPE = (int*)(ws + WS_TOPE); int* TOPP = (int*)(ws + WS_TOPP); float* TOPG = (float*)(ws + WS_TOPG); int* TOKSLOT = (int*)(ws + WS_TOKSLOT);
    int* SLOTTOK = (int*)(ws + WS_SLOTTOK); float* SLOTG = (float*)(ws + WS_SLOTG);
    unsigned char* ACT = ws + WS_ACT; bf16_t* OUTS = (bf16_t*)(ws + WS_OUTS);

    constexpr int CV_I_IN = (KD / 64) * (NP / 32), CV_I_OUT = (KD / 64) * (D / 32), CV_I_E1 = (KD / 128) * (2 * DE / 32), CV_I_E2 = (DE / 128) * (D / 32);
    constexpr int CV_NITEMS = CV_I_IN + CV_I_OUT + NE * CV_I_E1 + NE * CV_I_E2;
#ifndef CV_SHADOW
#define CV_SHADOW 9200
#endif
#ifndef CV_SHADOW1
#define CV_SHADOW1 5120
#endif
#define CONVERT_ITEM(it_) do { int r = (it_); LAS float* scr = (LAS float*)(lds + wave * 17408); \
        if (r < CV_I_IN) { const int nb = NP / 32, kb = r / nb, n0 = (r % nb) * 32; transpose_item(args.in[I_WIN], NP, WinT, kb * 64, n0, n0, scr, lane); break; } r -= CV_I_IN; \
        if (r < CV_I_OUT) { const int nb = D / 32, kb = r / nb, n0 = (r % nb) * 32; transpose_item(args.in[I_WOUT], D, WoT, kb * 64, n0, n0, scr, lane); break; } r -= CV_I_OUT; \
        if (r < NE * CV_I_E1) { const int e = r / CV_I_E1, q = r % CV_I_E1, nb = 2 * DE / 32, kb = q / nb, n0 = (q % nb) * 32; \
            const int isup = n0 >= DE ? 1 : 0, nn = n0 - isup * DE, drow = 256 * (nn >> 7) + 128 * isup + (nn & 127); \
            transpose_item_f8(args.in[I_WE1] + (size_t)e * KD * 2 * DE, 2 * DE, W1F + (size_t)e * 2 * DE * KD, kb * 128, n0, drow, F8_SW1, scr, lane); break; } r -= NE * CV_I_E1; \
        { const int e = r / CV_I_E2, q = r % CV_I_E2, nb = D / 32, kb = q / nb, n0 = (q % nb) * 32; \
            transpose_item_f8(args.in[I_WE2] + (size_t)e * DE * D, D, W2F + (size_t)e * D * DE, kb * 128, n0, n0, F8_SW2, scr, lane); } } while (0)

    if (IN(0)) REP(0) {
        LANE_TID();
        for (int it = gw; it < CV_NITEMS - CV_SHADOW - CV_SHADOW1; it += NGW) CONVERT_ITEM(it);
        { bf16_t* WG = (bf16_t*)(ws + WS_WG); bf16_t* WL = (bf16_t*)(ws + WS_WL);
            for (int i = gt; i < 2048 * 256; i += NGT) { const int row = i >> 8, kl = i & 255, g_ = row >> 10, nb = (row >> 6) & 15, k = row & 63, blk = kl >> 6, j = kl & 63;
                const float v = ((nb & 3) == blk) ? args.in[g_ ? I_WIG : I_WRG][(size_t)(nb * 64 + j) * 64 + k] : 0.f; WG[i] = cvt1(v); }
            for (int i = gt; i < 3072 * 256; i += NGT) { const int row = i >> 8, kl = i & 255, sel = row >> 10, c = row & 1023;
                float v = 0.f; if (sel == 0) { if (kl < DLORA) v = args.in[I_DECUP][(size_t)kl * RW_W + c]; } else if (sel == 1) { if (kl < ALORA) v = args.in[I_AAAUP][(size_t)kl * RW_W + c]; } else v = args.in[I_GATEUP][(size_t)kl * RW_W + c];
                WL[i] = cvt1(v); } }
        { bf16_t* WRH = (bf16_t*)(ws + WS_WRT); bf16_t* WRL = WRH + NE * D;
            for (int i = gt; i < NE * D; i += NGT) { const int e = i >> 11, k = i & 2047; const float w = args.in[I_WROUTER][(size_t)k * NE + e]; const unsigned short h = cvt1(w); WRH[i] = h; WRL[i] = cvt1(w - bf2f(h)); } }
        for (int i = gt; i < (NPP - NP) * KD / 8; i += NGT) ((u32x4*)(WinT + (size_t)NP * KD))[i] = (u32x4){0u, 0u, 0u, 0u};
        const float* lg = args.in[I_LNG]; const float* lb = args.in[I_LNB];
        for (int m = gw; m < M; m += NGW) {
            const f32x4* xr = (const f32x4*)(args.in[I_X] + (size_t)m * D) + lane;
            f32x4 v[8]; float s = 0.f;
#pragma unroll
            for (int j = 0; j < 8; ++j) { v[j] = xr[64 * j]; s += (v[j][0] + v[j][1]) + (v[j][2] + v[j][3]); }
            const float mean = wave_sum(s) * (1.f / D); float s2 = 0.f;
#pragma unroll
            for (int j = 0; j < 8; ++j) { v[j] = v[j] - mean; s2 += (v[j][0] * v[j][0] + v[j][1] * v[j][1]) + (v[j][2] * v[j][2] + v[j][3] * v[j][3]); }
            const float rstd = 1.f / sqrtf(wave_sum(s2) * (1.f / D) + LN_EPS);
            u32x2* o8 = (u32x2*)(XN + (size_t)m * D) + lane;
#pragma unroll
            for (int j = 0; j < 8; ++j) { const f32x4 g4 = ((const f32x4*)lg)[64 * j + lane], b4 = ((const f32x4*)lb)[64 * j + lane]; const f32x4 y = v[j] * rstd * g4 + b4;
                u32x2 w; w.x = pk2(y[0], y[1]); w.y = pk2(y[2], y[3]); o8[64 * j] = w; }
        }
    }
    SEAM(0);

    if (IN(1)) REP(1) {
        LANE_TID();
        pg8::StaticOrder S; S.init(M, NPP, G, bid);
        pg8::EpiBf16 E{P, NPP};
        pg8::gemm_phase<pg8::EpiBf16, pg8::StaticOrder, pg8::DenseRows, true>(lds, XN, WinT, S, E, pg8::DenseRows{}, wave);
        if (G == 256 && bid >= 128) {
            __syncthreads();
            for (int it = CV_NITEMS - CV_SHADOW - CV_SHADOW1 + (bid - 128) * NWAVES + wave; it < CV_NITEMS - CV_SHADOW; it += 128 * NWAVES) CONVERT_ITEM(it); }
        else if (G != 256) { for (int it = CV_NITEMS - CV_SHADOW - CV_SHADOW1 + gw; it < CV_NITEMS - CV_SHADOW; it += NGW) CONVERT_ITEM(it); }
    }
    SEAM(1);

    if (IN(2)) REP(2) {
        LANE_TID();
        bf16_t* UC = (bf16_t*)(ws + WS_UC); bf16_t* XL = (bf16_t*)(ws + WS_XL);
        const float* conv_w = args.in[I_CONVW]; const float* conv_b = args.in[I_CONVB]; const float* mu = args.in[I_MU];
        for (int idx = gt; idx < (M / 16) * (LRU_W / 8); idx += NGT) { const int m0 = (idx >> 7) * 16, c = (idx & 127) * 8, tin0 = m0 & (SEQ - 1);
            f32x4 wlo[4], whi[4];
#pragma unroll
            for (int j = 0; j < 4; ++j) { wlo[j] = *(const f32x4*)(conv_w + j * LRU_W + c); whi[j] = *(const f32x4*)(conv_w + j * LRU_W + c + 4); }
            const f32x4 cb0 = *(const f32x4*)(conv_b + c), cb1 = *(const f32x4*)(conv_b + c + 4);
            u32x4 row[19];
#pragma unroll
            for (int j = 0; j < 19; ++j) { row[j] = (u32x4){0u, 0u, 0u, 0u}; if (tin0 - 3 + j >= 0) row[j] = *(const u32x4*)(P + (size_t)(m0 - 3 + j) * NPP + c); }
#pragma unroll
            for (int t = 0; t < 16; ++t) { f32x4 o0 = cb0, o1 = cb1;
#pragma unroll
                for (int j = 0; j < 4; ++j) { const u32x4 pv = row[t + j];
                    o0[0] += wlo[j][0] * bflo(pv.x); o0[1] += wlo[j][1] * bfhi(pv.x); o0[2] += wlo[j][2] * bflo(pv.y); o0[3] += wlo[j][3] * bfhi(pv.y);
                    o1[0] += whi[j][0] * bflo(pv.z); o1[1] += whi[j][1] * bfhi(pv.z); o1[2] += whi[j][2] * bflo(pv.w); o1[3] += whi[j][3] * bfhi(pv.w); }
                *(u32x4*)(UC + (size_t)(m0 + t) * LRU_W + c) = (u32x4){cvt2(o0[0], o0[1]), cvt2(o0[2], o0[3]), cvt2(o1[0], o1[1]), cvt2(o1[2], o1[3])}; } }
        for (int idx = gt; idx < M * 64; idx += NGT) { const int m = idx >> 6, q = idx & 63, tin = m & (SEQ - 1);
            u32x4 res = {0u, 0u, 0u, 0u};
            const int kind = q < 12 ? 0 : (q < 16 ? 3 : (q < 28 ? 1 : (q < 32 ? 3 : 2)));
            if (kind != 3) { const int col = (kind == 0) ? 3 * RW_W + 8 * q : (kind == 1 ? 3 * RW_W + DLORA + 8 * (q - 16) : 3 * RW_W + DLORA + ALORA + 8 * (q - 32));
                const bf16_t* pp = P + (size_t)m * NPP + 2 * LRU_W + col; const u32x4 pc = *(const u32x4*)pp; u32x4 pq = {0u, 0u, 0u, 0u}; if (tin > 0) pq = *(const u32x4*)(pp - NPP);
                const f32x4 m0 = *(const f32x4*)(mu + col), m1 = *(const f32x4*)(mu + col + 4);
                float s[8]; const unsigned pcw[4] = {pc.x, pc.y, pc.z, pc.w}, pqw[4] = {pq.x, pq.y, pq.z, pq.w};
#pragma unroll
                for (int e = 0; e < 4; ++e) { const float c0 = bflo(pcw[e]), c1 = bfhi(pcw[e]), p0 = bflo(pqw[e]), p1 = bfhi(pqw[e]);
                    const float mu0 = (e < 2) ? m0[2 * e] : m1[2 * e - 4], mu1 = (e < 2) ? m0[2 * e + 1] : m1[2 * e - 3];
                    s[2 * e] = c0 + (p0 - c0) * mu0; s[2 * e + 1] = c1 + (p1 - c1) * mu1; }
#pragma unroll
                for (int e = 0; e < 8; ++e) s[e] = (kind == 0) ? tanh_fast(s[e]) : (kind == 1 ? s[e] : sigmoidf_(s[e]));
                res = (u32x4){cvt2(s[0], s[1]), cvt2(s[2], s[3]), cvt2(s[4], s[5]), cvt2(s[6], s[7])}; }
            *(u32x4*)(XL + (size_t)m * 512 + 8 * q) = res; }
    }
    SEAM(2);

    if (IN(3)) {
        LANE_TID();
        const bf16_t* UC = (const bf16_t*)(ws + WS_UC); const bf16_t* XL = (const bf16_t*)(ws + WS_XL);
        { pg8::SmallOrder<0> S{G, bid}; pg8::EpiBf16 E{(bf16_t*)(ws + WS_GATES), 2048};
          pg8::gemm_phase<pg8::EpiBf16, pg8::SmallOrder<0>, pg8::DenseRows, true, LRU_W, 256>(lds, UC, (const bf16_t*)(ws + WS_WG), S, E, pg8::DenseRows{}, wave); }
        { pg8::SmallOrder<1> S{G, bid}; pg8::EpiBf16 E{(bf16_t*)(ws + WS_LOUT), 3072};
          pg8::gemm_phase<pg8::EpiBf16, pg8::SmallOrder<1>, pg8::DenseRows, true, 512, 256>(lds, XL, (const bf16_t*)(ws + WS_WL), S, E, pg8::DenseRows{}, wave); }
    }
    SEAM(3);

    if (IN(4)) {
        LANE_TID();
        constexpr int RS = 144;
        constexpr int L_AT = 0, L_BT = 9216, L_KT = 18432, L_RT = 27648, L_VT = 36864, L_BH = 46080, L_KH = 55296, L_AAB = 64512, L_AAK = 80896, L_ARB = 90112, L_ARK = 99328,
                      L_PT = 108544, L_QT = 117760, L_WC = 126976, L_A16 = 129280, L_TB = 138496, L_SEG = 140544, L_U = L_BT, L_MST = L_AT, L_GST = L_BT;
        bf16_t* MT = (bf16_t*)(ws + WS_MT); bf16_t* GG = (bf16_t*)(ws + WS_GG); float* NN = (float*)(ws + WS_NN); float* HH = (float*)(ws + WS_HH);
        const bf16_t* LOUT = (const bf16_t*)(ws + WS_LOUT); bf16_t* V16 = (bf16_t*)(ws + WS_V16); bf16_t* G16 = (bf16_t*)(ws + WS_G16); const float* mu_ = args.in[I_MU];
        const int r = lane & 31, hh = lane >> 5;
        unsigned xr[5], xk[5], xv[5], xd[4], xa[4], xg[4];
#define E_LOAD(u_) do { const int cch_ = (u_) & 63, head_ = ((u_) >> 6) & 15, b_ = (u_) >> 10; const int sg_ = 2 * wave + (lane >> 5); const size_t tokb_ = (size_t)b_ * SEQ + cch_ * 64 + 4 * sg_; const int c_ = head_ * HS + 2 * (lane & 31); \
            const bf16_t* pp_ = P + tokb_ * NPP + 2 * LRU_W + c_; const bool hp_ = ((cch_ * 64 + 4 * sg_) & (SEQ - 1)) != 0; \
            xr[0] = hp_ ? *(const unsigned*)(pp_ - NPP) : 0u; xk[0] = hp_ ? *(const unsigned*)(pp_ - NPP + RW_W) : 0u; xv[0] = hp_ ? *(const unsigned*)(pp_ - NPP + 2 * RW_W) : 0u; \
            _Pragma("unroll") for (int j = 0; j < 4; ++j) { const bf16_t* pj = pp_ + (size_t)j * NPP; xr[j + 1] = *(const unsigned*)pj; xk[j + 1] = *(const unsigned*)(pj + RW_W); xv[j + 1] = *(const unsigned*)(pj + 2 * RW_W); \
                const bf16_t* lj = LOUT + (tokb_ + j) * 3072 + c_; xd[j] = *(const unsigned*)lj; xa[j] = *(const unsigned*)(lj + 1024); xg[j] = *(const unsigned*)(lj + 2048); } } while (0)
        if (bid < NUNIT) E_LOAD(bid);
        REP(4) for (int u = bid; u < NUNIT; u += G) {
            const int cch = u & 63, head = (u >> 6) & 15, b = u >> 10; const size_t tok0 = (size_t)b * SEQ + cch * 64;
            { const int cp = lane & 31, hq = lane >> 5, sg = 2 * wave + hq, ch = 2 * cp, c = head * HS + ch; const size_t tokb = tok0 + 4 * sg;
                float lw[4][2], rr_[4][2], kk_[4][2], vv_[4][2], kn_[4][2], aa_[4][2];
                { const f32x2 mur = *(const f32x2*)(mu_ + c), muk = *(const f32x2*)(mu_ + RW_W + c), muv = *(const f32x2*)(mu_ + 2 * RW_W + c);
                    const f32x2 w0c = *(const f32x2*)(args.in[I_W0] + c), a0c = *(const f32x2*)(args.in[I_A0] + c), kkc = *(const f32x2*)(args.in[I_KK] + c), kac = *(const f32x2*)(args.in[I_KA] + c), rkc = *(const f32x2*)(args.in[I_RK] + c);
                    float bonv[4];
#pragma unroll
                    for (int j = 0; j < 4; ++j) { float s_kk = 0.f, s_bo = 0.f;
#pragma unroll
                        for (int x = 0; x < 2; ++x) { const float cr = x ? bfhi(xr[j + 1]) : bflo(xr[j + 1]), ck = x ? bfhi(xk[j + 1]) : bflo(xk[j + 1]), cv = x ? bfhi(xv[j + 1]) : bflo(xv[j + 1]);
                            const float pr = x ? bfhi(xr[j]) : bflo(xr[j]), pk_ = x ? bfhi(xk[j]) : bflo(xk[j]), pvv = x ? bfhi(xv[j]) : bflo(xv[j]);
                            const float r = cr + (pr - cr) * mur[x], k = ck + (pk_ - ck) * muk[x], v = cv + (pvv - cv) * muv[x];
                            const float lgw = -0.6065306597126334f * sigmoidf_(w0c[x] + (x ? bfhi(xd[j]) : bflo(xd[j])));
                            const float a = sigmoidf_(a0c[x] + (x ? bfhi(xa[j]) : bflo(xa[j])));
                            const float kk = k * kkc[x]; const float km = k * (1.f + (a - 1.f) * kac[x]);
                            s_kk += kk * kk; s_bo += r * km * rkc[x];
                            lw[j][x] = lgw; rr_[j][x] = r; kk_[j][x] = km; vv_[j][x] = v; kn_[j][x] = kk; aa_[j][x] = a; }
                        const float inv = __builtin_amdgcn_rsqf(fmaxf(half_sum(s_kk, hq), 1e-24f)); kn_[j][0] *= inv; kn_[j][1] *= inv;
                        bonv[j] = half_sum(s_bo, hq); }
#pragma unroll
                    for (int j = 0; j < 4; ++j) { *(unsigned*)(V16 + (tokb + j) * RW_W + c) = cvt2(vv_[j][0], vv_[j][1]); *(unsigned*)(G16 + (tokb + j) * RW_W + c) = xg[j]; }
                    if (cp < 4) { float bsel = bonv[0];
#pragma unroll
                        for (int j = 1; j < 4; ++j) bsel = (cp == j) ? bonv[j] : bsel;
                        BON[(tokb + cp) * NHEAD + head] = bsel; }
                    if (u + G < NUNIT) E_LOAD(u + G); }
                f32x2 seg = {0.f, 0.f};
#pragma unroll
                for (int j = 0; j < 4; ++j) { seg[0] += lw[j][0]; seg[1] += lw[j][1]; }
                *(LAS f32x2*)(lds + L_SEG + (sg * 64 + ch) * 4) = seg;
                __syncthreads();
                f32x2 pre = {0.f, 0.f}, tot = {0.f, 0.f};
#pragma unroll
                for (int g = 0; g < 16; ++g) { const f32x2 sv = *(const LAS f32x2*)(lds + L_SEG + (g * 64 + ch) * 4); tot += sv; if (g < sg) pre += sv; }
                if (sg == 0) *(LAS f32x2*)(lds + L_WC + ch * 4) = (f32x2){__expf(tot[0]), __expf(tot[1])};
                float tv[2][4], tb_[2][4], tk[2][4];
#pragma unroll
                for (int x = 0; x < 2; ++x) { float L = pre[x]; const float eTot = __expf(tot[x]); float eLex = __expf(pre[x]);
#pragma unroll
                    for (int j = 0; j < 4; ++j) { L += lw[j][x];
                        const float eL = __expf(L), eNL = __builtin_amdgcn_rcpf(eL), eEnd = eTot * eNL; const float beta = kn_[j][x] * aa_[j][x];
                        rr_[j][x] = rr_[j][x] * eL; const float at_ = kn_[j][x] * eLex, bt_ = beta * eNL, kt_ = kk_[j][x] * eNL;
                        tv[x][j] = vv_[j][x]; tb_[x][j] = -beta * eEnd; tk[x][j] = kk_[j][x] * eEnd; eLex = eL;
                        kn_[j][x] = at_; aa_[j][x] = bt_; kk_[j][x] = kt_; } }
#pragma unroll
                for (int j = 0; j < 4; ++j) { const int t = 4 * sg + j;
                    *(LAS unsigned*)(lds + L_AT + t * RS + ch * 2) = cvt2(kn_[j][0], kn_[j][1]);
                    *(LAS unsigned*)(lds + L_BT + t * RS + ch * 2) = cvt2(aa_[j][0], aa_[j][1]);
                    *(LAS unsigned*)(lds + L_KT + t * RS + ch * 2) = cvt2(kk_[j][0], kk_[j][1]);
                    *(LAS unsigned*)(lds + L_RT + t * RS + ch * 2) = cvt2(rr_[j][0], rr_[j][1]); }
#pragma unroll
                for (int x = 0; x < 2; ++x) {
                    *(LAS u32x2*)(lds + L_VT + (ch + x) * RS + sg * 8) = (u32x2){cvt2(tv[x][0], tv[x][1]), cvt2(tv[x][2], tv[x][3])};
                    *(LAS u32x2*)(lds + L_BH + (ch + x) * RS + sg * 8) = (u32x2){cvt2(tb_[x][0], tb_[x][1]), cvt2(tb_[x][2], tb_[x][3])};
                    *(LAS u32x2*)(lds + L_KH + (ch + x) * RS + sg * 8) = (u32x2){cvt2(tk[x][0], tk[x][1]), cvt2(tk[x][2], tk[x][3])}; }
            }
            __syncthreads();
            { const int id = wave >> 1, i = wave & 1; const int X = (id < 2) ? L_AT : L_RT, Y = (id & 1) ? L_KT : L_BT;
                f32x16 acc[2];
#pragma unroll
                for (int q = 0; q < 2; ++q)
#pragma unroll
                    for (int e = 0; e < 16; ++e) acc[q][e] = 0.f;
#pragma unroll
                for (int s = 0; s < 4; ++s) { const bf16x8 a = *(const LAS bf16x8*)(lds + X + (32 * i + r) * RS + (16 * s + 8 * hh) * 2);
#pragma unroll
                    for (int q = 0; q < 2; ++q) { const bf16x8 bb = *(const LAS bf16x8*)(lds + Y + (32 * q + r) * RS + (16 * s + 8 * hh) * 2); acc[q] = MFMA32(a, bb, acc[q]); } }
#pragma unroll
                for (int q = 0; q < 2; ++q)
#pragma unroll
                    for (int e = 0; e < 16; ++e) { const int t = 32 * i + crow(e, hh), sc = 32 * q + r; const bool keep = (id < 2) ? (sc < t) : (sc <= t);
                        float val = keep ? acc[q][e] : 0.f; if (id == 2) val = -val;
                        if (id == 0) { ((LAS float*)(lds + L_AAB))[t * 64 + sc] = val; *(LAS unsigned short*)(lds + L_A16 + t * RS + sc * 2) = cvt1(-val); }
                        else *(LAS unsigned short*)(lds + L_AAK + (id - 1) * 9216 + t * RS + sc * 2) = cvt1(val); }
            }
            __syncthreads();
            if (wave < 4) { const int i = wave >> 1, q = wave & 1; f32x16 acc;
#pragma unroll
                for (int e = 0; e < 16; ++e) acc[e] = 0.f;
#pragma unroll
                for (int s = 0; s < 4; ++s) { const bf16x8 a = *(const LAS bf16x8*)(lds + L_AAK + (32 * i + r) * RS + (16 * s + 8 * hh) * 2);
                    const bf16x8 bb = *(const LAS bf16x8*)(lds + L_VT + (32 * q + r) * RS + (16 * s + 8 * hh) * 2); acc = MFMA32(a, bb, acc); }
#pragma unroll
                for (int e = 0; e < 16; ++e) ((LAS float*)(lds + L_U))[(32 * i + crow(e, hh)) * 64 + 32 * q + r] = acc[e];
            }
            if (wave == 4) { const int b2 = lane >> 4, j = lane & 15; float x[16];
                const LAS float* AB = (const LAS float*)(lds + L_AAB) + (16 * b2) * 64 + 16 * b2;
#pragma unroll
                for (int t = 0; t < 16; ++t) x[t] = (t == j) ? 1.f : 0.f;
                { f32x4 Ar[8][2];
#pragma unroll
                    for (int t = 1; t < 8; ++t)
#pragma unroll
                        for (int s4 = 0; s4 < (t + 3) / 4; ++s4) Ar[t][s4] = *(const LAS f32x4*)(AB + t * 64 + 4 * s4);
#pragma unroll
                    for (int s = 0; s < 7; ++s) { const float xs = x[s];
#pragma unroll
                        for (int t = s + 1; t < 8; ++t) x[t] -= Ar[t][s >> 2][s & 3] * xs; } }
                { f32x4 Ar[8][2];
#pragma unroll
                    for (int t = 0; t < 8; ++t)
#pragma unroll
                        for (int s4 = 0; s4 < 2; ++s4) Ar[t][s4] = *(const LAS f32x4*)(AB + (8 + t) * 64 + 4 * s4);
#pragma unroll
                    for (int t = 0; t < 8; ++t) { float a0 = 0.f, a1 = 0.f;
#pragma unroll
                        for (int s = 0; s < 8; s += 2) { a0 += Ar[t][s >> 2][s & 3] * x[s]; a1 += Ar[t][(s + 1) >> 2][(s + 1) & 3] * x[s + 1]; }
                        x[8 + t] -= (a0 + a1); } }
                { f32x4 Ar[8][2];
#pragma unroll
                    for (int t = 1; t < 8; ++t)
#pragma unroll
                        for (int s4 = 0; s4 < (t + 3) / 4; ++s4) Ar[t][s4] = *(const LAS f32x4*)(AB + (8 + t) * 64 + 8 + 4 * s4);
#pragma unroll
                    for (int s = 0; s < 7; ++s) { const float xs = x[8 + s];
#pragma unroll
                        for (int t = s + 1; t < 8; ++t) x[8 + t] -= Ar[t][s >> 2][s & 3] * xs; } }
#pragma unroll
                for (int t = 0; t < 16; ++t) *(LAS unsigned short*)(lds + L_TB + ((b2 * 16 + t) * 16 + j) * 2) = cvt1(x[t]);
            }
            __syncthreads();
            { const int c16 = lane & 15, quad = lane >> 4, isQ = wave >> 2, colb = 16 * (wave & 3) + c16;
                f32x4 Xr[4];
#pragma unroll
                for (int b2 = 0; b2 < 4; ++b2) Xr[b2] = (f32x4){0.f, 0.f, 0.f, 0.f};
#pragma unroll
                for (int b2 = 0; b2 < 4; ++b2) {
                    f32x4 y;
#pragma unroll
                    for (int g = 0; g < 4; ++g) { const int row = 16 * b2 + 4 * quad + g;
                        y[g] = isQ ? ((const LAS float*)(lds + L_U))[row * 64 + colb] : bf2f(*(const LAS unsigned short*)(lds + L_AT + row * RS + colb * 2)); }
#pragma unroll
                    for (int ks = 0; ks < 2; ++ks) if (2 * ks < b2) {
                        const u32x2 alo = *(const LAS u32x2*)(lds + L_A16 + (16 * b2 + c16) * RS + (32 * ks + 4 * quad) * 2);
                        u32x2 ahi = {0u, 0u}; if (2 * ks + 1 < b2) ahi = *(const LAS u32x2*)(lds + L_A16 + (16 * b2 + c16) * RS + (32 * ks + 16 + 4 * quad) * 2);
                        const u32x4 af = {alo.x, alo.y, ahi.x, ahi.y};
                        const u32x4 bf = {cvt2(Xr[2 * ks][0], Xr[2 * ks][1]), cvt2(Xr[2 * ks][2], Xr[2 * ks][3]), cvt2(Xr[2 * ks + 1][0], Xr[2 * ks + 1][1]), cvt2(Xr[2 * ks + 1][2], Xr[2 * ks + 1][3])};
                        y = __builtin_amdgcn_mfma_f32_16x16x32_bf16(__builtin_bit_cast(bf16x8, af), __builtin_bit_cast(bf16x8, bf), y, 0, 0, 0); }
                    const u32x2 tlo = *(const LAS u32x2*)(lds + L_TB + ((b2 * 16 + c16) * 16 + 4 * quad) * 2);
                    const u32x4 tf = {tlo.x, tlo.y, 0u, 0u};
                    const u32x4 yf = {cvt2(y[0], y[1]), cvt2(y[2], y[3]), 0u, 0u};
                    Xr[b2] = __builtin_amdgcn_mfma_f32_16x16x32_bf16(__builtin_bit_cast(bf16x8, tf), __builtin_bit_cast(bf16x8, yf), (f32x4){0.f, 0.f, 0.f, 0.f}, 0, 0, 0);
                    *(LAS u32x2*)(lds + (isQ ? L_QT : L_PT) + colb * RS + (16 * b2 + 4 * quad) * 2) = (u32x2){cvt2(Xr[b2][0], Xr[b2][1]), cvt2(Xr[b2][2], Xr[b2][3])};
                }
            }
            __syncthreads();
            { const int mtx = wave >> 1, i = wave & 1;
                const int X1 = (mtx == 0) ? L_BH : (mtx == 1) ? L_KH : (mtx == 2) ? L_ARB : L_ARK;
                const int Y1 = (mtx == 0 || mtx == 2) ? L_PT : L_VT;
                f32x16 acc[2];
#pragma unroll
                for (int q = 0; q < 2; ++q)
#pragma unroll
                    for (int e = 0; e < 16; ++e) acc[q][e] = 0.f;
#pragma unroll
                for (int s = 0; s < 4; ++s) { const bf16x8 a = *(const LAS bf16x8*)(lds + X1 + (32 * i + r) * RS + (16 * s + 8 * hh) * 2);
#pragma unroll
                    for (int q = 0; q < 2; ++q) { const bf16x8 bb = *(const LAS bf16x8*)(lds + Y1 + (32 * q + r) * RS + (16 * s + 8 * hh) * 2); acc[q] = MFMA32(a, bb, acc[q]); } }
                if (mtx & 1) { const int X2 = (mtx == 1) ? L_BH : L_ARB;
#pragma unroll
                    for (int s = 0; s < 4; ++s) { const bf16x8 a = *(const LAS bf16x8*)(lds + X2 + (32 * i + r) * RS + (16 * s + 8 * hh) * 2);
#pragma unroll
                        for (int q = 0; q < 2; ++q) { const bf16x8 bb = *(const LAS bf16x8*)(lds + L_QT + (32 * q + r) * RS + (16 * s + 8 * hh) * 2); acc[q] = MFMA32(a, bb, acc[q]); } } }
                if (mtx == 0) { const float wc = ((const LAS float*)(lds + L_WC))[32 * i + r];
#pragma unroll
                    for (int q = 0; q < 2; ++q)
#pragma unroll
                        for (int e = 0; e < 16; ++e) if (q == i && crow(e, hh) == r) acc[q][e] += wc; }
                if (mtx == 2) {
#pragma unroll
                    for (int q = 0; q < 2; ++q)
#pragma unroll
                        for (int e = 0; e < 16; ++e) acc[q][e] += bf2f(*(const LAS unsigned short*)(lds + L_RT + (32 * i + crow(e, hh)) * RS + (32 * q + r) * 2)); }
                if (mtx & 1) { unsigned* dstg = (unsigned*)((mtx == 1) ? NN : HH) + (size_t)u * 2048;
#pragma unroll
                    for (int q = 0; q < 2; ++q)
#pragma unroll
                        for (int e = 0; e < 16; e += 2) dstg[((i * 2 + q) * 8 + (e >> 1)) * 64 + lane] = cvt2(acc[q][e], acc[q][e + 1]);
                } else { const int dl = (mtx == 0) ? L_MST : L_GST;
#pragma unroll
                    for (int q = 0; q < 2; ++q)
#pragma unroll
                        for (int e = 0; e < 16; ++e) *(LAS unsigned short*)(lds + dl + (32 * i + crow(e, hh)) * RS + (32 * q + r) * 2) = cvt1(acc[q][e]); }
            }
            __syncthreads();
            { const int f = tid >> 6, i = f >> 2, q = (f >> 1) & 1, s = f & 1, r2 = lane & 31, h2 = lane >> 5; const int off = (32 * i + r2) * RS + (32 * q + 16 * s + 4 * h2) * 2;
                const u32x2 m0 = *(const LAS u32x2*)(lds + L_MST + off), m1 = *(const LAS u32x2*)(lds + L_MST + off + 16);
                const u32x2 g0 = *(const LAS u32x2*)(lds + L_GST + off), g1 = *(const LAS u32x2*)(lds + L_GST + off + 16);
                *(u32x4*)(MT + (size_t)u * 4096 + tid * 8) = (u32x4){m0.x, m0.y, m1.x, m1.y};
                *(u32x4*)(GG + (size_t)u * 4096 + tid * 8) = (u32x4){g0.x, g0.y, g1.x, g1.y}; }
            __syncthreads();
        }
        { float* CA = (float*)(ws + WS_CA); float* CH = (float*)(ws + WS_CH); const unsigned* UC2 = (const unsigned*)(ws + WS_UC); const unsigned* GT2 = (const unsigned*)(ws + WS_GATES);
            unsigned* LB2 = (unsigned*)LB; unsigned* LA2 = (unsigned*)LA;
            for (int bc = bid; bc < BATCH * 64; bc += G) { const size_t tok0 = (size_t)(bc >> 6) * SEQ + (bc & 63) * 64;
                float h[2] = {0.f, 0.f}, A[2] = {1.f, 1.f}, br[2], bi[2], sp[2];
#pragma unroll
                for (int cc = 0; cc < 2; ++cc) { const int c = 2 * tid + cc; br[cc] = args.in[I_BRG][c]; bi[cc] = args.in[I_BIG][c]; const float lam = args.in[I_LAMBDA][c];
                    sp[cc] = lam > 15.f ? __expf(-lam) : log1pf(__expf(-lam)); }
                unsigned gr[8], gi[8], uc[8];
#define LRU_LOAD(t_) do { _Pragma("unroll") for (int j = 0; j < 8; ++j) { const size_t tk = tok0 + (t_) + j; \
                    gr[j] = GT2[tk * 1024 + tid]; gi[j] = GT2[tk * 1024 + 512 + tid]; uc[j] = UC2[tk * 512 + tid]; } } while (0)
                LRU_LOAD(0);
#pragma unroll 1
                for (int t = 0; t < 64; t += 8) {
                    unsigned hv[8], av[8];
#pragma unroll
                    for (int j = 0; j < 8; ++j) { float hh_[2], aa_[2];
#pragma unroll
                        for (int cc = 0; cc < 2; ++cc) { const float gR = cc ? bfhi(gr[j]) : bflo(gr[j]), gI = cc ? bfhi(gi[j]) : bflo(gi[j]), uu = cc ? bfhi(uc[j]) : bflo(uc[j]);
                            const float rg = sigmoidf_(gR + br[cc]), ig = sigmoidf_(gI + bi[cc]);
                            const float a = __expf(-8.f * rg * sp[cc]), bb = sqrtf(fmaxf(1.f - a * a, 0.f)) * (ig * uu);
                            h[cc] = a * h[cc] + bb; A[cc] *= a; hh_[cc] = h[cc]; aa_[cc] = A[cc]; }
                        hv[j] = cvt2(hh_[0], hh_[1]); av[j] = cvt2(aa_[0], aa_[1]); }
                    if (t + 8 < 64) LRU_LOAD(t + 8);
#pragma unroll
                    for (int j = 0; j < 8; ++j) { LB2[(tok0 + t + j) * 512 + tid] = hv[j]; LA2[(tok0 + t + j) * 512 + tid] = av[j]; }
                }
#undef LRU_LOAD
                *(f32x2*)(CA + (size_t)bc * LRU_W + 2 * tid) = (f32x2){A[0], A[1]}; *(f32x2*)(CH + (size_t)bc * LRU_W + 2 * tid) = (f32x2){h[0], h[1]}; } }
    }
    SEAM(4);

    if (IN(5)) REP(5) {
        LANE_TID();
        if (bid < BATCH * NHEAD) {
            const bf16_t* MT = (const bf16_t*)(ws + WS_MT); const float* NN = (const float*)(ws + WS_NN); bf16_t* XS = (bf16_t*)(ws + WS_XS);
            constexpr int SLOT = 16384, NCH = SEQ / 64;
            const int u0 = bid * NCH;
            if (wave >= 2) {
                const int lw = wave - 2;
#define R2_ISSUE(c_) do { if (lw < 4) { const int _u = u0 + (c_); const int _sl = ((c_) & 3) * SLOT; _Pragma("unroll") for (int _rd = 0; _rd < 4; ++_rd) { const int _k0 = _rd * 256 + lw * 64; \
                    const char* _src = (_k0 < 512) ? (const char*)MT + (size_t)_u * 8192 + (size_t)(_k0 + lane) * 16 : (const char*)NN + (size_t)_u * 8192 + (size_t)(_k0 - 512 + lane) * 16; \
                    __builtin_amdgcn_global_load_lds((const unsigned*)_src, (LAS unsigned*)(lds + _sl + _k0 * 16), 16, 0, 0); } } } while (0)
                R2_ISSUE(0); R2_ISSUE(1); R2_ISSUE(2);
                for (int c = 0; c < NCH; ++c) {
                    if (c < NCH - 2) asm volatile("s_waitcnt vmcnt(8)" ::: "memory"); else if (c == NCH - 2) asm volatile("s_waitcnt vmcnt(4)" ::: "memory"); else asm volatile("s_waitcnt vmcnt(0)" ::: "memory");
                    __builtin_amdgcn_s_barrier();
                    asm volatile("" ::: "memory");
                    if (c + 3 < NCH) R2_ISSUE(c + 3);
                }
#undef R2_ISSUE
            } else {
                const int vh = wave;
                f32x16 X[2];
#pragma unroll
                for (int q = 0; q < 2; ++q)
#pragma unroll
                    for (int e = 0; e < 16; ++e) X[q][e] = 0.f;
                for (int c = 0; c < NCH; ++c) {
                    bf16x8 xb[2][2];
#pragma unroll
                    for (int q = 0; q < 2; ++q)
#pragma unroll
                        for (int s = 0; s < 2; ++s) { const u32x4 p = {cvt2(X[q][8 * s], X[q][8 * s + 1]), cvt2(X[q][8 * s + 2], X[q][8 * s + 3]), cvt2(X[q][8 * s + 4], X[q][8 * s + 5]), cvt2(X[q][8 * s + 6], X[q][8 * s + 7])};
                            xb[q][s] = __builtin_bit_cast(bf16x8, p);
                            *(u32x4*)(XS + (size_t)(u0 + c) * 4096 + (((vh * 2 + q) * 2 + s) * 64 + lane) * 8) = p; }
                    asm volatile("" ::: "memory");
                    __builtin_amdgcn_s_barrier();
                    asm volatile("" ::: "memory");
                    const LAS unsigned char* sl = lds + (c & 3) * SLOT;
#pragma unroll
                    for (int i = 0; i < 2; ++i) { f32x16 nx;
#pragma unroll
                        for (int e = 0; e < 16; e += 2) { const unsigned w_ = ((const LAS unsigned*)(sl + 8192))[((i * 2 + vh) * 8 + (e >> 1)) * 64 + lane]; nx[e] = bflo(w_); nx[e + 1] = bfhi(w_); }
#pragma unroll
                        for (int q = 0; q < 2; ++q)
#pragma unroll
                            for (int s = 0; s < 2; ++s) { const bf16x8 a = *(const LAS bf16x8*)(sl + ((i * 2 + q) * 2 + s) * 1024 + lane * 16); nx = MFMA32(a, xb[q][s], nx); }
                        X[i] = nx; }
                    asm volatile("s_waitcnt lgkmcnt(0)" ::: "memory");
                }
            }
        } else if (bid >= BATCH * NHEAD + 8) {
            const int nb_ = G - (BATCH * NHEAD + 8);
            for (int it = CV_NITEMS - CV_SHADOW + (bid - (BATCH * NHEAD + 8)) * NWAVES + wave; it < CV_NITEMS; it += nb_ * NWAVES) CONVERT_ITEM(it);
        } else {
            const float* CA = (const float*)(ws + WS_CA); const float* CH = (const float*)(ws + WS_CH); float* CIN = (float*)(ws + WS_CIN);
            const int i = (bid - BATCH * NHEAD) * NTHREADS + tid, b = i >> 10, c = i & 1023; float s = 0.f;
            for (int ch = 0; ch < 64; ch += 8) { float a[8], hh_[8];
#pragma unroll
                for (int j = 0; j < 8; ++j) { a[j] = CA[(size_t)(b * 64 + ch + j) * LRU_W + c]; hh_[j] = CH[(size_t)(b * 64 + ch + j) * LRU_W + c]; }
#pragma unroll
                for (int j = 0; j < 8; ++j) { CIN[(size_t)(b * 64 + ch + j) * LRU_W + c] = s; s = a[j] * s + hh_[j]; } }
        }
    }
    SEAM(5);

    if (IN(6)) REP(6) {
        LANE_TID();
        { const float* CIN = (const float*)(ws + WS_CIN);
            for (int idx = gt; idx < M * (LRU_W / 8); idx += NGT) { const int m = idx >> 7, c = (idx & 127) * 8; const size_t o = (size_t)m * LRU_W + c;
                const u32x4 gq = *(const u32x4*)(P + (size_t)m * NPP + LRU_W + c);
                const u32x4 hq = *(const u32x4*)((const bf16_t*)LB + o), aq = *(const u32x4*)((const bf16_t*)LA + o);
                const f32x4 h0 = {bflo(hq.x), bfhi(hq.x), bflo(hq.y), bfhi(hq.y)}, h1 = {bflo(hq.z), bfhi(hq.z), bflo(hq.w), bfhi(hq.w)}, a0 = {bflo(aq.x), bfhi(aq.x), bflo(aq.y), bfhi(aq.y)}, a1 = {bflo(aq.z), bfhi(aq.z), bflo(aq.w), bfhi(aq.w)};
                const f32x4 c0 = *(const f32x4*)(CIN + (size_t)(m >> 6) * LRU_W + c), c1 = *(const f32x4*)(CIN + (size_t)(m >> 6) * LRU_W + c + 4);
                const unsigned gw_[4] = {gq.x, gq.y, gq.z, gq.w}; float o8[8];
#pragma unroll
                for (int e = 0; e < 4; ++e) { const float hA = (e < 2 ? h0[2 * e] : h1[2 * e - 4]) + (e < 2 ? a0[2 * e] : a1[2 * e - 4]) * (e < 2 ? c0[2 * e] : c1[2 * e - 4]);
                    const float hB = (e < 2 ? h0[2 * e + 1] : h1[2 * e - 3]) + (e < 2 ? a0[2 * e + 1] : a1[2 * e - 3]) * (e < 2 ? c0[2 * e + 1] : c1[2 * e - 3]);
                    o8[2 * e] = hA * gelu_tanh(bflo(gw_[e])); o8[2 * e + 1] = hB * gelu_tanh(bfhi(gw_[e])); }
                *(u32x4*)(CAT + (size_t)m * D + c) = (u32x4){cvt2(o8[0], o8[1]), cvt2(o8[2], o8[3]), cvt2(o8[4], o8[5]), cvt2(o8[6], o8[7])}; } }
        const bf16_t* GG = (const bf16_t*)(ws + WS_GG); const bf16_t* XS = (const bf16_t*)(ws + WS_XS); const float* HH = (const float*)(ws + WS_HH);
        const bf16_t* V16 = (const bf16_t*)(ws + WS_V16); const bf16_t* G16 = (const bf16_t*)(ws + WS_G16);
        const float* gng = args.in[I_GNG]; const float* gnb = args.in[I_GNB];
        const int r = lane & 31, hh = lane >> 5;
        constexpr int YS = 68;
        LAS float* yt = (LAS float*)(lds + wave * (64 * YS * 4));
        for (int u = gw; u < NUNIT; u += NGW) {
            const int cch = u & 63, head = (u >> 6) & 15, b = u >> 10; const size_t tok0 = (size_t)b * SEQ + cch * 64;
            f32x16 acc[2][2];
#pragma unroll
            for (int i = 0; i < 2; ++i)
#pragma unroll
                for (int vh = 0; vh < 2; ++vh)
#pragma unroll
                    for (int e = 0; e < 16; e += 2) { const unsigned w_ = ((const unsigned*)HH)[(size_t)u * 2048 + ((i * 2 + vh) * 8 + (e >> 1)) * 64 + lane]; acc[i][vh][e] = bflo(w_); acc[i][vh][e + 1] = bfhi(w_); }
#pragma unroll
            for (int q = 0; q < 2; ++q)
#pragma unroll
                for (int s = 0; s < 2; ++s) { bf16x8 xb[2], ga[2];
#pragma unroll
                    for (int vh = 0; vh < 2; ++vh) xb[vh] = *(const bf16x8*)(XS + (size_t)u * 4096 + (((vh * 2 + q) * 2 + s) * 64 + lane) * 8);
#pragma unroll
                    for (int i = 0; i < 2; ++i) ga[i] = *(const bf16x8*)(GG + (size_t)u * 4096 + (((i * 2 + q) * 2 + s) * 64 + lane) * 8);
#pragma unroll
                    for (int i = 0; i < 2; ++i)
#pragma unroll
                        for (int vh = 0; vh < 2; ++vh) acc[i][vh] = MFMA32(ga[i], xb[vh], acc[i][vh]); }
#pragma unroll
            for (int i = 0; i < 2; ++i)
#pragma unroll
                for (int e = 0; e < 16; ++e) {
                    const float s1 = half_sum(acc[i][0][e] + acc[i][1][e], hh);
                    const float mean = s1 * (1.f / 64.f);
                    const float d0 = acc[i][0][e] - mean, d1 = acc[i][1][e] - mean; const float s2 = half_sum(d0 * d0 + d1 * d1, hh);
                    const float rstd = __builtin_amdgcn_rsqf(s2 * (1.f / 64.f) + GN_EPS);
                    const int t = 32 * i + crow(e, hh);
                    yt[t * YS + r] = d0 * rstd; yt[t * YS + 32 + r] = d1 * rstd; }
            asm volatile("s_waitcnt lgkmcnt(0)" ::: "memory");
            { const int tq = lane >> 3, c8 = (lane & 7) * 8, ch = head * HS + c8;
                const f32x4 g0 = *(const f32x4*)(gng + ch), g1 = *(const f32x4*)(gng + ch + 4), b0 = *(const f32x4*)(gnb + ch), b1 = *(const f32x4*)(gnb + ch + 4);
#pragma unroll 2
                for (int k = 0; k < 8; ++k) { const int t = tq + 8 * k; const size_t tok = tok0 + t; const size_t o = tok * RW_W + ch;
                    const f32x4 y0 = *(const LAS f32x4*)(yt + t * YS + c8), y1 = *(const LAS f32x4*)(yt + t * YS + c8 + 4);
                    const u32x4 vq = *(const u32x4*)(V16 + o), gq = *(const u32x4*)(G16 + o); const float bon = BON[tok * NHEAD + head];
                    const unsigned vw[4] = {vq.x, vq.y, vq.z, vq.w}, gw4[4] = {gq.x, gq.y, gq.z, gq.w}; float o8[8];
#pragma unroll
                    for (int e = 0; e < 4; ++e) { const float ya = (e < 2 ? y0[2 * e] : y1[2 * e - 4]), yb = (e < 2 ? y0[2 * e + 1] : y1[2 * e - 3]);
                        const float ga_ = (e < 2 ? g0[2 * e] : g1[2 * e - 4]), gb_ = (e < 2 ? g0[2 * e + 1] : g1[2 * e - 3]), ba_ = (e < 2 ? b0[2 * e] : b1[2 * e - 4]), bb_ = (e < 2 ? b0[2 * e + 1] : b1[2 * e - 3]);
                        o8[2 * e] = (ya * ga_ + ba_ + bon * bflo(vw[e])) * bflo(gw4[e]); o8[2 * e + 1] = (yb * gb_ + bb_ + bon * bfhi(vw[e])) * bfhi(gw4[e]); }
                    *(u32x4*)(CAT + tok * D + LRU_W + ch) = (u32x4){cvt2(o8[0], o8[1]), cvt2(o8[2], o8[3]), cvt2(o8[4], o8[5]), cvt2(o8[6], o8[7])}; } }
            asm volatile("s_waitcnt lgkmcnt(0)" ::: "memory");
        }
    }
    SEAM(6);

    if (IN(7)) REP(7) {
        LANE_TID();
        pg8::StaticOrder S; S.init(M, D, G, bid);
        pg8::EpiResF32 E{Z, XN, DN_ALPHA};
        pg8::gemm_phase<pg8::EpiResF32, pg8::StaticOrder, pg8::DenseRows, true>(lds, CAT, WoT, S, E, pg8::DenseRows{}, wave);
    }
    SEAM(7);

    if (IN(8)) {
        LANE_TID();
        constexpr int RSH = 4112;
        constexpr int L_LO = 16 * RSH, L_PART = 2 * 16 * RSH, L_LGT = L_PART + 16384;
        const float* g1 = args.in[I_LN1G]; const float* b1 = args.in[I_LN1B]; const float* br_ = args.in[I_BROUTER];
        const bf16_t* WRH = (const bf16_t*)(ws + WS_WRT); const bf16_t* WRL = WRH + NE * D;
        for (int tile = bid; tile < M / 16; tile += G) {
            const int t0 = tile * 16;
            __syncthreads();
#pragma unroll 1
            for (int rr = 0; rr < 2; ++rr) { const int tb = wave * 2 + rr, m = t0 + tb;
                const f32x4* zr = (const f32x4*)(Z + (size_t)m * D) + lane;
                f32x4 v[8]; float s = 0.f;
#pragma unroll
                for (int j = 0; j < 8; ++j) { v[j] = zr[64 * j]; s += (v[j][0] + v[j][1]) + (v[j][2] + v[j][3]); }
                const float mean = wave_sum(s) * (1.f / D); float s2 = 0.f;
#pragma unroll
                for (int j = 0; j < 8; ++j) { v[j] = v[j] - mean; s2 += (v[j][0] * v[j][0] + v[j][1] * v[j][1]) + (v[j][2] * v[j][2] + v[j][3] * v[j][3]); }
                const float rstd = __builtin_amdgcn_rsqf(wave_sum(s2) * (1.f / D) + LN_EPS);
                u32x2* ho = (u32x2*)((bf16_t*)H1 + (size_t)m * D) + lane; unsigned* hb = (unsigned*)(H1F + (size_t)m * D) + lane;
#pragma unroll
                for (int j = 0; j < 8; ++j) { const f32x4 g4 = ((const f32x4*)g1)[64 * j + lane], b4 = ((const f32x4*)b1)[64 * j + lane]; const f32x4 y = v[j] * rstd * g4 + b4;
                    const u32x2 hi = {cvt2(y[0], y[1]), cvt2(y[2], y[3])};
                    const u32x2 lo = {cvt2(y[0] - bflo(hi.x), y[1] - bfhi(hi.x)), cvt2(y[2] - bflo(hi.y), y[3] - bfhi(hi.y))};
                    ho[64 * j] = hi; hb[64 * j] = pk4_f8(y[0] * F8_SH, y[1] * F8_SH, y[2] * F8_SH, y[3] * F8_SH);
                    *(LAS u32x2*)(lds + tb * RSH + 512 * j + 8 * lane) = hi; *(LAS u32x2*)(lds + L_LO + tb * RSH + 512 * j + 8 * lane) = lo; } }
            __syncthreads();
            { const int c16 = lane & 15, q4 = lane >> 4; f32x4 acc[2] = {{0.f, 0.f, 0.f, 0.f}, {0.f, 0.f, 0.f, 0.f}};
#pragma unroll 2
                for (int kk = 0; kk < 8; ++kk) { const int k0 = 32 * (8 * wave + kk) + 8 * q4;
                    const bf16x8 hh = *(const LAS bf16x8*)(lds + c16 * RSH + k0 * 2), hl = *(const LAS bf16x8*)(lds + L_LO + c16 * RSH + k0 * 2);
#pragma unroll
                    for (int hf = 0; hf < 2; ++hf) { const bf16x8 wh = *(const bf16x8*)(WRH + (size_t)(hf * 16 + c16) * D + k0), wl = *(const bf16x8*)(WRL + (size_t)(hf * 16 + c16) * D + k0);
                        acc[hf] = __builtin_amdgcn_mfma_f32_16x16x32_bf16(wh, hh, acc[hf], 0, 0, 0);
                        acc[hf] = __builtin_amdgcn_mfma_f32_16x16x32_bf16(wl, hh, acc[hf], 0, 0, 0);
                        acc[hf] = __builtin_amdgcn_mfma_f32_16x16x32_bf16(wh, hl, acc[hf], 0, 0, 0); } }
#pragma unroll
                for (int hf = 0; hf < 2; ++hf)
#pragma unroll
                    for (int g = 0; g < 4; ++g) ((LAS float*)(lds + L_PART))[((wave * 2 + hf) * 4 + g) * 64 + lane] = acc[hf][g]; }
            __syncthreads();
            { const int tk = tid & 15, e = tid >> 4, hf = e >> 4, el = e & 15; float sacc = br_[e];
#pragma unroll
                for (int w = 0; w < 8; ++w) sacc += ((const LAS float*)(lds + L_PART))[((w * 2 + hf) * 4 + (el & 3)) * 64 + tk + 16 * (el >> 2)];
                ((LAS float*)(lds + L_LGT))[tk * 32 + e] = sacc; }
            __syncthreads();
            if (tid < 16) { const int m = t0 + tid; float bv[4]; int bi[4]; unsigned used = 0u; const LAS float* lgt = (const LAS float*)(lds + L_LGT);
#pragma unroll 1
                for (int k = 0; k < 4; ++k) { float best = -3.0e38f; int be = 0;
                    for (int e = 0; e < NE; ++e) { const float x = lgt[tid * 32 + e]; if (!((used >> e) & 1u) && x > best) { best = x; be = e; } }
                    used |= 1u << be; bv[k] = best; bi[k] = be; }
                float ex[4], den = 0.f;
#pragma unroll
                for (int k = 0; k < 4; ++k) { ex[k] = __expf(bv[k] - bv[0]); den += ex[k]; }
#pragma unroll 1
                for (int k = 0; k < 4; ++k) { const int pos = (int)__hip_atomic_fetch_add(ctl + CW_CNT + 64 * bi[k], 1u, RLX_AGENT);
                    TOPE[m * 4 + k] = bi[k]; TOPP[m * 4 + k] = pos; TOPG[m * 4 + k] = ex[k] / den; } }
        }
    }
    SEAM(8);

    if (IN(9)) REP(9) {
        LANE_TID();
        volatile LAS int* tb = (volatile LAS int*)(MISC + 16);
        moe_tables(tb, ctl, wave);
        for (int i = gt; i < M * TOPK; i += NGT) { const int e = TOPE[i], slot = tb[1 + e] * 256 + TOPP[i];
            SLOTTOK[slot] = i >> 2; SLOTG[slot] = TOPG[i]; TOKSLOT[i] = slot; }
        if (bid < NE) { const int e = bid, c = (int)__hip_atomic_load(ctl + CW_CNT + 64 * e, RLX_AGENT), s0 = tb[1 + e] * 256 + c, s1 = tb[2 + e] * 256;
            for (int s = s0 + tid; s < s1; s += NTHREADS) { SLOTTOK[s] = 0; SLOTG[s] = 0.f; } }
    }
    SEAM(9);

    if (IN(10)) REP(10) {
        LANE_TID();
        volatile LAS int* tb = (volatile LAS int*)(MISC + 16);
        moe_tables(tb, ctl, wave);
        pg8::MoeOrder S{(const LAS int*)(tb + 64), tb[0], 16, G, bid, KD / 128};
        pg8::EpiSwiglu E{ACT, args.in[I_BE1]};
        pg8::gemm_phase<pg8::EpiSwiglu, pg8::MoeOrder, pg8::GatherRows, true, KD / 2, KD / 2, true>(lds, (const bf16_t*)H1F, (const bf16_t*)W1F, S, E, pg8::GatherRows{SLOTTOK}, wave);
    }
    SEAM(10);

    if (IN(11)) REP(11) {
        LANE_TID();
        volatile LAS int* tb = (volatile LAS int*)(MISC + 16);
        moe_tables(tb, ctl, wave);
        pg8::MoeOrder S{(const LAS int*)(tb + 64), tb[0], 8, G, bid, KD / 128};
        pg8::EpiMoeOut E{OUTS, args.in[I_BE2], SLOTG};
        pg8::gemm_phase<pg8::EpiMoeOut, pg8::MoeOrder, pg8::DenseRows, true, KD / 2, KD / 2, true>(lds, (const bf16_t*)ACT, (const bf16_t*)W2F, S, E, pg8::DenseRows{}, wave);
    }
    SEAM(11);

    if (IN(12)) REP(12) {
        LANE_TID();
        const float* g2 = args.in[I_LN2G]; const float* b2 = args.in[I_LN2B];
        for (int m = gw; m < M; m += NGW) {
            const u32x2* hr = (const u32x2*)((const bf16_t*)H1 + (size_t)m * D) + lane;
            const int s0 = TOKSLOT[m * 4], s1 = TOKSLOT[m * 4 + 1], s2_ = TOKSLOT[m * 4 + 2], s3 = TOKSLOT[m * 4 + 3];
            const u32x2* o0 = (const u32x2*)(OUTS + (size_t)s0 * D) + lane; const u32x2* o1 = (const u32x2*)(OUTS + (size_t)s1 * D) + lane;
            const u32x2* o2 = (const u32x2*)(OUTS + (size_t)s2_ * D) + lane; const u32x2* o3 = (const u32x2*)(OUTS + (size_t)s3 * D) + lane;
            f32x4 v[8]; float s = 0.f;
#pragma unroll
            for (int j = 0; j < 8; ++j) { const u32x2 hq = hr[64 * j]; const f32x4 h4 = {bflo(hq.x), bfhi(hq.x), bflo(hq.y), bfhi(hq.y)}; const u32x2 a = o0[64 * j], b = o1[64 * j], c = o2[64 * j], d = o3[64 * j];
                f32x4 mo; mo[0] = (bflo(a.x) + bflo(b.x)) + (bflo(c.x) + bflo(d.x)); mo[1] = (bfhi(a.x) + bfhi(b.x)) + (bfhi(c.x) + bfhi(d.x));
                mo[2] = (bflo(a.y) + bflo(b.y)) + (bflo(c.y) + bflo(d.y)); mo[3] = (bfhi(a.y) + bfhi(b.y)) + (bfhi(c.y) + bfhi(d.y));
                v[j] = h4 * DN_ALPHA + mo; s += (v[j][0] + v[j][1]) + (v[j][2] + v[j][3]); }
            const float mean = wave_sum(s) * (1.f / D); float q2 = 0.f;
#pragma unroll
            for (int j = 0; j < 8; ++j) { v[j] = v[j] - mean; q2 += (v[j][0] * v[j][0] + v[j][1] * v[j][1]) + (v[j][2] * v[j][2] + v[j][3] * v[j][3]); }
            const float rstd = 1.f / sqrtf(wave_sum(q2) * (1.f / D) + LN_EPS);
            f32x4* orow = (f32x4*)(args.out + (size_t)m * D) + lane;
#pragma unroll
            for (int j = 0; j < 8; ++j) { const f32x4 g4 = ((const f32x4*)g2)[64 * j + lane], b4 = ((const f32x4*)b2)[64 * j + lane]; orow[64 * j] = v[j] * rstd * g4 + b4; }
        }
    }
    if (PROBE_PHASE >= 0) { if (PROBE_PHASE == NPHASE - 1) tprobe1 = __builtin_amdgcn_s_memrealtime();
        asm volatile("s_waitcnt vmcnt(0)" ::: "memory"); __syncthreads();
        if (bid == 0 && wave == 0 && lane_now() == 0) args.out[0] += 1.0f + (float)(tprobe1 - tprobe0) * 1e-4f; }
#undef IN
#undef SEAM
}

#ifndef MK_ONE_LAUNCH
#define MK_ONE_LAUNCH 1
#endif
extern "C" void kernel_launch(void* const* d_in, const int* in_sizes, int n_in, void* d_out, int out_size, void* d_ws, size_t ws_size, hipStream_t stream) {
    static int grid = 0;
    if (grid == 0) {
        if (n_in != 33 || out_size != M * D || ws_size < WS_END) { fprintf(stderr, "kernel_launch: unexpected sizes n_in %d out %d ws %zu (need %zu)\n", n_in, out_size, ws_size, (size_t)WS_END); grid = -1; return; }
        int dev = 0, cus = 0, per_cu = 0;
        if (hipGetDevice(&dev) != hipSuccess || hipDeviceGetAttribute(&cus, hipDeviceAttributeMultiprocessorCount, dev) != hipSuccess) { grid = -1; return; }
        if (hipFuncSetAttribute((const void*)fwd, hipFuncAttributeMaxDynamicSharedMemorySize, LDS_BYTES) != hipSuccess) { fprintf(stderr, "kernel_launch: hipFuncSetAttribute failed\n"); grid = -1; return; }
        if (hipOccupancyMaxActiveBlocksPerMultiprocessor(&per_cu, (const void*)fwd, NTHREADS, LDS_BYTES) != hipSuccess || per_cu < 1) fprintf(stderr, "kernel_launch: occupancy query says %d\n", per_cu);
        (void)hipGetLastError();
        grid = cus;
    }
    if (grid < 0) return;
    (void)hipMemsetAsync((char*)d_ws + WS_CTL, 0, CTL_ZERO_BYTES, stream);
    Args a{};
    for (int i = 0; i < 33; ++i) a.in[i] = (const float*)d_in[i];
    a.out = (float*)d_out; a.ws = (unsigned char*)d_ws;
#if MK_ONE_LAUNCH
    a.ph_lo = 0; a.ph_hi = NPHASE; a.use_bar = 1;
    hipLaunchKernelGGL(fwd, dim3(grid), dim3(NTHREADS), LDS_BYTES, stream, a);
#else
    for (int p = 0; p < NPHASE; ++p) { a.ph_lo = p; a.ph_hi = p + 1; a.use_bar = 0;
        hipLaunchKernelGGL(fwd, dim3(grid), dim3(NTHREADS), LDS_BYTES, stream, a); }
#endif
}
```

```cpp
#include <hip/hip_runtime.h>
#include <cstdio>
#include <cstdint>

#define LAS __attribute__((address_space(3)))
#define GAS __attribute__((address_space(1)))
typedef unsigned short bf16_t;
typedef short bf16x8 __attribute__((ext_vector_type(8)));
typedef float f32x4 __attribute__((ext_vector_type(4)));
typedef float f32x2 __attribute__((ext_vector_type(2)));
typedef unsigned u32x4 __attribute__((ext_vector_type(4)));
typedef unsigned u32x2 __attribute__((ext_vector_type(2)));
typedef float f32x16 __attribute__((ext_vector_type(16)));
typedef int i32x4 __attribute__((ext_vector_type(4)));
typedef int i32x8 __attribute__((ext_vector_type(8)));
typedef __bf16 bfv2 __attribute__((ext_vector_type(2)));
#define MFMA32(a, b, c) __builtin_amdgcn_mfma_f32_32x32x16_bf16((a), (b), (c), 0, 0, 0)

constexpr int BATCH = 4, SEQ = 4096, M = BATCH * SEQ, D = 2048;
constexpr int LRU_W = 1024, RW_W = 1024, NHEAD = 16, HS = 64;
constexpr int DLORA = 96, ALORA = 96, GLORA = 256;
constexpr int RW_SHIFT_W = 3 * RW_W + DLORA + ALORA + GLORA;
constexpr int NP = 2 * LRU_W + RW_SHIFT_W;
constexpr int NPP = 5632;
constexpr int NE = 32, TOPK = 4, DE = 2048;
constexpr int NSLOT_MAX = M * TOPK + NE * 256;
constexpr int NTILE_MAX = NSLOT_MAX / 256;
constexpr float LN_EPS = 1e-5f, GN_EPS = 64e-5f;
constexpr float DN_ALPHA = 1.189207115002721f;
constexpr int KD = 2048;
constexpr int LIST_CAP = M;

constexpr size_t MiB = 1u << 20;
constexpr size_t WS_CTL = 0, CTL_ZERO_BYTES = 1 * MiB;
constexpr size_t WS_WIN = 2 * MiB;
constexpr size_t WS_WO = WS_WIN + (size_t)NPP * KD * 2;
constexpr size_t WS_W1 = WS_WO + (size_t)D * KD * 2;
constexpr size_t WS_W2 = WS_W1 + (size_t)NE * 2 * DE * KD * 2;
constexpr size_t WS_XN = WS_W2 + (size_t)NE * D * DE * 2;
constexpr size_t WS_P = WS_XN + (size_t)M * D * 2;
constexpr size_t WS_LA = WS_P + (size_t)M * NPP * 2;
constexpr size_t WS_LB = WS_LA + (size_t)M * LRU_W * 4;
constexpr size_t WS_UC = WS_LB + (size_t)M * LRU_W * 4;
constexpr size_t WS_XL = WS_UC + (size_t)M * LRU_W * 2;
constexpr size_t WS_GATES = WS_XL + (size_t)M * 512 * 2;
constexpr size_t WS_LOUT = WS_GATES + (size_t)M * 2048 * 2;
constexpr size_t WS_V16 = WS_LOUT + (size_t)M * 3072 * 2;
constexpr size_t WS_G16 = WS_V16 + (size_t)M * RW_W * 2;
constexpr size_t WS_WG = WS_G16 + (size_t)M * RW_W * 2;
constexpr size_t WS_WL = WS_WG + (size_t)2048 * 256 * 2;
constexpr size_t WS_RY = WS_WL + (size_t)3072 * 256 * 2;
constexpr size_t WS_BON = WS_RY;
constexpr size_t WS_CAT = WS_BON + (size_t)M * NHEAD * 4;
constexpr size_t WS_Z = WS_CAT + (size_t)M * D * 2;
constexpr size_t WS_H1 = WS_Z + (size_t)M * D * 4;
constexpr size_t WS_H1B = WS_H1 + (size_t)M * D * 4;
constexpr size_t WS_TOPE = WS_H1B + (size_t)M * D * 2;
constexpr size_t WS_TOPP = WS_TOPE + (size_t)M * TOPK * 4;
constexpr size_t WS_TOPG = WS_TOPP + (size_t)M * TOPK * 4;
constexpr size_t WS_TOKSLOT = WS_TOPG + (size_t)M * TOPK * 4;
constexpr size_t WS_SLOTTOK = WS_TOKSLOT + (size_t)M * TOPK * 4;
constexpr size_t WS_SLOTG = WS_SLOTTOK + (size_t)NE * LIST_CAP * 4;
constexpr size_t WS_ACT = WS_SLOTG + (size_t)NE * LIST_CAP * 4;
constexpr size_t WS_OUTS = WS_ACT + (size_t)NSLOT_MAX * DE * 2;
constexpr int NUNIT = BATCH * NHEAD * (SEQ / 64);
constexpr size_t WS_MT = WS_OUTS + (size_t)NSLOT_MAX * D * 2;
constexpr size_t WS_GG = WS_MT + (size_t)NUNIT * 8192;
constexpr size_t WS_XS = WS_GG + (size_t)NUNIT * 8192;
constexpr size_t WS_NN = WS_XS + (size_t)NUNIT * 8192;
constexpr size_t WS_HH = WS_NN + (size_t)NUNIT * 16384;
constexpr size_t WS_CA = WS_HH + (size_t)NUNIT * 16384;
constexpr size_t WS_CH = WS_CA + (size_t)BATCH * 64 * LRU_W * 4;
constexpr size_t WS_CIN = WS_CH + (size_t)BATCH * 64 * LRU_W * 4;
constexpr size_t WS_XG = WS_CIN + (size_t)BATCH * 64 * LRU_W * 4;
constexpr size_t WS_WRT = WS_XG + (size_t)NSLOT_MAX * D;
constexpr size_t WS_END = WS_WRT + (size_t)2 * NE * D * 2;
constexpr int CW_CNT = 1024;
constexpr int CW_BAR = 4096;

constexpr int MISC_OFF = 159744;
constexpr int LDS_BYTES = 163840;

#define RLX_AGENT __ATOMIC_RELAXED, __HIP_MEMORY_SCOPE_AGENT
__device__ __forceinline__ unsigned f2bf(float f) { unsigned u = __builtin_bit_cast(unsigned, f); return (u + 0x7fffu + ((u >> 16) & 1u)) >> 16; }
__device__ __forceinline__ unsigned pk2(float lo, float hi) { return f2bf(lo) | (f2bf(hi) << 16); }
__device__ __forceinline__ float bf2f(unsigned short b) { return __builtin_bit_cast(float, (unsigned)b << 16); }
__device__ __forceinline__ float bflo(unsigned w) { return __builtin_bit_cast(float, w << 16); }
__device__ __forceinline__ float bfhi(unsigned w) { return __builtin_bit_cast(float, w & 0xffff0000u); }
__device__ __forceinline__ unsigned cvt2(float a, float b) { const f32x2 v = {a, b}; return __builtin_bit_cast(unsigned, __builtin_convertvector(v, bfv2)); }
__device__ __forceinline__ unsigned short cvt1(float a) { return (unsigned short)(cvt2(a, 0.f) & 0xffffu); }
constexpr float F8_SH = 4.f, F8_SW1 = 32.f, F8_SACT = 4.f, F8_SW2 = 64.f;
__device__ __forceinline__ float f8clamp(float x) { return fminf(fmaxf(x, -448.f), 448.f); }
__device__ __forceinline__ unsigned pk4_f8_bounded(float a, float b, float c, float d) { int w = 0; w = __builtin_amdgcn_cvt_pk_fp8_f32(a, b, w, false); w = __builtin_amdgcn_cvt_pk_fp8_f32(c, d, w, true); return (unsigned)w; }
__device__ __forceinline__ unsigned pk4_f8(float a, float b, float c, float d) { int w = 0; w = __builtin_amdgcn_cvt_pk_fp8_f32(f8clamp(a), f8clamp(b), w, false); w = __builtin_amdgcn_cvt_pk_fp8_f32(f8clamp(c), f8clamp(d), w, true); return (unsigned)w; }
__device__ __forceinline__ int lane_now() { int l; asm volatile("v_mbcnt_lo_u32_b32 %0, -1, 0\n\tv_mbcnt_hi_u32_b32 %0, -1, %0" : "=v"(l)); return l; }
__device__ __forceinline__ int crow(int reg, int h) { return (reg & 3) + 8 * (reg >> 2) + 4 * h; }
__device__ __forceinline__ float row_sum16(float v) {
    v += __builtin_bit_cast(float, __builtin_amdgcn_update_dpp(0, __builtin_bit_cast(int, v), 0xB1, 0xf, 0xf, false));
    v += __builtin_bit_cast(float, __builtin_amdgcn_update_dpp(0, __builtin_bit_cast(int, v), 0x4E, 0xf, 0xf, false));
    v += __builtin_bit_cast(float, __builtin_amdgcn_update_dpp(0, __builtin_bit_cast(int, v), 0x141, 0xf, 0xf, false));
    v += __builtin_bit_cast(float, __builtin_amdgcn_update_dpp(0, __builtin_bit_cast(int, v), 0x140, 0xf, 0xf, false));
    return v;
}
__device__ __forceinline__ float rdlane(float v, int l) { return __builtin_bit_cast(float, __builtin_amdgcn_readlane(__builtin_bit_cast(int, v), l)); }
__device__ __forceinline__ float wave_sum(float v) { v = row_sum16(v); return (rdlane(v, 0) + rdlane(v, 16)) + (rdlane(v, 32) + rdlane(v, 48)); }
__device__ __forceinline__ float half_sum(float v, int hh) { v = row_sum16(v); const float lo = rdlane(v, 0) + rdlane(v, 16), hi = rdlane(v, 32) + rdlane(v, 48); return hh ? hi : lo; }
__device__ __forceinline__ float sigmoidf_(float x) { return __builtin_amdgcn_rcpf(1.f + __expf(-x)); }
__device__ __forceinline__ float gelu_tanh(float x) { const float u = 0.7978845608028654f * (x + 0.044715f * x * x * x); return x * __builtin_amdgcn_rcpf(1.f + __expf(-2.f * u)); }
__device__ __forceinline__ float tanh_fast(float x) { const float e = __expf(-2.f * fabsf(x)); const float t = (1.f - e) * __builtin_amdgcn_rcpf(1.f + e); return x < 0.f ? -t : t; }

#define XB_TMO      128
#define XB_XCNT(j)  (256  + 64 * (j))
#define XB_XSUB(j)  (1280 + 64 * (j))
#define XB_XGEN(j)  (2304 + 64 * (j))
#define XB_TOP      3328
#define XB_TOPGEN   3392
#define XCD_BAR_WORDS 3456
#define XB_SPIN_CAP (1u << 18)
__device__ __forceinline__ unsigned xb_ld(unsigned* p)              { return __hip_atomic_load(p, __ATOMIC_RELAXED, __HIP_MEMORY_SCOPE_AGENT); }
__device__ __forceinline__ unsigned xb_add(unsigned* p, unsigned v) { return __hip_atomic_fetch_add(p, v, __ATOMIC_RELAXED, __HIP_MEMORY_SCOPE_AGENT); }
__device__ __forceinline__ unsigned xb_xcc_id() { return (unsigned)__builtin_amdgcn_s_getreg((3 << 11) | 20) & 0xFu; }
#define XB_SPIN(cond, bar) do { unsigned _sp = 0; while (cond) { __builtin_amdgcn_s_sleep(1); \
    if ((++_sp & 255u) == 0u) { if (xb_ld(&(bar)[XB_TMO])) break; if (_sp > XB_SPIN_CAP) { atomicAdd(&(bar)[XB_TMO], 1u); break; } } } } while (0)
struct XcdBarrier { unsigned* bar; unsigned x; volatile LAS unsigned* st; };
__device__ __forceinline__ XcdBarrier xcd_barrier_post(unsigned* bar, volatile LAS unsigned* st) {
    XcdBarrier b; b.bar = bar; b.x = xb_xcc_id(); b.st = st;
    if (__builtin_amdgcn_readfirstlane(threadIdx.x >> 6) == 0 && lane_now() == 0) (void)xb_add(&bar[XB_XCNT(b.x)], 1u);
    return b;
}
__device__ __forceinline__ void xcd_barrier_complete(unsigned* bar, unsigned x, unsigned& nloc, unsigned& nx) {
    const unsigned G = gridDim.x * gridDim.y * gridDim.z;
    unsigned sum, cnt, mine, sp = 0u;
    for (;;) {
        sum = 0u; cnt = 0u; mine = 0u;
#pragma unroll
        for (unsigned j = 0; j < 16; ++j) { const unsigned c = xb_ld(&bar[XB_XCNT(j)]); sum += c; cnt += (c > 0u) ? 1u : 0u; mine = (j == x) ? c : mine; }
        if (sum == G) break;
        __builtin_amdgcn_s_sleep(1);
        if ((++sp & 255u) == 0u) { if (xb_ld(&bar[XB_TMO])) break; if (sp > XB_SPIN_CAP) { atomicAdd(&bar[XB_TMO], 1u); break; } }
    }
    nloc = mine > 0u ? mine : 1u; nx = cnt > 0u ? cnt : 1u;
}
__device__ __forceinline__ void xcd_barrier(const XcdBarrier& b, int wave_id) {
    asm volatile("s_waitcnt vmcnt(0)" ::: "memory");
    __syncthreads();
    if (wave_id == 0 && lane_now() == 0) {
        unsigned* bar = b.bar;
        __builtin_amdgcn_s_waitcnt(0);
        unsigned nloc = b.st[0], nx = b.st[1];
        if (nloc == 0u) { xcd_barrier_complete(bar, b.x, nloc, nx); b.st[0] = nloc; b.st[1] = nx; }
        const unsigned old = xb_add(&bar[XB_XSUB(b.x)], 1u);
        const unsigned gen = old / nloc;
        if (old + 1u == (gen + 1u) * nloc) {
            __builtin_amdgcn_fence(__ATOMIC_RELEASE, "agent");
            asm volatile("s_waitcnt vmcnt(0)" ::: "memory");
            const unsigned og = xb_add(&bar[XB_TOP], 1u);
            const unsigned tg = og / nx;
            if (og + 1u == (tg + 1u) * nx) xb_add(&bar[XB_TOPGEN], 1u);
            else XB_SPIN(xb_ld(&bar[XB_TOPGEN]) == tg, bar);
            __builtin_amdgcn_fence(__ATOMIC_ACQUIRE, "agent");
            xb_add(&bar[XB_XGEN(b.x)], 1u);
            asm volatile("s_waitcnt vmcnt(0)" ::: "memory");
        } else {
            XB_SPIN(xb_ld(&bar[XB_XGEN(b.x)]) == gen, bar);
            __builtin_amdgcn_fence(__ATOMIC_ACQUIRE, "agent");
            asm volatile("s_waitcnt vmcnt(0)" ::: "memory");
        }
    }
    __syncthreads();
}

namespace pg8 {
constexpr int BM = 256, BK = 64, HALF = 128, HTB = HALF * BK * 2, STAGE_BYTES = 8 * HTB, NXCD = 8, WGM = 8;
__host__ __device__ __forceinline__ int lds_byte(int r, int c) { const int st = (r >> 4) * 2 + (c >> 5), rr = r & 15, cc = c & 31, ob = rr * 64 + cc * 2; return st * 1024 + (ob ^ (((ob >> 9) & 1) << 5)); }
__host__ __device__ __forceinline__ void stage_rc(int b, int& R, int& C) { const int st = b / 1024, sb = b % 1024, swz = sb ^ (((sb >> 9) & 1) << 5); R = (st >> 1) * 16 + swz / 64; C = (st & 1) * 32 + (swz % 64) / 2; }
__host__ __device__ __forceinline__ int perm32(int rho) { const int n = rho >> 4, i = rho & 15; return 8 * (i >> 2) + 4 * n + (i & 3); }
__host__ __device__ __forceinline__ int f8_g(int R) { return ((R >> 1) & 1) + 4 * ((R >> 3) & 1); }
__host__ __device__ __forceinline__ int f8_lds_byte(int R, int c) { return R * 128 + (((c + f8_g(R)) & 7) << 4); }
__host__ __device__ __forceinline__ void f8_stage_rc(int pos, int& R, int& Cb) { const int P = pos >> 4; R = P >> 3; Cb = (((P & 7) - f8_g(R)) & 7) << 4; }
struct Unit { int pm, pn, ak, nt, ab; };
__device__ __forceinline__ unsigned cvt_pk_bf16(float lo, float hi) { unsigned r; asm volatile("v_cvt_pk_bf16_f32 %0, %1, %2" : "=v"(r) : "v"(lo), "v"(hi)); return r; }

struct StaticOrder {
    int nM, nN, nwg, G, c, nt = KD / BK;
    __device__ void init(int M_, int N_, int G_, int c_) { nM = M_ / BM; nN = N_ / BM; nwg = nM * nN; G = G_; c = c_; }
    __device__ bool next(int i, Unit& u) const {
        const long L = (long)i * G + c; if (L >= nwg) return false;
        int wgid = (int)L; { const int q = nwg / NXCD, r = nwg % NXCD, xcd = wgid % NXCD, off = wgid / NXCD; wgid = (xcd < r ? xcd * (q + 1) : r * (q + 1) + (xcd - r) * q) + off; }
        const int nig = WGM * nN, gid = wgid / nig, fm = gid * WGM, gsz = (nM - fm) < WGM ? (nM - fm) : WGM;
        u.pm = fm + ((wgid % nig) % gsz); u.pn = (wgid % nig) / gsz; u.ak = 0; u.nt = nt; u.ab = u.pm * BM; return true;
    }
};
struct MoeOrder {
    const LAS int* tile_e; const LAS int* toff; int R, NCT, G, c, nt;
    __device__ bool next(int i, Unit& u) const {
        int rt, ct;
        if (G == 256) { const int x = c & 7, j = c >> 3;
            if (NCT == 16) { rt = 16 * i + (x >> 1) * 4 + (j >> 3); ct = (x & 1) * 8 + (j & 7); }
            else           { rt = 32 * i + 4 * x + (j >> 3); ct = j & 7; } }
        else { const long L = (long)i * G + c; rt = (int)(L / NCT); ct = (int)(L % NCT); }
        if (rt >= R) return false;
        { const int e_ = tile_e[rt]; u.pm = rt; u.pn = e_ * NCT + ct; u.ak = 0; u.nt = nt; u.ab = e_ * LIST_CAP + (rt - toff[e_]) * BM; } return true;
    }
};
template <int MODE> struct SmallOrder {
    int G, c;
    __device__ bool next(int i, Unit& u) const {
        constexpr int NCT = MODE == 0 ? 8 : 12;
        const int L = i * G + c; if (L >= (M / BM) * NCT) return false;
        u.pm = L / NCT; u.pn = L % NCT; u.ab = u.pm * BM;
        if (MODE == 0) { u.ak = 256 * (u.pn & 3); u.nt = 4; }
        else { u.ak = u.pn < 4 ? 0 : (u.pn < 8 ? 128 : 256); u.nt = u.pn < 8 ? 2 : 4; }
        return true;
    }
};
struct DenseRows { static constexpr bool DENSE = true; __device__ __forceinline__ const int* idxp() const { return nullptr; } __device__ __forceinline__ unsigned row(int pm, int r) const { return (unsigned)(pm * BM + r); } };
struct GatherRows { static constexpr bool DENSE = false; const int* idx; __device__ __forceinline__ const int* idxp() const { return idx; } __device__ __forceinline__ unsigned row(int pm, int r) const { return (unsigned)idx[pm * BM + r]; } };

struct EpiBf16 {
    static constexpr bool PERM = true; static constexpr int NSTORE = 16;
    bf16_t* O; int ldc;
    __device__ __forceinline__ void operator()(const f32x4 (&acc)[2][2][4][2], const Unit& u, int wr, int wc, int fr, int fq) const {
        const int row0 = u.pm * BM + wr * 64 + fr, col0 = u.pn * BM + wc * 32 + 8 * fq;
#pragma unroll
        for (int ai = 0; ai < 2; ++ai)
#pragma unroll
            for (int m = 0; m < 4; ++m) { bf16_t* rowp = O + (size_t)(row0 + ai * HALF + m * 16) * ldc + col0;
#pragma unroll
                for (int bj = 0; bj < 2; ++bj) { const f32x4 v0 = acc[ai][bj][m][0], v1 = acc[ai][bj][m][1];
                    u32x4 w; w.x = cvt_pk_bf16(v0[0], v0[1]); w.y = cvt_pk_bf16(v0[2], v0[3]); w.z = cvt_pk_bf16(v1[0], v1[1]); w.w = cvt_pk_bf16(v1[2], v1[3]);
                    *(u32x4*)(rowp + bj * HALF) = w; } }
    }
};
struct EpiResF32 {
    static constexpr bool PERM = false; static constexpr int NSTORE = 32;
    float* Z; const bf16_t* R; float alpha, sc;
    __device__ __forceinline__ void operator()(const f32x4 (&acc)[2][2][4][2], const Unit& u, int wr, int wc, int fr, int fq) const {
        const int row0 = u.pm * BM + wr * 64 + fr, col0 = u.pn * BM + wc * 32 + 4 * fq;
#pragma unroll
        for (int ai = 0; ai < 2; ++ai)
#pragma unroll
            for (int mp = 0; mp < 2; ++mp) {
                u32x2 rb[2][2][2];
#pragma unroll
                for (int m2 = 0; m2 < 2; ++m2)
#pragma unroll
                    for (int bj = 0; bj < 2; ++bj)
#pragma unroll
                        for (int n = 0; n < 2; ++n) rb[m2][bj][n] = *(const u32x2*)(R + (size_t)(row0 + ai * HALF + (2 * mp + m2) * 16) * D + col0 + bj * HALF + n * 16);
#pragma unroll
                for (int m2 = 0; m2 < 2; ++m2) { const int m = 2 * mp + m2; const size_t off = (size_t)(row0 + ai * HALF + m * 16) * D + col0;
#pragma unroll
                    for (int bj = 0; bj < 2; ++bj)
#pragma unroll
                        for (int n = 0; n < 2; ++n) { const u32x2 r2 = rb[m2][bj][n];
                            f32x4 o = acc[ai][bj][m][n] * sc; o[0] += alpha * bflo(r2.x); o[1] += alpha * bfhi(r2.x); o[2] += alpha * bflo(r2.y); o[3] += alpha * bfhi(r2.y);
                            *(f32x4*)(Z + off + bj * HALF + n * 16) = o; } } }
    }
};
typedef float f32x2 __attribute__((ext_vector_type(2)));
struct EpiSwiglu {
    static constexpr bool PERM = true; static constexpr int NSTORE = 8;
    unsigned char* O; const float* b1;
    __device__ __forceinline__ void operator()(const f32x4 (&acc)[2][2][4][2], const Unit& u, int wr, int wc, int fr, int fq) const {
        const int e = u.pn >> 4, ct = u.pn & 15;
        const int row0 = u.pm * BM + wr * 64 + fr, cin = wc * 32 + 8 * fq, col0 = ct * HALF + cin;
        const float* bg = b1 + (size_t)e * 2 * DE + col0; const float* bu = bg + DE;
        const f32x4 bg0 = *(const f32x4*)bg, bg1 = *(const f32x4*)(bg + 4), bu0 = *(const f32x4*)bu, bu1 = *(const f32x4*)(bu + 4);
        constexpr float inv = 1.f / (F8_SH * F8_SW1), invu = F8_SACT * inv, cexp = -1.702f * 1.44269504f;
        const f32x4 bu0s = (bu0 + 1.f) * (float)F8_SACT, bu1s = (bu1 + 1.f) * (float)F8_SACT;
#pragma unroll
        for (int ai = 0; ai < 2; ++ai)
#pragma unroll
            for (int m = 0; m < 4; ++m) { unsigned char* rowp = O + (size_t)(row0 + ai * HALF + m * 16) * DE + col0;
                float o[8];
#pragma unroll
                for (int n = 0; n < 2; ++n) { const f32x4 ga = acc[ai][0][m][n], ua = acc[ai][1][m][n], bgv = n ? bg1 : bg0, buv = n ? bu1s : bu0s;
#pragma unroll
                    for (int jp = 0; jp < 2; ++jp) {
                        f32x2 g = (f32x2){ga[2 * jp], ga[2 * jp + 1]} * inv + (f32x2){bgv[2 * jp], bgv[2 * jp + 1]};
                        f32x2 up = (f32x2){ua[2 * jp], ua[2 * jp + 1]} * invu + (f32x2){buv[2 * jp], buv[2 * jp + 1]};
                        g = (f32x2){fminf(g[0], 7.f), fminf(g[1], 7.f)};
                        up = (f32x2){__builtin_amdgcn_fmed3f(up[0], -6.f * F8_SACT, 8.f * F8_SACT), __builtin_amdgcn_fmed3f(up[1], -6.f * F8_SACT, 8.f * F8_SACT)};
                        const f32x2 t = g * cexp;
                        const f32x2 d = (f32x2){__builtin_amdgcn_exp2f(t[0]), __builtin_amdgcn_exp2f(t[1])} + 1.f;
                        const f32x2 r = (g * up) * (f32x2){__builtin_amdgcn_rcpf(d[0]), __builtin_amdgcn_rcpf(d[1])};
                        o[n * 4 + 2 * jp] = r[0]; o[n * 4 + 2 * jp + 1] = r[1]; } }
                *(u32x2*)rowp = (u32x2){pk4_f8_bounded(o[0], o[1], o[2], o[3]), pk4_f8_bounded(o[4], o[5], o[6], o[7])}; }
    }
};
struct EpiMoeOut {
    static constexpr bool PERM = true; static constexpr int NSTORE = 16;
    bf16_t* O; const float* b2; const float* sg;
    __device__ __forceinline__ void operator()(const f32x4 (&acc)[2][2][4][2], const Unit& u, int wr, int wc, int fr, int fq) const {
        const int e = u.pn >> 3, ct = u.pn & 7;
        const int row0 = u.pm * BM + wr * 64 + fr, col0 = ct * BM + wc * 32 + 8 * fq;
        f32x4 bv[2][2];
#pragma unroll
        for (int bj = 0; bj < 2; ++bj)
#pragma unroll
            for (int n = 0; n < 2; ++n) bv[bj][n] = *(const f32x4*)(b2 + (size_t)e * D + col0 + bj * HALF + 4 * n);
#pragma unroll
        for (int ai = 0; ai < 2; ++ai)
#pragma unroll
            for (int m = 0; m < 4; ++m) { const int row = row0 + ai * HALF + m * 16; bf16_t* rowp = O + (size_t)row * D + col0;
#pragma unroll
                for (int bj = 0; bj < 2; ++bj) { const f32x4 v0 = acc[ai][bj][m][0] * (1.f / (F8_SACT * F8_SW2)) + bv[bj][0], v1 = acc[ai][bj][m][1] * (1.f / (F8_SACT * F8_SW2)) + bv[bj][1];
                    u32x4 w; w.x = cvt_pk_bf16(v0[0], v0[1]); w.y = cvt_pk_bf16(v0[2], v0[3]); w.z = cvt_pk_bf16(v1[0], v1[1]); w.w = cvt_pk_bf16(v1[2], v1[3]);
                    *(u32x4*)(rowp + bj * HALF) = w; } }
    }
};

template <class Epi, class Sched, class ARows, bool ALIGN_EPI, int LDA = KD, int LDB = KD, bool F8 = false>
__device__ __forceinline__ void gemm_phase(LAS unsigned char* lds, const bf16_t* A, const bf16_t* Bt, const Sched& S, const Epi& E, const ARows& AR, const int wid) {
    const int lane = lane_now(), tid = wid * 64 + lane, wr = wid >> 2, wc = wid & 3, fr = lane & 15, fq = lane >> 4;
    int sR[2], sC[2]; unsigned voffB[2];
#pragma unroll
    for (int i = 0; i < 2; ++i) { if constexpr (F8) { int cb_; f8_stage_rc(tid * 16 + i * 8192, sR[i], cb_); sC[i] = cb_ >> 1; } else stage_rc(tid * 16 + i * 8192, sR[i], sC[i]); const int Rb = Epi::PERM ? ((sR[i] & ~31) + perm32(sR[i] & 31)) : sR[i];
        voffB[i] = (unsigned)(Rb * LDB + sC[i]) * 2u; }
    constexpr size_t kstep = (size_t)(BK * 2);
    constexpr size_t hstep = (size_t)HALF * LDB * 2;
    constexpr size_t tstep = 2 * hstep;
    const unsigned ldsw = (unsigned)wid * 1024u;
    int aoffs[2], boffs[2];
    if constexpr (F8) { aoffs[0] = f8_lds_byte(wr * 64 + fr, 2 * fq); aoffs[1] = f8_lds_byte(wr * 64 + fr, 2 * fq + 1); boffs[0] = 4 * HTB + f8_lds_byte(wc * 32 + fr, 2 * fq); boffs[1] = 4 * HTB + f8_lds_byte(wc * 32 + fr, 2 * fq + 1); }
    else { aoffs[0] = lds_byte(wr * 64 + fr, fq * 8); aoffs[1] = aoffs[0] + 1024; boffs[0] = 4 * HTB + lds_byte(wc * 32 + fr, fq * 8); boffs[1] = boffs[0] + 1024; }
#define PG8_SA(b, h) (((b) * 2 + (h)) * HTB)
#define PG8_SB(b, h) ((4 + (b) * 2 + (h)) * HTB)
#define PG8_SBR(b, h) (((b) * 2 + (h)) * HTB)
#define PG8_STAGE(bufoff, gbase, voff) do { const char* gb_ = (const char*)(gbase); _Pragma("unroll") for (int _i = 0; _i < 2; ++_i) { \
        asm volatile("s_mov_b32 m0, %2\n\ts_nop 0\n\tglobal_load_lds_dwordx4 %0, %1" : : "v"((voff)[_i]), "s"(gb_), "s"((unsigned)((bufoff) + ldsw + _i * 8192)) : "memory", "m0"); } } while (0)
#define PG8_LDA(dst, b, h) do { _Pragma("unroll") for (int m = 0; m < 4; ++m) { if constexpr (F8) { const i32x4 lo_ = *(const LAS i32x4*)(lds + PG8_SA(b, h) + aoffs[0] + m * 2048), hi_ = *(const LAS i32x4*)(lds + PG8_SA(b, h) + aoffs[1] + m * 2048); \
            dst##8[m] = __builtin_shufflevector(lo_, hi_, 0, 1, 2, 3, 4, 5, 6, 7); } else { _Pragma("unroll") for (int k = 0; k < 2; ++k) dst[m][k] = *(const LAS bf16x8*)(lds + PG8_SA(b, h) + aoffs[k] + m * 2048); } } } while (0)
#define PG8_LDB(dst, b, h) do { _Pragma("unroll") for (int n = 0; n < 2; ++n) { if constexpr (F8) { const i32x4 lo_ = *(const LAS i32x4*)(lds + PG8_SBR(b, h) + boffs[0] + n * 2048), hi_ = *(const LAS i32x4*)(lds + PG8_SBR(b, h) + boffs[1] + n * 2048); \
            dst##8[n] = __builtin_shufflevector(lo_, hi_, 0, 1, 2, 3, 4, 5, 6, 7); } else { _Pragma("unroll") for (int k = 0; k < 2; ++k) dst[n][k] = *(const LAS bf16x8*)(lds + PG8_SBR(b, h) + boffs[k] + n * 2048); } } } while (0)
#define PG8_MMA(ai, bj, At, Bt_) do { __builtin_amdgcn_s_setprio(1); _Pragma("unroll") for (int m = 0; m < 4; ++m) _Pragma("unroll") for (int n = 0; n < 2; ++n) { \
        if constexpr (F8) { acc[ai][bj][m][n] = __builtin_amdgcn_mfma_scale_f32_16x16x128_f8f6f4(Bt_##8[n], At##8[m], acc[ai][bj][m][n], 0, 0, 0, 0x7f7f7f7f, 0, 0x7f7f7f7f); } \
        else { _Pragma("unroll") for (int k = 0; k < 2; ++k) acc[ai][bj][m][n] = __builtin_amdgcn_mfma_f32_16x16x32_bf16(Bt_[n][k], At[m][k], acc[ai][bj][m][n], 0, 0, 0); } } __builtin_amdgcn_s_setprio(0); } while (0)
#define PG8_WAIT_V(n) asm volatile("s_waitcnt vmcnt(" #n ")" ::: "memory")
#define PG8_WAIT_VR(rx) asm volatile("s_cmp_eq_u32 %0, 0\n\ts_cbranch_scc1 1f\n\ts_waitcnt vmcnt(8)\n1:\n\ts_waitcnt vmcnt(%1)" : : "s"(rx), "n"(8 + Epi::NSTORE) : "scc", "memory")
#define PG8_WAIT_L(n) asm volatile("s_waitcnt lgkmcnt(" #n ")" ::: "memory")
#define PG8_BAR __builtin_amdgcn_s_barrier()
#define PG8_SCHED __builtin_amdgcn_sched_barrier(0)
#define PG8_AOFF(dst, u) do { const int tq_ = wid * 64 + lane_now(); _Pragma("unroll") for (int _i = 0; _i < 2; ++_i) { int R_, C_; if constexpr (F8) { int cb_; f8_stage_rc(tq_ * 16 + _i * 8192, R_, cb_); C_ = cb_ >> 1; } else stage_rc(tq_ * 16 + _i * 8192, R_, C_); \
        _Pragma("unroll") for (int _h = 0; _h < 2; ++_h) { \
        if constexpr (ARows::DENSE) dst[_h][_i] = (unsigned)(R_ * LDA + C_) * 2u; \
        else dst[_h][_i] = (AR.row((u).pm, _h * HALF + R_) * (unsigned)LDA + (unsigned)((u).ak + C_)) * 2u; } } } while (0)
#define PG8_ABASE(u) (ARows::DENSE ? (const char*)A + ((size_t)(u).pm * BM * LDA + (u).ak) * 2 : (const char*)A)
    constexpr size_t ahstep = ARows::DENSE ? (size_t)HALF * LDA * 2 : 0;
    Unit cur, nxt; int ui = 0;
    if (!S.next(0, cur)) return;
    f32x4 acc[2][2][4][2];
#pragma unroll
    for (int a = 0; a < 2; ++a)
#pragma unroll
        for (int b = 0; b < 2; ++b)
#pragma unroll
            for (int m = 0; m < 4; ++m)
#pragma unroll
                for (int n = 0; n < 2; ++n) acc[a][b][m][n] = (f32x4){0.f, 0.f, 0.f, 0.f};
    bf16x8 At[4][2], B0[2][2], B1[2][2]; i32x8 At8[4], B08[2], B18[2];
    unsigned ao[2][2];
    if constexpr (ARows::DENSE) { PG8_AOFF(ao, cur); } else { ao[0][0] = ao[0][1] = ao[1][0] = ao[1][1] = 0u; }
    unsigned gpk = 0u;
    if constexpr (!ARows::DENSE && F8) { int r_, cb_; f8_stage_rc(tid * 16, r_, cb_); gpk = (unsigned)(r_ * 4) | ((unsigned)cb_ << 16); asm volatile("" : "+v"(gpk)); }
    constexpr int TBL = 131072;
#define PG8_STAGE_A(bufoff, base, h_, slot_) do { if constexpr (ARows::DENSE) { PG8_STAGE(bufoff, (base) + ((h_) ? ahstep : (size_t)0), ao[0]); } else { \
        unsigned go_[2]; if constexpr (F8) { const LAS unsigned* tp_ = (const LAS unsigned*)(lds + TBL + (slot_) * 1024 + (h_) * HALF * 4 + (gpk & 0xffffu)); const unsigned cb_ = gpk >> 16; \
            go_[0] = tp_[0] * (unsigned)(2 * LDA) + cb_; go_[1] = tp_[64] * (unsigned)(2 * LDA) + cb_; }     \
        else { const int tq_ = wid * 64 + lane_now(); _Pragma("unroll") for (int _i = 0; _i < 2; ++_i) { int R_, C_; stage_rc(tq_ * 16 + _i * 8192, R_, C_); \
            const unsigned row_ = *(const LAS unsigned*)(lds + TBL + (slot_) * 1024 + ((h_) * HALF + R_) * 4); go_[_i] = (row_ * (unsigned)LDA + (unsigned)C_) * 2u; } } \
        PG8_STAGE(bufoff, base, go_); } } while (0)
#define PG8_TBL_FILL(u, slot_) do { if (wid < 4) { const unsigned vo_ = (unsigned)((u).ab + wid * 64 + lane_now()) * 4u; const char* ib_ = (const char*)AR.idxp(); \
        asm volatile("s_mov_b32 m0, %2\n\ts_nop 0\n\tglobal_load_lds_dword %0, %1" : : "v"(vo_), "s"(ib_), "s"((unsigned)(TBL + (slot_) * 1024 + wid * 256)) : "memory", "m0"); } } while (0)
    const char* cA = PG8_ABASE(cur);
    const char* cB = (const char*)Bt + (size_t)cur.pn * tstep;
    if constexpr (!ARows::DENSE) { PG8_TBL_FILL(cur, 0); PG8_WAIT_V(0); PG8_BAR; }
    PG8_STAGE(PG8_SB(0, 0), cB, voffB); PG8_STAGE(PG8_SB(0, 1), cB + hstep, voffB); PG8_STAGE_A(PG8_SA(0, 0), cA, 0, 0); PG8_STAGE_A(PG8_SA(0, 1), cA, 1, 0);
    if (wr == 1) PG8_BAR;
    PG8_WAIT_V(2); PG8_BAR;
    PG8_STAGE(PG8_SB(1, 0), cB + kstep, voffB); PG8_STAGE_A(PG8_SA(1, 0), cA + kstep, 0, 0); PG8_STAGE(PG8_SB(1, 1), cB + hstep + kstep, voffB);
    PG8_WAIT_V(6); PG8_BAR;
    for (;;) {
        const bool has_next = S.next(ui + 1, nxt);
        const int slc = ui & 1, sln = has_next ? (slc ^ 1) : slc;
        if constexpr (!ARows::DENSE) { if (has_next) PG8_TBL_FILL(nxt, sln); }
        const char* nB = has_next ? (const char*)Bt + (size_t)nxt.pn * tstep : cB;
        const char* nA = has_next ? PG8_ABASE(nxt) : cA;
        const int nt = cur.nt, rbase = __builtin_amdgcn_readfirstlane((ui == 0) ? 1 : 0);
#pragma unroll 1
        for (int t = 0; t < nt; t += 2) {
            const bool last = (t == nt - 2); const int relax = t + rbase;
            const char* a1 = cA + (size_t)(t + 1) * kstep;
            const char* a2 = last ? nA : cA + (size_t)(t + 2) * kstep; const char* b2 = last ? nB : cB + (size_t)(t + 2) * kstep;
            const char* a3 = a2 + kstep; const char* b3 = b2 + kstep;
            const int sl2 = last ? sln : slc;
            PG8_LDB(B0, 0, 0); PG8_LDB(B1, 0, 1); PG8_SCHED; PG8_LDA(At, 0, 0); PG8_STAGE_A(PG8_SA(1, 1), a1, 1, slc);
            PG8_WAIT_VR(relax); PG8_WAIT_L(0); PG8_BAR; PG8_MMA(0, 0, At, B0); PG8_MMA(0, 1, At, B1); PG8_BAR; PG8_SCHED;
            PG8_LDA(At, 0, 1); PG8_STAGE(PG8_SB(0, 0), b2, voffB); PG8_STAGE(PG8_SB(0, 1), b2 + hstep, voffB); PG8_STAGE_A(PG8_SA(0, 0), a2, 0, sl2);
            PG8_WAIT_VR(relax); PG8_WAIT_L(0); PG8_BAR; PG8_MMA(1, 0, At, B0); PG8_MMA(1, 1, At, B1); PG8_BAR; PG8_SCHED;
            PG8_LDB(B0, 1, 0); PG8_LDB(B1, 1, 1); PG8_SCHED; PG8_LDA(At, 1, 0); PG8_STAGE_A(PG8_SA(0, 1), a2, 1, sl2);
            PG8_WAIT_V(8); PG8_WAIT_L(0); PG8_BAR; PG8_MMA(0, 0, At, B0); PG8_MMA(0, 1, At, B1); PG8_BAR; PG8_SCHED;
            PG8_LDA(At, 1, 1); PG8_STAGE(PG8_SB(1, 0), b3, voffB); PG8_STAGE(PG8_SB(1, 1), b3 + hstep, voffB); PG8_STAGE_A(PG8_SA(1, 0), a3, 0, sl2);
            PG8_WAIT_V(8); PG8_WAIT_L(0); PG8_BAR; PG8_MMA(1, 0, At, B0); PG8_MMA(1, 1, At, B1); PG8_BAR; PG8_SCHED;
        }
        if constexpr (ALIGN_EPI) { if (wr == 0) PG8_BAR; }
        asm volatile("" : "+s"(cur.pm), "+s"(cur.pn));
        { const int tz = lane_now();
          E(acc, cur, wr, wc, tz & 15, (tz & 63) >> 4); }
        if (!has_next) break;
#pragma unroll
        for (int a = 0; a < 2; ++a)
#pragma unroll
            for (int b = 0; b < 2; ++b)
#pragma unroll
                for (int m = 0; m < 4; ++m)
#pragma unroll
                    for (int n = 0; n < 2; ++n) acc[a][b][m][n] = (f32x4){0.f, 0.f, 0.f, 0.f};
        cur = nxt; cB = nB; cA = nA; ++ui;
        if constexpr (ALIGN_EPI) { if (wr == 1) PG8_BAR; }
    }
    PG8_WAIT_V(0);
    if constexpr (!ALIGN_EPI) { if (wr == 0) PG8_BAR; }
    PG8_BAR;
#undef PG8_SA
#undef PG8_SB
#undef PG8_SBR
#undef PG8_STAGE
#undef PG8_LDA
#undef PG8_LDB
#undef PG8_MMA
#undef PG8_WAIT_V
#undef PG8_WAIT_L
#undef PG8_BAR
#undef PG8_SCHED
#undef PG8_AOFF
#undef PG8_WAIT_VR
#undef PG8_STAGE_A
#undef PG8_TBL_FILL
}
}

constexpr int NWAVES = 8, NTHREADS = 512;
constexpr int NPHASE = 12;
struct Args {
    const float* in[33]; float* out; unsigned char* ws; int ph_lo, ph_hi, use_bar, pad;
};
enum { I_X = 0, I_LNG, I_LNB, I_WIN, I_CONVW, I_CONVB, I_WRG, I_BRG, I_WIG, I_BIG, I_LAMBDA, I_MU, I_W0, I_DECUP, I_A0, I_AAAUP, I_GATEUP,
       I_KK, I_KA, I_RK, I_GNG, I_GNB, I_WOUT, I_LN1G, I_LN1B, I_WROUTER, I_BROUTER, I_WE1, I_BE1, I_WE2, I_BE2, I_LN2G, I_LN2B };

__device__ __forceinline__ void transpose_item(const float* W, int N, bf16_t* WT, int k0, int n0, int dst_row0, LAS float* scr, int lane) {
#pragma unroll 8
    for (int i = 0; i < 32; ++i) { const int kk = 2 * i + (lane >> 5); scr[kk * 33 + (lane & 31)] = W[(size_t)(k0 + kk) * N + n0 + (lane & 31)]; }
    asm volatile("s_waitcnt lgkmcnt(0)" ::: "memory");
    const int c = lane & 7;
#pragma unroll
    for (int j = 0; j < 4; ++j) { const int n = (lane >> 3) + 8 * j; const LAS float* s = scr + (8 * c) * 33 + n;
        u32x4 o; o.x = pk2(s[0 * 33], s[1 * 33]); o.y = pk2(s[2 * 33], s[3 * 33]); o.z = pk2(s[4 * 33], s[5 * 33]); o.w = pk2(s[6 * 33], s[7 * 33]);
        *(u32x4*)(WT + (size_t)(dst_row0 + n) * KD + k0 + 8 * c) = o; }
    asm volatile("s_waitcnt lgkmcnt(0)" ::: "memory");
}

__device__ __forceinline__ void transpose_item_f8(const float* W, int N, unsigned char* WT, int k0, int n0, int dst_row0, float scale, LAS float* scr, int lane) {
#pragma unroll 8
    for (int i = 0; i < 64; ++i) { const int kk = 2 * i + (lane >> 5); scr[kk * 33 + (lane & 31)] = __builtin_nontemporal_load(W + (size_t)(k0 + kk) * N + n0 + (lane & 31)); }
    asm volatile("s_waitcnt lgkmcnt(0)" ::: "memory");
    const int c = lane & 7;
#pragma unroll
    for (int j = 0; j < 4; ++j) { const int n = (lane >> 3) + 8 * j; const LAS float* s = scr + (16 * c) * 33 + n;
        u32x4 o;
        o.x = pk4_f8(s[0 * 33] * scale, s[1 * 33] * scale, s[2 * 33] * scale, s[3 * 33] * scale); o.y = pk4_f8(s[4 * 33] * scale, s[5 * 33] * scale, s[6 * 33] * scale, s[7 * 33] * scale);
        o.z = pk4_f8(s[8 * 33] * scale, s[9 * 33] * scale, s[10 * 33] * scale, s[11 * 33] * scale); o.w = pk4_f8(s[12 * 33] * scale, s[13 * 33] * scale, s[14 * 33] * scale, s[15 * 33] * scale);
        __builtin_nontemporal_store(o, (u32x4*)(WT + (size_t)(dst_row0 + n) * KD + k0 + 16 * c)); }
    asm volatile("s_waitcnt lgkmcnt(0)" ::: "memory");
}

__device__ __forceinline__ void moe_tables(volatile LAS int* tb, unsigned* ctl, int wave_id) {
    if (wave_id == 0 && lane_now() == 0) {
        int off = 0;
        for (int e = 0; e < NE; ++e) { const int c = (int)__hip_atomic_load(ctl + CW_CNT + 64 * e, RLX_AGENT); const int nt = (c + 255) >> 8;
            tb[1 + e] = off; for (int r = 0; r < nt; ++r) tb[64 + off + r] = e; off += nt; }
        tb[1 + NE] = off; tb[0] = off;
    }
    __syncthreads();
}

__global__ void __launch_bounds__(NTHREADS, 2) fwd(Args args) {
    extern __shared__ __attribute__((aligned(16))) unsigned char lds_raw[];
    LAS unsigned char* lds = (LAS unsigned char*)lds_raw;
    volatile LAS unsigned* MISC = (volatile LAS unsigned*)(lds + MISC_OFF);
    const int wave = __builtin_amdgcn_readfirstlane(threadIdx.x >> 6);
#define LANE_TID() const int lane = lane_now(), tid = wave * 64 + lane, gt = bid * NTHREADS + tid; (void)tid; (void)gt
    const int G = gridDim.x, bid = blockIdx.x;
    unsigned char* ws = args.ws;
    unsigned* ctl = (unsigned*)(ws + WS_CTL);
    if (wave == 0) MISC[lane_now()] = 0u;
    __syncthreads();
    XcdBarrier bar; bar.bar = ctl + CW_BAR; bar.x = 0; bar.st = nullptr;
    if (args.use_bar) bar = xcd_barrier_post(ctl + CW_BAR, MISC);
    const int lo = args.ph_lo, hi = args.ph_hi;
#ifndef DUP_MASK
#define DUP_MASK 0
#endif
#define REP(k) for (int rep_ = 0; rep_ <= ((DUP_MASK >> (k)) & 1); ++rep_)
#define IN(k) (lo <= (k) && (k) < hi)
#ifndef PROBE_PHASE
#define PROBE_PHASE -1
#endif
    unsigned long long tprobe0 = 0ull, tprobe1 = 0ull;
#define SEAM(k) do { if (IN(k) && IN((k) + 1)) xcd_barrier(bar, wave); if (PROBE_PHASE >= 0) { if ((k) + 1 == PROBE_PHASE) tprobe0 = __builtin_amdgcn_s_memrealtime(); if ((k) == PROBE_PHASE) tprobe1 = __builtin_amdgcn_s_memrealtime(); } } while (0)
    if (PROBE_PHASE == 0) tprobe0 = __builtin_amdgcn_s_memrealtime();
    const int gw = bid * NWAVES + wave, NGW = G * NWAVES;
    const int NGT = G * NTHREADS;

    bf16_t* WinT = (bf16_t*)(ws + WS_WIN); bf16_t* WoT = (bf16_t*)(ws + WS_WO); unsigned char* W1F = ws + WS_W1; unsigned char* W2F = ws + WS_W2;
    bf16_t* XN = (bf16_t*)(ws + WS_XN); bf16_t* P = (bf16_t*)(ws + WS_P);
    float* LA = (float*)(ws + WS_LA); float* LB = (float*)(ws + WS_LB);
    float* BON = (float*)(ws + WS_BON);
    bf16_t* CAT = (bf16_t*)(ws + WS_CAT); float* Z = (float*)(ws + WS_Z); float* H1 = (float*)(ws + WS_H1); unsigned char* H1F = ws + WS_H1B;
    int* TOPE = (int*)(ws + WS_TOPE); int* TOPP = (int*)(ws + WS_TOPP); float* TOPG = (float*)(ws + WS_TOPG); int* TOKSLOT = (int*)(ws + WS_TOKSLOT);
    int* SLOTTOK = (int*)(ws + WS_SLOTTOK); float* SLOTG = (float*)(ws + WS_SLOTG);
    unsigned char* ACT = ws + WS_ACT; bf16_t* OUTS = (bf16_t*)(ws + WS_OUTS);

    constexpr int CV_I_IN = (KD / 64) * (NP / 32), CV_I_OUT = (KD / 128) * (D / 32), CV_I_E1 = (KD / 128) * (2 * DE / 32), CV_I_E2 = (DE / 128) * (D / 32);
    constexpr int CV_NITEMS = CV_I_IN + CV_I_OUT + NE * CV_I_E1 + NE * CV_I_E2;
#ifndef CV_SHADOW
#define CV_SHADOW 9200
#endif
#ifndef CV_SHADOW1
#define CV_SHADOW1 5120
#endif
#define CONVERT_ITEM(it_) do { int r = (it_); LAS float* scr = (LAS float*)(lds + wave * 17408); \
        if (r < CV_I_IN) { const int nb = NP / 32, kb = r / nb, n0 = (r % nb) * 32; transpose_item(args.in[I_WIN], NP, WinT, kb * 64, n0, n0, scr, lane); break; } r -= CV_I_IN; \
        if (r < CV_I_OUT) { const int nb = D / 32, kb = r / nb, n0 = (r % nb) * 32; transpose_item_f8(args.in[I_WOUT], D, (unsigned char*)WoT, kb * 128, n0, n0, F8_SW1, scr, lane); break; } r -= CV_I_OUT; \
        if (r < NE * CV_I_E1) { const int e = r / CV_I_E1, q = r % CV_I_E1, nb = 2 * DE / 32, kb = q / nb, n0 = (q % nb) * 32; \
            const int isup = n0 >= DE ? 1 : 0, nn = n0 - isup * DE, drow = 256 * (nn >> 7) + 128 * isup + (nn & 127); \
            transpose_item_f8(args.in[I_WE1] + (size_t)e * KD * 2 * DE, 2 * DE, W1F + (size_t)e * 2 * DE * KD, kb * 128, n0, drow, F8_SW1, scr, lane); break; } r -= NE * CV_I_E1; \
        { const int e = r / CV_I_E2, q = r % CV_I_E2, nb = D / 32, kb = q / nb, n0 = (q % nb) * 32; \
            transpose_item_f8(args.in[I_WE2] + (size_t)e * DE * D, D, W2F + (size_t)e * D * DE, kb * 128, n0, n0, F8_SW2, scr, lane); } } while (0)

    if (IN(0)) REP(0) {
        LANE_TID();
        for (int it = gw; it < CV_NITEMS - CV_SHADOW - CV_SHADOW1; it += NGW) CONVERT_ITEM(it);
        { bf16_t* WG = (bf16_t*)(ws + WS_WG); bf16_t* WL = (bf16_t*)(ws + WS_WL);
            for (int i = gt; i < 2048 * 256; i += NGT) { const int row = i >> 8, kl = i & 255, g_ = row >> 10, nb = (row >> 6) & 15, k = row & 63, blk = kl >> 6, j = kl & 63;
                const float v = ((nb & 3) == blk) ? args.in[g_ ? I_WIG : I_WRG][(size_t)(nb * 64 + j) * 64 + k] : 0.f; WG[i] = cvt1(v); }
            for (int i = gt; i < 3072 * 256; i += NGT) { const int row = i >> 8, kl = i & 255, sel = row >> 10, c = row & 1023;
                float v = 0.f; if (sel == 0) { if (kl < DLORA) v = args.in[I_DECUP][(size_t)kl * RW_W + c]; } else if (sel == 1) { if (kl < ALORA) v = args.in[I_AAAUP][(size_t)kl * RW_W + c]; } else v = args.in[I_GATEUP][(size_t)kl * RW_W + c];
                WL[i] = cvt1(v); } }
        { bf16_t* WRH = (bf16_t*)(ws + WS_WRT); bf16_t* WRL = WRH + NE * D;
            for (int i = gt; i < NE * D; i += NGT) { const int e = i >> 11, k = i & 2047; const float w = args.in[I_WROUTER][(size_t)k * NE + e]; const unsigned short h = cvt1(w); WRH[i] = h; WRL[i] = cvt1(w - bf2f(h)); } }
        for (int i = gt; i < 2 * NE * LIST_CAP / 4; i += NGT) ((u32x4*)(ws + WS_SLOTTOK))[i] = (u32x4){0u, 0u, 0u, 0u};
        for (int i = gt; i < (NPP - NP) * KD / 8; i += NGT) ((u32x4*)(WinT + (size_t)NP * KD))[i] = (u32x4){0u, 0u, 0u, 0u};
        const float* lg = args.in[I_LNG]; const float* lb = args.in[I_LNB];
        for (int m = gw; m < M; m += NGW) {
            const f32x4* xr = (const f32x4*)(args.in[I_X] + (size_t)m * D) + lane;
            f32x4 v[8]; float s = 0.f;
#pragma unroll
            for (int j = 0; j < 8; ++j) { v[j] = __builtin_nontemporal_load(xr + 64 * j); s += (v[j][0] + v[j][1]) + (v[j][2] + v[j][3]); }
            const float mean = wave_sum(s) * (1.f / D); float s2 = 0.f;
#pragma unroll
            for (int j = 0; j < 8; ++j) { v[j] = v[j] - mean; s2 += (v[j][0] * v[j][0] + v[j][1] * v[j][1]) + (v[j][2] * v[j][2] + v[j][3] * v[j][3]); }
            const float rstd = 1.f / sqrtf(wave_sum(s2) * (1.f / D) + LN_EPS);
            u32x2* o8 = (u32x2*)(XN + (size_t)m * D) + lane;
#pragma unroll
            for (int j = 0; j < 8; ++j) { const f32x4 g4 = ((const f32x4*)lg)[64 * j + lane], b4 = ((const f32x4*)lb)[64 * j + lane]; const f32x4 y = v[j] * rstd * g4 + b4;
                u32x2 w; w.x = pk2(y[0], y[1]); w.y = pk2(y[2], y[3]); o8[64 * j] = w; }
        }
    }
    SEAM(0);

    if (IN(1)) REP(1) {
        LANE_TID();
        pg8::StaticOrder S; S.init(M, NPP, G, bid);
        pg8::EpiBf16 E{P, NPP};
        pg8::gemm_phase<pg8::EpiBf16, pg8::StaticOrder, pg8::DenseRows, true>(lds, XN, WinT, S, E, pg8::DenseRows{}, wave);
        if (G == 256 && bid >= 128) {
            __syncthreads();
            for (int it = CV_NITEMS - CV_SHADOW - CV_SHADOW1 + (bid - 128) * NWAVES + wave; it < CV_NITEMS - CV_SHADOW; it += 128 * NWAVES) CONVERT_ITEM(it); }
        else if (G != 256) { for (int it = CV_NITEMS - CV_SHADOW - CV_SHADOW1 + gw; it < CV_NITEMS - CV_SHADOW; it += NGW) CONVERT_ITEM(it); }
    }
    SEAM(1);

    if (IN(2)) REP(2) {
        LANE_TID();
        bf16_t* UC = (bf16_t*)(ws + WS_UC); bf16_t* XL = (bf16_t*)(ws + WS_XL);
        const float* conv_w = args.in[I_CONVW]; const float* conv_b = args.in[I_CONVB]; const float* mu = args.in[I_MU];
        for (int idx = gt; idx < (M / 16) * (LRU_W / 8); idx += NGT) { const int m0 = (idx >> 7) * 16, c = (idx & 127) * 8, tin0 = m0 & (SEQ - 1);
            f32x4 wlo[4], whi[4];
#pragma unroll
            for (int j = 0; j < 4; ++j) { wlo[j] = *(const f32x4*)(conv_w + j * LRU_W + c); whi[j] = *(const f32x4*)(conv_w + j * LRU_W + c + 4); }
            const f32x4 cb0 = *(const f32x4*)(conv_b + c), cb1 = *(const f32x4*)(conv_b + c + 4);
            u32x4 row[19];
#pragma unroll
            for (int j = 0; j < 19; ++j) { row[j] = (u32x4){0u, 0u, 0u, 0u}; if (tin0 - 3 + j >= 0) row[j] = *(const u32x4*)(P + (size_t)(m0 - 3 + j) * NPP + c); }
#pragma unroll
            for (int t = 0; t < 16; ++t) { f32x4 o0 = cb0, o1 = cb1;
#pragma unroll
                for (int j = 0; j < 4; ++j) { const u32x4 pv = row[t + j];
                    o0[0] += wlo[j][0] * bflo(pv.x); o0[1] += wlo[j][1] * bfhi(pv.x); o0[2] += wlo[j][2] * bflo(pv.y); o0[3] += wlo[j][3] * bfhi(pv.y);
                    o1[0] += whi[j][0] * bflo(pv.z); o1[1] += whi[j][1] * bfhi(pv.z); o1[2] += whi[j][2] * bflo(pv.w); o1[3] += whi[j][3] * bfhi(pv.w); }
                *(u32x4*)(UC + (size_t)(m0 + t) * LRU_W + c) = (u32x4){cvt2(o0[0], o0[1]), cvt2(o0[2], o0[3]), cvt2(o1[0], o1[1]), cvt2(o1[2], o1[3])}; } }
        for (int idx = gt; idx < M * 64; idx += NGT) { const int m = idx >> 6, q = idx & 63, tin = m & (SEQ - 1);
            u32x4 res = {0u, 0u, 0u, 0u};
            const int kind = q < 12 ? 0 : (q < 16 ? 3 : (q < 28 ? 1 : (q < 32 ? 3 : 2)));
            if (kind != 3) { const int col = (kind == 0) ? 3 * RW_W + 8 * q : (kind == 1 ? 3 * RW_W + DLORA + 8 * (q - 16) : 3 * RW_W + DLORA + ALORA + 8 * (q - 32));
                const bf16_t* pp = P + (size_t)m * NPP + 2 * LRU_W + col; const u32x4 pc = *(const u32x4*)pp; u32x4 pq = {0u, 0u, 0u, 0u}; if (tin > 0) pq = *(const u32x4*)(pp - NPP);
                const f32x4 m0 = *(const f32x4*)(mu + col), m1 = *(const f32x4*)(mu + col + 4);
                float s[8]; const unsigned pcw[4] = {pc.x, pc.y, pc.z, pc.w}, pqw[4] = {pq.x, pq.y, pq.z, pq.w};
#pragma unroll
                for (int e = 0; e < 4; ++e) { const float c0 = bflo(pcw[e]), c1 = bfhi(pcw[e]), p0 = bflo(pqw[e]), p1 = bfhi(pqw[e]);
                    const float mu0 = (e < 2) ? m0[2 * e] : m1[2 * e - 4], mu1 = (e < 2) ? m0[2 * e + 1] : m1[2 * e - 3];
                    s[2 * e] = c0 + (p0 - c0) * mu0; s[2 * e + 1] = c1 + (p1 - c1) * mu1; }
#pragma unroll
                for (int e = 0; e < 8; ++e) s[e] = (kind == 0) ? tanh_fast(s[e]) : (kind == 1 ? s[e] : sigmoidf_(s[e]));
                res = (u32x4){cvt2(s[0], s[1]), cvt2(s[2], s[3]), cvt2(s[4], s[5]), cvt2(s[6], s[7])}; }
            *(u32x4*)(XL + (size_t)m * 512 + 8 * q) = res; }
    }
    SEAM(2);

    if (IN(3)) {
        LANE_TID();
        const bf16_t* UC = (const bf16_t*)(ws + WS_UC); const bf16_t* XL = (const bf16_t*)(ws + WS_XL);
        { pg8::SmallOrder<0> S{G, bid}; pg8::EpiBf16 E{(bf16_t*)(ws + WS_GATES), 2048};
          pg8::gemm_phase<pg8::EpiBf16, pg8::SmallOrder<0>, pg8::DenseRows, true, LRU_W, 256>(lds, UC, (const bf16_t*)(ws + WS_WG), S, E, pg8::DenseRows{}, wave); }
        { pg8::SmallOrder<1> S{G, bid}; pg8::EpiBf16 E{(bf16_t*)(ws + WS_LOUT), 3072};
          pg8::gemm_phase<pg8::EpiBf16, pg8::SmallOrder<1>, pg8::DenseRows, true, 512, 256>(lds, XL, (const bf16_t*)(ws + WS_WL), S, E, pg8::DenseRows{}, wave); }
    }
    SEAM(3);

    if (IN(4)) {
        LANE_TID();
        constexpr int RS = 144;
        constexpr int L_AT = 0, L_BT = 9216, L_KT = 18432, L_RT = 27648, L_VT = 36864, L_BH = 46080, L_KH = 55296, L_AAB = 64512, L_AAK = 80896, L_ARB = 90112, L_ARK = 99328,
                      L_PT = 108544, L_QT = 117760, L_WC = 126976, L_A16 = 129280, L_TB = 138496, L_SEG = 140544, L_U = L_BT, L_MST = L_AT, L_GST = L_BT;
        bf16_t* MT = (bf16_t*)(ws + WS_MT); bf16_t* GG = (bf16_t*)(ws + WS_GG); float* NN = (float*)(ws + WS_NN); float* HH = (float*)(ws + WS_HH);
        const bf16_t* LOUT = (const bf16_t*)(ws + WS_LOUT); bf16_t* V16 = (bf16_t*)(ws + WS_V16); bf16_t* G16 = (bf16_t*)(ws + WS_G16); const float* mu_ = args.in[I_MU];
        const int r = lane & 31, hh = lane >> 5;
        unsigned xr[5], xk[5], xv[5], xd[4], xa[4], xg[4];
#define E_LOAD(u_) do { const int cch_ = (u_) & 63, head_ = ((u_) >> 6) & 15, b_ = (u_) >> 10; const int sg_ = 2 * wave + (lane >> 5); const size_t tokb_ = (size_t)b_ * SEQ + cch_ * 64 + 4 * sg_; const int c_ = head_ * HS + 2 * (lane & 31); \
            const bf16_t* pp_ = P + tokb_ * NPP + 2 * LRU_W + c_; const bool hp_ = ((cch_ * 64 + 4 * sg_) & (SEQ - 1)) != 0; \
            xr[0] = hp_ ? *(const unsigned*)(pp_ - NPP) : 0u; xk[0] = hp_ ? *(const unsigned*)(pp_ - NPP + RW_W) : 0u; xv[0] = hp_ ? *(const unsigned*)(pp_ - NPP + 2 * RW_W) : 0u; \
            _Pragma("unroll") for (int j = 0; j < 4; ++j) { const bf16_t* pj = pp_ + (size_t)j * NPP; xr[j + 1] = *(const unsigned*)pj; xk[j + 1] = *(const unsigned*)(pj + RW_W); xv[j + 1] = *(const unsigned*)(pj + 2 * RW_W); \
                const bf16_t* lj = LOUT + (tokb_ + j) * 3072 + c_; xd[j] = *(const unsigned*)lj; xa[j] = *(const unsigned*)(lj + 1024); xg[j] = *(const unsigned*)(lj + 2048); } } while (0)
        if (bid < NUNIT) E_LOAD(bid);
        REP(4) for (int u = bid; u < NUNIT; u += G) {
            const int cch = u & 63, head = (u >> 6) & 15, b = u >> 10; const size_t tok0 = (size_t)b * SEQ + cch * 64;
            { const int cp = lane & 31, hq = lane >> 5, sg = 2 * wave + hq, ch = 2 * cp, c = head * HS + ch; const size_t tokb = tok0 + 4 * sg;
                float lw[4][2], rr_[4][2], kk_[4][2], vv_[4][2], kn_[4][2], aa_[4][2];
                { const f32x2 mur = *(const f32x2*)(mu_ + c), muk = *(const f32x2*)(mu_ + RW_W + c), muv = *(const f32x2*)(mu_ + 2 * RW_W + c);
                    const f32x2 w0c = *(const f32x2*)(args.in[I_W0] + c), a0c = *(const f32x2*)(args.in[I_A0] + c), kkc = *(const f32x2*)(args.in[I_KK] + c), kac = *(const f32x2*)(args.in[I_KA] + c), rkc = *(const f32x2*)(args.in[I_RK] + c);
                    float bonv[4];
#pragma unroll
                    for (int j = 0; j < 4; ++j) { float s_kk = 0.f, s_bo = 0.f;
#pragma unroll
                        for (int x = 0; x < 2; ++x) { const float cr = x ? bfhi(xr[j + 1]) : bflo(xr[j + 1]), ck = x ? bfhi(xk[j + 1]) : bflo(xk[j + 1]), cv = x ? bfhi(xv[j + 1]) : bflo(xv[j + 1]);
                            const float pr = x ? bfhi(xr[j]) : bflo(xr[j]), pk_ = x ? bfhi(xk[j]) : bflo(xk[j]), pvv = x ? bfhi(xv[j]) : bflo(xv[j]);
                            const float r = cr + (pr - cr) * mur[x], k = ck + (pk_ - ck) * muk[x], v = cv + (pvv - cv) * muv[x];
                            const float lgw = -0.6065306597126334f * sigmoidf_(w0c[x] + (x ? bfhi(xd[j]) : bflo(xd[j])));
                            const float a = sigmoidf_(a0c[x] + (x ? bfhi(xa[j]) : bflo(xa[j])));
                            const float kk = k * kkc[x]; const float km = k * (1.f + (a - 1.f) * kac[x]);
                            s_kk += kk * kk; s_bo += r * km * rkc[x];
                            lw[j][x] = lgw; rr_[j][x] = r; kk_[j][x] = km; vv_[j][x] = v; kn_[j][x] = kk; aa_[j][x] = a; }
                        const float inv = __builtin_amdgcn_rsqf(fmaxf(half_sum(s_kk, hq), 1e-24f)); kn_[j][0] *= inv; kn_[j][1] *= inv;
                        bonv[j] = half_sum(s_bo, hq); }
#pragma unroll
                    for (int j = 0; j < 4; ++j) { *(unsigned*)(V16 + (tokb + j) * RW_W + c) = cvt2(vv_[j][0], vv_[j][1]); *(unsigned*)(G16 + (tokb + j) * RW_W + c) = xg[j]; }
                    if (cp < 4) { float bsel = bonv[0];
#pragma unroll
                        for (int j = 1; j < 4; ++j) bsel = (cp == j) ? bonv[j] : bsel;
                        BON[(tokb + cp) * NHEAD + head] = bsel; }
                    if (u + G < NUNIT) E_LOAD(u + G); }
                f32x2 seg = {0.f, 0.f};
#pragma unroll
                for (int j = 0; j < 4; ++j) { seg[0] += lw[j][0]; seg[1] += lw[j][1]; }
                *(LAS f32x2*)(lds + L_SEG + (sg * 64 + ch) * 4) = seg;
                __syncthreads();
                f32x2 pre = {0.f, 0.f}, tot = {0.f, 0.f};
#pragma unroll
                for (int g = 0; g < 16; ++g) { const f32x2 sv = *(const LAS f32x2*)(lds + L_SEG + (g * 64 + ch) * 4); tot += sv; if (g < sg) pre += sv; }
                if (sg == 0) *(LAS f32x2*)(lds + L_WC + ch * 4) = (f32x2){__expf(tot[0]), __expf(tot[1])};
                float tv[2][4], tb_[2][4], tk[2][4];
#pragma unroll
                for (int x = 0; x < 2; ++x) { float L = pre[x]; const float eTot = __expf(tot[x]); float eLex = __expf(pre[x]);
#pragma unroll
                    for (int j = 0; j < 4; ++j) { L += lw[j][x];
                        const float eL = __expf(L), eNL = __builtin_amdgcn_rcpf(eL), eEnd = eTot * eNL; const float beta = kn_[j][x] * aa_[j][x];
                        rr_[j][x] = rr_[j][x] * eL; const float at_ = kn_[j][x] * eLex, bt_ = beta * eNL, kt_ = kk_[j][x] * eNL;
                        tv[x][j] = vv_[j][x]; tb_[x][j] = -beta * eEnd; tk[x][j] = kk_[j][x] * eEnd; eLex = eL;
                        kn_[j][x] = at_; aa_[j][x] = bt_; kk_[j][x] = kt_; } }
#pragma unroll
                for (int j = 0; j < 4; ++j) { const int t = 4 * sg + j;
                    *(LAS unsigned*)(lds + L_AT + t * RS + ch * 2) = cvt2(kn_[j][0], kn_[j][1]);
                    *(LAS unsigned*)(lds + L_BT + t * RS + ch * 2) = cvt2(aa_[j][0], aa_[j][1]);
                    *(LAS unsigned*)(lds + L_KT + t * RS + ch * 2) = cvt2(kk_[j][0], kk_[j][1]);
                    *(LAS unsigned*)(lds + L_RT + t * RS + ch * 2) = cvt2(rr_[j][0], rr_[j][1]); }
#pragma unroll
                for (int x = 0; x < 2; ++x) {
                    *(LAS u32x2*)(lds + L_VT + (ch + x) * RS + sg * 8) = (u32x2){cvt2(tv[x][0], tv[x][1]), cvt2(tv[x][2], tv[x][3])};
                    *(LAS u32x2*)(lds + L_BH + (ch + x) * RS + sg * 8) = (u32x2){cvt2(tb_[x][0], tb_[x][1]), cvt2(tb_[x][2], tb_[x][3])};
                    *(LAS u32x2*)(lds + L_KH + (ch + x) * RS + sg * 8) = (u32x2){cvt2(tk[x][0], tk[x][1]), cvt2(tk[x][2], tk[x][3])}; }
            }
            __syncthreads();
            { const int id = wave >> 1, i = wave & 1; const int X = (id < 2) ? L_AT : L_RT, Y = (id & 1) ? L_KT : L_BT;
                f32x16 acc[2];
#pragma unroll
                for (int q = 0; q < 2; ++q)
#pragma unroll
                    for (int e = 0; e < 16; ++e) acc[q][e] = 0.f;
#pragma unroll
                for (int s = 0; s < 4; ++s) { const bf16x8 a = *(const LAS bf16x8*)(lds + X + (32 * i + r) * RS + (16 * s + 8 * hh) * 2);
#pragma unroll
                    for (int q = 0; q < 2; ++q) { const bf16x8 bb = *(const LAS bf16x8*)(lds + Y + (32 * q + r) * RS + (16 * s + 8 * hh) * 2); acc[q] = MFMA32(a, bb, acc[q]); } }
#pragma unroll
                for (int q = 0; q < 2; ++q)
#pragma unroll
                    for (int e = 0; e < 16; ++e) { const int t = 32 * i + crow(e, hh), sc = 32 * q + r; const bool keep = (id < 2) ? (sc < t) : (sc <= t);
                        float val = keep ? acc[q][e] : 0.f; if (id == 2) val = -val;
                        if (id == 0) { ((LAS float*)(lds + L_AAB))[t * 64 + sc] = val; *(LAS unsigned short*)(lds + L_A16 + t * RS + sc * 2) = cvt1(-val); }
                        else *(LAS unsigned short*)(lds + L_AAK + (id - 1) * 9216 + t * RS + sc * 2) = cvt1(val); }
            }
            __syncthreads();
            if (wave < 4) { const int i = wave >> 1, q = wave & 1; f32x16 acc;
#pragma unroll
                for (int e = 0; e < 16; ++e) acc[e] = 0.f;
#pragma unroll
                for (int s = 0; s < 4; ++s) { const bf16x8 a = *(const LAS bf16x8*)(lds + L_AAK + (32 * i + r) * RS + (16 * s + 8 * hh) * 2);
                    const bf16x8 bb = *(const LAS bf16x8*)(lds + L_VT + (32 * q + r) * RS + (16 * s + 8 * hh) * 2); acc = MFMA32(a, bb, acc); }
#pragma unroll
                for (int e = 0; e < 16; ++e) ((LAS float*)(lds + L_U))[(32 * i + crow(e, hh)) * 64 + 32 * q + r] = acc[e];
            }
            if (wave == 4) { const int b2 = lane >> 4, j = lane & 15; float x[16];
                const LAS float* AB = (const LAS float*)(lds + L_AAB) + (16 * b2) * 64 + 16 * b2;
#pragma unroll
                for (int t = 0; t < 16; ++t) x[t] = (t == j) ? 1.f : 0.f;
                { f32x4 Ar[8][2];
#pragma unroll
                    for (int t = 1; t < 8; ++t)
#pragma unroll
                        for (int s4 = 0; s4 < (t + 3) / 4; ++s4) Ar[t][s4] = *(const LAS f32x4*)(AB + t * 64 + 4 * s4);
#pragma unroll
                    for (int s = 0; s < 7; ++s) { const float xs = x[s];
#pragma unroll
                        for (int t = s + 1; t < 8; ++t) x[t] -= Ar[t][s >> 2][s & 3] * xs; } }
                { f32x4 Ar[8][2];
#pragma unroll
                    for (int t = 0; t < 8; ++t)
#pragma unroll
                        for (int s4 = 0; s4 < 2; ++s4) Ar[t][s4] = *(const LAS f32x4*)(AB + (8 + t) * 64 + 4 * s4);
#pragma unroll
                    for (int t = 0; t < 8; ++t) { float a0 = 0.f, a1 = 0.f;
#pragma unroll
                        for (int s = 0; s < 8; s += 2) { a0 += Ar[t][s >> 2][s & 3] * x[s]; a1 += Ar[t][(s + 1) >> 2][(s + 1) & 3] * x[s + 1]; }
                        x[8 + t] -= (a0 + a1); } }
                { f32x4 Ar[8][2];
#pragma unroll
                    for (int t = 1; t < 8; ++t)
#pragma unroll
                        for (int s4 = 0; s4 < (t + 3) / 4; ++s4) Ar[t][s4] = *(const LAS f32x4*)(AB + (8 + t) * 64 + 8 + 4 * s4);
#pragma unroll
                    for (int s = 0; s < 7; ++s) { const float xs = x[8 + s];
#pragma unroll
                        for (int t = s + 1; t < 8; ++t) x[8 + t] -= Ar[t][s >> 2][s & 3] * xs; } }
#pragma unroll
                for (int t = 0; t < 16; ++t) *(LAS unsigned short*)(lds + L_TB + ((b2 * 16 + t) * 16 + j) * 2) = cvt1(x[t]);
            }
            __syncthreads();
            { const int c16 = lane & 15, quad = lane >> 4, isQ = wave >> 2, colb = 16 * (wave & 3) + c16;
                f32x4 Xr[4];
#pragma unroll
                for (int b2 = 0; b2 < 4; ++b2) Xr[b2] = (f32x4){0.f, 0.f, 0.f, 0.f};
#pragma unroll
                for (int b2 = 0; b2 < 4; ++b2) {
                    f32x4 y;
#pragma unroll
                    for (int g = 0; g < 4; ++g) { const int row = 16 * b2 + 4 * quad + g;
                        y[g] = isQ ? ((const LAS float*)(lds + L_U))[row * 64 + colb] : bf2f(*(const LAS unsigned short*)(lds + L_AT + row * RS + colb * 2)); }
#pragma unroll
                    for (int ks = 0; ks < 2; ++ks) if (2 * ks < b2) {
                        const u32x2 alo = *(const LAS u32x2*)(lds + L_A16 + (16 * b2 + c16) * RS + (32 * ks + 4 * quad) * 2);
                        u32x2 ahi = {0u, 0u}; if (2 * ks + 1 < b2) ahi = *(const LAS u32x2*)(lds + L_A16 + (16 * b2 + c16) * RS + (32 * ks + 16 + 4 * quad) * 2);
                        const u32x4 af = {alo.x, alo.y, ahi.x, ahi.y};
                        const u32x4 bf = {cvt2(Xr[2 * ks][0], Xr[2 * ks][1]), cvt2(Xr[2 * ks][2], Xr[2 * ks][3]), cvt2(Xr[2 * ks + 1][0], Xr[2 * ks + 1][1]), cvt2(Xr[2 * ks + 1][2], Xr[2 * ks + 1][3])};
                        y = __builtin_amdgcn_mfma_f32_16x16x32_bf16(__builtin_bit_cast(bf16x8, af), __builtin_bit_cast(bf16x8, bf), y, 0, 0, 0); }
                    const u32x2 tlo = *(const LAS u32x2*)(lds + L_TB + ((b2 * 16 + c16) * 16 + 4 * quad) * 2);
                    const u32x4 tf = {tlo.x, tlo.y, 0u, 0u};
                    const u32x4 yf = {cvt2(y[0], y[1]), cvt2(y[2], y[3]), 0u, 0u};
                    Xr[b2] = __builtin_amdgcn_mfma_f32_16x16x32_bf16(__builtin_bit_cast(bf16x8, tf), __builtin_bit_cast(bf16x8, yf), (f32x4){0.f, 0.f, 0.f, 0.f}, 0, 0, 0);
                    *(LAS u32x2*)(lds + (isQ ? L_QT : L_PT) + colb * RS + (16 * b2 + 4 * quad) * 2) = (u32x2){cvt2(Xr[b2][0], Xr[b2][1]), cvt2(Xr[b2][2], Xr[b2][3])};
                }
            }
            __syncthreads();
            { const int mtx = wave >> 1, i = wave & 1;
                const int X1 = (mtx == 0) ? L_BH : (mtx == 1) ? L_KH : (mtx == 2) ? L_ARB : L_ARK;
                const int Y1 = (mtx == 0 || mtx == 2) ? L_PT : L_VT;
                f32x16 acc[2];
#pragma unroll
                for (int q = 0; q < 2; ++q)
#pragma unroll
                    for (int e = 0; e < 16; ++e) acc[q][e] = 0.f;
#pragma unroll
                for (int s = 0; s < 4; ++s) { const bf16x8 a = *(const LAS bf16x8*)(lds + X1 + (32 * i + r) * RS + (16 * s + 8 * hh) * 2);
#pragma unroll
                    for (int q = 0; q < 2; ++q) { const bf16x8 bb = *(const LAS bf16x8*)(lds + Y1 + (32 * q + r) * RS + (16 * s + 8 * hh) * 2); acc[q] = MFMA32(a, bb, acc[q]); } }
                if (mtx & 1) { const int X2 = (mtx == 1) ? L_BH : L_ARB;
#pragma unroll
                    for (int s = 0; s < 4; ++s) { const bf16x8 a = *(const LAS bf16x8*)(lds + X2 + (32 * i + r) * RS + (16 * s + 8 * hh) * 2);
#pragma unroll
                        for (int q = 0; q < 2; ++q) { const bf16x8 bb = *(const LAS bf16x8*)(lds + L_QT + (32 * q + r) * RS + (16 * s + 8 * hh) * 2); acc[q] = MFMA32(a, bb, acc[q]); } } }
                if (mtx == 0) { const float wc = ((const LAS float*)(lds + L_WC))[32 * i + r];
#pragma unroll
                    for (int q = 0; q < 2; ++q)
#pragma unroll
                        for (int e = 0; e < 16; ++e) if (q == i && crow(e, hh) == r) acc[q][e] += wc; }
                if (mtx == 2) {
#pragma unroll
                    for (int q = 0; q < 2; ++q)
#pragma unroll
                        for (int e = 0; e < 16; ++e) acc[q][e] += bf2f(*(const LAS unsigned short*)(lds + L_RT + (32 * i + crow(e, hh)) * RS + (32 * q + r) * 2)); }
                if (mtx & 1) { unsigned* dstg = (unsigned*)((mtx == 1) ? NN : HH) + (size_t)u * 2048;
#pragma unroll
                    for (int q = 0; q < 2; ++q)
#pragma unroll
                        for (int e = 0; e < 16; e += 2) dstg[((i * 2 + q) * 8 + (e >> 1)) * 64 + lane] = cvt2(acc[q][e], acc[q][e + 1]);
                } else { const int dl = (mtx == 0) ? L_MST : L_GST;
#pragma unroll
                    for (int q = 0; q < 2; ++q)
#pragma unroll
                        for (int e = 0; e < 16; ++e) *(LAS unsigned short*)(lds + dl + (32 * i + crow(e, hh)) * RS + (32 * q + r) * 2) = cvt1(acc[q][e]); }
            }
            __syncthreads();
            { const int f = tid >> 6, i = f >> 2, q = (f >> 1) & 1, s = f & 1, r2 = lane & 31, h2 = lane >> 5; const int off = (32 * i + r2) * RS + (32 * q + 16 * s + 4 * h2) * 2;
                const u32x2 m0 = *(const LAS u32x2*)(lds + L_MST + off), m1 = *(const LAS u32x2*)(lds + L_MST + off + 16);
                const u32x2 g0 = *(const LAS u32x2*)(lds + L_GST + off), g1 = *(const LAS u32x2*)(lds + L_GST + off + 16);
                *(u32x4*)(MT + (size_t)u * 4096 + tid * 8) = (u32x4){m0.x, m0.y, m1.x, m1.y};
                *(u32x4*)(GG + (size_t)u * 4096 + tid * 8) = (u32x4){g0.x, g0.y, g1.x, g1.y}; }
            __syncthreads();
        }
        { float* CA = (float*)(ws + WS_CA); float* CH = (float*)(ws + WS_CH); const unsigned* UC2 = (const unsigned*)(ws + WS_UC); const unsigned* GT2 = (const unsigned*)(ws + WS_GATES);
            unsigned* LB2 = (unsigned*)LB; unsigned* LA2 = (unsigned*)LA;
            for (int bc = bid; bc < BATCH * 64; bc += G) { const size_t tok0 = (size_t)(bc >> 6) * SEQ + (bc & 63) * 64;
                float h[2] = {0.f, 0.f}, A[2] = {1.f, 1.f}, br[2], bi[2], sp[2];
#pragma unroll
                for (int cc = 0; cc < 2; ++cc) { const int c = 2 * tid + cc; br[cc] = args.in[I_BRG][c]; bi[cc] = args.in[I_BIG][c]; const float lam = args.in[I_LAMBDA][c];
                    sp[cc] = lam > 15.f ? __expf(-lam) : log1pf(__expf(-lam)); }
                unsigned gr[8], gi[8], uc[8];
#define LRU_LOAD(t_) do { _Pragma("unroll") for (int j = 0; j < 8; ++j) { const size_t tk = tok0 + (t_) + j; \
                    gr[j] = GT2[tk * 1024 + tid]; gi[j] = GT2[tk * 1024 + 512 + tid]; uc[j] = UC2[tk * 512 + tid]; } } while (0)
                LRU_LOAD(0);
#pragma unroll 1
                for (int t = 0; t < 64; t += 8) {
                    unsigned hv[8], av[8];
#pragma unroll
                    for (int j = 0; j < 8; ++j) { float hh_[2], aa_[2];
#pragma unroll
                        for (int cc = 0; cc < 2; ++cc) { const float gR = cc ? bfhi(gr[j]) : bflo(gr[j]), gI = cc ? bfhi(gi[j]) : bflo(gi[j]), uu = cc ? bfhi(uc[j]) : bflo(uc[j]);
                            const float rg = sigmoidf_(gR + br[cc]), ig = sigmoidf_(gI + bi[cc]);
                            const float a = __expf(-8.f * rg * sp[cc]), bb = sqrtf(fmaxf(1.f - a * a, 0.f)) * (ig * uu);
                            h[cc] = a * h[cc] + bb; A[cc] *= a; hh_[cc] = h[cc]; aa_[cc] = A[cc]; }
                        hv[j] = cvt2(hh_[0], hh_[1]); av[j] = cvt2(aa_[0], aa_[1]); }
                    if (t + 8 < 64) LRU_LOAD(t + 8);
#pragma unroll
                    for (int j = 0; j < 8; ++j) { LB2[(tok0 + t + j) * 512 + tid] = hv[j]; LA2[(tok0 + t + j) * 512 + tid] = av[j]; }
                }
#undef LRU_LOAD
                *(f32x2*)(CA + (size_t)bc * LRU_W + 2 * tid) = (f32x2){A[0], A[1]}; *(f32x2*)(CH + (size_t)bc * LRU_W + 2 * tid) = (f32x2){h[0], h[1]}; } }
    }
    SEAM(4);

    if (IN(5)) REP(5) {
        LANE_TID();
        if (bid < BATCH * NHEAD) {
            const bf16_t* MT = (const bf16_t*)(ws + WS_MT); const float* NN = (const float*)(ws + WS_NN); bf16_t* XS = (bf16_t*)(ws + WS_XS);
            constexpr int SLOT = 16384, NCH = SEQ / 64;
            const int u0 = bid * NCH;
            if (wave >= 2) {
                const int lw = wave - 2;
#define R2_ISSUE(c_) do { if (lw < 4) { const int _u = u0 + (c_); const int _sl = ((c_) & 3) * SLOT; _Pragma("unroll") for (int _rd = 0; _rd < 4; ++_rd) { const int _k0 = _rd * 256 + lw * 64; \
                    const char* _src = (_k0 < 512) ? (const char*)MT + (size_t)_u * 8192 + (size_t)(_k0 + lane) * 16 : (const char*)NN + (size_t)_u * 8192 + (size_t)(_k0 - 512 + lane) * 16; \
                    __builtin_amdgcn_global_load_lds((const unsigned*)_src, (LAS unsigned*)(lds + _sl + _k0 * 16), 16, 0, 0); } } } while (0)
                R2_ISSUE(0); R2_ISSUE(1); R2_ISSUE(2);
                for (int c = 0; c < NCH; ++c) {
                    if (c < NCH - 2) asm volatile("s_waitcnt vmcnt(8)" ::: "memory"); else if (c == NCH - 2) asm volatile("s_waitcnt vmcnt(4)" ::: "memory"); else asm volatile("s_waitcnt vmcnt(0)" ::: "memory");
                    __builtin_amdgcn_s_barrier();
                    asm volatile("" ::: "memory");
                    if (c + 3 < NCH) R2_ISSUE(c + 3);
                }
#undef R2_ISSUE
            } else {
                const int vh = wave;
                f32x16 X[2];
#pragma unroll
                for (int q = 0; q < 2; ++q)
#pragma unroll
                    for (int e = 0; e < 16; ++e) X[q][e] = 0.f;
                for (int c = 0; c < NCH; ++c) {
                    bf16x8 xb[2][2];
#pragma unroll
                    for (int q = 0; q < 2; ++q)
#pragma unroll
                        for (int s = 0; s < 2; ++s) { const u32x4 p = {cvt2(X[q][8 * s], X[q][8 * s + 1]), cvt2(X[q][8 * s + 2], X[q][8 * s + 3]), cvt2(X[q][8 * s + 4], X[q][8 * s + 5]), cvt2(X[q][8 * s + 6], X[q][8 * s + 7])};
                            xb[q][s] = __builtin_bit_cast(bf16x8, p);
                            *(u32x4*)(XS + (size_t)(u0 + c) * 4096 + (((vh * 2 + q) * 2 + s) * 64 + lane) * 8) = p; }
                    asm volatile("" ::: "memory");
                    __builtin_amdgcn_s_barrier();
                    asm volatile("" ::: "memory");
                    const LAS unsigned char* sl = lds + (c & 3) * SLOT;
#pragma unroll
                    for (int i = 0; i < 2; ++i) { f32x16 nx;
#pragma unroll
                        for (int e = 0; e < 16; e += 2) { const unsigned w_ = ((const LAS unsigned*)(sl + 8192))[((i * 2 + vh) * 8 + (e >> 1)) * 64 + lane]; nx[e] = bflo(w_); nx[e + 1] = bfhi(w_); }
#pragma unroll
                        for (int q = 0; q < 2; ++q)
#pragma unroll
                            for (int s = 0; s < 2; ++s) { const bf16x8 a = *(const LAS bf16x8*)(sl + ((i * 2 + q) * 2 + s) * 1024 + lane * 16); nx = MFMA32(a, xb[q][s], nx); }
                        X[i] = nx; }
                    asm volatile("s_waitcnt lgkmcnt(0)" ::: "memory");
                }
            }
        } else if (bid >= BATCH * NHEAD + 8) {
            const int nb_ = G - (BATCH * NHEAD + 8);
            for (int it = CV_NITEMS - CV_SHADOW + (bid - (BATCH * NHEAD + 8)) * NWAVES + wave; it < CV_NITEMS; it += nb_ * NWAVES) CONVERT_ITEM(it);
        } else {
            const float* CA = (const float*)(ws + WS_CA); const float* CH = (const float*)(ws + WS_CH); float* CIN = (float*)(ws + WS_CIN);
            const int i = (bid - BATCH * NHEAD) * NTHREADS + tid, b = i >> 10, c = i & 1023; float s = 0.f;
            for (int ch = 0; ch < 64; ch += 8) { float a[8], hh_[8];
#pragma unroll
                for (int j = 0; j < 8; ++j) { a[j] = CA[(size_t)(b * 64 + ch + j) * LRU_W + c]; hh_[j] = CH[(size_t)(b * 64 + ch + j) * LRU_W + c]; }
#pragma unroll
                for (int j = 0; j < 8; ++j) { CIN[(size_t)(b * 64 + ch + j) * LRU_W + c] = s; s = a[j] * s + hh_[j]; } }
        }
    }
    SEAM(5);

    if (IN(6)) REP(6) {
        LANE_TID();
        { const float* CIN = (const float*)(ws + WS_CIN);
            for (int idx0 = gt; idx0 < M * (LRU_W / 8); idx0 += 4 * NGT) {
                u32x4 gq4[4], hq4[4], aq4[4]; f32x4 c04[4], c14[4];
#pragma unroll
                for (int q = 0; q < 4; ++q) { const int idx = idx0 + q * NGT; if (idx < M * (LRU_W / 8)) { const int m = idx >> 7, c = (idx & 127) * 8; const size_t o = (size_t)m * LRU_W + c;
                    gq4[q] = *(const u32x4*)(P + (size_t)m * NPP + LRU_W + c); hq4[q] = *(const u32x4*)((const bf16_t*)LB + o); aq4[q] = *(const u32x4*)((const bf16_t*)LA + o);
                    c04[q] = *(const f32x4*)(CIN + (size_t)(m >> 6) * LRU_W + c); c14[q] = *(const f32x4*)(CIN + (size_t)(m >> 6) * LRU_W + c + 4); } }
#pragma unroll
                for (int q = 0; q < 4; ++q) { const int idx = idx0 + q * NGT; if (idx < M * (LRU_W / 8)) { const int m = idx >> 7, c = (idx & 127) * 8;
                    const u32x4 gq = gq4[q], hq = hq4[q], aq = aq4[q]; const f32x4 c0 = c04[q], c1 = c14[q];
                    const f32x4 h0 = {bflo(hq.x), bfhi(hq.x), bflo(hq.y), bfhi(hq.y)}, h1 = {bflo(hq.z), bfhi(hq.z), bflo(hq.w), bfhi(hq.w)}, a0 = {bflo(aq.x), bfhi(aq.x), bflo(aq.y), bfhi(aq.y)}, a1 = {bflo(aq.z), bfhi(aq.z), bflo(aq.w), bfhi(aq.w)};
                    const unsigned gw_[4] = {gq.x, gq.y, gq.z, gq.w}; float o8[8];
#pragma unroll
                    for (int e = 0; e < 4; ++e) { const float hA = (e < 2 ? h0[2 * e] : h1[2 * e - 4]) + (e < 2 ? a0[2 * e] : a1[2 * e - 4]) * (e < 2 ? c0[2 * e] : c1[2 * e - 4]);
                        const float hB = (e < 2 ? h0[2 * e + 1] : h1[2 * e - 3]) + (e < 2 ? a0[2 * e + 1] : a1[2 * e - 3]) * (e < 2 ? c0[2 * e + 1] : c1[2 * e - 3]);
                        o8[2 * e] = hA * gelu_tanh(bflo(gw_[e])); o8[2 * e + 1] = hB * gelu_tanh(bfhi(gw_[e])); }
                    *(u32x2*)((unsigned char*)CAT + (size_t)m * D + c) = (u32x2){pk4_f8(o8[0] * F8_SACT, o8[1] * F8_SACT, o8[2] * F8_SACT, o8[3] * F8_SACT), pk4_f8(o8[4] * F8_SACT, o8[5] * F8_SACT, o8[6] * F8_SACT, o8[7] * F8_SACT)}; } } } }
        const bf16_t* GG = (const bf16_t*)(ws + WS_GG); const bf16_t* XS = (const bf16_t*)(ws + WS_XS); const float* HH = (const float*)(ws + WS_HH);
        const bf16_t* V16 = (const bf16_t*)(ws + WS_V16); const bf16_t* G16 = (const bf16_t*)(ws + WS_G16);
        const float* gng = args.in[I_GNG]; const float* gnb = args.in[I_GNB];
        const int r = lane & 31, hh = lane >> 5;
        constexpr int YS = 68;
        LAS float* yt = (LAS float*)(lds + wave * (64 * YS * 4));
        for (int u = gw; u < NUNIT; u += NGW) {
            const int cch = u & 63, head = (u >> 6) & 15, b = u >> 10; const size_t tok0 = (size_t)b * SEQ + cch * 64;
            f32x16 acc[2][2];
#pragma unroll
            for (int i = 0; i < 2; ++i)
#pragma unroll
                for (int vh = 0; vh < 2; ++vh)
#pragma unroll
                    for (int e = 0; e < 16; e += 2) { const unsigned w_ = ((const unsigned*)HH)[(size_t)u * 2048 + ((i * 2 + vh) * 8 + (e >> 1)) * 64 + lane]; acc[i][vh][e] = bflo(w_); acc[i][vh][e + 1] = bfhi(w_); }
#pragma unroll
            for (int q = 0; q < 2; ++q)
#pragma unroll
                for (int s = 0; s < 2; ++s) { bf16x8 xb[2], ga[2];
#pragma unroll
                    for (int vh = 0; vh < 2; ++vh) xb[vh] = *(const bf16x8*)(XS + (size_t)u * 4096 + (((vh * 2 + q) * 2 + s) * 64 + lane) * 8);
#pragma unroll
                    for (int i = 0; i < 2; ++i) ga[i] = *(const bf16x8*)(GG + (size_t)u * 4096 + (((i * 2 + q) * 2 + s) * 64 + lane) * 8);
#pragma unroll
                    for (int i = 0; i < 2; ++i)
#pragma unroll
                        for (int vh = 0; vh < 2; ++vh) acc[i][vh] = MFMA32(ga[i], xb[vh], acc[i][vh]); }
#pragma unroll
            for (int i = 0; i < 2; ++i)
#pragma unroll
                for (int e = 0; e < 16; ++e) {
                    const float s1 = half_sum(acc[i][0][e] + acc[i][1][e], hh);
                    const float mean = s1 * (1.f / 64.f);
                    const float d0 = acc[i][0][e] - mean, d1 = acc[i][1][e] - mean; const float s2 = half_sum(d0 * d0 + d1 * d1, hh);
                    const float rstd = __builtin_amdgcn_rsqf(s2 * (1.f / 64.f) + GN_EPS);
                    const int t = 32 * i + crow(e, hh);
                    yt[t * YS + r] = d0 * rstd; yt[t * YS + 32 + r] = d1 * rstd; }
            asm volatile("s_waitcnt lgkmcnt(0)" ::: "memory");
            { const int tq = lane >> 3, c8 = (lane & 7) * 8, ch = head * HS + c8;
                const f32x4 g0 = *(const f32x4*)(gng + ch), g1 = *(const f32x4*)(gng + ch + 4), b0 = *(const f32x4*)(gnb + ch), b1 = *(const f32x4*)(gnb + ch + 4);
                u32x4 vq8[8], gq8[8]; float bon8[8];
#pragma unroll
                for (int k = 0; k < 8; ++k) { const size_t tok = tok0 + tq + 8 * k; const size_t o = tok * RW_W + ch; vq8[k] = *(const u32x4*)(V16 + o); gq8[k] = *(const u32x4*)(G16 + o); bon8[k] = BON[tok * NHEAD + head]; }
#pragma unroll
                for (int k = 0; k < 8; ++k) { const int t = tq + 8 * k; const size_t tok = tok0 + t;
                    const f32x4 y0 = *(const LAS f32x4*)(yt + t * YS + c8), y1 = *(const LAS f32x4*)(yt + t * YS + c8 + 4);
                    const u32x4 vq = vq8[k], gq = gq8[k]; const float bon = bon8[k];
                    const unsigned vw[4] = {vq.x, vq.y, vq.z, vq.w}, gw4[4] = {gq.x, gq.y, gq.z, gq.w}; float o8[8];
#pragma unroll
                    for (int e = 0; e < 4; ++e) { const float ya = (e < 2 ? y0[2 * e] : y1[2 * e - 4]), yb = (e < 2 ? y0[2 * e + 1] : y1[2 * e - 3]);
                        const float ga_ = (e < 2 ? g0[2 * e] : g1[2 * e - 4]), gb_ = (e < 2 ? g0[2 * e + 1] : g1[2 * e - 3]), ba_ = (e < 2 ? b0[2 * e] : b1[2 * e - 4]), bb_ = (e < 2 ? b0[2 * e + 1] : b1[2 * e - 3]);
                        o8[2 * e] = (ya * ga_ + ba_ + bon * bflo(vw[e])) * bflo(gw4[e]); o8[2 * e + 1] = (yb * gb_ + bb_ + bon * bfhi(vw[e])) * bfhi(gw4[e]); }
                    *(u32x2*)((unsigned char*)CAT + tok * D + LRU_W + ch) = (u32x2){pk4_f8(o8[0] * F8_SACT, o8[1] * F8_SACT, o8[2] * F8_SACT, o8[3] * F8_SACT), pk4_f8(o8[4] * F8_SACT, o8[5] * F8_SACT, o8[6] * F8_SACT, o8[7] * F8_SACT)}; } }
            asm volatile("s_waitcnt lgkmcnt(0)" ::: "memory");
        }
    }
    SEAM(6);

    if (IN(7)) REP(7) {
        LANE_TID();
        pg8::StaticOrder S; S.init(M, D, G, bid); S.nt = KD / 128;
        pg8::EpiResF32 E{Z, XN, DN_ALPHA, 1.f / (F8_SACT * F8_SW1)};
        pg8::gemm_phase<pg8::EpiResF32, pg8::StaticOrder, pg8::DenseRows, true, KD / 2, KD / 2, true>(lds, (const bf16_t*)CAT, (const bf16_t*)WoT, S, E, pg8::DenseRows{}, wave);
    }
    SEAM(7);

    if (IN(8)) {
        LANE_TID();
        constexpr int RSH = 4112;
        constexpr int L_LO = 16 * RSH, L_PART = 2 * 16 * RSH, L_G1 = L_PART + 16384, L_CNT = L_G1 + 8192, L_BASE = L_CNT + 128, L_PICK = L_BASE + 128;
        const float* g1 = args.in[I_LN1G]; const float* b1 = args.in[I_LN1B]; const float* br_ = args.in[I_BROUTER];
        const bf16_t* WRH = (const bf16_t*)(ws + WS_WRT); const bf16_t* WRL = WRH + NE * D;
        ((LAS f32x4*)(lds + L_G1))[tid] = ((const f32x4*)g1)[tid];
        if (tid < 32) ((LAS unsigned*)(lds + L_CNT))[tid] = 0u;
        int tl = 0;
#define P8_FLUSH() do { __syncthreads(); \
            if (tid < 32) { LAS unsigned* lc_ = (LAS unsigned*)(lds + L_CNT) + tid; const unsigned c_ = *lc_; ((LAS unsigned*)(lds + L_BASE))[tid] = c_ ? __hip_atomic_fetch_add(ctl + CW_CNT + 64 * tid, c_, RLX_AGENT) : 0u; *lc_ = 0u; } \
            __syncthreads(); \
            for (int pi = tid; pi < tl * 64; pi += NTHREADS) { const unsigned w0 = ((const LAS unsigned*)(lds + L_PICK))[2 * pi]; const float ge_ = ((const LAS float*)(lds + L_PICK))[2 * pi + 1]; \
                const int m_ = (int)(w0 & 16383u), be_ = (int)((w0 >> 14) & 31u), k_ = pi & 3; const int pos_ = (int)(((const LAS unsigned*)(lds + L_BASE))[be_] + (w0 >> 19)); \
                TOPE[m_ * 4 + k_] = be_; TOPP[m_ * 4 + k_] = pos_; SLOTTOK[be_ * LIST_CAP + pos_] = m_; SLOTG[be_ * LIST_CAP + pos_] = ge_; } \
            tl = 0; } while (0)
        for (int tile = bid; tile < M / 16; tile += G) {
            const int t0 = tile * 16;
            __syncthreads();
            { f32x4 v[2][8];
                f32x4 bq[8];
#pragma unroll
                for (int j = 0; j < 8; ++j) bq[j] = ((const f32x4*)b1)[64 * j + lane];
#pragma unroll
                for (int rr = 0; rr < 2; ++rr) { const f32x4* zr = (const f32x4*)(Z + (size_t)(t0 + wave * 2 + rr) * D) + lane;
#pragma unroll
                    for (int j = 0; j < 8; ++j) v[rr][j] = zr[64 * j]; }
#pragma unroll
                for (int rr = 0; rr < 2; ++rr) { const int tb = wave * 2 + rr, m = t0 + tb; float s = 0.f;
#pragma unroll
                    for (int j = 0; j < 8; ++j) s += (v[rr][j][0] + v[rr][j][1]) + (v[rr][j][2] + v[rr][j][3]);
                    const float mean = wave_sum(s) * (1.f / D); float s2 = 0.f;
#pragma unroll
                    for (int j = 0; j < 8; ++j) { v[rr][j] = v[rr][j] - mean; s2 += (v[rr][j][0] * v[rr][j][0] + v[rr][j][1] * v[rr][j][1]) + (v[rr][j][2] * v[rr][j][2] + v[rr][j][3] * v[rr][j][3]); }
                    const float rstd = __builtin_amdgcn_rsqf(wave_sum(s2) * (1.f / D) + LN_EPS);
                    u32x2* ho = (u32x2*)((bf16_t*)H1 + (size_t)m * D) + lane; unsigned* hb = (unsigned*)(H1F + (size_t)m * D) + lane;
#pragma unroll
                    for (int j = 0; j < 8; ++j) { const f32x4 y = v[rr][j] * rstd * ((const LAS f32x4*)(lds + L_G1))[64 * j + lane] + bq[j];
                        const u32x2 hi = {cvt2(y[0], y[1]), cvt2(y[2], y[3])};
                        const u32x2 lo = {cvt2(y[0] - bflo(hi.x), y[1] - bfhi(hi.x)), cvt2(y[2] - bflo(hi.y), y[3] - bfhi(hi.y))};
                        ho[64 * j] = hi; hb[64 * j] = pk4_f8(y[0] * F8_SH, y[1] * F8_SH, y[2] * F8_SH, y[3] * F8_SH);
                        *(LAS u32x2*)(lds + tb * RSH + 512 * j + 8 * lane) = hi; *(LAS u32x2*)(lds + L_LO + tb * RSH + 512 * j + 8 * lane) = lo; } } }
            __syncthreads();
            { const int c16 = lane & 15, q4 = lane >> 4; f32x4 acc[2] = {{0.f, 0.f, 0.f, 0.f}, {0.f, 0.f, 0.f, 0.f}};
#pragma unroll
                for (int kb = 0; kb < 2; ++kb) {
                    bf16x8 wq[4][2][2];
#pragma unroll
                    for (int k4 = 0; k4 < 4; ++k4) { const int k0 = 32 * (8 * wave + 4 * kb + k4) + 8 * q4;
#pragma unroll
                        for (int hf = 0; hf < 2; ++hf) { wq[k4][hf][0] = *(const bf16x8*)(WRH + (size_t)(hf * 16 + c16) * D + k0); wq[k4][hf][1] = *(const bf16x8*)(WRL + (size_t)(hf * 16 + c16) * D + k0); } }
                    __builtin_amdgcn_sched_barrier(0);
#pragma unroll
                    for (int k4 = 0; k4 < 4; ++k4) { const int k0 = 32 * (8 * wave + 4 * kb + k4) + 8 * q4;
                        const bf16x8 hh = *(const LAS bf16x8*)(lds + c16 * RSH + k0 * 2), hl = *(const LAS bf16x8*)(lds + L_LO + c16 * RSH + k0 * 2);
#pragma unroll
                        for (int hf = 0; hf < 2; ++hf) { const bf16x8 wh = wq[k4][hf][0], wl = wq[k4][hf][1];
                            acc[hf] = __builtin_amdgcn_mfma_f32_16x16x32_bf16(wh, hh, acc[hf], 0, 0, 0);
                            acc[hf] = __builtin_amdgcn_mfma_f32_16x16x32_bf16(wl, hh, acc[hf], 0, 0, 0);
                            acc[hf] = __builtin_amdgcn_mfma_f32_16x16x32_bf16(wh, hl, acc[hf], 0, 0, 0); } }
                    __builtin_amdgcn_sched_barrier(0); }
#pragma unroll
                for (int hf = 0; hf < 2; ++hf)
#pragma unroll
                    for (int g = 0; g < 4; ++g) ((LAS float*)(lds + L_PART))[((wave * 2 + hf) * 4 + g) * 64 + lane] = acc[hf][g]; }
            __syncthreads();
            { const int tk = tid >> 5, e = tid & 31, hf = e >> 4, el = e & 15; float sacc = br_[e];
#pragma unroll
                for (int w = 0; w < 8; ++w) sacc += ((const LAS float*)(lds + L_PART))[((w * 2 + hf) * 4 + (el & 3)) * 64 + tk + 16 * (el >> 2)];
                const int m = t0 + tk; float bv[4]; int bi[4]; bool used = false;
#pragma unroll
                for (int k = 0; k < 4; ++k) { float v = used ? -3.0e38f : sacc; int idx = e;
#pragma unroll
                    for (int off = 16; off >= 1; off >>= 1) { const float ov = __shfl_xor(v, off); const int oi = __shfl_xor(idx, off); const bool take = (ov > v) || (ov == v && oi < idx); v = take ? ov : v; idx = take ? oi : idx; }
                    bv[k] = v; bi[k] = idx; used = used || (idx == e); }
                float ex[4], den = 0.f;
#pragma unroll
                for (int k = 0; k < 4; ++k) { ex[k] = __expf(bv[k] - bv[0]); den += ex[k]; }
                if (e < 4) {
                    const int be = (e == 0) ? bi[0] : (e == 1) ? bi[1] : (e == 2) ? bi[2] : bi[3]; const float ge = ((e == 0) ? ex[0] : (e == 1) ? ex[1] : (e == 2) ? ex[2] : ex[3]) / den;
                    const unsigned lr = __hip_atomic_fetch_add((LAS unsigned*)(lds + L_CNT) + be, 1u, __ATOMIC_RELAXED, __HIP_MEMORY_SCOPE_WORKGROUP);
                    const int pi = tl * 64 + tk * 4 + e;
                    ((LAS unsigned*)(lds + L_PICK))[2 * pi] = (unsigned)m | ((unsigned)be << 14) | (lr << 19); ((LAS float*)(lds + L_PICK))[2 * pi + 1] = ge; } }
            if (++tl == 4) P8_FLUSH();
        }
        if (tl > 0) P8_FLUSH();
#undef P8_FLUSH
    }
    SEAM(8);

    if (IN(9)) REP(9) {
        LANE_TID();
        volatile LAS int* tb = (volatile LAS int*)(MISC + 16);
        moe_tables(tb, ctl, wave);
        pg8::MoeOrder S{(const LAS int*)(tb + 64), (const LAS int*)(tb + 1), tb[0], 16, G, bid, KD / 128};
        pg8::EpiSwiglu E{ACT, args.in[I_BE1]};
        pg8::gemm_phase<pg8::EpiSwiglu, pg8::MoeOrder, pg8::GatherRows, true, KD / 2, KD / 2, true>(lds, (const bf16_t*)H1F, (const bf16_t*)W1F, S, E, pg8::GatherRows{SLOTTOK}, wave);
    }
    SEAM(9);

    if (IN(10)) REP(10) {
        LANE_TID();
        volatile LAS int* tb = (volatile LAS int*)(MISC + 16);
        moe_tables(tb, ctl, wave);
        pg8::MoeOrder S{(const LAS int*)(tb + 64), (const LAS int*)(tb + 1), tb[0], 8, G, bid, KD / 128};
        pg8::EpiMoeOut E{OUTS, args.in[I_BE2], SLOTG};
        pg8::gemm_phase<pg8::EpiMoeOut, pg8::MoeOrder, pg8::DenseRows, true, KD / 2, KD / 2, true>(lds, (const bf16_t*)ACT, (const bf16_t*)W2F, S, E, pg8::DenseRows{}, wave);
    }
    SEAM(10);

    if (IN(11)) REP(11) {
        LANE_TID();
        const float* g2 = args.in[I_LN2G]; const float* b2 = args.in[I_LN2B];
        volatile LAS int* tb = (volatile LAS int*)(MISC + 16);
        moe_tables(tb, ctl, wave);
        for (int m = gw; m < M; m += NGW) {
            const u32x2* hr = (const u32x2*)((const bf16_t*)H1 + (size_t)m * D) + lane;
            const int e0 = TOPE[m * 4], e1 = TOPE[m * 4 + 1], e2 = TOPE[m * 4 + 2], e3 = TOPE[m * 4 + 3], p0 = TOPP[m * 4], p1 = TOPP[m * 4 + 1], p2 = TOPP[m * 4 + 2], p3 = TOPP[m * 4 + 3];
            const int s0 = tb[1 + e0] * 256 + p0, s1 = tb[1 + e1] * 256 + p1, s2_ = tb[1 + e2] * 256 + p2, s3 = tb[1 + e3] * 256 + p3;
            const float w0 = SLOTG[e0 * LIST_CAP + p0], w1 = SLOTG[e1 * LIST_CAP + p1], w2 = SLOTG[e2 * LIST_CAP + p2], w3 = SLOTG[e3 * LIST_CAP + p3];
            const u32x2* o0 = (const u32x2*)(OUTS + (size_t)s0 * D) + lane; const u32x2* o1 = (const u32x2*)(OUTS + (size_t)s1 * D) + lane;
            const u32x2* o2 = (const u32x2*)(OUTS + (size_t)s2_ * D) + lane; const u32x2* o3 = (const u32x2*)(OUTS + (size_t)s3 * D) + lane;
            f32x4 v[8]; float s = 0.f;
#pragma unroll
            for (int j = 0; j < 8; ++j) { const u32x2 hq = hr[64 * j]; const f32x4 h4 = {bflo(hq.x), bfhi(hq.x), bflo(hq.y), bfhi(hq.y)}; const u32x2 a = o0[64 * j], b = o1[64 * j], c = o2[64 * j], d = o3[64 * j];
                f32x4 mo; mo[0] = (w0 * bflo(a.x) + w1 * bflo(b.x)) + (w2 * bflo(c.x) + w3 * bflo(d.x)); mo[1] = (w0 * bfhi(a.x) + w1 * bfhi(b.x)) + (w2 * bfhi(c.x) + w3 * bfhi(d.x));
                mo[2] = (w0 * bflo(a.y) + w1 * bflo(b.y)) + (w2 * bflo(c.y) + w3 * bflo(d.y)); mo[3] = (w0 * bfhi(a.y) + w1 * bfhi(b.y)) + (w2 * bfhi(c.y) + w3 * bfhi(d.y));
                v[j] = h4 * DN_ALPHA + mo; s += (v[j][0] + v[j][1]) + (v[j][2] + v[j][3]); }
            const float mean = wave_sum(s) * (1.f / D); float q2 = 0.f;
#pragma unroll
            for (int j = 0; j < 8; ++j) { v[j] = v[j] - mean; q2 += (v[j][0] * v[j][0] + v[j][1] * v[j][1]) + (v[j][2] * v[j][2] + v[j][3] * v[j][3]); }
            const float rstd = 1.f / sqrtf(wave_sum(q2) * (1.f / D) + LN_EPS);
            f32x4* orow = (f32x4*)(args.out + (size_t)m * D) + lane;
#pragma unroll
            for (int j = 0; j < 8; ++j) { const f32x4 g4 = ((const f32x4*)g2)[64 * j + lane], b4 = ((const f32x4*)b2)[64 * j + lane]; orow[64 * j] = v[j] * rstd * g4 + b4; }
        }
    }
    if (PROBE_PHASE >= 0) { if (PROBE_PHASE == NPHASE - 1) tprobe1 = __builtin_amdgcn_s_memrealtime();
        asm volatile("s_waitcnt vmcnt(0)" ::: "memory"); __syncthreads();
        if (bid == 0 && wave == 0 && lane_now() == 0) args.out[0] += 1.0f + (float)(tprobe1 - tprobe0) * 1e-4f; }
#undef IN
#undef SEAM
}

#ifndef MK_ONE_LAUNCH
#define MK_ONE_LAUNCH 1
#endif
extern "C" void kernel_launch(void* const* d_in, const int* in_sizes, int n_in, void* d_out, int out_size, void* d_ws, size_t ws_size, hipStream_t stream) {
    static int grid = 0;
    if (grid == 0) {
        if (n_in != 33 || out_size != M * D || ws_size < WS_END) { fprintf(stderr, "kernel_launch: unexpected sizes n_in %d out %d ws %zu (need %zu)\n", n_in, out_size, ws_size, (size_t)WS_END); grid = -1; return; }
        int dev = 0, cus = 0, per_cu = 0;
        if (hipGetDevice(&dev) != hipSuccess || hipDeviceGetAttribute(&cus, hipDeviceAttributeMultiprocessorCount, dev) != hipSuccess) { grid = -1; return; }
        if (hipFuncSetAttribute((const void*)fwd, hipFuncAttributeMaxDynamicSharedMemorySize, LDS_BYTES) != hipSuccess) { fprintf(stderr, "kernel_launch: hipFuncSetAttribute failed\n"); grid = -1; return; }
        if (hipOccupancyMaxActiveBlocksPerMultiprocessor(&per_cu, (const void*)fwd, NTHREADS, LDS_BYTES) != hipSuccess || per_cu < 1) fprintf(stderr, "kernel_launch: occupancy query says %d\n", per_cu);
        (void)hipGetLastError();
        grid = cus;
    }
    if (grid < 0) return;
    (void)hipMemsetAsync((char*)d_ws + WS_CTL, 0, CTL_ZERO_BYTES, stream);
    Args a{};
    for (int i = 0; i < 33; ++i) a.in[i] = (const float*)d_in[i];
    a.out = (float*)d_out; a.ws = (unsigned char*)d_ws;
#if MK_ONE_LAUNCH
    a.ph_lo = 0; a.ph_hi = NPHASE; a.use_bar = 1;
    hipLaunchKernelGGL(fwd, dim3(grid), dim3(NTHREADS), LDS_BYTES, stream, a);
#else
    for (int p = 0; p < NPHASE; ++p) { a.ph_lo = p; a.ph_hi = p + 1; a.use_bar = 0;
        hipLaunchKernelGGL(fwd, dim3(grid), dim3(NTHREADS), LDS_BYTES, stream, a); }
#endif
}
```

```cpp
#include <hip/hip_runtime.h>
#include <cstdio>
#include <cstdint>

#define LAS __attribute__((address_space(3)))
#define GAS __attribute__((address_space(1)))
typedef unsigned short bf16_t;
typedef short bf16x8 __attribute__((ext_vector_type(8)));
typedef float f32x4 __attribute__((ext_vector_type(4)));
typedef float f32x2 __attribute__((ext_vector_type(2)));
typedef unsigned u32x4 __attribute__((ext_vector_type(4)));
typedef unsigned u32x2 __attribute__((ext_vector_type(2)));
typedef float f32x16 __attribute__((ext_vector_type(16)));
typedef int i32x4 __attribute__((ext_vector_type(4)));
typedef int i32x8 __attribute__((ext_vector_type(8)));
typedef __bf16 bfv2 __attribute__((ext_vector_type(2)));
#define MFMA32(a, b, c) __builtin_amdgcn_mfma_f32_32x32x16_bf16((a), (b), (c), 0, 0, 0)

constexpr int BATCH = 4, SEQ = 4096, M = BATCH * SEQ, D = 2048;
constexpr int LRU_W = 1024, RW_W = 1024, NHEAD = 16, HS = 64;
constexpr int DLORA = 96, ALORA = 96, GLORA = 256;
constexpr int RW_SHIFT_W = 3 * RW_W + DLORA + ALORA + GLORA;
constexpr int NP = 2 * LRU_W + RW_SHIFT_W;
constexpr int NPP = 5632;
constexpr int NE = 32, TOPK = 4, DE = 2048;
constexpr int NSLOT_MAX = M * TOPK + NE * 256;
constexpr int NTILE_MAX = NSLOT_MAX / 256;
constexpr float LN_EPS = 1e-5f, GN_EPS = 64e-5f;
constexpr float DN_ALPHA = 1.189207115002721f;
constexpr int KD = 2048;
constexpr int LIST_CAP = M;

constexpr size_t MiB = 1u << 20;
constexpr size_t WS_CTL = 0, CTL_ZERO_BYTES = 1 * MiB;
constexpr size_t WS_WIN = 2 * MiB;
constexpr size_t WS_WO = WS_WIN + (size_t)NPP * KD * 2;
constexpr size_t WS_W1 = WS_WO + (size_t)D * KD * 2;
constexpr size_t WS_W2 = WS_W1 + (size_t)NE * 2 * DE * KD * 2;
constexpr size_t WS_XN = WS_W2 + (size_t)NE * D * DE * 2;
constexpr size_t WS_P = WS_XN + (size_t)M * D * 2;
constexpr size_t WS_LA = WS_P + (size_t)M * NPP * 2;
constexpr size_t WS_LB = WS_LA + (size_t)M * LRU_W * 4;
constexpr size_t WS_UC = WS_LB + (size_t)M * LRU_W * 4;
constexpr size_t WS_XL = WS_UC + (size_t)M * LRU_W * 2;
constexpr size_t WS_GATES = WS_XL + (size_t)M * 512 * 2;
constexpr size_t WS_LOUT = WS_GATES + (size_t)M * 2048 * 2;
constexpr size_t WS_V16 = WS_LOUT + (size_t)M * 3072 * 2;
constexpr size_t WS_G16 = WS_V16 + (size_t)M * RW_W * 2;
constexpr size_t WS_WG = WS_G16 + (size_t)M * RW_W * 2;
constexpr size_t WS_WL = WS_WG + (size_t)2048 * 256 * 2;
constexpr size_t WS_RY = WS_WL + (size_t)3072 * 256 * 2;
constexpr size_t WS_BON = WS_RY;
constexpr size_t WS_CAT = WS_BON + (size_t)M * NHEAD * 4;
constexpr size_t WS_Z = WS_CAT + (size_t)M * D * 2;
constexpr size_t WS_H1 = WS_Z + (size_t)M * D * 4;
constexpr size_t WS_H1B = WS_H1 + (size_t)M * D * 4;
constexpr size_t WS_TOPE = WS_H1B + (size_t)M * D * 2;
constexpr size_t WS_TOPP = WS_TOPE + (size_t)M * TOPK * 4;
constexpr size_t WS_TOPG = WS_TOPP + (size_t)M * TOPK * 4;
constexpr size_t WS_TOKSLOT = WS_TOPG + (size_t)M * TOPK * 4;
constexpr size_t WS_SLOTTOK = WS_TOKSLOT + (size_t)M * TOPK * 4;
constexpr size_t WS_SLOTG = WS_SLOTTOK + (size_t)NE * LIST_CAP * 4;
constexpr size_t WS_ACT = WS_SLOTG + (size_t)NE * LIST_CAP * 4;
constexpr size_t WS_OUTS = WS_ACT + (size_t)NSLOT_MAX * DE * 2;
constexpr int NUNIT = BATCH * NHEAD * (SEQ / 64);
constexpr size_t WS_MT = WS_OUTS + (size_t)NSLOT_MAX * D * 2;
constexpr size_t WS_GG = WS_MT + (size_t)NUNIT * 8192;
constexpr size_t WS_XS = WS_GG + (size_t)NUNIT * 8192;
constexpr size_t WS_NN = WS_XS + (size_t)NUNIT * 8192;
constexpr size_t WS_HH = WS_NN + (size_t)NUNIT * 16384;
constexpr size_t WS_CA = WS_HH + (size_t)NUNIT * 16384;
constexpr size_t WS_CH = WS_CA + (size_t)BATCH * 64 * LRU_W * 4;
constexpr size_t WS_CIN = WS_CH + (size_t)BATCH * 64 * LRU_W * 4;
constexpr size_t WS_XG = WS_CIN + (size_t)BATCH * 64 * LRU_W * 4;
constexpr size_t WS_WRT = WS_XG + (size_t)NSLOT_MAX * D;
constexpr size_t WS_END = WS_WRT + (size_t)2 * NE * D * 2;
constexpr int CW_CNT = 1024;
constexpr int CW_BAR = 4096;

constexpr int MISC_OFF = 159744;
constexpr int LDS_BYTES = 163840;

#define RLX_AGENT __ATOMIC_RELAXED, __HIP_MEMORY_SCOPE_AGENT
__device__ __forceinline__ unsigned f2bf(float f) { unsigned u = __builtin_bit_cast(unsigned, f); return (u + 0x7fffu + ((u >> 16) & 1u)) >> 16; }
__device__ __forceinline__ unsigned pk2(float lo, float hi) { return f2bf(lo) | (f2bf(hi) << 16); }
__device__ __forceinline__ float bf2f(unsigned short b) { return __builtin_bit_cast(float, (unsigned)b << 16); }
__device__ __forceinline__ float bflo(unsigned w) { return __builtin_bit_cast(float, w << 16); }
__device__ __forceinline__ float bfhi(unsigned w) { return __builtin_bit_cast(float, w & 0xffff0000u); }
__device__ __forceinline__ unsigned cvt2(float a, float b) { const f32x2 v = {a, b}; return __builtin_bit_cast(unsigned, __builtin_convertvector(v, bfv2)); }
__device__ __forceinline__ unsigned short cvt1(float a) { return (unsigned short)(cvt2(a, 0.f) & 0xffffu); }
constexpr float F8_SH = 4.f, F8_SW1 = 32.f, F8_SACT = 4.f, F8_SW2 = 64.f;
__device__ __forceinline__ float f8clamp(float x) { return fminf(fmaxf(x, -448.f), 448.f); }
__device__ __forceinline__ unsigned pk4_f8_bounded(float a, float b, float c, float d) { int w = 0; w = __builtin_amdgcn_cvt_pk_fp8_f32(a, b, w, false); w = __builtin_amdgcn_cvt_pk_fp8_f32(c, d, w, true); return (unsigned)w; }
__device__ __forceinline__ unsigned pk4_f8(float a, float b, float c, float d) { int w = 0; w = __builtin_amdgcn_cvt_pk_fp8_f32(f8clamp(a), f8clamp(b), w, false); w = __builtin_amdgcn_cvt_pk_fp8_f32(f8clamp(c), f8clamp(d), w, true); return (unsigned)w; }
__device__ __forceinline__ int lane_now() { int l; asm volatile("v_mbcnt_lo_u32_b32 %0, -1, 0\n\tv_mbcnt_hi_u32_b32 %0, -1, %0" : "=v"(l)); return l; }
__device__ __forceinline__ int crow(int reg, int h) { return (reg & 3) + 8 * (reg >> 2) + 4 * h; }
__device__ __forceinline__ float row_sum16(float v) {
    v += __builtin_bit_cast(float, __builtin_amdgcn_update_dpp(0, __builtin_bit_cast(int, v), 0xB1, 0xf, 0xf, false));
    v += __builtin_bit_cast(float, __builtin_amdgcn_update_dpp(0, __builtin_bit_cast(int, v), 0x4E, 0xf, 0xf, false));
    v += __builtin_bit_cast(float, __builtin_amdgcn_update_dpp(0, __builtin_bit_cast(int, v), 0x141, 0xf, 0xf, false));
    v += __builtin_bit_cast(float, __builtin_amdgcn_update_dpp(0, __builtin_bit_cast(int, v), 0x140, 0xf, 0xf, false));
    return v;
}
__device__ __forceinline__ float rdlane(float v, int l) { return __builtin_bit_cast(float, __builtin_amdgcn_readlane(__builtin_bit_cast(int, v), l)); }
__device__ __forceinline__ float wave_sum(float v) { v = row_sum16(v); return (rdlane(v, 0) + rdlane(v, 16)) + (rdlane(v, 32) + rdlane(v, 48)); }
__device__ __forceinline__ float half_sum(float v, int hh) { v = row_sum16(v); const float lo = rdlane(v, 0) + rdlane(v, 16), hi = rdlane(v, 32) + rdlane(v, 48); return hh ? hi : lo; }
__device__ __forceinline__ float sigmoidf_(float x) { return __builtin_amdgcn_rcpf(1.f + __expf(-x)); }
__device__ __forceinline__ float gelu_tanh(float x) { const float u = 0.7978845608028654f * (x + 0.044715f * x * x * x); return x * __builtin_amdgcn_rcpf(1.f + __expf(-2.f * u)); }
__device__ __forceinline__ float tanh_fast(float x) { const float e = __expf(-2.f * fabsf(x)); const float t = (1.f - e) * __builtin_amdgcn_rcpf(1.f + e); return x < 0.f ? -t : t; }

#define XB_TMO      128
#define XB_XCNT(j)  (256  + 64 * (j))
#define XB_XSUB(j)  (1280 + 64 * (j))
#define XB_XGEN(j)  (2304 + 64 * (j))
#define XB_TOP      3328
#define XB_TOPGEN   3392
#define XCD_BAR_WORDS 3456
#define XB_SPIN_CAP (1u << 18)
__device__ __forceinline__ unsigned xb_ld(unsigned* p)              { return __hip_atomic_load(p, __ATOMIC_RELAXED, __HIP_MEMORY_SCOPE_AGENT); }
__device__ __forceinline__ unsigned xb_add(unsigned* p, unsigned v) { return __hip_atomic_fetch_add(p, v, __ATOMIC_RELAXED, __HIP_MEMORY_SCOPE_AGENT); }
__device__ __forceinline__ unsigned xb_xcc_id() { return (unsigned)__builtin_amdgcn_s_getreg((3 << 11) | 20) & 0xFu; }
#define XB_SPIN(cond, bar) do { unsigned _sp = 0; while (cond) { __builtin_amdgcn_s_sleep(1); \
    if ((++_sp & 255u) == 0u) { if (xb_ld(&(bar)[XB_TMO])) break; if (_sp > XB_SPIN_CAP) { atomicAdd(&(bar)[XB_TMO], 1u); break; } } } } while (0)
struct XcdBarrier { unsigned* bar; unsigned x; volatile LAS unsigned* st; };
__device__ __forceinline__ XcdBarrier xcd_barrier_post(unsigned* bar, volatile LAS unsigned* st) {
    XcdBarrier b; b.bar = bar; b.x = xb_xcc_id(); b.st = st;
    if (__builtin_amdgcn_readfirstlane(threadIdx.x >> 6) == 0 && lane_now() == 0) (void)xb_add(&bar[XB_XCNT(b.x)], 1u);
    return b;
}
__device__ __forceinline__ void xcd_barrier_complete(unsigned* bar, unsigned x, unsigned& nloc, unsigned& nx) {
    const unsigned G = gridDim.x * gridDim.y * gridDim.z;
    unsigned sum, cnt, mine, sp = 0u;
    for (;;) {
        sum = 0u; cnt = 0u; mine = 0u;
#pragma unroll
        for (unsigned j = 0; j < 16; ++j) { const unsigned c = xb_ld(&bar[XB_XCNT(j)]); sum += c; cnt += (c > 0u) ? 1u : 0u; mine = (j == x) ? c : mine; }
        if (sum == G) break;
        __builtin_amdgcn_s_sleep(1);
        if ((++sp & 255u) == 0u) { if (xb_ld(&bar[XB_TMO])) break; if (sp > XB_SPIN_CAP) { atomicAdd(&bar[XB_TMO], 1u); break; } }
    }
    nloc = mine > 0u ? mine : 1u; nx = cnt > 0u ? cnt : 1u;
}
__device__ __forceinline__ void xcd_barrier(const XcdBarrier& b, int wave_id) {
    asm volatile("s_waitcnt vmcnt(0)" ::: "memory");
    __syncthreads();
    if (wave_id == 0 && lane_now() == 0) {
        unsigned* bar = b.bar;
        __builtin_amdgcn_s_waitcnt(0);
        unsigned nloc = b.st[0], nx = b.st[1];
        if (nloc == 0u) { xcd_barrier_complete(bar, b.x, nloc, nx); b.st[0] = nloc; b.st[1] = nx; }
        const unsigned old = xb_add(&bar[XB_XSUB(b.x)], 1u);
        const unsigned gen = old / nloc;
        if (old + 1u == (gen + 1u) * nloc) {
            __builtin_amdgcn_fence(__ATOMIC_RELEASE, "agent");
            asm volatile("s_waitcnt vmcnt(0)" ::: "memory");
            const unsigned og = xb_add(&bar[XB_TOP], 1u);
            const unsigned tg = og / nx;
            if (og + 1u == (tg + 1u) * nx) xb_add(&bar[XB_TOPGEN], 1u);
            else XB_SPIN(xb_ld(&bar[XB_TOPGEN]) == tg, bar);
            __builtin_amdgcn_fence(__ATOMIC_ACQUIRE, "agent");
            xb_add(&bar[XB_XGEN(b.x)], 1u);
            asm volatile("s_waitcnt vmcnt(0)" ::: "memory");
        } else {
            XB_SPIN(xb_ld(&bar[XB_XGEN(b.x)]) == gen, bar);
            __builtin_amdgcn_fence(__ATOMIC_ACQUIRE, "agent");
            asm volatile("s_waitcnt vmcnt(0)" ::: "memory");
        }
    }
    __syncthreads();
}

namespace pg8 {
constexpr int BM = 256, BK = 64, HALF = 128, HTB = HALF * BK * 2, STAGE_BYTES = 8 * HTB, NXCD = 8, WGM = 8;
__host__ __device__ __forceinline__ int lds_byte(int r, int c) { const int st = (r >> 4) * 2 + (c >> 5), rr = r & 15, cc = c & 31, ob = rr * 64 + cc * 2; return st * 1024 + (ob ^ (((ob >> 9) & 1) << 5)); }
__host__ __device__ __forceinline__ void stage_rc(int b, int& R, int& C) { const int st = b / 1024, sb = b % 1024, swz = sb ^ (((sb >> 9) & 1) << 5); R = (st >> 1) * 16 + swz / 64; C = (st & 1) * 32 + (swz % 64) / 2; }
__host__ __device__ __forceinline__ int perm32(int rho) { const int n = rho >> 4, i = rho & 15; return 8 * (i >> 2) + 4 * n + (i & 3); }
__host__ __device__ __forceinline__ int f8_g(int R) { return ((R >> 1) & 1) + 4 * ((R >> 3) & 1); }
__host__ __device__ __forceinline__ int f8_lds_byte(int R, int c) { return R * 128 + (((c + f8_g(R)) & 7) << 4); }
__host__ __device__ __forceinline__ void f8_stage_rc(int pos, int& R, int& Cb) { const int P = pos >> 4; R = P >> 3; Cb = (((P & 7) - f8_g(R)) & 7) << 4; }
struct Unit { int pm, pn, ak, nt, ab; };
__device__ __forceinline__ unsigned cvt_pk_bf16(float lo, float hi) { unsigned r; asm volatile("v_cvt_pk_bf16_f32 %0, %1, %2" : "=v"(r) : "v"(lo), "v"(hi)); return r; }

struct StaticOrder {
    int nM, nN, nwg, G, c, nt = KD / BK;
    __device__ void init(int M_, int N_, int G_, int c_) { nM = M_ / BM; nN = N_ / BM; nwg = nM * nN; G = G_; c = c_; }
    __device__ bool next(int i, Unit& u) const {
        const long L = (long)i * G + c; if (L >= nwg) return false;
        int wgid = (int)L; { const int q = nwg / NXCD, r = nwg % NXCD, xcd = wgid % NXCD, off = wgid / NXCD; wgid = (xcd < r ? xcd * (q + 1) : r * (q + 1) + (xcd - r) * q) + off; }
        const int nig = WGM * nN, gid = wgid / nig, fm = gid * WGM, gsz = (nM - fm) < WGM ? (nM - fm) : WGM;
        u.pm = fm + ((wgid % nig) % gsz); u.pn = (wgid % nig) / gsz; u.ak = 0; u.nt = nt; u.ab = u.pm * BM; return true;
    }
};
struct MoeOrder {
    const LAS int* tile_e; const LAS int* toff; int R, NCT, G, c, nt;
    __device__ bool next(int i, Unit& u) const {
        int rt, ct;
        if (G == 256) { const int x = c & 7, j = c >> 3;
            if (NCT == 16) { rt = 16 * i + (x >> 1) * 4 + (j >> 3); ct = (x & 1) * 8 + (j & 7); }
            else           { rt = 32 * i + 4 * x + (j >> 3); ct = j & 7; } }
        else { const long L = (long)i * G + c; rt = (int)(L / NCT); ct = (int)(L % NCT); }
        if (rt >= R) return false;
        { const int e_ = tile_e[rt]; u.pm = rt; u.pn = e_ * NCT + ct; u.ak = 0; u.nt = nt; u.ab = e_ * LIST_CAP + (rt - toff[e_]) * BM; } return true;
    }
};
template <int MODE> struct SmallOrder {
    int G, c;
    __device__ bool next(int i, Unit& u) const {
        constexpr int NCT = MODE == 0 ? 8 : 12;
        const int L = i * G + c; if (L >= (M / BM) * NCT) return false;
        u.pm = L / NCT; u.pn = L % NCT; u.ab = u.pm * BM;
        if (MODE == 0) { u.ak = 256 * (u.pn & 3); u.nt = 4; }
        else { u.ak = u.pn < 4 ? 0 : (u.pn < 8 ? 128 : 256); u.nt = u.pn < 8 ? 2 : 4; }
        return true;
    }
};
struct DenseRows { static constexpr bool DENSE = true; __device__ __forceinline__ const int* idxp() const { return nullptr; } __device__ __forceinline__ unsigned row(int pm, int r) const { return (unsigned)(pm * BM + r); } };
struct GatherRows { static constexpr bool DENSE = false; const int* idx; __device__ __forceinline__ const int* idxp() const { return idx; } __device__ __forceinline__ unsigned row(int pm, int r) const { return (unsigned)idx[pm * BM + r]; } };

struct EpiBf16 {
    static constexpr bool PERM = true; static constexpr int NSTORE = 16;
    bf16_t* O; int ldc;
    __device__ __forceinline__ void operator()(const f32x4 (&acc)[2][2][4][2], const Unit& u, int wr, int wc, int fr, int fq) const {
        const int row0 = u.pm * BM + wr * 64 + fr, col0 = u.pn * BM + wc * 32 + 8 * fq;
#pragma unroll
        for (int ai = 0; ai < 2; ++ai)
#pragma unroll
            for (int m = 0; m < 4; ++m) { bf16_t* rowp = O + (size_t)(row0 + ai * HALF + m * 16) * ldc + col0;
#pragma unroll
                for (int bj = 0; bj < 2; ++bj) { const f32x4 v0 = acc[ai][bj][m][0], v1 = acc[ai][bj][m][1];
                    u32x4 w; w.x = cvt_pk_bf16(v0[0], v0[1]); w.y = cvt_pk_bf16(v0[2], v0[3]); w.z = cvt_pk_bf16(v1[0], v1[1]); w.w = cvt_pk_bf16(v1[2], v1[3]);
                    *(u32x4*)(rowp + bj * HALF) = w; } }
    }
};
struct EpiResBf16 {
    static constexpr bool PERM = true; static constexpr int NSTORE = 16;
    bf16_t* O; const bf16_t* R; float alpha, sc;
    __device__ __forceinline__ void operator()(const f32x4 (&acc)[2][2][4][2], const Unit& u, int wr, int wc, int fr, int fq) const {
        const int row0 = u.pm * BM + wr * 64 + fr, col0 = u.pn * BM + wc * 32 + 8 * fq;
#pragma unroll
        for (int ai = 0; ai < 2; ++ai) { u32x4 rb[4][2];
#pragma unroll
            for (int m = 0; m < 4; ++m)
#pragma unroll
                for (int bj = 0; bj < 2; ++bj) rb[m][bj] = *(const u32x4*)(R + (size_t)(row0 + ai * HALF + m * 16) * D + col0 + bj * HALF);
#pragma unroll
            for (int m = 0; m < 4; ++m) { bf16_t* rowp = O + (size_t)(row0 + ai * HALF + m * 16) * D + col0;
#pragma unroll
                for (int bj = 0; bj < 2; ++bj) { const u32x4 r = rb[m][bj]; f32x4 v0 = acc[ai][bj][m][0] * sc, v1 = acc[ai][bj][m][1] * sc;
                    v0[0] += alpha * bflo(r.x); v0[1] += alpha * bfhi(r.x); v0[2] += alpha * bflo(r.y); v0[3] += alpha * bfhi(r.y);
                    v1[0] += alpha * bflo(r.z); v1[1] += alpha * bfhi(r.z); v1[2] += alpha * bflo(r.w); v1[3] += alpha * bfhi(r.w);
                    u32x4 w; w.x = cvt_pk_bf16(v0[0], v0[1]); w.y = cvt_pk_bf16(v0[2], v0[3]); w.z = cvt_pk_bf16(v1[0], v1[1]); w.w = cvt_pk_bf16(v1[2], v1[3]);
                    *(u32x4*)(rowp + bj * HALF) = w; } } }
    }
};
struct EpiResF32 {
    static constexpr bool PERM = false; static constexpr int NSTORE = 32;
    float* Z; const bf16_t* R; float alpha, sc;
    __device__ __forceinline__ void operator()(const f32x4 (&acc)[2][2][4][2], const Unit& u, int wr, int wc, int fr, int fq) const {
        const int row0 = u.pm * BM + wr * 64 + fr, col0 = u.pn * BM + wc * 32 + 4 * fq;
#pragma unroll
        for (int ai = 0; ai < 2; ++ai)
#pragma unroll
            for (int mp = 0; mp < 2; ++mp) {
                u32x2 rb[2][2][2];
#pragma unroll
                for (int m2 = 0; m2 < 2; ++m2)
#pragma unroll
                    for (int bj = 0; bj < 2; ++bj)
#pragma unroll
                        for (int n = 0; n < 2; ++n) rb[m2][bj][n] = *(const u32x2*)(R + (size_t)(row0 + ai * HALF + (2 * mp + m2) * 16) * D + col0 + bj * HALF + n * 16);
#pragma unroll
                for (int m2 = 0; m2 < 2; ++m2) { const int m = 2 * mp + m2; const size_t off = (size_t)(row0 + ai * HALF + m * 16) * D + col0;
#pragma unroll
                    for (int bj = 0; bj < 2; ++bj)
#pragma unroll
                        for (int n = 0; n < 2; ++n) { const u32x2 r2 = rb[m2][bj][n];
                            f32x4 o = acc[ai][bj][m][n] * sc; o[0] += alpha * bflo(r2.x); o[1] += alpha * bfhi(r2.x); o[2] += alpha * bflo(r2.y); o[3] += alpha * bfhi(r2.y);
                            *(f32x4*)(Z + off + bj * HALF + n * 16) = o; } } }
    }
};
typedef float f32x2 __attribute__((ext_vector_type(2)));
struct EpiSwiglu {
    static constexpr bool PERM = true; static constexpr int NSTORE = 8;
    unsigned char* O; const float* b1;
    __device__ __forceinline__ void operator()(const f32x4 (&acc)[2][2][4][2], const Unit& u, int wr, int wc, int fr, int fq) const {
        const int e = u.pn >> 4, ct = u.pn & 15;
        const int row0 = u.pm * BM + wr * 64 + fr, cin = wc * 32 + 8 * fq, col0 = ct * HALF + cin;
        const float* bg = b1 + (size_t)e * 2 * DE + col0; const float* bu = bg + DE;
        const f32x4 bg0 = *(const f32x4*)bg, bg1 = *(const f32x4*)(bg + 4), bu0 = *(const f32x4*)bu, bu1 = *(const f32x4*)(bu + 4);
        constexpr float inv = 1.f / (F8_SH * F8_SW1), invu = F8_SACT * inv, cexp = -1.702f * 1.44269504f;
        const f32x4 bu0s = (bu0 + 1.f) * (float)F8_SACT, bu1s = (bu1 + 1.f) * (float)F8_SACT;
#pragma unroll
        for (int ai = 0; ai < 2; ++ai)
#pragma unroll
            for (int m = 0; m < 4; ++m) { unsigned char* rowp = O + (size_t)(row0 + ai * HALF + m * 16) * DE + col0;
                float o[8];
#pragma unroll
                for (int n = 0; n < 2; ++n) { const f32x4 ga = acc[ai][0][m][n], ua = acc[ai][1][m][n], bgv = n ? bg1 : bg0, buv = n ? bu1s : bu0s;
#pragma unroll
                    for (int jp = 0; jp < 2; ++jp) {
                        f32x2 g = (f32x2){ga[2 * jp], ga[2 * jp + 1]} * inv + (f32x2){bgv[2 * jp], bgv[2 * jp + 1]};
                        f32x2 up = (f32x2){ua[2 * jp], ua[2 * jp + 1]} * invu + (f32x2){buv[2 * jp], buv[2 * jp + 1]};
                        g = (f32x2){fminf(g[0], 7.f), fminf(g[1], 7.f)};
                        up = (f32x2){__builtin_amdgcn_fmed3f(up[0], -6.f * F8_SACT, 8.f * F8_SACT), __builtin_amdgcn_fmed3f(up[1], -6.f * F8_SACT, 8.f * F8_SACT)};
                        const f32x2 t = g * cexp;
                        const f32x2 d = (f32x2){__builtin_amdgcn_exp2f(t[0]), __builtin_amdgcn_exp2f(t[1])} + 1.f;
                        const f32x2 r = (g * up) * (f32x2){__builtin_amdgcn_rcpf(d[0]), __builtin_amdgcn_rcpf(d[1])};
                        o[n * 4 + 2 * jp] = r[0]; o[n * 4 + 2 * jp + 1] = r[1]; } }
                *(u32x2*)rowp = (u32x2){pk4_f8_bounded(o[0], o[1], o[2], o[3]), pk4_f8_bounded(o[4], o[5], o[6], o[7])}; }
    }
};
struct EpiMoeOut {
    static constexpr bool PERM = true; static constexpr int NSTORE = 16;
    bf16_t* O; const float* b2; const float* sg;
    __device__ __forceinline__ void operator()(const f32x4 (&acc)[2][2][4][2], const Unit& u, int wr, int wc, int fr, int fq) const {
        const int e = u.pn >> 3, ct = u.pn & 7;
        const int row0 = u.pm * BM + wr * 64 + fr, col0 = ct * BM + wc * 32 + 8 * fq;
        f32x4 bv[2][2];
#pragma unroll
        for (int bj = 0; bj < 2; ++bj)
#pragma unroll
            for (int n = 0; n < 2; ++n) bv[bj][n] = *(const f32x4*)(b2 + (size_t)e * D + col0 + bj * HALF + 4 * n);
#pragma unroll
        for (int ai = 0; ai < 2; ++ai)
#pragma unroll
            for (int m = 0; m < 4; ++m) { const int row = row0 + ai * HALF + m * 16; bf16_t* rowp = O + (size_t)row * D + col0;
#pragma unroll
                for (int bj = 0; bj < 2; ++bj) { const f32x4 v0 = acc[ai][bj][m][0] * (1.f / (F8_SACT * F8_SW2)) + bv[bj][0], v1 = acc[ai][bj][m][1] * (1.f / (F8_SACT * F8_SW2)) + bv[bj][1];
                    u32x4 w; w.x = cvt_pk_bf16(v0[0], v0[1]); w.y = cvt_pk_bf16(v0[2], v0[3]); w.z = cvt_pk_bf16(v1[0], v1[1]); w.w = cvt_pk_bf16(v1[2], v1[3]);
                    *(u32x4*)(rowp + bj * HALF) = w; } }
    }
};

template <class Epi, class Sched, class ARows, bool ALIGN_EPI, int LDA = KD, int LDB = KD, bool F8 = false>
__device__ __forceinline__ void gemm_phase(LAS unsigned char* lds, const bf16_t* A, const bf16_t* Bt, const Sched& S, const Epi& E, const ARows& AR, const int wid) {
    const int lane = lane_now(), tid = wid * 64 + lane, wr = wid >> 2, wc = wid & 3, fr = lane & 15, fq = lane >> 4;
    int sR[2], sC[2]; unsigned voffB[2];
#pragma unroll
    for (int i = 0; i < 2; ++i) { if constexpr (F8) { int cb_; f8_stage_rc(tid * 16 + i * 8192, sR[i], cb_); sC[i] = cb_ >> 1; } else stage_rc(tid * 16 + i * 8192, sR[i], sC[i]); const int Rb = Epi::PERM ? ((sR[i] & ~31) + perm32(sR[i] & 31)) : sR[i];
        voffB[i] = (unsigned)(Rb * LDB + sC[i]) * 2u; }
    constexpr size_t kstep = (size_t)(BK * 2);
    constexpr size_t hstep = (size_t)HALF * LDB * 2;
    constexpr size_t tstep = 2 * hstep;
    const unsigned ldsw = (unsigned)wid * 1024u;
    int aoffs[2], boffs[2];
    if constexpr (F8) { aoffs[0] = f8_lds_byte(wr * 64 + fr, 2 * fq); aoffs[1] = f8_lds_byte(wr * 64 + fr, 2 * fq + 1); boffs[0] = 4 * HTB + f8_lds_byte(wc * 32 + fr, 2 * fq); boffs[1] = 4 * HTB + f8_lds_byte(wc * 32 + fr, 2 * fq + 1); }
    else { aoffs[0] = lds_byte(wr * 64 + fr, fq * 8); aoffs[1] = aoffs[0] + 1024; boffs[0] = 4 * HTB + lds_byte(wc * 32 + fr, fq * 8); boffs[1] = boffs[0] + 1024; }
#define PG8_SA(b, h) (((b) * 2 + (h)) * HTB)
#define PG8_SB(b, h) ((4 + (b) * 2 + (h)) * HTB)
#define PG8_SBR(b, h) (((b) * 2 + (h)) * HTB)
#define PG8_STAGE(bufoff, gbase, voff) do { const char* gb_ = (const char*)(gbase); _Pragma("unroll") for (int _i = 0; _i < 2; ++_i) { \
        asm volatile("s_mov_b32 m0, %2\n\ts_nop 0\n\tglobal_load_lds_dwordx4 %0, %1" : : "v"((voff)[_i]), "s"(gb_), "s"((unsigned)((bufoff) + ldsw + _i * 8192)) : "memory", "m0"); } } while (0)
#define PG8_LDA(dst, b, h) do { _Pragma("unroll") for (int m = 0; m < 4; ++m) { if constexpr (F8) { const i32x4 lo_ = *(const LAS i32x4*)(lds + PG8_SA(b, h) + aoffs[0] + m * 2048), hi_ = *(const LAS i32x4*)(lds + PG8_SA(b, h) + aoffs[1] + m * 2048); \
            dst##8[m] = __builtin_shufflevector(lo_, hi_, 0, 1, 2, 3, 4, 5, 6, 7); } else { _Pragma("unroll") for (int k = 0; k < 2; ++k) dst[m][k] = *(const LAS bf16x8*)(lds + PG8_SA(b, h) + aoffs[k] + m * 2048); } } } while (0)
#define PG8_LDB(dst, b, h) do { _Pragma("unroll") for (int n = 0; n < 2; ++n) { if constexpr (F8) { const i32x4 lo_ = *(const LAS i32x4*)(lds + PG8_SBR(b, h) + boffs[0] + n * 2048), hi_ = *(const LAS i32x4*)(lds + PG8_SBR(b, h) + boffs[1] + n * 2048); \
            dst##8[n] = __builtin_shufflevector(lo_, hi_, 0, 1, 2, 3, 4, 5, 6, 7); } else { _Pragma("unroll") for (int k = 0; k < 2; ++k) dst[n][k] = *(const LAS bf16x8*)(lds + PG8_SBR(b, h) + boffs[k] + n * 2048); } } } while (0)
#define PG8_MMA(ai, bj, At, Bt_) do { __builtin_amdgcn_s_setprio(1); _Pragma("unroll") for (int m = 0; m < 4; ++m) _Pragma("unroll") for (int n = 0; n < 2; ++n) { \
        if constexpr (F8) { acc[ai][bj][m][n] = __builtin_amdgcn_mfma_scale_f32_16x16x128_f8f6f4(Bt_##8[n], At##8[m], acc[ai][bj][m][n], 0, 0, 0, 0x7f7f7f7f, 0, 0x7f7f7f7f); } \
        else { _Pragma("unroll") for (int k = 0; k < 2; ++k) acc[ai][bj][m][n] = __builtin_amdgcn_mfma_f32_16x16x32_bf16(Bt_[n][k], At[m][k], acc[ai][bj][m][n], 0, 0, 0); } } __builtin_amdgcn_s_setprio(0); } while (0)
#define PG8_WAIT_V(n) asm volatile("s_waitcnt vmcnt(" #n ")" ::: "memory")
#define PG8_WAIT_VR(rx) asm volatile("s_cmp_eq_u32 %0, 0\n\ts_cbranch_scc1 1f\n\ts_waitcnt vmcnt(8)\n1:\n\ts_waitcnt vmcnt(%1)" : : "s"(rx), "n"(8 + Epi::NSTORE) : "scc", "memory")
#define PG8_WAIT_L(n) asm volatile("s_waitcnt lgkmcnt(" #n ")" ::: "memory")
#define PG8_BAR __builtin_amdgcn_s_barrier()
#define PG8_SCHED __builtin_amdgcn_sched_barrier(0)
#define PG8_AOFF(dst, u) do { const int tq_ = wid * 64 + lane_now(); _Pragma("unroll") for (int _i = 0; _i < 2; ++_i) { int R_, C_; if constexpr (F8) { int cb_; f8_stage_rc(tq_ * 16 + _i * 8192, R_, cb_); C_ = cb_ >> 1; } else stage_rc(tq_ * 16 + _i * 8192, R_, C_); \
        _Pragma("unroll") for (int _h = 0; _h < 2; ++_h) { \
        if constexpr (ARows::DENSE) dst[_h][_i] = (unsigned)(R_ * LDA + C_) * 2u; \
        else dst[_h][_i] = (AR.row((u).pm, _h * HALF + R_) * (unsigned)LDA + (unsigned)((u).ak + C_)) * 2u; } } } while (0)
#define PG8_ABASE(u) (ARows::DENSE ? (const char*)A + ((size_t)(u).pm * BM * LDA + (u).ak) * 2 : (const char*)A)
    constexpr size_t ahstep = ARows::DENSE ? (size_t)HALF * LDA * 2 : 0;
    Unit cur, nxt; int ui = 0;
    if (!S.next(0, cur)) return;
    f32x4 acc[2][2][4][2];
#pragma unroll
    for (int a = 0; a < 2; ++a)
#pragma unroll
        for (int b = 0; b < 2; ++b)
#pragma unroll
            for (int m = 0; m < 4; ++m)
#pragma unroll
                for (int n = 0; n < 2; ++n) acc[a][b][m][n] = (f32x4){0.f, 0.f, 0.f, 0.f};
    bf16x8 At[4][2], B0[2][2], B1[2][2]; i32x8 At8[4], B08[2], B18[2];
    unsigned ao[2][2];
    if constexpr (ARows::DENSE) { PG8_AOFF(ao, cur); } else { ao[0][0] = ao[0][1] = ao[1][0] = ao[1][1] = 0u; }
    unsigned gpk = 0u;
    if constexpr (!ARows::DENSE && F8) { int r_, cb_; f8_stage_rc(tid * 16, r_, cb_); gpk = (unsigned)(r_ * 4) | ((unsigned)cb_ << 16); asm volatile("" : "+v"(gpk)); }
    constexpr int TBL = 131072;
#define PG8_STAGE_A(bufoff, base, h_, slot_) do { if constexpr (ARows::DENSE) { PG8_STAGE(bufoff, (base) + ((h_) ? ahstep : (size_t)0), ao[0]); } else { \
        unsigned go_[2]; if constexpr (F8) { const LAS unsigned* tp_ = (const LAS unsigned*)(lds + TBL + (slot_) * 1024 + (h_) * HALF * 4 + (gpk & 0xffffu)); const unsigned cb_ = gpk >> 16; \
            go_[0] = tp_[0] * (unsigned)(2 * LDA) + cb_; go_[1] = tp_[64] * (unsigned)(2 * LDA) + cb_; }     \
        else { const int tq_ = wid * 64 + lane_now(); _Pragma("unroll") for (int _i = 0; _i < 2; ++_i) { int R_, C_; stage_rc(tq_ * 16 + _i * 8192, R_, C_); \
            const unsigned row_ = *(const LAS unsigned*)(lds + TBL + (slot_) * 1024 + ((h_) * HALF + R_) * 4); go_[_i] = (row_ * (unsigned)LDA + (unsigned)C_) * 2u; } } \
        PG8_STAGE(bufoff, base, go_); } } while (0)
#define PG8_TBL_FILL(u, slot_) do { if (wid < 4) { const unsigned vo_ = (unsigned)((u).ab + wid * 64 + lane_now()) * 4u; const char* ib_ = (const char*)AR.idxp(); \
        asm volatile("s_mov_b32 m0, %2\n\ts_nop 0\n\tglobal_load_lds_dword %0, %1" : : "v"(vo_), "s"(ib_), "s"((unsigned)(TBL + (slot_) * 1024 + wid * 256)) : "memory", "m0"); } } while (0)
    const char* cA = PG8_ABASE(cur);
    const char* cB = (const char*)Bt + (size_t)cur.pn * tstep;
    if constexpr (!ARows::DENSE) { PG8_TBL_FILL(cur, 0); PG8_WAIT_V(0); PG8_BAR; }
    PG8_STAGE(PG8_SB(0, 0), cB, voffB); PG8_STAGE(PG8_SB(0, 1), cB + hstep, voffB); PG8_STAGE_A(PG8_SA(0, 0), cA, 0, 0); PG8_STAGE_A(PG8_SA(0, 1), cA, 1, 0);
    if (wr == 1) PG8_BAR;
    PG8_WAIT_V(2); PG8_BAR;
    PG8_STAGE(PG8_SB(1, 0), cB + kstep, voffB); PG8_STAGE_A(PG8_SA(1, 0), cA + kstep, 0, 0); PG8_STAGE(PG8_SB(1, 1), cB + hstep + kstep, voffB);
    PG8_WAIT_V(6); PG8_BAR;
    for (;;) {
        const bool has_next = S.next(ui + 1, nxt);
        const int slc = ui & 1, sln = has_next ? (slc ^ 1) : slc;
        if constexpr (!ARows::DENSE) { if (has_next) PG8_TBL_FILL(nxt, sln); }
        const char* nB = has_next ? (const char*)Bt + (size_t)nxt.pn * tstep : cB;
        const char* nA = has_next ? PG8_ABASE(nxt) : cA;
        const int nt = cur.nt, rbase = __builtin_amdgcn_readfirstlane((ui == 0) ? 1 : 0);
#pragma unroll 1
        for (int t = 0; t < nt; t += 2) {
            const bool last = (t == nt - 2); const int relax = t + rbase;
            const char* a1 = cA + (size_t)(t + 1) * kstep;
            const char* a2 = last ? nA : cA + (size_t)(t + 2) * kstep; const char* b2 = last ? nB : cB + (size_t)(t + 2) * kstep;
            const char* a3 = a2 + kstep; const char* b3 = b2 + kstep;
            const int sl2 = last ? sln : slc;
            PG8_LDB(B0, 0, 0); PG8_LDB(B1, 0, 1); PG8_SCHED; PG8_LDA(At, 0, 0); PG8_STAGE_A(PG8_SA(1, 1), a1, 1, slc);
            PG8_WAIT_VR(relax); PG8_WAIT_L(0); PG8_BAR; PG8_MMA(0, 0, At, B0); PG8_MMA(0, 1, At, B1); PG8_BAR; PG8_SCHED;
            PG8_LDA(At, 0, 1); PG8_STAGE(PG8_SB(0, 0), b2, voffB); PG8_STAGE(PG8_SB(0, 1), b2 + hstep, voffB); PG8_STAGE_A(PG8_SA(0, 0), a2, 0, sl2);
            PG8_WAIT_VR(relax); PG8_WAIT_L(0); PG8_BAR; PG8_MMA(1, 0, At, B0); PG8_MMA(1, 1, At, B1); PG8_BAR; PG8_SCHED;
            PG8_LDB(B0, 1, 0); PG8_LDB(B1, 1, 1); PG8_SCHED; PG8_LDA(At, 1, 0); PG8_STAGE_A(PG8_SA(0, 1), a2, 1, sl2);
            PG8_WAIT_V(8); PG8_WAIT_L(0); PG8_BAR; PG8_MMA(0, 0, At, B0); PG8_MMA(0, 1, At, B1); PG8_BAR; PG8_SCHED;
            PG8_LDA(At, 1, 1); PG8_STAGE(PG8_SB(1, 0), b3, voffB); PG8_STAGE(PG8_SB(1, 1), b3 + hstep, voffB); PG8_STAGE_A(PG8_SA(1, 0), a3, 0, sl2);
            PG8_WAIT_V(8); PG8_WAIT_L(0); PG8_BAR; PG8_MMA(1, 0, At, B0); PG8_MMA(1, 1, At, B1); PG8_BAR; PG8_SCHED;
        }
        if constexpr (ALIGN_EPI) { if (wr == 0) PG8_BAR; }
        asm volatile("" : "+s"(cur.pm), "+s"(cur.pn));
        { const int tz = lane_now();
          E(acc, cur, wr, wc, tz & 15, (tz & 63) >> 4); }
        if (!has_next) break;
#pragma unroll
        for (int a = 0; a < 2; ++a)
#pragma unroll
            for (int b = 0; b < 2; ++b)
#pragma unroll
                for (int m = 0; m < 4; ++m)
#pragma unroll
                    for (int n = 0; n < 2; ++n) acc[a][b][m][n] = (f32x4){0.f, 0.f, 0.f, 0.f};
        cur = nxt; cB = nB; cA = nA; ++ui;
        if constexpr (ALIGN_EPI) { if (wr == 1) PG8_BAR; }
    }
    PG8_WAIT_V(0);
    if constexpr (!ALIGN_EPI) { if (wr == 0) PG8_BAR; }
    PG8_BAR;
#undef PG8_SA
#undef PG8_SB
#undef PG8_SBR
#undef PG8_STAGE
#undef PG8_LDA
#undef PG8_LDB
#undef PG8_MMA
#undef PG8_WAIT_V
#undef PG8_WAIT_L
#undef PG8_BAR
#undef PG8_SCHED
#undef PG8_AOFF
#undef PG8_WAIT_VR
#undef PG8_STAGE_A
#undef PG8_TBL_FILL
}
}

constexpr int NWAVES = 8, NTHREADS = 512;
constexpr int NPHASE = 12;
struct Args {
    const float* in[33]; float* out; unsigned char* ws; int ph_lo, ph_hi, use_bar, pad;
};
enum { I_X = 0, I_LNG, I_LNB, I_WIN, I_CONVW, I_CONVB, I_WRG, I_BRG, I_WIG, I_BIG, I_LAMBDA, I_MU, I_W0, I_DECUP, I_A0, I_AAAUP, I_GATEUP,
       I_KK, I_KA, I_RK, I_GNG, I_GNB, I_WOUT, I_LN1G, I_LN1B, I_WROUTER, I_BROUTER, I_WE1, I_BE1, I_WE2, I_BE2, I_LN2G, I_LN2B };

__device__ __forceinline__ void transpose_item(const float* W, int N, bf16_t* WT, int k0, int n0, int dst_row0, LAS float* scr, int lane) {
#pragma unroll 8
    for (int i = 0; i < 32; ++i) { const int kk = 2 * i + (lane >> 5); scr[kk * 33 + (lane & 31)] = W[(size_t)(k0 + kk) * N + n0 + (lane & 31)]; }
    asm volatile("s_waitcnt lgkmcnt(0)" ::: "memory");
    const int c = lane & 7;
#pragma unroll
    for (int j = 0; j < 4; ++j) { const int n = (lane >> 3) + 8 * j; const LAS float* s = scr + (8 * c) * 33 + n;
        u32x4 o; o.x = pk2(s[0 * 33], s[1 * 33]); o.y = pk2(s[2 * 33], s[3 * 33]); o.z = pk2(s[4 * 33], s[5 * 33]); o.w = pk2(s[6 * 33], s[7 * 33]);
        *(u32x4*)(WT + (size_t)(dst_row0 + n) * KD + k0 + 8 * c) = o; }
    asm volatile("s_waitcnt lgkmcnt(0)" ::: "memory");
}

__device__ __forceinline__ void transpose_item_f8(const float* W, int N, unsigned char* WT, int k0, int n0, int dst_row0, float scale, LAS float* scr, int lane) {
#pragma unroll 8
    for (int i = 0; i < 64; ++i) { const int kk = 2 * i + (lane >> 5); scr[kk * 33 + (lane & 31)] = __builtin_nontemporal_load(W + (size_t)(k0 + kk) * N + n0 + (lane & 31)); }
    asm volatile("s_waitcnt lgkmcnt(0)" ::: "memory");
    const int c = lane & 7;
#pragma unroll
    for (int j = 0; j < 4; ++j) { const int n = (lane >> 3) + 8 * j; const LAS float* s = scr + (16 * c) * 33 + n;
        u32x4 o;
        o.x = pk4_f8(s[0 * 33] * scale, s[1 * 33] * scale, s[2 * 33] * scale, s[3 * 33] * scale); o.y = pk4_f8(s[4 * 33] * scale, s[5 * 33] * scale, s[6 * 33] * scale, s[7 * 33] * scale);
        o.z = pk4_f8(s[8 * 33] * scale, s[9 * 33] * scale, s[10 * 33] * scale, s[11 * 33] * scale); o.w = pk4_f8(s[12 * 33] * scale, s[13 * 33] * scale, s[14 * 33] * scale, s[15 * 33] * scale);
        __builtin_nontemporal_store(o, (u32x4*)(WT + (size_t)(dst_row0 + n) * KD + k0 + 16 * c)); }
    asm volatile("s_waitcnt lgkmcnt(0)" ::: "memory");
}

__device__ __forceinline__ void moe_tables(volatile LAS int* tb, unsigned* ctl, int wave_id) {
    if (wave_id == 0) {
        const int l = lane_now(); int nt = 0;
        if (l < NE) { const int c = (int)__hip_atomic_load(ctl + CW_CNT + 64 * l, RLX_AGENT); nt = (c + 255) >> 8; }
        int incl = nt;
#pragma unroll
        for (int d = 1; d < 32; d <<= 1) { const int t = __shfl_up(incl, d); if (l >= d) incl += t; }
        const int off = incl - nt;
        if (l < NE) { tb[1 + l] = off; for (int r = 0; r < nt; ++r) tb[64 + off + r] = l; }
        if (l == NE - 1) { tb[1 + NE] = incl; tb[0] = incl; }
    }
    __syncthreads();
}

__global__ void __launch_bounds__(NTHREADS, 2) fwd(Args args) {
    extern __shared__ __attribute__((aligned(16))) unsigned char lds_raw[];
    LAS unsigned char* lds = (LAS unsigned char*)lds_raw;
    volatile LAS unsigned* MISC = (volatile LAS unsigned*)(lds + MISC_OFF);
    const int wave = __builtin_amdgcn_readfirstlane(threadIdx.x >> 6);
#define LANE_TID() const int lane = lane_now(), tid = wave * 64 + lane, gt = bid * NTHREADS + tid; (void)tid; (void)gt
    const int G = gridDim.x, bid = blockIdx.x;
    unsigned char* ws = args.ws;
    unsigned* ctl = (unsigned*)(ws + WS_CTL);
    if (wave == 0) MISC[lane_now()] = 0u;
    __syncthreads();
    XcdBarrier bar; bar.bar = ctl + CW_BAR; bar.x = 0; bar.st = nullptr;
    if (args.use_bar) bar = xcd_barrier_post(ctl + CW_BAR, MISC);
    const int lo = args.ph_lo, hi = args.ph_hi;
#ifndef DUP_MASK
#define DUP_MASK 0
#endif
#define REP(k) for (int rep_ = 0; rep_ <= ((DUP_MASK >> (k)) & 1); ++rep_)
#define IN(k) (lo <= (k) && (k) < hi)
#ifndef PROBE_PHASE
#define PROBE_PHASE -1
#endif
    unsigned long long tprobe0 = 0ull, tprobe1 = 0ull;
#define SEAM(k) do { if (IN(k) && IN((k) + 1)) xcd_barrier(bar, wave); if (PROBE_PHASE >= 0) { if ((k) + 1 == PROBE_PHASE) tprobe0 = __builtin_amdgcn_s_memrealtime(); if ((k) == PROBE_PHASE) tprobe1 = __builtin_amdgcn_s_memrealtime(); } } while (0)
    if (PROBE_PHASE == 0) tprobe0 = __builtin_amdgcn_s_memrealtime();
    const int gw = bid * NWAVES + wave, NGW = G * NWAVES;
    const int NGT = G * NTHREADS;

    bf16_t* WinT = (bf16_t*)(ws + WS_WIN); bf16_t* WoT = (bf16_t*)(ws + WS_WO); unsigned char* W1F = ws + WS_W1; unsigned char* W2F = ws + WS_W2;
    bf16_t* XN = (bf16_t*)(ws + WS_XN); bf16_t* P = (bf16_t*)(ws + WS_P);
    float* LA = (float*)(ws + WS_LA); float* LB = (float*)(ws + WS_LB);
    float* BON = (float*)(ws + WS_BON);
    bf16_t* CAT = (bf16_t*)(ws + WS_CAT); float* Z = (float*)(ws + WS_Z); float* H1 = (float*)(ws + WS_H1); unsigned char* H1F = ws + WS_H1B;
    int* TOPE = (int*)(ws + WS_TOPE); int* TOPP = (int*)(ws + WS_TOPP); float* TOPG = (float*)(ws + WS_TOPG); int* TOKSLOT = (int*)(ws + WS_TOKSLOT);
    int* SLOTTOK = (int*)(ws + WS_SLOTTOK); float* SLOTG = (float*)(ws + WS_SLOTG);
    unsigned char* ACT = ws + WS_ACT; bf16_t* OUTS = (bf16_t*)(ws + WS_OUTS);

    constexpr int CV_I_IN = (KD / 64) * (NP / 32), CV_I_OUT = (KD / 128) * (D / 32), CV_I_E1 = (KD / 128) * (2 * DE / 32), CV_I_E2 = (DE / 128) * (D / 32);
    constexpr int CV_NITEMS = CV_I_IN + CV_I_OUT + NE * CV_I_E1 + NE * CV_I_E2;
#ifndef CV_SHADOW
#define CV_SHADOW 5888
#endif
#ifndef CV_SHADOW1
#define CV_SHADOW1 5120
#endif
#define CONVERT_ITEM(it_) do { int r = (it_); LAS float* scr = (LAS float*)(lds + wave * 17408); \
        if (r < CV_I_IN) { const int nb = NP / 32, kb = r / nb, n0 = (r % nb) * 32; transpose_item(args.in[I_WIN], NP, WinT, kb * 64, n0, n0, scr, lane); break; } r -= CV_I_IN; \
        if (r < CV_I_OUT) { const int nb = D / 32, kb = r / nb, n0 = (r % nb) * 32; transpose_item_f8(args.in[I_WOUT], D, (unsigned char*)WoT, kb * 128, n0, n0, F8_SW1, scr, lane); break; } r -= CV_I_OUT; \
        if (r < NE * CV_I_E1) { const int e = r / CV_I_E1, q = r % CV_I_E1, nb = 2 * DE / 32, kb = q / nb, n0 = (q % nb) * 32; \
            const int isup = n0 >= DE ? 1 : 0, nn = n0 - isup * DE, drow = 256 * (nn >> 7) + 128 * isup + (nn & 127); \
            transpose_item_f8(args.in[I_WE1] + (size_t)e * KD * 2 * DE, 2 * DE, W1F + (size_t)e * 2 * DE * KD, kb * 128, n0, drow, F8_SW1, scr, lane); break; } r -= NE * CV_I_E1; \
        { const int e = r / CV_I_E2, q = r % CV_I_E2, nb = D / 32, kb = q / nb, n0 = (q % nb) * 32; \
            transpose_item_f8(args.in[I_WE2] + (size_t)e * DE * D, D, W2F + (size_t)e * D * DE, kb * 128, n0, n0, F8_SW2, scr, lane); } } while (0)

    if (IN(0)) REP(0) {
        LANE_TID();
        for (int it = gw; it < CV_NITEMS - CV_SHADOW - CV_SHADOW1; it += NGW) CONVERT_ITEM(it);
        { bf16_t* WG = (bf16_t*)(ws + WS_WG); bf16_t* WL = (bf16_t*)(ws + WS_WL);
            for (int i = gt; i < 2048 * 256; i += NGT) { const int row = i >> 8, kl = i & 255, g_ = row >> 10, nb = (row >> 6) & 15, k = row & 63, blk = kl >> 6, j = kl & 63;
                const float v = ((nb & 3) == blk) ? args.in[g_ ? I_WIG : I_WRG][(size_t)(nb * 64 + j) * 64 + k] : 0.f; WG[i] = cvt1(v); }
            for (int i = gt; i < 3072 * 256; i += NGT) { const int row = i >> 8, kl = i & 255, sel = row >> 10, c = row & 1023;
                float v = 0.f; if (sel == 0) { if (kl < DLORA) v = args.in[I_DECUP][(size_t)kl * RW_W + c]; } else if (sel == 1) { if (kl < ALORA) v = args.in[I_AAAUP][(size_t)kl * RW_W + c]; } else v = args.in[I_GATEUP][(size_t)kl * RW_W + c];
                WL[i] = cvt1(v); } }
        { bf16_t* WRH = (bf16_t*)(ws + WS_WRT); bf16_t* WRL = WRH + NE * D;
            for (int i = gt; i < NE * D; i += NGT) { const int e = i >> 11, k = i & 2047; const float w = args.in[I_WROUTER][(size_t)k * NE + e]; const unsigned short h = cvt1(w); WRH[i] = h; WRL[i] = cvt1(w - bf2f(h)); } }
        for (int i = gt; i < 2 * NE * LIST_CAP / 4; i += NGT) ((u32x4*)(ws + WS_SLOTTOK))[i] = (u32x4){0u, 0u, 0u, 0u};
        for (int i = gt; i < (NPP - NP) * KD / 8; i += NGT) ((u32x4*)(WinT + (size_t)NP * KD))[i] = (u32x4){0u, 0u, 0u, 0u};
        const float* lg = args.in[I_LNG]; const float* lb = args.in[I_LNB];
        for (int m = gw; m < M; m += NGW) {
            const f32x4* xr = (const f32x4*)(args.in[I_X] + (size_t)m * D) + lane;
            f32x4 v[8]; float s = 0.f;
#pragma unroll
            for (int j = 0; j < 8; ++j) { v[j] = __builtin_nontemporal_load(xr + 64 * j); s += (v[j][0] + v[j][1]) + (v[j][2] + v[j][3]); }
            const float mean = wave_sum(s) * (1.f / D); float s2 = 0.f;
#pragma unroll
            for (int j = 0; j < 8; ++j) { v[j] = v[j] - mean; s2 += (v[j][0] * v[j][0] + v[j][1] * v[j][1]) + (v[j][2] * v[j][2] + v[j][3] * v[j][3]); }
            const float rstd = 1.f / sqrtf(wave_sum(s2) * (1.f / D) + LN_EPS);
            u32x2* o8 = (u32x2*)(XN + (size_t)m * D) + lane;
#pragma unroll
            for (int j = 0; j < 8; ++j) { const f32x4 g4 = ((const f32x4*)lg)[64 * j + lane], b4 = ((const f32x4*)lb)[64 * j + lane]; const f32x4 y = v[j] * rstd * g4 + b4;
                u32x2 w; w.x = pk2(y[0], y[1]); w.y = pk2(y[2], y[3]); o8[64 * j] = w; }
        }
    }
    SEAM(0);

    if (IN(1)) REP(1) {
        LANE_TID();
        pg8::StaticOrder S; S.init(M, NPP, G, bid);
        pg8::EpiBf16 E{P, NPP};
        pg8::gemm_phase<pg8::EpiBf16, pg8::StaticOrder, pg8::DenseRows, true>(lds, XN, WinT, S, E, pg8::DenseRows{}, wave);
        if (G == 256 && bid >= 128) {
            __syncthreads();
            for (int it = CV_NITEMS - CV_SHADOW - CV_SHADOW1 + (bid - 128) * NWAVES + wave; it < CV_NITEMS - CV_SHADOW; it += 128 * NWAVES) CONVERT_ITEM(it); }
        else if (G != 256) { for (int it = CV_NITEMS - CV_SHADOW - CV_SHADOW1 + gw; it < CV_NITEMS - CV_SHADOW; it += NGW) CONVERT_ITEM(it); }
    }
    SEAM(1);

    if (IN(2)) REP(2) {
        LANE_TID();
        bf16_t* UC = (bf16_t*)(ws + WS_UC); bf16_t* XL = (bf16_t*)(ws + WS_XL);
        const float* conv_w = args.in[I_CONVW]; const float* conv_b = args.in[I_CONVB]; const float* mu = args.in[I_MU];
        for (int idx = gt; idx < (M / 16) * (LRU_W / 8); idx += NGT) { const int m0 = (idx >> 7) * 16, c = (idx & 127) * 8, tin0 = m0 & (SEQ - 1);
            f32x4 wlo[4], whi[4];
#pragma unroll
            for (int j = 0; j < 4; ++j) { wlo[j] = *(const f32x4*)(conv_w + j * LRU_W + c); whi[j] = *(const f32x4*)(conv_w + j * LRU_W + c + 4); }
            const f32x4 cb0 = *(const f32x4*)(conv_b + c), cb1 = *(const f32x4*)(conv_b + c + 4);
            u32x4 row[19];
#pragma unroll
            for (int j = 0; j < 19; ++j) { row[j] = (u32x4){0u, 0u, 0u, 0u}; if (tin0 - 3 + j >= 0) row[j] = *(const u32x4*)(P + (size_t)(m0 - 3 + j) * NPP + c); }
#pragma unroll
            for (int t = 0; t < 16; ++t) { f32x4 o0 = cb0, o1 = cb1;
#pragma unroll
                for (int j = 0; j < 4; ++j) { const u32x4 pv = row[t + j];
                    o0[0] += wlo[j][0] * bflo(pv.x); o0[1] += wlo[j][1] * bfhi(pv.x); o0[2] += wlo[j][2] * bflo(pv.y); o0[3] += wlo[j][3] * bfhi(pv.y);
                    o1[0] += whi[j][0] * bflo(pv.z); o1[1] += whi[j][1] * bfhi(pv.z); o1[2] += whi[j][2] * bflo(pv.w); o1[3] += whi[j][3] * bfhi(pv.w); }
                *(u32x4*)(UC + (size_t)(m0 + t) * LRU_W + c) = (u32x4){cvt2(o0[0], o0[1]), cvt2(o0[2], o0[3]), cvt2(o1[0], o1[1]), cvt2(o1[2], o1[3])}; } }
        for (int idx = gt; idx < M * 64; idx += NGT) { const int m = idx >> 6, q = idx & 63, tin = m & (SEQ - 1);
            u32x4 res = {0u, 0u, 0u, 0u};
            const int kind = q < 12 ? 0 : (q < 16 ? 3 : (q < 28 ? 1 : (q < 32 ? 3 : 2)));
            if (kind != 3) { const int col = (kind == 0) ? 3 * RW_W + 8 * q : (kind == 1 ? 3 * RW_W + DLORA + 8 * (q - 16) : 3 * RW_W + DLORA + ALORA + 8 * (q - 32));
                const bf16_t* pp = P + (size_t)m * NPP + 2 * LRU_W + col; const u32x4 pc = *(const u32x4*)pp; u32x4 pq = {0u, 0u, 0u, 0u}; if (tin > 0) pq = *(const u32x4*)(pp - NPP);
                const f32x4 m0 = *(const f32x4*)(mu + col), m1 = *(const f32x4*)(mu + col + 4);
                float s[8]; const unsigned pcw[4] = {pc.x, pc.y, pc.z, pc.w}, pqw[4] = {pq.x, pq.y, pq.z, pq.w};
#pragma unroll
                for (int e = 0; e < 4; ++e) { const float c0 = bflo(pcw[e]), c1 = bfhi(pcw[e]), p0 = bflo(pqw[e]), p1 = bfhi(pqw[e]);
                    const float mu0 = (e < 2) ? m0[2 * e] : m1[2 * e - 4], mu1 = (e < 2) ? m0[2 * e + 1] : m1[2 * e - 3];
                    s[2 * e] = c0 + (p0 - c0) * mu0; s[2 * e + 1] = c1 + (p1 - c1) * mu1; }
#pragma unroll
                for (int e = 0; e < 8; ++e) s[e] = (kind == 0) ? tanh_fast(s[e]) : (kind == 1 ? s[e] : sigmoidf_(s[e]));
                res = (u32x4){cvt2(s[0], s[1]), cvt2(s[2], s[3]), cvt2(s[4], s[5]), cvt2(s[6], s[7])}; }
            *(u32x4*)(XL + (size_t)m * 512 + 8 * q) = res; }
    }
    SEAM(2);

    if (IN(3)) {
        LANE_TID();
        const bf16_t* UC = (const bf16_t*)(ws + WS_UC); const bf16_t* XL = (const bf16_t*)(ws + WS_XL);
        { pg8::SmallOrder<0> S{G, bid}; pg8::EpiBf16 E{(bf16_t*)(ws + WS_GATES), 2048};
          pg8::gemm_phase<pg8::EpiBf16, pg8::SmallOrder<0>, pg8::DenseRows, true, LRU_W, 256>(lds, UC, (const bf16_t*)(ws + WS_WG), S, E, pg8::DenseRows{}, wave); }
        { pg8::SmallOrder<1> S{G, bid}; pg8::EpiBf16 E{(bf16_t*)(ws + WS_LOUT), 3072};
          pg8::gemm_phase<pg8::EpiBf16, pg8::SmallOrder<1>, pg8::DenseRows, true, 512, 256>(lds, XL, (const bf16_t*)(ws + WS_WL), S, E, pg8::DenseRows{}, wave); }
    }
    SEAM(3);

    if (IN(4)) {
        LANE_TID();
        constexpr int RS = 144;
        constexpr int L_AT = 0, L_BT = 9216, L_KT = 18432, L_RT = 27648, L_VT = 36864, L_BH = 46080, L_KH = 55296, L_AAB = 64512, L_AAK = 80896, L_ARB = 90112, L_ARK = 99328,
                      L_PT = 108544, L_QT = 117760, L_WC = 126976, L_A16 = 129280, L_TB = 138496, L_SEG = 140544, L_U = L_BT, L_MST = L_AT, L_GST = L_BT;
        bf16_t* MT = (bf16_t*)(ws + WS_MT); bf16_t* GG = (bf16_t*)(ws + WS_GG); float* NN = (float*)(ws + WS_NN); float* HH = (float*)(ws + WS_HH);
        const bf16_t* LOUT = (const bf16_t*)(ws + WS_LOUT); bf16_t* V16 = (bf16_t*)(ws + WS_V16); const float* mu_ = args.in[I_MU];
        const int r = lane & 31, hh = lane >> 5;
        unsigned xr[5], xk[5], xv[5], xd[4], xa[4]; f32x2 cq[8];
#define E_LOAD(u_) do { const int cch_ = (u_) & 63, head_ = ((u_) >> 6) & 15, b_ = (u_) >> 10; const int sg_ = 2 * wave + (lane >> 5); const size_t tokb_ = (size_t)b_ * SEQ + cch_ * 64 + 4 * sg_; const int c_ = head_ * HS + 2 * (lane & 31); \
            const bf16_t* pp_ = P + tokb_ * NPP + 2 * LRU_W + c_; const bool hp_ = ((cch_ * 64 + 4 * sg_) & (SEQ - 1)) != 0; \
            xr[0] = hp_ ? *(const unsigned*)(pp_ - NPP) : 0u; xk[0] = hp_ ? *(const unsigned*)(pp_ - NPP + RW_W) : 0u; xv[0] = hp_ ? *(const unsigned*)(pp_ - NPP + 2 * RW_W) : 0u; \
            _Pragma("unroll") for (int j = 0; j < 4; ++j) { const bf16_t* pj = pp_ + (size_t)j * NPP; xr[j + 1] = *(const unsigned*)pj; xk[j + 1] = *(const unsigned*)(pj + RW_W); xv[j + 1] = *(const unsigned*)(pj + 2 * RW_W); \
                const bf16_t* lj = LOUT + (tokb_ + j) * 3072 + c_; xd[j] = *(const unsigned*)lj; xa[j] = *(const unsigned*)(lj + 1024); } \
            cq[0] = *(const f32x2*)(mu_ + c_); cq[1] = *(const f32x2*)(mu_ + RW_W + c_); cq[2] = *(const f32x2*)(mu_ + 2 * RW_W + c_); cq[3] = *(const f32x2*)(args.in[I_W0] + c_); cq[4] = *(const f32x2*)(args.in[I_A0] + c_); \
            cq[5] = *(const f32x2*)(args.in[I_KK] + c_); cq[6] = *(const f32x2*)(args.in[I_KA] + c_); cq[7] = *(const f32x2*)(args.in[I_RK] + c_); } while (0)
        if (bid < NUNIT) E_LOAD(bid);
        REP(4) for (int u = bid; u < NUNIT; u += G) {
            const int cch = u & 63, head = (u >> 6) & 15, b = u >> 10; const size_t tok0 = (size_t)b * SEQ + cch * 64;
            { const int cp = lane & 31, hq = lane >> 5, sg = 2 * wave + hq, ch = 2 * cp, c = head * HS + ch; const size_t tokb = tok0 + 4 * sg;
                float lw[4][2], rr_[4][2], kk_[4][2], vv_[4][2], kn_[4][2], aa_[4][2];
                { const f32x2 mur = cq[0], muk = cq[1], muv = cq[2];
                    const f32x2 w0c = cq[3], a0c = cq[4], kkc = cq[5], kac = cq[6], rkc = cq[7];
                    float bonv[4];
#pragma unroll
                    for (int j = 0; j < 4; ++j) { float s_kk = 0.f, s_bo = 0.f;
#pragma unroll
                        for (int x = 0; x < 2; ++x) { const float cr = x ? bfhi(xr[j + 1]) : bflo(xr[j + 1]), ck = x ? bfhi(xk[j + 1]) : bflo(xk[j + 1]), cv = x ? bfhi(xv[j + 1]) : bflo(xv[j + 1]);
                            const float pr = x ? bfhi(xr[j]) : bflo(xr[j]), pk_ = x ? bfhi(xk[j]) : bflo(xk[j]), pvv = x ? bfhi(xv[j]) : bflo(xv[j]);
                            const float r = cr + (pr - cr) * mur[x], k = ck + (pk_ - ck) * muk[x], v = cv + (pvv - cv) * muv[x];
                            const float lgw = -0.6065306597126334f * sigmoidf_(w0c[x] + (x ? bfhi(xd[j]) : bflo(xd[j])));
                            const float a = sigmoidf_(a0c[x] + (x ? bfhi(xa[j]) : bflo(xa[j])));
                            const float kk = k * kkc[x]; const float km = k * (1.f + (a - 1.f) * kac[x]);
                            s_kk += kk * kk; s_bo += r * km * rkc[x];
                            lw[j][x] = lgw; rr_[j][x] = r; kk_[j][x] = km; vv_[j][x] = v; kn_[j][x] = kk; aa_[j][x] = a; }
                        const float inv = __builtin_amdgcn_rsqf(fmaxf(half_sum(s_kk, hq), 1e-24f)); kn_[j][0] *= inv; kn_[j][1] *= inv;
                        bonv[j] = half_sum(s_bo, hq); }
#pragma unroll
                    for (int j = 0; j < 4; ++j) { *(unsigned*)(V16 + (tokb + j) * RW_W + c) = cvt2(vv_[j][0], vv_[j][1]); }
                    if (cp < 4) { float bsel = bonv[0];
#pragma unroll
                        for (int j = 1; j < 4; ++j) bsel = (cp == j) ? bonv[j] : bsel;
                        BON[(tokb + cp) * NHEAD + head] = bsel; }
                    if (u + G < NUNIT) E_LOAD(u + G); }
                f32x2 seg = {0.f, 0.f};
#pragma unroll
                for (int j = 0; j < 4; ++j) { seg[0] += lw[j][0]; seg[1] += lw[j][1]; }
                *(LAS f32x2*)(lds + L_SEG + (sg * 64 + ch) * 4) = seg;
                __syncthreads();
                f32x2 pre = {0.f, 0.f}, tot = {0.f, 0.f};
#pragma unroll
                for (int g = 0; g < 16; ++g) { const f32x2 sv = *(const LAS f32x2*)(lds + L_SEG + (g * 64 + ch) * 4); tot += sv; if (g < sg) pre += sv; }
                if (sg == 0) *(LAS f32x2*)(lds + L_WC + ch * 4) = (f32x2){__expf(tot[0]), __expf(tot[1])};
                float tv[2][4], tb_[2][4], tk[2][4];
#pragma unroll
                for (int x = 0; x < 2; ++x) { float L = pre[x]; const float eTot = __expf(tot[x]); float eLex = __expf(pre[x]);
#pragma unroll
                    for (int j = 0; j < 4; ++j) { L += lw[j][x];
                        const float eL = __expf(L), eNL = __builtin_amdgcn_rcpf(eL), eEnd = eTot * eNL; const float beta = kn_[j][x] * aa_[j][x];
                        rr_[j][x] = rr_[j][x] * eL; const float at_ = kn_[j][x] * eLex, bt_ = beta * eNL, kt_ = kk_[j][x] * eNL;
                        tv[x][j] = vv_[j][x]; tb_[x][j] = -beta * eEnd; tk[x][j] = kk_[j][x] * eEnd; eLex = eL;
                        kn_[j][x] = at_; aa_[j][x] = bt_; kk_[j][x] = kt_; } }
#pragma unroll
                for (int j = 0; j < 4; ++j) { const int t = 4 * sg + j;
                    *(LAS unsigned*)(lds + L_AT + t * RS + ch * 2) = cvt2(kn_[j][0], kn_[j][1]);
                    *(LAS unsigned*)(lds + L_BT + t * RS + ch * 2) = cvt2(aa_[j][0], aa_[j][1]);
                    *(LAS unsigned*)(lds + L_KT + t * RS + ch * 2) = cvt2(kk_[j][0], kk_[j][1]);
                    *(LAS unsigned*)(lds + L_RT + t * RS + ch * 2) = cvt2(rr_[j][0], rr_[j][1]); }
#pragma unroll
                for (int x = 0; x < 2; ++x) {
                    *(LAS u32x2*)(lds + L_VT + (ch + x) * RS + sg * 8) = (u32x2){cvt2(tv[x][0], tv[x][1]), cvt2(tv[x][2], tv[x][3])};
                    *(LAS u32x2*)(lds + L_BH + (ch + x) * RS + sg * 8) = (u32x2){cvt2(tb_[x][0], tb_[x][1]), cvt2(tb_[x][2], tb_[x][3])};
                    *(LAS u32x2*)(lds + L_KH + (ch + x) * RS + sg * 8) = (u32x2){cvt2(tk[x][0], tk[x][1]), cvt2(tk[x][2], tk[x][3])}; }
            }
            __syncthreads();
            { const int id = wave >> 1, i = wave & 1; const int X = (id < 2) ? L_AT : L_RT, Y = (id & 1) ? L_KT : L_BT;
                f32x16 acc[2];
#pragma unroll
                for (int q = 0; q < 2; ++q)
#pragma unroll
                    for (int e = 0; e < 16; ++e) acc[q][e] = 0.f;
#pragma unroll
                for (int s = 0; s < 4; ++s) { const bf16x8 a = *(const LAS bf16x8*)(lds + X + (32 * i + r) * RS + (16 * s + 8 * hh) * 2);
#pragma unroll
                    for (int q = 0; q < 2; ++q) { const bf16x8 bb = *(const LAS bf16x8*)(lds + Y + (32 * q + r) * RS + (16 * s + 8 * hh) * 2); acc[q] = MFMA32(a, bb, acc[q]); } }
#pragma unroll
                for (int q = 0; q < 2; ++q)
#pragma unroll
                    for (int e = 0; e < 16; ++e) { const int t = 32 * i + crow(e, hh), sc = 32 * q + r; const bool keep = (id < 2) ? (sc < t) : (sc <= t);
                        float val = keep ? acc[q][e] : 0.f; if (id == 2) val = -val;
                        if (id == 0) { ((LAS float*)(lds + L_AAB))[t * 64 + sc] = val; *(LAS unsigned short*)(lds + L_A16 + t * RS + sc * 2) = cvt1(-val); }
                        else *(LAS unsigned short*)(lds + L_AAK + (id - 1) * 9216 + t * RS + sc * 2) = cvt1(val); }
            }
            __syncthreads();
            if (wave < 4) { const int i = wave >> 1, q = wave & 1; f32x16 acc;
#pragma unroll
                for (int e = 0; e < 16; ++e) acc[e] = 0.f;
#pragma unroll
                for (int s = 0; s < 4; ++s) { const bf16x8 a = *(const LAS bf16x8*)(lds + L_AAK + (32 * i + r) * RS + (16 * s + 8 * hh) * 2);
                    const bf16x8 bb = *(const LAS bf16x8*)(lds + L_VT + (32 * q + r) * RS + (16 * s + 8 * hh) * 2); acc = MFMA32(a, bb, acc); }
#pragma unroll
                for (int e = 0; e < 16; ++e) ((LAS float*)(lds + L_U))[(32 * i + crow(e, hh)) * 64 + 32 * q + r] = acc[e];
            }
            if (wave == 4) { const int b2 = lane >> 4, j = lane & 15; float x[16];
                const LAS float* AB = (const LAS float*)(lds + L_AAB) + (16 * b2) * 64 + 16 * b2;
#pragma unroll
                for (int t = 0; t < 16; ++t) x[t] = (t == j) ? 1.f : 0.f;
                { f32x4 Ar[8][2];
#pragma unroll
                    for (int t = 1; t < 8; ++t)
#pragma unroll
                        for (int s4 = 0; s4 < (t + 3) / 4; ++s4) Ar[t][s4] = *(const LAS f32x4*)(AB + t * 64 + 4 * s4);
#pragma unroll
                    for (int s = 0; s < 7; ++s) { const float xs = x[s];
#pragma unroll
                        for (int t = s + 1; t < 8; ++t) x[t] -= Ar[t][s >> 2][s & 3] * xs; } }
                { f32x4 Ar[8][2];
#pragma unroll
                    for (int t = 0; t < 8; ++t)
#pragma unroll
                        for (int s4 = 0; s4 < 2; ++s4) Ar[t][s4] = *(const LAS f32x4*)(AB + (8 + t) * 64 + 4 * s4);
#pragma unroll
                    for (int t = 0; t < 8; ++t) { float a0 = 0.f, a1 = 0.f;
#pragma unroll
                        for (int s = 0; s < 8; s += 2) { a0 += Ar[t][s >> 2][s & 3] * x[s]; a1 += Ar[t][(s + 1) >> 2][(s + 1) & 3] * x[s + 1]; }
                        x[8 + t] -= (a0 + a1); } }
                { f32x4 Ar[8][2];
#pragma unroll
                    for (int t = 1; t < 8; ++t)
#pragma unroll
                        for (int s4 = 0; s4 < (t + 3) / 4; ++s4) Ar[t][s4] = *(const LAS f32x4*)(AB + (8 + t) * 64 + 8 + 4 * s4);
#pragma unroll
                    for (int s = 0; s < 7; ++s) { const float xs = x[8 + s];
#pragma unroll
                        for (int t = s + 1; t < 8; ++t) x[8 + t] -= Ar[t][s >> 2][s & 3] * xs; } }
#pragma unroll
                for (int t = 0; t < 16; ++t) *(LAS unsigned short*)(lds + L_TB + ((b2 * 16 + t) * 16 + j) * 2) = cvt1(x[t]);
            }
            __syncthreads();
            { const int c16 = lane & 15, quad = lane >> 4, isQ = wave >> 2, colb = 16 * (wave & 3) + c16;
                f32x4 Xr[4];
#pragma unroll
                for (int b2 = 0; b2 < 4; ++b2) Xr[b2] = (f32x4){0.f, 0.f, 0.f, 0.f};
#pragma unroll
                for (int b2 = 0; b2 < 4; ++b2) {
                    f32x4 y;
#pragma unroll
                    for (int g = 0; g < 4; ++g) { const int row = 16 * b2 + 4 * quad + g;
                        y[g] = isQ ? ((const LAS float*)(lds + L_U))[row * 64 + colb] : bf2f(*(const LAS unsigned short*)(lds + L_AT + row * RS + colb * 2)); }
#pragma unroll
                    for (int ks = 0; ks < 2; ++ks) if (2 * ks < b2) {
                        const u32x2 alo = *(const LAS u32x2*)(lds + L_A16 + (16 * b2 + c16) * RS + (32 * ks + 4 * quad) * 2);
                        u32x2 ahi = {0u, 0u}; if (2 * ks + 1 < b2) ahi = *(const LAS u32x2*)(lds + L_A16 + (16 * b2 + c16) * RS + (32 * ks + 16 + 4 * quad) * 2);
                        const u32x4 af = {alo.x, alo.y, ahi.x, ahi.y};
                        const u32x4 bf = {cvt2(Xr[2 * ks][0], Xr[2 * ks][1]), cvt2(Xr[2 * ks][2], Xr[2 * ks][3]), cvt2(Xr[2 * ks + 1][0], Xr[2 * ks + 1][1]), cvt2(Xr[2 * ks + 1][2], Xr[2 * ks + 1][3])};
                        y = __builtin_amdgcn_mfma_f32_16x16x32_bf16(__builtin_bit_cast(bf16x8, af), __builtin_bit_cast(bf16x8, bf), y, 0, 0, 0); }
                    const u32x2 tlo = *(const LAS u32x2*)(lds + L_TB + ((b2 * 16 + c16) * 16 + 4 * quad) * 2);
                    const u32x4 tf = {tlo.x, tlo.y, 0u, 0u};
                    const u32x4 yf = {cvt2(y[0], y[1]), cvt2(y[2], y[3]), 0u, 0u};
                    Xr[b2] = __builtin_amdgcn_mfma_f32_16x16x32_bf16(__builtin_bit_cast(bf16x8, tf), __builtin_bit_cast(bf16x8, yf), (f32x4){0.f, 0.f, 0.f, 0.f}, 0, 0, 0);
                    *(LAS u32x2*)(lds + (isQ ? L_QT : L_PT) + colb * RS + (16 * b2 + 4 * quad) * 2) = (u32x2){cvt2(Xr[b2][0], Xr[b2][1]), cvt2(Xr[b2][2], Xr[b2][3])};
                }
            }
            __syncthreads();
            { const int mtx = wave >> 1, i = wave & 1;
                const int X1 = (mtx == 0) ? L_BH : (mtx == 1) ? L_KH : (mtx == 2) ? L_ARB : L_ARK;
                const int Y1 = (mtx == 0 || mtx == 2) ? L_PT : L_VT;
                f32x16 acc[2];
#pragma unroll
                for (int q = 0; q < 2; ++q)
#pragma unroll
                    for (int e = 0; e < 16; ++e) acc[q][e] = 0.f;
#pragma unroll
                for (int s = 0; s < 4; ++s) { const bf16x8 a = *(const LAS bf16x8*)(lds + X1 + (32 * i + r) * RS + (16 * s + 8 * hh) * 2);
#pragma unroll
                    for (int q = 0; q < 2; ++q) { const bf16x8 bb = *(const LAS bf16x8*)(lds + Y1 + (32 * q + r) * RS + (16 * s + 8 * hh) * 2); acc[q] = MFMA32(a, bb, acc[q]); } }
                if (mtx & 1) { const int X2 = (mtx == 1) ? L_BH : L_ARB;
#pragma unroll
                    for (int s = 0; s < 4; ++s) { const bf16x8 a = *(const LAS bf16x8*)(lds + X2 + (32 * i + r) * RS + (16 * s + 8 * hh) * 2);
#pragma unroll
                        for (int q = 0; q < 2; ++q) { const bf16x8 bb = *(const LAS bf16x8*)(lds + L_QT + (32 * q + r) * RS + (16 * s + 8 * hh) * 2); acc[q] = MFMA32(a, bb, acc[q]); } } }
                if (mtx == 0) { const float wc = ((const LAS float*)(lds + L_WC))[32 * i + r];
#pragma unroll
                    for (int q = 0; q < 2; ++q)
#pragma unroll
                        for (int e = 0; e < 16; ++e) if (q == i && crow(e, hh) == r) acc[q][e] += wc; }
                if (mtx == 2) {
#pragma unroll
                    for (int q = 0; q < 2; ++q)
#pragma unroll
                        for (int e = 0; e < 16; ++e) acc[q][e] += bf2f(*(const LAS unsigned short*)(lds + L_RT + (32 * i + crow(e, hh)) * RS + (32 * q + r) * 2)); }
                if (mtx & 1) { unsigned* dstg = (unsigned*)((mtx == 1) ? NN : HH) + (size_t)u * 2048;
#pragma unroll
                    for (int q = 0; q < 2; ++q)
#pragma unroll
                        for (int e = 0; e < 16; e += 8) *(u32x4*)(dstg + ((i * 2 + q) * 64 + lane) * 8 + (e >> 1)) = (u32x4){cvt2(acc[q][e], acc[q][e + 1]), cvt2(acc[q][e + 2], acc[q][e + 3]), cvt2(acc[q][e + 4], acc[q][e + 5]), cvt2(acc[q][e + 6], acc[q][e + 7])};
                } else { const int dl = (mtx == 0) ? L_MST : L_GST;
#pragma unroll
                    for (int q = 0; q < 2; ++q)
#pragma unroll
                        for (int e = 0; e < 16; ++e) *(LAS unsigned short*)(lds + dl + (32 * i + crow(e, hh)) * RS + (32 * q + r) * 2) = cvt1(acc[q][e]); }
            }
            __syncthreads();
            { const int f = tid >> 6, i = f >> 2, q = (f >> 1) & 1, s = f & 1, r2 = lane & 31, h2 = lane >> 5; const int off = (32 * i + r2) * RS + (32 * q + 16 * s + 4 * h2) * 2;
                const u32x2 m0 = *(const LAS u32x2*)(lds + L_MST + off), m1 = *(const LAS u32x2*)(lds + L_MST + off + 16);
                const u32x2 g0 = *(const LAS u32x2*)(lds + L_GST + off), g1 = *(const LAS u32x2*)(lds + L_GST + off + 16);
                *(u32x4*)(MT + (size_t)u * 4096 + tid * 8) = (u32x4){m0.x, m0.y, m1.x, m1.y};
                *(u32x4*)(GG + (size_t)u * 4096 + tid * 8) = (u32x4){g0.x, g0.y, g1.x, g1.y}; }
            __syncthreads();
        }
        { float* CA = (float*)(ws + WS_CA); float* CH = (float*)(ws + WS_CH); const unsigned* UC2 = (const unsigned*)(ws + WS_UC); const unsigned* GT2 = (const unsigned*)(ws + WS_GATES);
            unsigned* LB2 = (unsigned*)LB; unsigned* LA2 = (unsigned*)LA;
            for (int bc = bid; bc < BATCH * 64; bc += G) { const size_t tok0 = (size_t)(bc >> 6) * SEQ + (bc & 63) * 64;
                float h[2] = {0.f, 0.f}, A[2] = {1.f, 1.f}, br[2], bi[2], sp[2];
#pragma unroll
                for (int cc = 0; cc < 2; ++cc) { const int c = 2 * tid + cc; br[cc] = args.in[I_BRG][c]; bi[cc] = args.in[I_BIG][c]; const float lam = args.in[I_LAMBDA][c];
                    sp[cc] = lam > 15.f ? __expf(-lam) : log1pf(__expf(-lam)); }
                unsigned gr[8], gi[8], uc[8];
#define LRU_LOAD(t_) do { _Pragma("unroll") for (int j = 0; j < 8; ++j) { const size_t tk = tok0 + (t_) + j; \
                    gr[j] = GT2[tk * 1024 + tid]; gi[j] = GT2[tk * 1024 + 512 + tid]; uc[j] = UC2[tk * 512 + tid]; } } while (0)
                LRU_LOAD(0);
#pragma unroll 1
                for (int t = 0; t < 64; t += 8) {
                    unsigned hv[8], av[8];
#pragma unroll
                    for (int j = 0; j < 8; ++j) { float hh_[2], aa_[2];
#pragma unroll
                        for (int cc = 0; cc < 2; ++cc) { const float gR = cc ? bfhi(gr[j]) : bflo(gr[j]), gI = cc ? bfhi(gi[j]) : bflo(gi[j]), uu = cc ? bfhi(uc[j]) : bflo(uc[j]);
                            const float rg = sigmoidf_(gR + br[cc]), ig = sigmoidf_(gI + bi[cc]);
                            const float a = __expf(-8.f * rg * sp[cc]), bb = sqrtf(fmaxf(1.f - a * a, 0.f)) * (ig * uu);
                            h[cc] = a * h[cc] + bb; A[cc] *= a; hh_[cc] = h[cc]; aa_[cc] = A[cc]; }
                        hv[j] = cvt2(hh_[0], hh_[1]); av[j] = cvt2(aa_[0], aa_[1]); }
                    if (t + 8 < 64) LRU_LOAD(t + 8);
#pragma unroll
                    for (int j = 0; j < 8; ++j) { LB2[(tok0 + t + j) * 512 + tid] = hv[j]; LA2[(tok0 + t + j) * 512 + tid] = av[j]; }
                }
#undef LRU_LOAD
                *(f32x2*)(CA + (size_t)bc * LRU_W + 2 * tid) = (f32x2){A[0], A[1]}; *(f32x2*)(CH + (size_t)bc * LRU_W + 2 * tid) = (f32x2){h[0], h[1]}; } }
    }
    SEAM(4);

    if (IN(5)) REP(5) {
        LANE_TID();
        if (bid < BATCH * NHEAD) {
            const bf16_t* MT = (const bf16_t*)(ws + WS_MT); const float* NN = (const float*)(ws + WS_NN); bf16_t* XS = (bf16_t*)(ws + WS_XS);
            constexpr int SLOT = 16384, NCH = SEQ / 64;
            const int u0 = bid * NCH;
            if (wave >= 2) {
                const int lw = wave - 2;
#define R2_ISSUE(c_) do { if (lw < 4) { const int _u = u0 + (c_); const int _sl = ((c_) & 7) * SLOT; _Pragma("unroll") for (int _rd = 0; _rd < 4; ++_rd) { const int _k0 = _rd * 256 + lw * 64; \
                    const char* _src = (_k0 < 512) ? (const char*)MT + (size_t)_u * 8192 + (size_t)(_k0 + lane) * 16 : (const char*)NN + (size_t)_u * 8192 + (size_t)(_k0 - 512 + lane) * 16; \
                    __builtin_amdgcn_global_load_lds((const unsigned*)_src, (LAS unsigned*)(lds + _sl + _k0 * 16), 16, 0, 0); } } } while (0)
                R2_ISSUE(0); R2_ISSUE(1); R2_ISSUE(2); R2_ISSUE(3); R2_ISSUE(4); R2_ISSUE(5); R2_ISSUE(6);
                asm volatile("s_waitcnt vmcnt(24)" ::: "memory"); __builtin_amdgcn_s_barrier(); asm volatile("" ::: "memory");
                for (int c = 0; c < NCH; ++c) {
                    const int ah_ = (NCH - 2 - c) < 5 ? (NCH - 2 - c) : 5; const int ahead = ah_ < 0 ? 0 : ah_;
                    if (ahead == 6) asm volatile("s_waitcnt vmcnt(24)" ::: "memory"); else if (ahead == 5) asm volatile("s_waitcnt vmcnt(20)" ::: "memory"); else if (ahead == 4) asm volatile("s_waitcnt vmcnt(16)" ::: "memory");
                    else if (ahead == 3) asm volatile("s_waitcnt vmcnt(12)" ::: "memory"); else if (ahead == 2) asm volatile("s_waitcnt vmcnt(8)" ::: "memory"); else if (ahead == 1) asm volatile("s_waitcnt vmcnt(4)" ::: "memory");
                    else asm volatile("s_waitcnt vmcnt(0)" ::: "memory");
                    __builtin_amdgcn_s_barrier();
                    asm volatile("" ::: "memory");
                    if (c + 7 < NCH) R2_ISSUE(c + 7);
                }
#undef R2_ISSUE
            } else {
                const int vh = wave;
                f32x16 X[2];
#pragma unroll
                for (int q = 0; q < 2; ++q)
#pragma unroll
                    for (int e = 0; e < 16; ++e) X[q][e] = 0.f;
                bf16x8 afA[2][2][2], afB[2][2][2]; unsigned nwA[2][8], nwB[2][8];
#define P5_READ(AF, NW, c_) do { const LAS unsigned char* sl_ = lds + ((c_) & 7) * SLOT; _Pragma("unroll") for (int i = 0; i < 2; ++i) { \
                    _Pragma("unroll") for (int q = 0; q < 2; ++q) _Pragma("unroll") for (int s = 0; s < 2; ++s) AF[i][q][s] = *(const LAS bf16x8*)(sl_ + ((i * 2 + q) * 2 + s) * 1024 + lane * 16); \
                    _Pragma("unroll") for (int e2 = 0; e2 < 8; ++e2) NW[i][e2] = ((const LAS unsigned*)(sl_ + 8192))[((i * 2 + vh) * 64 + lane) * 8 + e2]; } } while (0)
#define P5_STEP(c_, AF, NW, AFN, NWN) do { bf16x8 xb[2][2]; \
                    _Pragma("unroll") for (int q = 0; q < 2; ++q) _Pragma("unroll") for (int s = 0; s < 2; ++s) { const u32x4 p = {cvt2(X[q][8 * s], X[q][8 * s + 1]), cvt2(X[q][8 * s + 2], X[q][8 * s + 3]), cvt2(X[q][8 * s + 4], X[q][8 * s + 5]), cvt2(X[q][8 * s + 6], X[q][8 * s + 7])}; \
                        xb[q][s] = __builtin_bit_cast(bf16x8, p); *(u32x4*)(XS + (size_t)(u0 + (c_)) * 4096 + (((vh * 2 + q) * 2 + s) * 64 + lane) * 8) = p; } \
                    asm volatile("" ::: "memory"); __builtin_amdgcn_s_barrier(); asm volatile("" ::: "memory"); \
                    if ((c_) + 1 < NCH) P5_READ(AFN, NWN, (c_) + 1); \
                    __builtin_amdgcn_sched_barrier(0); \
                    f32x16 nx[2]; _Pragma("unroll") for (int i = 0; i < 2; ++i) _Pragma("unroll") for (int e2 = 0; e2 < 8; ++e2) { nx[i][2 * e2] = bflo(NW[i][e2]); nx[i][2 * e2 + 1] = bfhi(NW[i][e2]); } \
                    _Pragma("unroll") for (int q = 0; q < 2; ++q) _Pragma("unroll") for (int s = 0; s < 2; ++s) _Pragma("unroll") for (int i = 0; i < 2; ++i) nx[i] = MFMA32(AF[i][q][s], xb[q][s], nx[i]); \
                    X[0] = nx[0]; X[1] = nx[1]; } while (0)
                __builtin_amdgcn_s_barrier(); asm volatile("" ::: "memory");
                P5_READ(afA, nwA, 0); asm volatile("s_waitcnt lgkmcnt(0)" ::: "memory");
                static_assert(NCH % 2 == 0, "two steps per trip");
                for (int c = 0; c < NCH; c += 2) { P5_STEP(c, afA, nwA, afB, nwB); P5_STEP(c + 1, afB, nwB, afA, nwA); }
#undef P5_READ
#undef P5_STEP
            }
        } else if (bid >= BATCH * NHEAD + 8) {
            const int nb_ = G - (BATCH * NHEAD + 8);
            for (int it = CV_NITEMS - CV_SHADOW + (bid - (BATCH * NHEAD + 8)) * NWAVES + wave; it < CV_NITEMS; it += nb_ * NWAVES) CONVERT_ITEM(it);
        } else {
            const float* CA = (const float*)(ws + WS_CA); const float* CH = (const float*)(ws + WS_CH); float* CIN = (float*)(ws + WS_CIN);
            const int i = (bid - BATCH * NHEAD) * NTHREADS + tid, b = i >> 10, c = i & 1023; float s = 0.f;
            for (int ch = 0; ch < 64; ch += 8) { float a[8], hh_[8];
#pragma unroll
                for (int j = 0; j < 8; ++j) { a[j] = CA[(size_t)(b * 64 + ch + j) * LRU_W + c]; hh_[j] = CH[(size_t)(b * 64 + ch + j) * LRU_W + c]; }
#pragma unroll
                for (int j = 0; j < 8; ++j) { CIN[(size_t)(b * 64 + ch + j) * LRU_W + c] = s; s = a[j] * s + hh_[j]; } }
        }
    }
    SEAM(5);

    if (IN(6)) REP(6) {
        LANE_TID();
        { const float* CIN = (const float*)(ws + WS_CIN);
            for (int idx = gt; idx < M * (LRU_W / 8); idx += NGT) { const int m = idx >> 7, c = (idx & 127) * 8; const size_t o = (size_t)m * LRU_W + c;
                const u32x4 gq = *(const u32x4*)(P + (size_t)m * NPP + LRU_W + c);
                const u32x4 hq = *(const u32x4*)((const bf16_t*)LB + o), aq = *(const u32x4*)((const bf16_t*)LA + o);
                const f32x4 h0 = {bflo(hq.x), bfhi(hq.x), bflo(hq.y), bfhi(hq.y)}, h1 = {bflo(hq.z), bfhi(hq.z), bflo(hq.w), bfhi(hq.w)}, a0 = {bflo(aq.x), bfhi(aq.x), bflo(aq.y), bfhi(aq.y)}, a1 = {bflo(aq.z), bfhi(aq.z), bflo(aq.w), bfhi(aq.w)};
                const f32x4 c0 = *(const f32x4*)(CIN + (size_t)(m >> 6) * LRU_W + c), c1 = *(const f32x4*)(CIN + (size_t)(m >> 6) * LRU_W + c + 4);
                const unsigned gw_[4] = {gq.x, gq.y, gq.z, gq.w}; float o8[8];
#pragma unroll
                for (int e = 0; e < 4; ++e) { const float hA = (e < 2 ? h0[2 * e] : h1[2 * e - 4]) + (e < 2 ? a0[2 * e] : a1[2 * e - 4]) * (e < 2 ? c0[2 * e] : c1[2 * e - 4]);
                    const float hB = (e < 2 ? h0[2 * e + 1] : h1[2 * e - 3]) + (e < 2 ? a0[2 * e + 1] : a1[2 * e - 3]) * (e < 2 ? c0[2 * e + 1] : c1[2 * e - 3]);
                    o8[2 * e] = hA * gelu_tanh(bflo(gw_[e])); o8[2 * e + 1] = hB * gelu_tanh(bfhi(gw_[e])); }
                *(u32x2*)((unsigned char*)CAT + (size_t)m * D + c) = (u32x2){pk4_f8(o8[0] * F8_SACT, o8[1] * F8_SACT, o8[2] * F8_SACT, o8[3] * F8_SACT), pk4_f8(o8[4] * F8_SACT, o8[5] * F8_SACT, o8[6] * F8_SACT, o8[7] * F8_SACT)}; } }
        const bf16_t* GG = (const bf16_t*)(ws + WS_GG); const bf16_t* XS = (const bf16_t*)(ws + WS_XS); const float* HH = (const float*)(ws + WS_HH);
        const bf16_t* V16 = (const bf16_t*)(ws + WS_V16); const bf16_t* LOUTG = (const bf16_t*)(ws + WS_LOUT) + 2048;
        const float* gng = args.in[I_GNG]; const float* gnb = args.in[I_GNB];
        const int r = lane & 31, hh = lane >> 5;
        constexpr int YS = 68;
        LAS float* yt = (LAS float*)(lds + wave * (64 * YS * 4));
        for (int u = gw; u < NUNIT; u += NGW) {
            const int cch = u & 63, head = (u >> 6) & 15, b = u >> 10; const size_t tok0 = (size_t)b * SEQ + cch * 64;
            f32x16 acc[2][2];
#pragma unroll
            for (int i = 0; i < 2; ++i)
#pragma unroll
                for (int vh = 0; vh < 2; ++vh)
#pragma unroll
                    for (int e = 0; e < 16; e += 2) { const unsigned w_ = ((const unsigned*)HH)[(size_t)u * 2048 + ((i * 2 + vh) * 64 + lane) * 8 + (e >> 1)]; acc[i][vh][e] = bflo(w_); acc[i][vh][e + 1] = bfhi(w_); }
#pragma unroll
            for (int q = 0; q < 2; ++q)
#pragma unroll
                for (int s = 0; s < 2; ++s) { bf16x8 xb[2], ga[2];
#pragma unroll
                    for (int vh = 0; vh < 2; ++vh) xb[vh] = *(const bf16x8*)(XS + (size_t)u * 4096 + (((vh * 2 + q) * 2 + s) * 64 + lane) * 8);
#pragma unroll
                    for (int i = 0; i < 2; ++i) ga[i] = *(const bf16x8*)(GG + (size_t)u * 4096 + (((i * 2 + q) * 2 + s) * 64 + lane) * 8);
#pragma unroll
                    for (int i = 0; i < 2; ++i)
#pragma unroll
                        for (int vh = 0; vh < 2; ++vh) acc[i][vh] = MFMA32(ga[i], xb[vh], acc[i][vh]); }
#pragma unroll
            for (int i = 0; i < 2; ++i)
#pragma unroll
                for (int e = 0; e < 16; ++e) {
                    const float s1 = half_sum(acc[i][0][e] + acc[i][1][e], hh);
                    const float mean = s1 * (1.f / 64.f);
                    const float d0 = acc[i][0][e] - mean, d1 = acc[i][1][e] - mean; const float s2 = half_sum(d0 * d0 + d1 * d1, hh);
                    const float rstd = __builtin_amdgcn_rsqf(s2 * (1.f / 64.f) + GN_EPS);
                    const int t = 32 * i + crow(e, hh);
                    yt[t * YS + r] = d0 * rstd; yt[t * YS + 32 + r] = d1 * rstd; }
            asm volatile("s_waitcnt lgkmcnt(0)" ::: "memory");
            { const int tq = lane >> 3, c8 = (lane & 7) * 8, ch = head * HS + c8;
                const f32x4 g0 = *(const f32x4*)(gng + ch), g1 = *(const f32x4*)(gng + ch + 4), b0 = *(const f32x4*)(gnb + ch), b1 = *(const f32x4*)(gnb + ch + 4);
#pragma unroll 2
                for (int k = 0; k < 8; ++k) { const int t = tq + 8 * k; const size_t tok = tok0 + t; const size_t o = tok * RW_W + ch;
                    const f32x4 y0 = *(const LAS f32x4*)(yt + t * YS + c8), y1 = *(const LAS f32x4*)(yt + t * YS + c8 + 4);
                    const u32x4 vq = *(const u32x4*)(V16 + o), gq = *(const u32x4*)(LOUTG + tok * 3072 + ch); const float bon = BON[tok * NHEAD + head];
                    const unsigned vw[4] = {vq.x, vq.y, vq.z, vq.w}, gw4[4] = {gq.x, gq.y, gq.z, gq.w}; float o8[8];
#pragma unroll
                    for (int e = 0; e < 4; ++e) { const float ya = (e < 2 ? y0[2 * e] : y1[2 * e - 4]), yb = (e < 2 ? y0[2 * e + 1] : y1[2 * e - 3]);
                        const float ga_ = (e < 2 ? g0[2 * e] : g1[2 * e - 4]), gb_ = (e < 2 ? g0[2 * e + 1] : g1[2 * e - 3]), ba_ = (e < 2 ? b0[2 * e] : b1[2 * e - 4]), bb_ = (e < 2 ? b0[2 * e + 1] : b1[2 * e - 3]);
                        o8[2 * e] = (ya * ga_ + ba_ + bon * bflo(vw[e])) * bflo(gw4[e]); o8[2 * e + 1] = (yb * gb_ + bb_ + bon * bfhi(vw[e])) * bfhi(gw4[e]); }
                    *(u32x2*)((unsigned char*)CAT + tok * D + LRU_W + ch) = (u32x2){pk4_f8(o8[0] * F8_SACT, o8[1] * F8_SACT, o8[2] * F8_SACT, o8[3] * F8_SACT), pk4_f8(o8[4] * F8_SACT, o8[5] * F8_SACT, o8[6] * F8_SACT, o8[7] * F8_SACT)}; } }
            asm volatile("s_waitcnt lgkmcnt(0)" ::: "memory");
        }
    }
    SEAM(6);

    if (IN(7)) REP(7) {
        LANE_TID();
        pg8::StaticOrder S; S.init(M, D, G, bid); S.nt = KD / 128;
        pg8::EpiResBf16 E{(bf16_t*)Z, XN, DN_ALPHA, 1.f / (F8_SACT * F8_SW1)};
        pg8::gemm_phase<pg8::EpiResBf16, pg8::StaticOrder, pg8::DenseRows, true, KD / 2, KD / 2, true>(lds, (const bf16_t*)CAT, (const bf16_t*)WoT, S, E, pg8::DenseRows{}, wave);
    }
    SEAM(7);

    if (IN(8)) {
        LANE_TID();
        constexpr int RSH = 4112;
        constexpr int L_LO = 16 * RSH, L_PART = 2 * 16 * RSH, L_G1 = L_PART + 16384, L_CNT = L_G1 + 8192, L_BASE = L_CNT + 128, L_PICK = L_BASE + 128;
        const float* g1 = args.in[I_LN1G]; const float* b1 = args.in[I_LN1B]; const float* br_ = args.in[I_BROUTER];
        const bf16_t* WRH = (const bf16_t*)(ws + WS_WRT); const bf16_t* WRL = WRH + NE * D;
        ((LAS f32x4*)(lds + L_G1))[tid] = ((const f32x4*)g1)[tid];
        if (tid < 32) ((LAS unsigned*)(lds + L_CNT))[tid] = 0u;
        bf16x8 wq0[4][2][2], wq1[4][2][2];
#define P8_LOADW(WQ, kb_) do { _Pragma("unroll") for (int k4 = 0; k4 < 4; ++k4) { const int k0 = 32 * (8 * wave + 4 * (kb_) + k4) + 8 * (lane >> 4); \
            _Pragma("unroll") for (int hf = 0; hf < 2; ++hf) { WQ[k4][hf][0] = *(const bf16x8*)(WRH + (size_t)(hf * 16 + (lane & 15)) * D + k0); WQ[k4][hf][1] = *(const bf16x8*)(WRL + (size_t)(hf * 16 + (lane & 15)) * D + k0); } } } while (0)
        P8_LOADW(wq0, 0);
        const float bre = br_[tid & 31];
        int tl = 0;
#define P8_FLUSH() do { __syncthreads(); \
            if (tid < 32) { LAS unsigned* lc_ = (LAS unsigned*)(lds + L_CNT) + tid; const unsigned c_ = *lc_; ((LAS unsigned*)(lds + L_BASE))[tid] = c_ ? __hip_atomic_fetch_add(ctl + CW_CNT + 64 * tid, c_, RLX_AGENT) : 0u; *lc_ = 0u; } \
            __syncthreads(); \
            for (int pi = tid; pi < tl * 64; pi += NTHREADS) { const unsigned w0 = ((const LAS unsigned*)(lds + L_PICK))[2 * pi]; const float ge_ = ((const LAS float*)(lds + L_PICK))[2 * pi + 1]; \
                const int m_ = (int)(w0 & 16383u), be_ = (int)((w0 >> 14) & 31u), k_ = pi & 3; const int pos_ = (int)(((const LAS unsigned*)(lds + L_BASE))[be_] + (w0 >> 19)); \
                TOPE[m_ * 4 + k_] = be_; TOPP[m_ * 4 + k_] = pos_; SLOTTOK[be_ * LIST_CAP + pos_] = m_; SLOTG[be_ * LIST_CAP + pos_] = ge_; } \
            tl = 0; } while (0)
        for (int tile = bid; tile < M / 16; tile += G) {
            const int t0 = tile * 16;
            __syncthreads();
            { u32x2 zq[2][8];
                f32x4 bq[8];
#pragma unroll
                for (int j = 0; j < 8; ++j) bq[j] = ((const f32x4*)b1)[64 * j + lane];
#pragma unroll
                for (int rr = 0; rr < 2; ++rr) { const u32x2* zr = (const u32x2*)((const bf16_t*)Z + (size_t)(t0 + wave * 2 + rr) * D) + lane;
#pragma unroll
                    for (int j = 0; j < 8; ++j) zq[rr][j] = zr[64 * j]; }
#pragma unroll
                for (int rr = 0; rr < 2; ++rr) { const int tb = wave * 2 + rr, m = t0 + tb; float s = 0.f; f32x4 vv[8];
#pragma unroll
                    for (int j = 0; j < 8; ++j) { vv[j] = (f32x4){bflo(zq[rr][j].x), bfhi(zq[rr][j].x), bflo(zq[rr][j].y), bfhi(zq[rr][j].y)}; s += (vv[j][0] + vv[j][1]) + (vv[j][2] + vv[j][3]); }
                    const float mean = wave_sum(s) * (1.f / D); float s2 = 0.f;
#pragma unroll
                    for (int j = 0; j < 8; ++j) { vv[j] = vv[j] - mean; s2 += (vv[j][0] * vv[j][0] + vv[j][1] * vv[j][1]) + (vv[j][2] * vv[j][2] + vv[j][3] * vv[j][3]); }
                    const float rstd = __builtin_amdgcn_rsqf(wave_sum(s2) * (1.f / D) + LN_EPS);
                    u32x2* ho = (u32x2*)((bf16_t*)H1 + (size_t)m * D) + lane; unsigned* hb = (unsigned*)(H1F + (size_t)m * D) + lane;
#pragma unroll
                    for (int j = 0; j < 8; ++j) { const f32x4 y = vv[j] * rstd * ((const LAS f32x4*)(lds + L_G1))[64 * j + lane] + bq[j];
                        const u32x2 hi = {cvt2(y[0], y[1]), cvt2(y[2], y[3])};
                        const u32x2 lo = {cvt2(y[0] - bflo(hi.x), y[1] - bfhi(hi.x)), cvt2(y[2] - bflo(hi.y), y[3] - bfhi(hi.y))};
                        ho[64 * j] = hi; hb[64 * j] = pk4_f8(y[0] * F8_SH, y[1] * F8_SH, y[2] * F8_SH, y[3] * F8_SH);
                        *(LAS u32x2*)(lds + tb * RSH + 512 * j + 8 * lane) = hi; *(LAS u32x2*)(lds + L_LO + tb * RSH + 512 * j + 8 * lane) = lo; } } }
            P8_LOADW(wq1, 1);
            __syncthreads();
            { const int c16 = lane & 15, q4 = lane >> 4; f32x4 acc[2] = {{0.f, 0.f, 0.f, 0.f}, {0.f, 0.f, 0.f, 0.f}};
#define P8_MMA(WQ, kb_) do { _Pragma("unroll") for (int k4 = 0; k4 < 4; ++k4) { const int k0 = 32 * (8 * wave + 4 * (kb_) + k4) + 8 * q4; \
                    const bf16x8 hh = *(const LAS bf16x8*)(lds + c16 * RSH + k0 * 2), hl = *(const LAS bf16x8*)(lds + L_LO + c16 * RSH + k0 * 2); \
                    _Pragma("unroll") for (int hf = 0; hf < 2; ++hf) { const bf16x8 wh = WQ[k4][hf][0], wl = WQ[k4][hf][1]; \
                        acc[hf] = __builtin_amdgcn_mfma_f32_16x16x32_bf16(wh, hh, acc[hf], 0, 0, 0); acc[hf] = __builtin_amdgcn_mfma_f32_16x16x32_bf16(wl, hh, acc[hf], 0, 0, 0); \
                        acc[hf] = __builtin_amdgcn_mfma_f32_16x16x32_bf16(wh, hl, acc[hf], 0, 0, 0); } } } while (0)
                P8_MMA(wq0, 0); P8_MMA(wq1, 1);
#undef P8_MMA
#pragma unroll
                for (int hf = 0; hf < 2; ++hf)
#pragma unroll
                    for (int g = 0; g < 4; ++g) ((LAS float*)(lds + L_PART))[((wave * 2 + hf) * 4 + g) * 64 + lane] = acc[hf][g]; }
            __syncthreads();
            { const int tk = tid >> 5, e = tid & 31, hf = e >> 4, el = e & 15; float sacc = bre;
#pragma unroll
                for (int w = 0; w < 8; ++w) sacc += ((const LAS float*)(lds + L_PART))[((w * 2 + hf) * 4 + (el & 3)) * 64 + tk + 16 * (el >> 2)];
                const int m = t0 + tk; float bv[4]; int bi[4]; bool used = false;
#pragma unroll
                for (int k = 0; k < 4; ++k) { float v = used ? -3.0e38f : sacc; int idx = e;
#pragma unroll
                    for (int off = 16; off >= 1; off >>= 1) { const float ov = __shfl_xor(v, off); const int oi = __shfl_xor(idx, off); const bool take = (ov > v) || (ov == v && oi < idx); v = take ? ov : v; idx = take ? oi : idx; }
                    bv[k] = v; bi[k] = idx; used = used || (idx == e); }
                float ex[4], den = 0.f;
#pragma unroll
                for (int k = 0; k < 4; ++k) { ex[k] = __expf(bv[k] - bv[0]); den += ex[k]; }
                if (e < 4) {
                    const int be = (e == 0) ? bi[0] : (e == 1) ? bi[1] : (e == 2) ? bi[2] : bi[3]; const float ge = ((e == 0) ? ex[0] : (e == 1) ? ex[1] : (e == 2) ? ex[2] : ex[3]) / den;
                    const unsigned lr = __hip_atomic_fetch_add((LAS unsigned*)(lds + L_CNT) + be, 1u, __ATOMIC_RELAXED, __HIP_MEMORY_SCOPE_WORKGROUP);
                    const int pi = tl * 64 + tk * 4 + e;
                    ((LAS unsigned*)(lds + L_PICK))[2 * pi] = (unsigned)m | ((unsigned)be << 14) | (lr << 19); ((LAS float*)(lds + L_PICK))[2 * pi + 1] = ge; } }
            if (++tl == 4) P8_FLUSH();
        }
        if (tl > 0) P8_FLUSH();
#undef P8_FLUSH
#undef P8_LOADW
    }
    SEAM(8);

    if (IN(9)) REP(9) {
        LANE_TID();
        volatile LAS int* tb = (volatile LAS int*)(MISC + 16);
        moe_tables(tb, ctl, wave);
        pg8::MoeOrder S{(const LAS int*)(tb + 64), (const LAS int*)(tb + 1), tb[0], 16, G, bid, KD / 128};
        pg8::EpiSwiglu E{ACT, args.in[I_BE1]};
        pg8::gemm_phase<pg8::EpiSwiglu, pg8::MoeOrder, pg8::GatherRows, true, KD / 2, KD / 2, true>(lds, (const bf16_t*)H1F, (const bf16_t*)W1F, S, E, pg8::GatherRows{SLOTTOK}, wave);
    }
    SEAM(9);

    if (IN(10)) REP(10) {
        LANE_TID();
        volatile LAS int* tb = (volatile LAS int*)(MISC + 16);
        moe_tables(tb, ctl, wave);
        pg8::MoeOrder S{(const LAS int*)(tb + 64), (const LAS int*)(tb + 1), tb[0], 8, G, bid, KD / 128};
        pg8::EpiMoeOut E{OUTS, args.in[I_BE2], SLOTG};
        pg8::gemm_phase<pg8::EpiMoeOut, pg8::MoeOrder, pg8::DenseRows, true, KD / 2, KD / 2, true>(lds, (const bf16_t*)ACT, (const bf16_t*)W2F, S, E, pg8::DenseRows{}, wave);
    }
    SEAM(10);

    if (IN(11)) REP(11) {
        LANE_TID();
        const float* g2 = args.in[I_LN2G]; const float* b2 = args.in[I_LN2B];
        volatile LAS int* tb = (volatile LAS int*)(MISC + 16);
        moe_tables(tb, ctl, wave);
        for (int m = gw; m < M; m += NGW) {
            const u32x2* hr = (const u32x2*)((const bf16_t*)H1 + (size_t)m * D) + lane;
            const int e0 = TOPE[m * 4], e1 = TOPE[m * 4 + 1], e2 = TOPE[m * 4 + 2], e3 = TOPE[m * 4 + 3], p0 = TOPP[m * 4], p1 = TOPP[m * 4 + 1], p2 = TOPP[m * 4 + 2], p3 = TOPP[m * 4 + 3];
            const int s0 = tb[1 + e0] * 256 + p0, s1 = tb[1 + e1] * 256 + p1, s2_ = tb[1 + e2] * 256 + p2, s3 = tb[1 + e3] * 256 + p3;
            const float w0 = SLOTG[e0 * LIST_CAP + p0], w1 = SLOTG[e1 * LIST_CAP + p1], w2 = SLOTG[e2 * LIST_CAP + p2], w3 = SLOTG[e3 * LIST_CAP + p3];
            const u32x2* o0 = (const u32x2*)(OUTS + (size_t)s0 * D) + lane; const u32x2* o1 = (const u32x2*)(OUTS + (size_t)s1 * D) + lane;
            const u32x2* o2 = (const u32x2*)(OUTS + (size_t)s2_ * D) + lane; const u32x2* o3 = (const u32x2*)(OUTS + (size_t)s3 * D) + lane;
            f32x4 v[8]; float s = 0.f;
#pragma unroll
            for (int j = 0; j < 8; ++j) { const u32x2 hq = hr[64 * j]; const f32x4 h4 = {bflo(hq.x), bfhi(hq.x), bflo(hq.y), bfhi(hq.y)}; const u32x2 a = o0[64 * j], b = o1[64 * j], c = o2[64 * j], d = o3[64 * j];
                f32x4 mo; mo[0] = (w0 * bflo(a.x) + w1 * bflo(b.x)) + (w2 * bflo(c.x) + w3 * bflo(d.x)); mo[1] = (w0 * bfhi(a.x) + w1 * bfhi(b.x)) + (w2 * bfhi(c.x) + w3 * bfhi(d.x));
                mo[2] = (w0 * bflo(a.y) + w1 * bflo(b.y)) + (w2 * bflo(c.y) + w3 * bflo(d.y)); mo[3] = (w0 * bfhi(a.y) + w1 * bfhi(b.y)) + (w2 * bfhi(c.y) + w3 * bfhi(d.y));
                v[j] = h4 * DN_ALPHA + mo; s += (v[j][0] + v[j][1]) + (v[j][2] + v[j][3]); }
            const float mean = wave_sum(s) * (1.f / D); float q2 = 0.f;
#pragma unroll
            for (int j = 0; j < 8; ++j) { v[j] = v[j] - mean; q2 += (v[j][0] * v[j][0] + v[j][1] * v[j][1]) + (v[j][2] * v[j][2] + v[j][3] * v[j][3]); }
            const float rstd = 1.f / sqrtf(wave_sum(q2) * (1.f / D) + LN_EPS);
            f32x4* orow = (f32x4*)(args.out + (size_t)m * D) + lane;
#pragma unroll
            for (int j = 0; j < 8; ++j) { const f32x4 g4 = ((const f32x4*)g2)[64 * j + lane], b4 = ((const f32x4*)b2)[64 * j + lane]; orow[64 * j] = v[j] * rstd * g4 + b4; }
        }
    }
    if (PROBE_PHASE >= 0) { if (PROBE_PHASE == NPHASE - 1) tprobe1 = __builtin_amdgcn_s_memrealtime();
        asm volatile("s_waitcnt vmcnt(0)" ::: "memory"); __syncthreads();
        if (bid == 0 && wave == 0 && lane_now() == 0) args.out[0] += 1.0f + (float)(tprobe1 - tprobe0) * 1e-4f; }
#undef IN
#undef SEAM
}

#ifndef MK_ONE_LAUNCH
#define MK_ONE_LAUNCH 1
#endif
extern "C" void kernel_launch(void* const* d_in, const int* in_sizes, int n_in, void* d_out, int out_size, void* d_ws, size_t ws_size, hipStream_t stream) {
    static int grid = 0;
    if (grid == 0) {
        if (n_in != 33 || out_size != M * D || ws_size < WS_END) { fprintf(stderr, "kernel_launch: unexpected sizes n_in %d out %d ws %zu (need %zu)\n", n_in, out_size, ws_size, (size_t)WS_END); grid = -1; return; }
        int dev = 0, cus = 0, per_cu = 0;
        if (hipGetDevice(&dev) != hipSuccess || hipDeviceGetAttribute(&cus, hipDeviceAttributeMultiprocessorCount, dev) != hipSuccess) { grid = -1; return; }
        if (hipFuncSetAttribute((const void*)fwd, hipFuncAttributeMaxDynamicSharedMemorySize, LDS_BYTES) != hipSuccess) { fprintf(stderr, "kernel_launch: hipFuncSetAttribute failed\n"); grid = -1; return; }
        if (hipOccupancyMaxActiveBlocksPerMultiprocessor(&per_cu, (const void*)fwd, NTHREADS, LDS_BYTES) != hipSuccess || per_cu < 1) fprintf(stderr, "kernel_launch: occupancy query says %d\n", per_cu);
        (void)hipGetLastError();
        grid = cus;
    }
    if (grid < 0) return;
    (void)hipMemsetAsync((char*)d_ws + WS_CTL, 0, CTL_ZERO_BYTES, stream);
    Args a{};
    for (int i = 0; i < 33; ++i) a.in[i] = (const float*)d_in[i];
    a.out = (float*)d_out; a.ws = (unsigned char*)d_ws;
#if MK_ONE_LAUNCH
    a.ph_lo = 0; a.ph_hi = NPHASE; a.use_bar = 1;
    hipLaunchKernelGGL(fwd, dim3(grid), dim3(NTHREADS), LDS_BYTES, stream, a);
#else
    for (int p = 0; p < NPHASE; ++p) { a.ph_lo = p; a.ph_hi = p + 1; a.use_bar = 0;
        hipLaunchKernelGGL(fwd, dim3(grid), dim3(NTHREADS), LDS_BYTES, stream, a); }
#endif
}
```
